# Optimizing an MI355X kernel written in HIP

```python
import jax, jax.numpy as jnp
from jax import lax
import numpy as np

D_MODEL = 1024
BATCH = 4
SEQ = 4096
DEPTH = 4

GRID_W = 64
CTX_LEN = 256
N_MIXERS = 3
Q_BLOCK = 128
ROPE_THETA = 10000.0
NORM_EPS = 1e-6
N_MOD = 6
MLA_HEADS = 8
MLA_Q_LORA = 512
MLA_KV_LORA = 256
MLA_NOPE = 128
MLA_ROPE = 64
MLA_V = 128
CONV_WIDTH = 3
CONV_DIM = D_MODEL
GQA_HEADS = 16
GQA_KV_HEADS = 8
GQA_HEAD_DIM = 128
MOE_GROUPS = 4
MOE_EXPERTS_PER_GROUP = 8
MOE_EXPERTS = MOE_GROUPS * MOE_EXPERTS_PER_GROUP
MOE_TOP_K = 2
MOE_FF = 512
MOE_BLOCK = 128

kernel_name = "hybrid_mla_conv_gqa_hier_moe_dit"


def _n_layers_of(kind):
    return len(range(kind, DEPTH, N_MIXERS))


def _rmsnorm(x, g):
    xf = x.astype(jnp.float32)
    y = xf * lax.rsqrt(jnp.mean(xf * xf, axis=-1, keepdims=True) + NORM_EPS)
    return (y * g.astype(jnp.float32)).astype(x.dtype)


def _modulate(x, g, shift, scale):
    return _rmsnorm(x, g) * (1 + scale) + shift


def _rope_1d(x, pos):
    half = x.shape[-1] // 2
    inv_freq = ROPE_THETA ** (-jnp.arange(half, dtype=jnp.float32) / half)
    ang = pos.astype(jnp.float32)[:, None] * inv_freq[None, :]
    cos, sin = jnp.cos(ang)[:, None, :], jnp.sin(ang)[:, None, :]
    xf = x.astype(jnp.float32)
    x1, x2 = xf[..., :half], xf[..., half:]
    return jnp.concatenate([x1 * cos - x2 * sin, x1 * sin + x2 * cos], axis=-1).astype(x.dtype)


def _axial_rope(x, rows, cols):
    half = x.shape[-1] // 2
    return jnp.concatenate([_rope_1d(x[..., :half], rows), _rope_1d(x[..., half:], cols)], axis=-1)


def _attend(q, k, v, scale):
    B, n, H, dk = q.shape
    Hk, dv = k.shape[2], v.shape[-1]
    G = H // Hk
    nb = n // Q_BLOCK
    qb = q.reshape(B, nb, Q_BLOCK, Hk, G, dk).transpose(1, 0, 2, 3, 4, 5)

    def block(qblk):
        s = jnp.einsum("bqhgd,bkhd->bhgqk", qblk, k).astype(jnp.float32) * scale
        p = jax.nn.softmax(s, axis=-1).astype(v.dtype)
        return jnp.einsum("bhgqk,bkhd->bqhgd", p, v)

    o = lax.map(block, qb)
    return o.transpose(1, 0, 2, 3, 4, 5).reshape(B, n, H * dv)


def _mla_project(a, w_dq, g_q, w_uq, w_dkv, g_kv, w_ukv, pos, want_q):
    B, n, _ = a.shape
    ckv = a @ w_dkv
    c_kv = _rmsnorm(ckv[..., :MLA_KV_LORA], g_kv)
    k_pe = ckv[..., MLA_KV_LORA:][:, :, None, :]
    kv = (c_kv @ w_ukv).reshape(B, n, MLA_HEADS, MLA_NOPE + MLA_V)
    k_nope, v = kv[..., :MLA_NOPE], kv[..., MLA_NOPE:]
    if pos is not None:
        k_pe = _axial_rope(k_pe, *pos)
    k = jnp.concatenate([k_nope, jnp.broadcast_to(k_pe, (B, n, MLA_HEADS, MLA_ROPE))], axis=-1)
    q = None
    if want_q:
        cq = _rmsnorm(a @ w_dq, g_q)
        q = (cq @ w_uq).reshape(B, n, MLA_HEADS, MLA_NOPE + MLA_ROPE)
        if pos is not None:
            q = jnp.concatenate([q[..., :MLA_NOPE], _axial_rope(q[..., MLA_NOPE:], *pos)], axis=-1)
    return q, k, v


def _mla(a_lat, a_ctx, pos, ctx_out, w_dq, g_q, w_uq, w_dkv, g_kv, w_ukv, w_o):
    scale = (MLA_NOPE + MLA_ROPE) ** -0.5
    q_l, k_l, v_l = _mla_project(a_lat, w_dq, g_q, w_uq, w_dkv, g_kv, w_ukv, pos, True)
    q_c, k_c, v_c = _mla_project(a_ctx, w_dq, g_q, w_uq, w_dkv, g_kv, w_ukv, None, ctx_out)
    k_all = jnp.concatenate([k_c, k_l], axis=1)
    v_all = jnp.concatenate([v_c, v_l], axis=1)
    y_lat = _attend(q_l, k_all, v_all, scale) @ w_o
    y_ctx = _attend(q_c, k_c, v_c, scale) @ w_o if ctx_out else None
    return y_lat, y_ctx


def _short_conv_seq(a, w_in, conv_w, w_out):
    bcu = a @ w_in
    b_gate, c_gate, u = jnp.split(bcu, 3, axis=-1)
    z = lax.conv_general_dilated(
        c_gate * u, conv_w[:, None, :], window_strides=(1,),
        padding=[((CONV_WIDTH - 1) // 2, (CONV_WIDTH - 1) // 2)],
        dimension_numbers=("NWC", "WIO", "NWC"), feature_group_count=CONV_DIM)
    return (b_gate * z) @ w_out


def _short_conv(a_lat, a_ctx, ctx_out, w_in, conv_w, w_out):
    y_lat = _short_conv_seq(a_lat, w_in, conv_w, w_out)
    y_ctx = _short_conv_seq(a_ctx, w_in, conv_w, w_out) if ctx_out else None
    return y_lat, y_ctx


def _gqa_project(a, w_qkv, q_g, k_g, pos, want_q):
    B, n, _ = a.shape
    dq = GQA_HEADS * GQA_HEAD_DIM
    dkv = GQA_KV_HEADS * GQA_HEAD_DIM
    kv = a @ w_qkv[:, dq:]
    k = _rmsnorm(kv[..., :dkv].reshape(B, n, GQA_KV_HEADS, GQA_HEAD_DIM), k_g)
    v = kv[..., dkv:].reshape(B, n, GQA_KV_HEADS, GQA_HEAD_DIM)
    if pos is not None:
        k = _axial_rope(k, *pos)
    q = None
    if want_q:
        q = _rmsnorm((a @ w_qkv[:, :dq]).reshape(B, n, GQA_HEADS, GQA_HEAD_DIM), q_g)
        if pos is not None:
            q = _axial_rope(q, *pos)
    return q, k, v


def _gqa(a_lat, a_ctx, pos, ctx_out, w_qkv, q_g, k_g, w_o):
    scale = GQA_HEAD_DIM ** -0.5
    q_l, k_l, v_l = _gqa_project(a_lat, w_qkv, q_g, k_g, pos, True)
    q_c, k_c, v_c = _gqa_project(a_ctx, w_qkv, q_g, k_g, None, ctx_out)
    k_all = jnp.concatenate([k_c, k_l], axis=1)
    v_all = jnp.concatenate([v_c, v_l], axis=1)
    y_lat = _attend(q_l, k_all, v_all, scale) @ w_o
    y_ctx = _attend(q_c, k_c, v_c, scale) @ w_o if ctx_out else None
    return y_lat, y_ctx


def _hier_moe(h, w_group, b_group, w_expert, b_expert, w_gate, w_up, w_down):
    T, D = h.shape
    hf = h.astype(jnp.float32)
    g_prob = jax.nn.softmax(hf @ w_group.astype(jnp.float32), axis=-1)
    g_sel = jnp.argmax(g_prob + b_group.astype(jnp.float32), axis=-1)
    g_w = jnp.take_along_axis(g_prob, g_sel[:, None], axis=-1)
    e_logits = (hf @ w_expert.astype(jnp.float32)).reshape(T, MOE_GROUPS, MOE_EXPERTS_PER_GROUP)
    e_prob = jax.nn.softmax(jnp.take_along_axis(e_logits, g_sel[:, None, None], axis=1)[:, 0], axis=-1)
    e_bias = b_expert.astype(jnp.float32).reshape(MOE_GROUPS, MOE_EXPERTS_PER_GROUP)[g_sel]
    _, top_idx = lax.top_k(e_prob + e_bias, MOE_TOP_K)
    top_w = jnp.take_along_axis(e_prob, top_idx, axis=-1)
    top_w = top_w / jnp.sum(top_w, axis=-1, keepdims=True) * g_w
    expert_id = g_sel[:, None] * MOE_EXPERTS_PER_GROUP + top_idx

    A = T * MOE_TOP_K
    eid = expert_id.reshape(A)
    tok = jnp.arange(A, dtype=jnp.int32) // MOE_TOP_K
    wts = top_w.reshape(A)
    order = jnp.argsort(eid)
    e_s, tok_s, w_s = eid[order], tok[order], wts[order]
    counts = jnp.bincount(eid, length=MOE_EXPERTS)
    starts = jnp.cumsum(counts) - counts
    padded = (counts + MOE_BLOCK - 1) // MOE_BLOCK * MOE_BLOCK
    pends = jnp.cumsum(padded)
    pstarts = pends - padded
    dest = pstarts[e_s] + (jnp.arange(A, dtype=jnp.int32) - starts[e_s])
    nb = -(-A // MOE_BLOCK) + MOE_EXPERTS
    xp = jnp.zeros((nb * MOE_BLOCK, D), h.dtype).at[dest].set(h[tok_s])
    blk_e = jnp.clip(jnp.searchsorted(pends, jnp.arange(nb, dtype=jnp.int32) * MOE_BLOCK, side="right"),
                     0, MOE_EXPERTS - 1)

    def expert_block(args):
        xb, e = args
        return (jax.nn.silu(xb @ w_gate[e]) * (xb @ w_up[e])) @ w_down[e]

    yp = lax.map(expert_block, (xp.reshape(nb, MOE_BLOCK, D), blk_e)).reshape(nb * MOE_BLOCK, D)
    return jax.ops.segment_sum(yp[dest] * w_s[:, None].astype(h.dtype), tok_s, num_segments=T)


def _normal(k, shape, scale):
    return jax.random.normal(k, shape, jnp.float32) * scale


def setup_inputs(seed: int = 0) -> dict:
    key = jax.random.key(seed)
    ks = iter(jax.random.split(key, 40))
    D = D_MODEL
    nA, nB, nC = _n_layers_of(0), _n_layers_of(1), _n_layers_of(2)
    dq = GQA_HEADS * GQA_HEAD_DIM
    dkv = GQA_KV_HEADS * GQA_HEAD_DIM
    return {
        "x": _normal(next(ks), (BATCH, SEQ, D), 1.0),
        "c": _normal(next(ks), (BATCH, D), 1.0),
        "ctx": _normal(next(ks), (BATCH, CTX_LEN, D), 1.0),
        "c_ctx": _normal(next(ks), (D,), 1.0),
        "w_mod": _normal(next(ks), (DEPTH, D, N_MOD * D), 0.5 * D ** -0.5),
        "b_mod": _normal(next(ks), (DEPTH, N_MOD * D), 0.02),
        "norm_mix_g": 1.0 + _normal(next(ks), (DEPTH, D), 0.05),
        "norm_ffn_g": 1.0 + _normal(next(ks), (DEPTH, D), 0.05),
        "mla_w_dq": _normal(next(ks), (nA, D, MLA_Q_LORA), D ** -0.5),
        "mla_g_q": 1.0 + _normal(next(ks), (nA, MLA_Q_LORA), 0.05),
        "mla_w_uq": _normal(next(ks), (nA, MLA_Q_LORA, MLA_HEADS * (MLA_NOPE + MLA_ROPE)), MLA_Q_LORA ** -0.5),
        "mla_w_dkv": _normal(next(ks), (nA, D, MLA_KV_LORA + MLA_ROPE), D ** -0.5),
        "mla_g_kv": 1.0 + _normal(next(ks), (nA, MLA_KV_LORA), 0.05),
        "mla_w_ukv": _normal(next(ks), (nA, MLA_KV_LORA, MLA_HEADS * (MLA_NOPE + MLA_V)), MLA_KV_LORA ** -0.5),
        "mla_w_o": _normal(next(ks), (nA, MLA_HEADS * MLA_V, D), (MLA_HEADS * MLA_V) ** -0.5),
        "conv_w_in": _normal(next(ks), (nB, D, 3 * CONV_DIM), D ** -0.5),
        "conv_w": _normal(next(ks), (nB, CONV_WIDTH, CONV_DIM), CONV_WIDTH ** -0.5),
        "conv_w_out": _normal(next(ks), (nB, CONV_DIM, D), CONV_DIM ** -0.5),
        "gqa_w_qkv": _normal(next(ks), (nC, D, dq + 2 * dkv), D ** -0.5),
        "gqa_q_norm_g": 1.0 + _normal(next(ks), (nC, GQA_HEAD_DIM), 0.05),
        "gqa_k_norm_g": 1.0 + _normal(next(ks), (nC, GQA_HEAD_DIM), 0.05),
        "gqa_w_o": _normal(next(ks), (nC, dq, D), dq ** -0.5),
        "moe_w_group": _normal(next(ks), (DEPTH, D, MOE_GROUPS), D ** -0.5),
        "moe_b_group": _normal(next(ks), (DEPTH, MOE_GROUPS), 0.01),
        "moe_w_expert": _normal(next(ks), (DEPTH, D, MOE_EXPERTS), D ** -0.5),
        "moe_b_expert": _normal(next(ks), (DEPTH, MOE_EXPERTS), 0.01),
        "moe_w_gate": _normal(next(ks), (DEPTH, MOE_EXPERTS, D, MOE_FF), D ** -0.5),
        "moe_w_up": _normal(next(ks), (DEPTH, MOE_EXPERTS, D, MOE_FF), D ** -0.5),
        "moe_w_down": _normal(next(ks), (DEPTH, MOE_EXPERTS, MOE_FF, D), MOE_FF ** -0.5),
        "final_norm_g": 1.0 + _normal(next(ks), (D,), 0.05),
    }


def reference(x, c, ctx, c_ctx, w_mod, b_mod, norm_mix_g, norm_ffn_g,
              mla_w_dq, mla_g_q, mla_w_uq, mla_w_dkv, mla_g_kv, mla_w_ukv, mla_w_o,
              conv_w_in, conv_w, conv_w_out,
              gqa_w_qkv, gqa_q_norm_g, gqa_k_norm_g, gqa_w_o,
              moe_w_group, moe_b_group, moe_w_expert, moe_b_expert, moe_w_gate, moe_w_up, moe_w_down,
              final_norm_g):
    B, S, D = x.shape
    L = ctx.shape[1]
    ROWS = S // GRID_W
    rows = jnp.repeat(jnp.arange(ROWS, dtype=jnp.int32), GRID_W)
    cols = jnp.tile(jnp.arange(GRID_W, dtype=jnp.int32), ROWS)
    pos = (rows, cols)
    cond_lat = jax.nn.silu(c)
    cond_ctx = jax.nn.silu(c_ctx)[None]
    h = ctx
    for i in range(DEPTH):
        kind, j = i % N_MIXERS, i // N_MIXERS
        ctx_out = i < DEPTH - 1
        mod_l = (cond_lat @ w_mod[i] + b_mod[i])[:, None, :]
        mod_c = (cond_ctx @ w_mod[i] + b_mod[i])[:, None, :]
        sh1, sc1, g1, sh2, sc2, g2 = jnp.split(mod_l, N_MOD, axis=-1)
        csh1, csc1, cg1, csh2, csc2, cg2 = jnp.split(mod_c, N_MOD, axis=-1)
        a_lat = _modulate(x, norm_mix_g[i], sh1, sc1)
        a_ctx = _modulate(h, norm_mix_g[i], csh1, csc1)
        if kind == 0:
            y_lat, y_ctx = _mla(a_lat, a_ctx, pos, ctx_out, mla_w_dq[j], mla_g_q[j], mla_w_uq[j],
                                mla_w_dkv[j], mla_g_kv[j], mla_w_ukv[j], mla_w_o[j])
        elif kind == 1:
            y_lat, y_ctx = _short_conv(a_lat, a_ctx, ctx_out, conv_w_in[j], conv_w[j], conv_w_out[j])
        else:
            y_lat, y_ctx = _gqa(a_lat, a_ctx, pos, ctx_out, gqa_w_qkv[j], gqa_q_norm_g[j],
                                gqa_k_norm_g[j], gqa_w_o[j])
        x = x + g1 * y_lat
        f_lat = _modulate(x, norm_ffn_g[i], sh2, sc2)
        moe_args = (moe_w_group[i], moe_b_group[i], moe_w_expert[i], moe_b_expert[i],
                    moe_w_gate[i], moe_w_up[i], moe_w_down[i])
        if ctx_out:
            h = h + cg1 * y_ctx
            f_ctx = _modulate(h, norm_ffn_g[i], csh2, csc2)
            tokens = jnp.concatenate([f_lat.reshape(B * S, D), f_ctx.reshape(B * L, D)], axis=0)
            y = _hier_moe(tokens, *moe_args)
            x = x + g2 * y[:B * S].reshape(B, S, D)
            h = h + cg2 * y[B * S:].reshape(B, L, D)
        else:
            y = _hier_moe(f_lat.reshape(B * S, D), *moe_args)
            x = x + g2 * y.reshape(B, S, D)
    return _rmsnorm(x, final_norm_g)
```

```cpp
#include <hip/hip_runtime.h>
#include <hip/hip_cooperative_groups.h>
#include <cstdio>
#include <cstdint>
namespace cg = cooperative_groups;

#define SANITIZE 1
#ifndef DBG_PROBE
#define DBG_PROBE 0
#endif
#ifndef STOP_AFTER
#define STOP_AFTER 8
#endif

#define LAS __attribute__((address_space(3)))
typedef unsigned short bf16_t;
typedef short bf16x8 __attribute__((ext_vector_type(8)));
typedef short s16x4 __attribute__((ext_vector_type(4)));
typedef float f32x4 __attribute__((ext_vector_type(4)));
typedef float f32x16 __attribute__((ext_vector_type(16)));
typedef unsigned u32x4 __attribute__((ext_vector_type(4)));
typedef unsigned u32x2 __attribute__((ext_vector_type(2)));

constexpr int D = 1024, NB = 4, SEQ = 4096, CTX = 256, RPB = SEQ + CTX, R = NB * RPB;
constexpr int DEPTH = 4, NMOD = 6 * D;
constexpr int MLA_H = 8, QL = 512, KVL = 256, NOPE = 128, ROPE = 64, MV = 128;
constexpr int GH = 16, GKV = 8, GD = 128;
constexpr int ME = 32, FF = 512;
constexpr float EPS = 1e-6f;
constexpr int NTHR = 512;

enum { I_X = 0, I_C, I_CTX, I_CCTX, I_WMOD, I_BMOD, I_NMG, I_NFG, I_MLA_WDQ, I_MLA_GQ, I_MLA_WUQ, I_MLA_WDKV, I_MLA_GKV, I_MLA_WUKV, I_MLA_WO,
       I_CONV_WIN, I_CONV_W, I_CONV_WOUT, I_GQA_WQKV, I_GQA_QG, I_GQA_KG, I_GQA_WO, I_MOE_WG, I_MOE_BG, I_MOE_WE, I_MOE_BE, I_MOE_GATE, I_MOE_UP, I_MOE_DOWN, I_FG, N_IN };

constexpr size_t al256(size_t x) { return (x + 255) / 256 * 256; }
constexpr size_t WS_CNT = 0;
constexpr size_t WS_MODP = 4096;
constexpr size_t WS_MODV = WS_MODP + (size_t)8 * 4 * 5 * NMOD * 4;
constexpr size_t WS_WTS = WS_MODV + (size_t)4 * 5 * NMOD * 4;
constexpr size_t WS_LIST = al256(WS_WTS + (size_t)2 * R * 4);
constexpr size_t WS_X32 = al256(WS_LIST + (size_t)32 * R * 4);
constexpr size_t WS_ACT = WS_X32 + (size_t)R * D * 4;
constexpr size_t WS_HID = WS_ACT + (size_t)R * D * 2;
constexpr size_t WS_Y = WS_HID + (size_t)(2 * R + 256) * FF * 2;
constexpr size_t WS_MIX = WS_Y + (size_t)2 * R * D * 2;
constexpr size_t MIX_BYTES = (size_t)R * (896 * 4 + 512 * 2 + 256 * 2 + 64 * 2 + 1536 * 2 + 2048 * 2 + 1024 * 2);
constexpr size_t WS_C1 = WS_MIX;
constexpr size_t WS_CQ = WS_C1 + (size_t)R * 896 * 4;
constexpr size_t WS_CKV = WS_CQ + (size_t)R * 512 * 2;
constexpr size_t WS_KPE = WS_CKV + (size_t)R * 256 * 2;
constexpr size_t WS_Q = WS_KPE + (size_t)R * 64 * 2;
constexpr size_t WS_KV = WS_Q + (size_t)R * 1536 * 2;
constexpr size_t WS_O = WS_KV + (size_t)R * 2048 * 2;
constexpr size_t WS_QKV = WS_MIX;
constexpr size_t WS_KN = WS_QKV + (size_t)R * 4096 * 2;
constexpr size_t WS_OG = WS_KN + (size_t)R * 1024 * 2;
constexpr size_t WS_BCU = WS_MIX;
constexpr size_t WS_G = WS_BCU + (size_t)R * 3072 * 2;
static_assert(WS_OG + (size_t)R * 2048 * 2 <= WS_MIX + MIX_BYTES, "gqa scratch");
static_assert(WS_G + (size_t)R * 1024 * 2 <= WS_MIX + MIX_BYTES, "conv scratch");
constexpr size_t WS_WT = al256(WS_MIX + MIX_BYTES);
constexpr size_t MLA_W1T = 0, MLA_WUQT = MLA_W1T + (size_t)896 * 1024 * 2, MLA_WUKVT = MLA_WUQT + (size_t)1536 * 512 * 2, MLA_WOT = MLA_WUKVT + (size_t)2048 * 256 * 2,
                 MLA_WBYTES = MLA_WOT + (size_t)1024 * 1024 * 2;
constexpr size_t WS_WMLA = WS_WT;
constexpr size_t WS_WCONV_IN = WS_WMLA + 2 * MLA_WBYTES;
constexpr size_t WS_WCONV_OUT = WS_WCONV_IN + (size_t)3072 * 1024 * 2;
constexpr size_t WS_WGQA_QKV = WS_WCONV_OUT + (size_t)1024 * 1024 * 2;
constexpr size_t WS_WGQA_O = WS_WGQA_QKV + (size_t)4096 * 1024 * 2;
constexpr size_t WS_WMOE = WS_WGQA_O + (size_t)1024 * 2048 * 2;
constexpr size_t MOE_WBYTES = (size_t)1024 * 1024 * 2 + (size_t)1024 * 512 * 2;
constexpr size_t WS_END = WS_WMOE + (size_t)DEPTH * ME * MOE_WBYTES;
static_assert(WS_END <= (size_t)1073741824, "workspace over 1 GiB");

struct TJob { const float* src; bf16_t* dst; int K, N, rmul, roff; };
struct Params {
  const float* in[N_IN];
  float* out;
  char* ws;
  TJob jobs[14];
};

typedef __bf16 bf16x2_t __attribute__((ext_vector_type(2)));
__device__ __forceinline__ unsigned cvtpk(float lo, float hi) { bf16x2_t v = {(__bf16)lo, (__bf16)hi}; return __builtin_bit_cast(unsigned, v); }
__device__ __forceinline__ float bf2f(unsigned short h) { return __uint_as_float((unsigned)h << 16); }
__device__ __forceinline__ float bflo(unsigned w) { return __uint_as_float(w << 16); }
__device__ __forceinline__ float bfhi(unsigned w) { return __uint_as_float(w & 0xffff0000u); }
__device__ __forceinline__ float wave_sum(float v) {
#pragma unroll
  for (int o = 32; o > 0; o >>= 1) v += __shfl_xor(v, o);
  return v;
}
__device__ __forceinline__ float silu_f(float x) { return x / (1.0f + __expf(-x)); }
__device__ __forceinline__ void glds16(const void* g, char* l) { __builtin_amdgcn_global_load_lds((const unsigned*)g, (LAS unsigned*)l, 16, 0, 0); }
__device__ __forceinline__ char* opaque_ptr(char* q) {
  unsigned lo = __builtin_amdgcn_readfirstlane((unsigned)(uintptr_t)q), hi = __builtin_amdgcn_readfirstlane((unsigned)((uintptr_t)q >> 32));
  asm volatile("" : "+s"(lo), "+s"(hi));
  return (char*)(((uintptr_t)hi << 32) | (uintptr_t)lo); }
__device__ __forceinline__ float rope_invf(int j, int half) { return exp2f(-(float)j * (13.287712379549449f / (float)half)); }

template <int WM, int WN> struct GemmCfg { static constexpr int BM = WM * 64, BN = WN * 64, A_BYTES = BM * 128, STAGE = (BM + BN) * 128; };

template <int WM, int WN, class ARow, class Epi>
__device__ __forceinline__ void gemm_tile(const ARow& arow, const bf16_t* __restrict__ Bt, int ldb, int K, char* lds, const Epi& epi) {
  constexpr int BM = WM * 64, BN = WN * 64, A_BYTES = BM * 128, STAGE = (BM + BN) * 128;
  int tid = threadIdx.x; asm volatile("" : "+v"(tid));
  const int wid = tid >> 6, lane = tid & 63, fr = lane & 15, fq = lane >> 4;
  const int wm = wid / WN, wn = wid % WN;
  const int srow = tid >> 3, pc = tid & 7, lc = pc ^ (srow & 7);
  const bf16_t* ap[BM / 64]; const bf16_t* bp[BN / 64];
#pragma unroll
  for (int i = 0; i < BM / 64; ++i) ap[i] = arow(srow + 64 * i) + lc * 8;
#pragma unroll
  for (int i = 0; i < BN / 64; ++i) bp[i] = Bt + (size_t)(srow + 64 * i) * ldb + lc * 8;
  const int a_off = (wm * 64 + fr) * 128, b_off = A_BYTES + (wn * 64 + fr) * 128;
  const int ch0 = ((fq) ^ (fr & 7)) * 16, ch1 = ((4 + fq) ^ (fr & 7)) * 16;
  f32x4 acc[4][4];
#pragma unroll
  for (int m = 0; m < 4; ++m)
#pragma unroll
    for (int n = 0; n < 4; ++n) acc[m][n] = (f32x4){0.f, 0.f, 0.f, 0.f};
  const int nk = K >> 6;
  {
    char* base = lds;
#pragma unroll
    for (int i = 0; i < BM / 64; ++i) glds16(ap[i], base + i * 8192 + tid * 16);
#pragma unroll
    for (int i = 0; i < BN / 64; ++i) glds16(bp[i], base + A_BYTES + i * 8192 + tid * 16);
  }
  for (int kt = 0; kt < nk; ++kt) {
    asm volatile("s_waitcnt vmcnt(0)" ::: "memory");
    __syncthreads();
    if (kt + 1 < nk) {
      char* base = lds + ((kt + 1) & 1) * STAGE; const int ko = (kt + 1) * 64;
#pragma unroll
      for (int i = 0; i < BM / 64; ++i) glds16(ap[i] + ko, base + i * 8192 + tid * 16);
#pragma unroll
      for (int i = 0; i < BN / 64; ++i) glds16(bp[i] + ko, base + A_BYTES + i * 8192 + tid * 16);
    }
    const char* sb = lds + (kt & 1) * STAGE;
#pragma unroll
    for (int kk = 0; kk < 2; ++kk) {
      const int ch = kk ? ch1 : ch0;
      bf16x8 af[4], bfr[4];
#pragma unroll
      for (int m = 0; m < 4; ++m) af[m] = *(const bf16x8*)(sb + a_off + m * 2048 + ch);
#pragma unroll
      for (int n = 0; n < 4; ++n) bfr[n] = *(const bf16x8*)(sb + b_off + n * 2048 + ch);
#pragma unroll
      for (int m = 0; m < 4; ++m)
#pragma unroll
        for (int n = 0; n < 4; ++n) acc[m][n] = __builtin_amdgcn_mfma_f32_16x16x32_bf16(bfr[n], af[m], acc[m][n], 0, 0, 0);
    }
  }
#pragma unroll
  for (int m = 0; m < 4; ++m)
#pragma unroll
    for (int n = 0; n < 4; ++n) epi(wm * 64 + m * 16 + fr, wn * 64 + n * 16 + fq * 4, acc[m][n]);
  __syncthreads();
}

struct ARowLin { const bf16_t* A; int lda; __device__ __forceinline__ const bf16_t* operator()(int r) const { return A + (size_t)r * lda; } };
struct ARowGather { const bf16_t* A; const int* list; int nvalid; __device__ __forceinline__ const bf16_t* operator()(int r) const {
  const int rr = r < nvalid ? r : 0; return A + (size_t)(list[rr] >> 1) * D; } };

struct EpiBf16 { bf16_t* C; int ldc; __device__ __forceinline__ void operator()(int r, int c, f32x4 v) const {
  u32x2 w = {cvtpk(v[0], v[1]), cvtpk(v[2], v[3])}; *(u32x2*)(C + (size_t)r * ldc + c) = w; } };
struct EpiF32 { float* C; int ldc; __device__ __forceinline__ void operator()(int r, int c, f32x4 v) const { *(f32x4*)(C + (size_t)r * ldc + c) = v; } };
struct EpiResid { float* X; const float* gate; int row0, c0; __device__ __forceinline__ void operator()(int r, int c, f32x4 v) const {
  const int row = row0 + r, b = row / RPB, ii = row - b * RPB, bsel = ii < CTX ? 4 : b;
  const f32x4 g = *(const f32x4*)(gate + (size_t)bsel * NMOD + c0 + c);
  float* xp = X + (size_t)row * D + c0 + c; f32x4 x = *(f32x4*)xp; x += g * v; *(f32x4*)xp = x; } };
struct EpiMoeGU { bf16_t* H; int c0, nvalid; __device__ __forceinline__ void operator()(int r, int c, f32x4 v) const {
  if (r < nvalid) { const float h0 = silu_f(v[0]) * v[1], h1 = silu_f(v[2]) * v[3]; *(unsigned*)(H + (size_t)r * FF + ((c0 + c) >> 1)) = cvtpk(h0, h1); } } };
struct EpiMoeDown { bf16_t* Y; const int* list; const float* wts; int c0, nvalid; __device__ __forceinline__ void operator()(int r, int c, f32x4 v) const {
  if (r < nvalid) { const int aid = list[r]; const float w = wts[aid]; u32x2 o = {cvtpk(v[0] * w, v[1] * w), cvtpk(v[2] * w, v[3] * w)};
    *(u32x2*)(Y + (size_t)aid * D + c0 + c) = o; } } };

template <int WM, int WN, class EpiMaker>
__device__ __forceinline__ void gemm_phase(const bf16_t* A, int lda, const bf16_t* Bt, int M, int N, int K, char* lds, const EpiMaker& mk, int unit0, int& ucount) {
  constexpr int BM = WM * 64, BN = WN * 64;
  const int nM = M / BM, nN = N / BN, nT = nM * nN;
  for (int t = blockIdx.x - unit0; t < nT; t += gridDim.x) {
    if (t < 0) continue;
    const int mt = t / nN, nt = t - mt * nN;
    ARowLin ar{A + (size_t)mt * BM * lda, lda};
    gemm_tile<WM, WN>(ar, Bt + (size_t)nt * BN * K, K, K, lds, mk(mt * BM, nt * BN));
  }
  ucount = nT;
}

template <int DK> struct AttnCfg {
  static constexpr int KROW = DK * 2;
  static constexpr int SHM_V = 64 * 128 * 2, SHM_K = 64 * KROW;
  static constexpr int SHM = 2 * SHM_V + 2 * SHM_K + 8 * 64 * 4;
};
#define SBAR() __builtin_amdgcn_sched_barrier(0)
__device__ __forceinline__ int crow(int r, int hi) { return (r & 3) + 8 * (r >> 2) + 4 * hi; }
__device__ __forceinline__ int v_st(int k, int c) { const int kk = (k & ~0xC) | ((k & 4) << 1) | ((k & 8) >> 1); return ((kk >> 3) * 4 + (c >> 5)) * 512 + ((kk & 7) * 32 + (c & 31)) * 2; }
__device__ __forceinline__ int v_rd_base(int lane) { return ((lane & 3) << 3) | (((lane >> 2) & 3) << 6) | (((lane >> 4) & 1) << 5) | (((lane >> 5) & 1) << 8); }
constexpr int v_rd_off(int d0, int ks, int half) { return d0 * 512 + ks * 4096 + half * 2048; }
template <int OFF> __device__ __forceinline__ s16x4 tr_read(int vb) {
  s16x4 r; asm volatile("ds_read_b64_tr_b16 %0, %1 offset:%2" : "=&v"(r) : "v"(vb), "i"(OFF) : "memory"); return r;
}
template <int D0> __device__ __forceinline__ void pv_one(f32x16& od, int vb, bf16x8 pa0, bf16x8 pa1, bf16x8 pa2, bf16x8 pa3) {
  const s16x4 l0 = tr_read<v_rd_off(D0, 0, 0)>(vb), h0 = tr_read<v_rd_off(D0, 0, 1)>(vb), l1 = tr_read<v_rd_off(D0, 1, 0)>(vb), h1 = tr_read<v_rd_off(D0, 1, 1)>(vb);
  const s16x4 l2 = tr_read<v_rd_off(D0, 2, 0)>(vb), h2 = tr_read<v_rd_off(D0, 2, 1)>(vb), l3 = tr_read<v_rd_off(D0, 3, 0)>(vb), h3 = tr_read<v_rd_off(D0, 3, 1)>(vb);
  asm volatile("s_waitcnt lgkmcnt(0)" ::: "memory"); SBAR();
#define PK(L, H) (bf16x8){L[0], L[1], L[2], L[3], H[0], H[1], H[2], H[3]}
  od = __builtin_amdgcn_mfma_f32_32x32x16_bf16(pa0, PK(l0, h0), od, 0, 0, 0);
  od = __builtin_amdgcn_mfma_f32_32x32x16_bf16(pa1, PK(l1, h1), od, 0, 0, 0);
  od = __builtin_amdgcn_mfma_f32_32x32x16_bf16(pa2, PK(l2, h2), od, 0, 0, 0);
  od = __builtin_amdgcn_mfma_f32_32x32x16_bf16(pa3, PK(l3, h3), od, 0, 0, 0);
#undef PK
}
__device__ __forceinline__ void pv_d0(f32x16* o, int vb, bf16x8 pa0, bf16x8 pa1, bf16x8 pa2, bf16x8 pa3) {
  pv_one<0>(o[0], vb, pa0, pa1, pa2, pa3); pv_one<1>(o[1], vb, pa0, pa1, pa2, pa3); pv_one<2>(o[2], vb, pa0, pa1, pa2, pa3); pv_one<3>(o[3], vb, pa0, pa1, pa2, pa3);
}
constexpr float ATT_THR = 8.f;
template <int DK> __device__ __forceinline__ void partialSM(f32x16& p0, f32x16& p1, float& m_reg, float& mn, float& alpha) {
  constexpr float SCALE = DK == 192 ? 0.07216878364870322f : 0.08838834764831845f;
  constexpr float C = SCALE * 1.4426950408889634f;
  float pmax = p0[0];
#pragma unroll
  for (int r = 1; r < 16; ++r) pmax = fmaxf(pmax, p0[r]);
#pragma unroll
  for (int r = 0; r < 16; ++r) pmax = fmaxf(pmax, p1[r]);
  { auto rr = __builtin_amdgcn_permlane32_swap(__float_as_uint(pmax), __float_as_uint(pmax), false, false);
    pmax = fmaxf(__uint_as_float(rr[0]), __uint_as_float(rr[1])); }
  if (__builtin_expect(__all(pmax - m_reg <= ATT_THR / SCALE), 1)) { mn = m_reg; alpha = 1.f; }
  else { mn = fmaxf(m_reg, pmax); alpha = __builtin_amdgcn_exp2f((m_reg - mn) * C); m_reg = mn; }
  const float mnC = -mn * C;
#pragma unroll
  for (int r = 0; r < 16; ++r) p0[r] = fmaf(p0[r], C, mnC);
#pragma unroll
  for (int r = 0; r < 16; ++r) p1[r] = fmaf(p1[r], C, mnC);
#pragma unroll
  for (int r = 0; r < 16; ++r) p0[r] = __builtin_amdgcn_exp2f(p0[r]);
}
__device__ __forceinline__ void finishSM(f32x16& p0, f32x16& p1, float alpha, float& l_reg, bf16x8& pa0, bf16x8& pa1, bf16x8& pa2, bf16x8& pa3) {
#pragma unroll
  for (int r = 0; r < 16; ++r) p1[r] = __builtin_amdgcn_exp2f(p1[r]);
  float ps = 0;
#pragma unroll
  for (int r = 0; r < 16; ++r) ps += p0[r];
#pragma unroll
  for (int r = 0; r < 16; ++r) ps += p1[r];
  { auto rr = __builtin_amdgcn_permlane32_swap(__float_as_uint(ps), __float_as_uint(ps), false, false);
    ps = __uint_as_float(rr[0]) + __uint_as_float(rr[1]); }
  l_reg = l_reg * alpha + ps;
#define PK4(P, BASE, OUT) do { unsigned a0 = cvtpk(P[BASE + 0], P[BASE + 1]), a1 = cvtpk(P[BASE + 2], P[BASE + 3]);   \
    unsigned b0 = cvtpk(P[BASE + 4], P[BASE + 5]), b1 = cvtpk(P[BASE + 6], P[BASE + 7]);                              \
    auto r0 = __builtin_amdgcn_permlane32_swap(a0, b0, false, false); auto r1 = __builtin_amdgcn_permlane32_swap(a1, b1, false, false); \
    u32x4 w = {r0[0], r1[0], r0[1], r1[1]}; OUT = *reinterpret_cast<bf16x8*>(&w); } while (0)
  PK4(p0, 0, pa0); PK4(p0, 8, pa1); PK4(p1, 0, pa2); PK4(p1, 8, pa3);
#undef PK4
}
template <int DK> __device__ __forceinline__ void qkt(f32x16& p0, f32x16& p1, const char* Ks, const bf16x8* qr, const int* kro) {
  constexpr int KROW = DK * 2;
  p0 = f32x16{}; p1 = f32x16{};
#pragma unroll
  for (int d0 = 0; d0 < DK / 16; ++d0) {
    bf16x8 b0 = *reinterpret_cast<const bf16x8*>(Ks + kro[d0 & 3] + (d0 >> 2) * 128);
    bf16x8 b1 = *reinterpret_cast<const bf16x8*>(Ks + kro[d0 & 3] + (d0 >> 2) * 128 + 32 * KROW);
    p0 = __builtin_amdgcn_mfma_f32_32x32x16_bf16(b0, qr[d0], p0, 0, 0, 0);
    p1 = __builtin_amdgcn_mfma_f32_32x32x16_bf16(b1, qr[d0], p1, 0, 0, 0); }
}

template <int DK, int ldq, int ldk, int ldv, int ldo>
__device__ __forceinline__ void attn_unit(const bf16_t* __restrict__ Qb, const bf16_t* __restrict__ Kh, const bf16_t* __restrict__ Kp,
                                          const bf16_t* __restrict__ Vh, bf16_t* __restrict__ Ob, int nkeys, bool rope, int qpos0,
                                          const float* __restrict__ qg, char* lds) {
  using Cfg = AttnCfg<DK>;
  constexpr int KROW = Cfg::KROW, SHM_V = Cfg::SHM_V, SHM_K = Cfg::SHM_K, ND0 = DK / 16;
  int tid = threadIdx.x; asm volatile("" : "+v"(tid));
  const int wid = tid >> 6, lane = tid & 63, r32 = lane & 31, hi = lane >> 5;
  char* V_lds = lds; char* K_lds = lds + 2 * SHM_V;
  float* wsl = (float*)(lds + 2 * SHM_V + 2 * SHM_K) + wid * 64; float* li_l = wsl; float* al_l = wsl + 32;
  float m_reg = -1e30f, l_reg = 0; f32x16 o[4] = {}; bf16x8 qr[ND0];
  {
    const int qrow = wid * 32 + r32;
    const bf16_t* Qw = Qb + (size_t)qrow * ldq + hi * 8;
    float qf[ND0][8];
#pragma unroll
    for (int d0 = 0; d0 < ND0; ++d0) { const u32x4 w = *reinterpret_cast<const u32x4*>(Qw + d0 * 16);
#pragma unroll
      for (int e = 0; e < 4; ++e) { qf[d0][2 * e] = bflo(w[e]); qf[d0][2 * e + 1] = bfhi(w[e]); } }
    const int qpos = qpos0 + qrow; const float prow = (float)(qpos >> 6), pcol = (float)(qpos & 63);
    int hio = hi; asm volatile("" : "+v"(hio));
    if constexpr (DK == 128) {
      float ss = 0.f;
#pragma unroll
      for (int d0 = 0; d0 < 8; ++d0)
#pragma unroll
        for (int e = 0; e < 8; ++e) ss += qf[d0][e] * qf[d0][e];
      ss += __shfl_xor(ss, 32);
      const float rs = rsqrtf(ss * (1.0f / 128.0f) + EPS);
#pragma unroll
      for (int d0 = 0; d0 < 8; ++d0) { const f32x4 g0 = *(const f32x4*)(qg + d0 * 16 + hi * 8), g1 = *(const f32x4*)(qg + d0 * 16 + hi * 8 + 4);
#pragma unroll
        for (int e = 0; e < 4; ++e) { qf[d0][e] *= rs * g0[e]; qf[d0][4 + e] *= rs * g1[e]; } }
      if (rope) {
#pragma unroll
        for (int hf = 0; hf < 2; ++hf) { const float pos = hf ? pcol : prow;
#pragma unroll
          for (int dd = 0; dd < 2; ++dd)
#pragma unroll
            for (int e = 0; e < 8; ++e) { const int j = dd * 16 + hio * 8 + e; const float ang = pos * rope_invf(j, 32); const float cs = __cosf(ang), sn = __sinf(ang);
              const float x1 = qf[hf * 4 + dd][e], x2 = qf[hf * 4 + dd + 2][e]; qf[hf * 4 + dd][e] = x1 * cs - x2 * sn; qf[hf * 4 + dd + 2][e] = x1 * sn + x2 * cs; } }
      }
    } else {
      if (rope) {
#pragma unroll
        for (int hf = 0; hf < 2; ++hf) { const float pos = hf ? pcol : prow;
#pragma unroll
          for (int e = 0; e < 8; ++e) { const int j = hio * 8 + e; const float ang = pos * rope_invf(j, 16); const float cs = __cosf(ang), sn = __sinf(ang);
            const float x1 = qf[8 + hf * 2][e], x2 = qf[9 + hf * 2][e]; qf[8 + hf * 2][e] = x1 * cs - x2 * sn; qf[9 + hf * 2][e] = x1 * sn + x2 * cs; } }
      }
    }
#pragma unroll
    for (int d0 = 0; d0 < ND0; ++d0) { u32x4 w = {cvtpk(qf[d0][0], qf[d0][1]), cvtpk(qf[d0][2], qf[d0][3]), cvtpk(qf[d0][4], qf[d0][5]), cvtpk(qf[d0][6], qf[d0][7])};
      qr[d0] = *reinterpret_cast<bf16x8*>(&w); }
  }
  int kro[4];
#pragma unroll
  for (int bq = 0; bq < 4; ++bq) kro[bq] = r32 * KROW + (((2 * bq + hi) ^ (r32 & 7)) << 4);
  const int sr = tid >> 4, sc = (tid & 15) * 8, vst0 = v_st(sr, sc), vst1 = v_st(32 + sr, sc);
  const int pr = tid >> 3, pcc = (tid & 7) * 8;
  const int vb0 = (int)(uintptr_t)(LAS char*)V_lds + v_rd_base(lane);
  bf16x8 vs0, vs1, ks0, ks1, kp0;
  const unsigned voff = sr * ldv + sc, koff = sr * ldk + sc, poff = pr * ROPE + pcc;
#define SLOAD(k0) do { const bf16_t* Vt = Vh + (size_t)(k0) * ldv; const bf16_t* Kt = Kh + (size_t)(k0) * ldk; \
    vs0 = *(const bf16x8*)(Vt + voff); vs1 = *(const bf16x8*)(Vt + 32 * ldv + voff); \
    ks0 = *(const bf16x8*)(Kt + koff); ks1 = *(const bf16x8*)(Kt + 32 * ldk + koff); \
    if constexpr (DK == 192) kp0 = *(const bf16x8*)(Kp + (size_t)(k0) * ROPE + poff); } while (0)
#define SWRITE(b) do { *(bf16x8*)(V_lds + (b) * SHM_V + vst0) = vs0; *(bf16x8*)(V_lds + (b) * SHM_V + vst1) = vs1; const int kc = sc * 2; \
    *(bf16x8*)(K_lds + (b) * SHM_K + sr * KROW + (kc ^ ((sr & 7) << 4))) = ks0; \
    *(bf16x8*)(K_lds + (b) * SHM_K + (32 + sr) * KROW + (kc ^ ((sr & 7) << 4))) = ks1; \
    if constexpr (DK == 192) *(bf16x8*)(K_lds + (b) * SHM_K + pr * KROW + ((256 + pcc * 2) ^ ((pr & 7) << 4))) = kp0; } while (0)
#define RESC(a) do { if (__any((a) < 1.f)) { if (hi == 0) al_l[r32] = (a); asm volatile("s_waitcnt lgkmcnt(0)" ::: "memory"); \
    for (int d = 0; d < 4; ++d) for (int r = 0; r < 16; ++r) o[d][r] *= al_l[crow(r, hi)]; } } while (0)
  f32x16 pA0, pA1, pB0, pB1; float mnA, mnB, alA, alB; bf16x8 pa0, pa1, pa2, pa3; const int NT = nkeys / 64;
  SLOAD(0); SWRITE(0); __syncthreads();
  qkt<DK>(pA0, pA1, K_lds, qr, kro); partialSM<DK>(pA0, pA1, m_reg, mnA, alA);
  SLOAD(64); SWRITE(1); __syncthreads();
  for (int j = 1; j + 1 < NT; j += 2) {
    SBAR(); qkt<DK>(pB0, pB1, K_lds + SHM_K, qr, kro);
    finishSM(pA0, pA1, alA, l_reg, pa0, pa1, pa2, pa3); SBAR();
    SLOAD((j + 1) * 64); SBAR();
    pv_d0(o, vb0, pa0, pa1, pa2, pa3); partialSM<DK>(pB0, pB1, m_reg, mnB, alB);
    __syncthreads(); SWRITE(0);
    RESC(alB); __syncthreads();
    SBAR(); qkt<DK>(pA0, pA1, K_lds, qr, kro);
    finishSM(pB0, pB1, alB, l_reg, pa0, pa1, pa2, pa3); SBAR();
    SLOAD((j + 2) * 64); SBAR();
    pv_d0(o, vb0 + SHM_V, pa0, pa1, pa2, pa3); partialSM<DK>(pA0, pA1, m_reg, mnA, alA);
    __syncthreads(); SWRITE(1);
    RESC(alA); __syncthreads();
  }
  SBAR(); qkt<DK>(pB0, pB1, K_lds + SHM_K, qr, kro);
  finishSM(pA0, pA1, alA, l_reg, pa0, pa1, pa2, pa3); SBAR();
  pv_d0(o, vb0, pa0, pa1, pa2, pa3); partialSM<DK>(pB0, pB1, m_reg, mnB, alB);
  __syncthreads(); RESC(alB);
  finishSM(pB0, pB1, alB, l_reg, pa0, pa1, pa2, pa3); SBAR();
  pv_d0(o, vb0 + SHM_V, pa0, pa1, pa2, pa3);
  if (hi == 0) li_l[r32] = l_reg; asm volatile("s_waitcnt lgkmcnt(0)" ::: "memory");
  float rli[16];
#pragma unroll
  for (int r = 0; r < 16; ++r) rli[r] = __builtin_amdgcn_rcpf(li_l[crow(r, hi)]);
  bf16_t* Ow = Ob + (size_t)(wid * 32) * ldo;
#pragma unroll
  for (int r = 0; r < 16; ++r) { const int orow = crow(r, hi);
#pragma unroll
    for (int d0 = 0; d0 < 4; ++d0) Ow[(size_t)orow * ldo + d0 * 32 + r32] = (bf16_t)(cvtpk(o[d0][r] * rli[r], 0.f) & 0xffffu); }
  __syncthreads();
#undef SLOAD
#undef SWRITE
#undef RESC
}

__device__ __forceinline__ void tconv_tile(const float* __restrict__ src, int ldn, int k0, int n0, bf16_t* __restrict__ dst, int ldk, int rmul, int roff, float* lw, int lane) {
  const float* s = src + (size_t)k0 * ldn + n0 + lane;
#pragma unroll
  for (int kb = 0; kb < 64; kb += 16) {
    float v[16];
#pragma unroll
    for (int i = 0; i < 16; ++i) v[i] = s[(size_t)(kb + i) * ldn];
#pragma unroll
    for (int i = 0; i < 16; ++i) lw[(kb + i) * 65 + lane] = v[i];
  }
  const int kc = (lane & 7) * 8;
#pragma unroll
  for (int it = 0; it < 8; ++it) {
    const int n = it * 8 + (lane >> 3);
    float v[8];
#pragma unroll
    for (int j = 0; j < 8; ++j) v[j] = lw[(kc + j) * 65 + n];
    u32x4 w = {cvtpk(v[0], v[1]), cvtpk(v[2], v[3]), cvtpk(v[4], v[5]), cvtpk(v[6], v[7])};
    *(u32x4*)(dst + (size_t)((n0 + n) * rmul + roff) * ldk + k0 + kc) = w;
  }
}

__device__ __forceinline__ void phase_prep(const Params& p, char* lds) {
  int tid = threadIdx.x; asm volatile("" : "+v"(tid));
  const int wid = tid >> 6, lane = tid & 63;
  const int gw = blockIdx.x * 8 + wid, nw = gridDim.x * 8;
  char* ws = opaque_ptr(p.ws);
  float* lw = (float*)lds + wid * (64 * 65);
  for (int t = gw; t < DEPTH * ME * 384; t += nw) {
    const int le = t / 384, tt = t - le * 384, which = tt >> 7, ti = tt & 127;
    bf16_t* wgu = (bf16_t*)(ws + WS_WMOE + (size_t)le * MOE_WBYTES); bf16_t* wd = wgu + 1024 * 1024;
    if (which < 2) { const float* src = p.in[which == 0 ? I_MOE_GATE : I_MOE_UP] + (size_t)le * D * FF;
      const int kt = ti >> 3, nt = ti & 7; tconv_tile(src, FF, kt * 64, nt * 64, wgu, D, 2, which, lw, lane); }
    else { const float* src = p.in[I_MOE_DOWN] + (size_t)le * FF * D;
      const int kt = ti >> 4, nt = ti & 15; tconv_tile(src, D, kt * 64, nt * 64, wd, FF, 1, 0, lw, lane); }
  }
  {
    int base = 0;
#pragma unroll 1
    for (int q = 0; q < 14; ++q) {
      const float* jsrc = p.jobs[q].src; bf16_t* jdst = p.jobs[q].dst; const int jK = p.jobs[q].K, jN = p.jobs[q].N, jroff = p.jobs[q].roff;
      const int nnt = jN >> 6, ntile = (jK >> 6) * nnt;
      for (int t = gw - base; t < ntile; t += nw) { if (t < 0) continue; const int kt = t / nnt, nt = t - kt * nnt;
        tconv_tile(jsrc, jN, kt * 64, nt * 64, jdst, jK, 1, jroff, lw, lane); }
      base = (base + ntile) % nw;
    }
  }
  for (int j = 0; j < 2; ++j) { u32x4* z = (u32x4*)(ws + WS_WMLA + j * MLA_WBYTES + MLA_W1T + (size_t)832 * 1024 * 2);
    for (int i = blockIdx.x * NTHR + tid; i < 64 * 1024 * 2 / 16; i += gridDim.x * NTHR) z[i] = (u32x4){0u, 0u, 0u, 0u}; }
  if (blockIdx.x == 0 && tid < DEPTH * ME) ((int*)(ws + WS_CNT))[tid] = 0;
  if (blockIdx.x == 0 && tid == 0) ((int*)(ws + WS_CNT))[1000] = 0;
  for (int r = gw; r < R; r += nw) {
    const int b = r / RPB, ii = r - b * RPB;
    const f32x4* src = (const f32x4*)(ii < CTX ? p.in[I_CTX] + ((size_t)b * CTX + ii) * D : p.in[I_X] + ((size_t)b * SEQ + (ii - CTX)) * D);
    f32x4* dst = (f32x4*)(ws + WS_X32) + (size_t)r * (D / 4);
#pragma unroll
    for (int q = 0; q < 4; ++q) dst[lane + 64 * q] = src[lane + 64 * q];
  }
  {
    float* sc = (float*)lds;
    __syncthreads();
    for (int u = blockIdx.x; u < DEPTH * 12 * 8; u += gridDim.x) {
      const int i = u / 96, rem = u - i * 96, cch = rem >> 3, ks = rem & 7;
      __syncthreads();
      for (int e = tid; e < 5 * 128; e += NTHR) { const int b = e >> 7, k = ks * 128 + (e & 127); const float c = b < 4 ? p.in[I_C][b * D + k] : p.in[I_CCTX][k]; sc[e] = silu_f(c); }
      __syncthreads();
      const int col = cch * 512 + tid;
      const float* w = p.in[I_WMOD] + (size_t)i * D * NMOD + (size_t)(ks * 128) * NMOD + col;
      float a0 = 0, a1 = 0, a2 = 0, a3 = 0, a4 = 0;
#pragma unroll 8
      for (int k = 0; k < 128; ++k) { const float wv = w[(size_t)k * NMOD]; a0 += sc[k] * wv; a1 += sc[128 + k] * wv; a2 += sc[256 + k] * wv; a3 += sc[384 + k] * wv; a4 += sc[512 + k] * wv; }
      float* mp = (float*)(ws + WS_MODP) + ((size_t)(ks * DEPTH + i) * 5) * NMOD + col;
      mp[0] = a0; mp[NMOD] = a1; mp[2 * NMOD] = a2; mp[3 * NMOD] = a3; mp[4 * NMOD] = a4;
    }
    __syncthreads();
  }
}
__device__ __forceinline__ void phase_modfin(const Params& p) {
  const float* mp = (const float*)(p.ws + WS_MODP); float* mv = (float*)(p.ws + WS_MODV);
  for (int e = blockIdx.x * NTHR + threadIdx.x; e < DEPTH * 5 * NMOD; e += gridDim.x * NTHR) {
    const int i = e / (5 * NMOD), col = e % NMOD;
    float s = p.in[I_BMOD][i * NMOD + col];
#pragma unroll
    for (int ks = 0; ks < 8; ++ks) s += mp[(size_t)ks * DEPTH * 5 * NMOD + e];
    mv[e] = s;
  }
}

template <int MODE, bool COMBINE>
__device__ __forceinline__ void phase_norm(const Params& p, int layer) {
  int tid = threadIdx.x; asm volatile("" : "+v"(tid));
  const int wid = tid >> 6, lane = tid & 63;
  const int gw = blockIdx.x * 8 + wid, nw = gridDim.x * 8;
  char* ws = opaque_ptr(p.ws);
  const float* modv = (const float*)(ws + WS_MODV);
  const bf16_t* Y = (const bf16_t*)(ws + WS_Y);
  for (int r = gw; r < R; r += nw) {
    const int b = r / RPB, ii = r - b * RPB; const bool is_ctx = ii < CTX; const int bsel = is_ctx ? 4 : b;
    if (MODE == 2 && is_ctx) continue;
    float* xp = (float*)(ws + WS_X32) + (size_t)r * D;
    f32x4 v[4];
#pragma unroll
    for (int q = 0; q < 4; ++q) v[q] = *(const f32x4*)(xp + (lane + 64 * q) * 4);
    if (COMBINE) {
      const int pl = MODE == 2 ? DEPTH - 1 : layer - 1;
      if (!(pl == DEPTH - 1 && is_ctx)) {
        const float* g2 = modv + ((size_t)pl * 5 + bsel) * NMOD + 5 * D;
#pragma unroll
        for (int q = 0; q < 4; ++q) { const int c = (lane + 64 * q) * 4; const f32x4 g = *(const f32x4*)(g2 + c);
          const u32x2 y0 = *(const u32x2*)(Y + (size_t)(2 * r) * D + c), y1 = *(const u32x2*)(Y + (size_t)(2 * r + 1) * D + c);
          v[q][0] += g[0] * (bflo(y0[0]) + bflo(y1[0])); v[q][1] += g[1] * (bfhi(y0[0]) + bfhi(y1[0]));
          v[q][2] += g[2] * (bflo(y0[1]) + bflo(y1[1])); v[q][3] += g[3] * (bfhi(y0[1]) + bfhi(y1[1])); }
        if (MODE != 2) {
#pragma unroll
          for (int q = 0; q < 4; ++q) *(f32x4*)(xp + (lane + 64 * q) * 4) = v[q];
        }
      }
    }
    float ss = 0.f;
#pragma unroll
    for (int q = 0; q < 4; ++q) ss += v[q][0] * v[q][0] + v[q][1] * v[q][1] + v[q][2] * v[q][2] + v[q][3] * v[q][3];
    ss = wave_sum(ss);
    const float rs = rsqrtf(ss * (1.0f / D) + EPS);
    if (MODE == 2) {
      float* op = p.out + ((size_t)b * SEQ + (ii - CTX)) * D;
#pragma unroll
      for (int q = 0; q < 4; ++q) { const int c = (lane + 64 * q) * 4; const f32x4 g = *(const f32x4*)(p.in[I_FG] + c); f32x4 ov = v[q] * rs * g;
#ifdef SANITIZE
        for (int e = 0; e < 4; ++e) if (!(fabsf(ov[e]) < 1e30f)) ov[e] = DBG_PROBE ? 0.f : 1000.0f;
        if (DBG_PROBE && ((const int*)(ws + WS_CNT))[1000]) ov = (f32x4){1000.f, 1000.f, 1000.f, 1000.f};
#endif
        *(f32x4*)(op + c) = ov; }
      continue;
    }
    const float* ng = p.in[MODE == 0 ? I_NMG : I_NFG] + layer * D;
    const float* sh = modv + ((size_t)layer * 5 + bsel) * NMOD + (MODE == 0 ? 0 : 3) * D;
    const float* scl = sh + D;
    bf16_t* ap = (bf16_t*)(ws + WS_ACT) + (size_t)r * D;
    f32x4 f[4];
#pragma unroll
    for (int q = 0; q < 4; ++q) { const int c = (lane + 64 * q) * 4; const f32x4 g = *(const f32x4*)(ng + c), s1 = *(const f32x4*)(scl + c), s0 = *(const f32x4*)(sh + c);
      f[q] = (v[q] * rs * g) * (1.0f + s1) + s0;
      u32x2 w = {cvtpk(f[q][0], f[q][1]), cvtpk(f[q][2], f[q][3])}; *(u32x2*)(ap + c) = w; }
    if (MODE == 1) {
      if (layer == DEPTH - 1 && is_ctx) continue;
      const float* wg = p.in[I_MOE_WG] + (size_t)layer * D * 4; const float* we = p.in[I_MOE_WE] + (size_t)layer * D * ME;
      float gl[4] = {0.f, 0.f, 0.f, 0.f};
#pragma unroll
      for (int q = 0; q < 4; ++q)
#pragma unroll
        for (int e = 0; e < 4; ++e) { const int c = (lane + 64 * q) * 4 + e; const f32x4 w = *(const f32x4*)(wg + (size_t)c * 4);
          gl[0] += f[q][e] * w[0]; gl[1] += f[q][e] * w[1]; gl[2] += f[q][e] * w[2]; gl[3] += f[q][e] * w[3]; }
#pragma unroll
      for (int k = 0; k < 4; ++k) gl[k] = wave_sum(gl[k]);
      const float gm = fmaxf(fmaxf(gl[0], gl[1]), fmaxf(gl[2], gl[3]));
      float gp[4], gs = 0.f;
#pragma unroll
      for (int k = 0; k < 4; ++k) { gp[k] = __expf(gl[k] - gm); gs += gp[k]; }
      const float gsi = 1.0f / gs;
      int gsel = 0; float gbest = -1e30f, gw_ = 0.f;
#pragma unroll
      for (int k = 0; k < 4; ++k) { const float pr = gp[k] * gsi; const float sc = pr + p.in[I_MOE_BG][layer * 4 + k]; if (sc > gbest) { gbest = sc; gsel = k; gw_ = pr; } }
      gsel = __builtin_amdgcn_readfirstlane(gsel);
      float el[8] = {0.f, 0.f, 0.f, 0.f, 0.f, 0.f, 0.f, 0.f};
#pragma unroll
      for (int q = 0; q < 4; ++q)
#pragma unroll
        for (int e = 0; e < 4; ++e) { const int c = (lane + 64 * q) * 4 + e; const f32x4 w0 = *(const f32x4*)(we + (size_t)c * ME + gsel * 8), w1 = *(const f32x4*)(we + (size_t)c * ME + gsel * 8 + 4);
          el[0] += f[q][e] * w0[0]; el[1] += f[q][e] * w0[1]; el[2] += f[q][e] * w0[2]; el[3] += f[q][e] * w0[3];
          el[4] += f[q][e] * w1[0]; el[5] += f[q][e] * w1[1]; el[6] += f[q][e] * w1[2]; el[7] += f[q][e] * w1[3]; }
#pragma unroll
      for (int k = 0; k < 8; ++k) el[k] = wave_sum(el[k]);
      float em = el[0];
#pragma unroll
      for (int k = 1; k < 8; ++k) em = fmaxf(em, el[k]);
      float ep[8], es = 0.f;
#pragma unroll
      for (int k = 0; k < 8; ++k) { ep[k] = __expf(el[k] - em); es += ep[k]; }
      const float esi = 1.0f / es;
      int t1 = 0, t2 = 0; float b1 = -1e30f, b2 = -1e30f, p1 = 0.f, p2 = 0.f;
#pragma unroll
      for (int k = 0; k < 8; ++k) { const float pr = ep[k] * esi; const float sc = pr + p.in[I_MOE_BE][layer * ME + gsel * 8 + k];
        if (sc > b1) { b2 = b1; t2 = t1; p2 = p1; b1 = sc; t1 = k; p1 = pr; } else if (sc > b2) { b2 = sc; t2 = k; p2 = pr; } }
      if (lane == 0) {
        const float inv = gw_ / (p1 + p2);
        int* cnt = (int*)(ws + WS_CNT) + layer * ME; int* list = (int*)(ws + WS_LIST); float* wts = (float*)(ws + WS_WTS);
        const int e1 = gsel * 8 + t1, e2 = gsel * 8 + t2;
        const int q1 = atomicAdd(cnt + e1, 1); list[(size_t)e1 * R + q1] = 2 * r;     wts[2 * r] = p1 * inv;
        const int q2 = atomicAdd(cnt + e2, 1); list[(size_t)e2 * R + q2] = 2 * r + 1; wts[2 * r + 1] = p2 * inv;
      }
    }
  }
}

__device__ __forceinline__ void phase_mla_mid(const Params& p, int j) {
  int tid = threadIdx.x; asm volatile("" : "+v"(tid));
  const int wid = tid >> 6, lane = tid & 63;
  const int gw = blockIdx.x * 8 + wid, nw = gridDim.x * 8;
  char* ws = opaque_ptr(p.ws);
  const float* gq = p.in[I_MLA_GQ] + j * QL; const float* gkv = p.in[I_MLA_GKV] + j * KVL;
  for (int r = gw; r < R; r += nw) {
    const int b = r / RPB, ii = r - b * RPB; const bool is_ctx = ii < CTX;
    const float* c1 = (const float*)(ws + WS_C1) + (size_t)r * 896;
    const f32x4 q0 = *(const f32x4*)(c1 + lane * 4), q1 = *(const f32x4*)(c1 + 256 + lane * 4), kv = *(const f32x4*)(c1 + 512 + lane * 4);
    const float pe = c1[768 + lane];
    float sq = q0[0] * q0[0] + q0[1] * q0[1] + q0[2] * q0[2] + q0[3] * q0[3] + q1[0] * q1[0] + q1[1] * q1[1] + q1[2] * q1[2] + q1[3] * q1[3];
    float sk = kv[0] * kv[0] + kv[1] * kv[1] + kv[2] * kv[2] + kv[3] * kv[3];
    sq = wave_sum(sq); sk = wave_sum(sk);
    const float rq = rsqrtf(sq * (1.0f / QL) + EPS), rk = rsqrtf(sk * (1.0f / KVL) + EPS);
    bf16_t* cq = (bf16_t*)(ws + WS_CQ) + (size_t)r * QL; bf16_t* ckv = (bf16_t*)(ws + WS_CKV) + (size_t)r * KVL; bf16_t* kpe = (bf16_t*)(ws + WS_KPE) + (size_t)r * ROPE;
    { const f32x4 g = *(const f32x4*)(gq + lane * 4); u32x2 w = {cvtpk(q0[0] * rq * g[0], q0[1] * rq * g[1]), cvtpk(q0[2] * rq * g[2], q0[3] * rq * g[3])}; *(u32x2*)(cq + lane * 4) = w; }
    { const f32x4 g = *(const f32x4*)(gq + 256 + lane * 4); u32x2 w = {cvtpk(q1[0] * rq * g[0], q1[1] * rq * g[1]), cvtpk(q1[2] * rq * g[2], q1[3] * rq * g[3])}; *(u32x2*)(cq + 256 + lane * 4) = w; }
    { const f32x4 g = *(const f32x4*)(gkv + lane * 4); u32x2 w = {cvtpk(kv[0] * rk * g[0], kv[1] * rk * g[1]), cvtpk(kv[2] * rk * g[2], kv[3] * rk * g[3])}; *(u32x2*)(ckv + lane * 4) = w; }
    float outv = pe;
    const float other = __shfl_xor(pe, 16);
    if (!is_ctx) {
      const int s = ii - CTX; const float pos = (lane < 32) ? (float)(s >> 6) : (float)(s & 63);
      const float ang = pos * rope_invf(lane & 15, 16); const float cs = __cosf(ang), sn = __sinf(ang);
      outv = (lane & 16) ? (other * sn + pe * cs) : (pe * cs - other * sn);
    }
    kpe[lane] = (bf16_t)(cvtpk(outv, 0.f) & 0xffffu);
  }
}

__device__ __forceinline__ void phase_gqa_k(const Params& p) {
  int tid = threadIdx.x; asm volatile("" : "+v"(tid));
  const int wid = tid >> 6, lane = tid & 63;
  const int gw = blockIdx.x * 8 + wid, nw = gridDim.x * 8;
  char* ws = opaque_ptr(p.ws); const float* kg = p.in[I_GQA_KG];
  const int sub = lane & 7;
  for (int r = gw; r < R; r += nw) {
    const int b = r / RPB, ii = r - b * RPB; const bool is_ctx = ii < CTX;
    const bf16_t* kp = (const bf16_t*)(ws + WS_QKV) + (size_t)r * 4096 + 2048 + lane * 16;
    const u32x4 w0 = *(const u32x4*)kp, w1 = *(const u32x4*)(kp + 8);
    float v[16];
#pragma unroll
    for (int e = 0; e < 4; ++e) { v[2 * e] = bflo(w0[e]); v[2 * e + 1] = bfhi(w0[e]); v[8 + 2 * e] = bflo(w1[e]); v[9 + 2 * e] = bfhi(w1[e]); }
    float ss = 0.f;
#pragma unroll
    for (int e = 0; e < 16; ++e) ss += v[e] * v[e];
    ss += __shfl_xor(ss, 1); ss += __shfl_xor(ss, 2); ss += __shfl_xor(ss, 4);
    const float rs = rsqrtf(ss * (1.0f / GD) + EPS);
#pragma unroll
    for (int e = 0; e < 16; ++e) v[e] *= rs * kg[sub * 16 + e];
    float o[16];
#pragma unroll
    for (int e = 0; e < 16; ++e) o[e] = __shfl_xor(v[e], 2);
    if (!is_ctx) {
      const int s = ii - CTX; const float pos = (sub < 4) ? (float)(s >> 6) : (float)(s & 63);
#pragma unroll
      for (int e = 0; e < 16; ++e) { const int j = (sub & 1) * 16 + e; const float ang = pos * rope_invf(j, 32); const float cs = __cosf(ang), sn = __sinf(ang);
        v[e] = (sub & 2) ? (o[e] * sn + v[e] * cs) : (v[e] * cs - o[e] * sn); }
    }
    bf16_t* op = (bf16_t*)(ws + WS_KN) + (size_t)r * 1024 + lane * 16;
    u32x4 o0 = {cvtpk(v[0], v[1]), cvtpk(v[2], v[3]), cvtpk(v[4], v[5]), cvtpk(v[6], v[7])}, o1 = {cvtpk(v[8], v[9]), cvtpk(v[10], v[11]), cvtpk(v[12], v[13]), cvtpk(v[14], v[15])};
    *(u32x4*)op = o0; *(u32x4*)(op + 8) = o1;
  }
}

__device__ __forceinline__ void phase_conv_mid(const Params& p) {
  int tid = threadIdx.x; asm volatile("" : "+v"(tid));
  const int wid = tid >> 6, lane = tid & 63;
  const int gw = blockIdx.x * 8 + wid, nw = gridDim.x * 8;
  char* ws = opaque_ptr(p.ws); const float* cw = p.in[I_CONV_W];
  const bf16_t* bcu = (const bf16_t*)(ws + WS_BCU);
  for (int r = gw; r < R; r += nw) {
    const int b = r / RPB, ii = r - b * RPB; const bool is_ctx = ii < CTX;
    const bool hp = is_ctx ? (ii > 0) : (ii > CTX), hn = is_ctx ? (ii < CTX - 1) : (ii < RPB - 1);
    bf16_t* gp = (bf16_t*)(ws + WS_G) + (size_t)r * D;
#pragma unroll
    for (int q = 0; q < 4; ++q) {
      const int c = (lane + 64 * q) * 4;
      const bf16_t* row = bcu + (size_t)r * 3072 + c;
      const u32x2 bg = *(const u32x2*)row, c0 = *(const u32x2*)(row + 1024), u0 = *(const u32x2*)(row + 2048);
      u32x2 cp = {0u, 0u}, up = {0u, 0u}, cn = {0u, 0u}, un = {0u, 0u};
      if (hp) { cp = *(const u32x2*)(row - 3072 + 1024); up = *(const u32x2*)(row - 3072 + 2048); }
      if (hn) { cn = *(const u32x2*)(row + 3072 + 1024); un = *(const u32x2*)(row + 3072 + 2048); }
      const f32x4 w0 = *(const f32x4*)(cw + c), w1 = *(const f32x4*)(cw + D + c), w2 = *(const f32x4*)(cw + 2 * D + c);
      float z[4];
      z[0] = w0[0] * bflo(cp[0]) * bflo(up[0]) + w1[0] * bflo(c0[0]) * bflo(u0[0]) + w2[0] * bflo(cn[0]) * bflo(un[0]);
      z[1] = w0[1] * bfhi(cp[0]) * bfhi(up[0]) + w1[1] * bfhi(c0[0]) * bfhi(u0[0]) + w2[1] * bfhi(cn[0]) * bfhi(un[0]);
      z[2] = w0[2] * bflo(cp[1]) * bflo(up[1]) + w1[2] * bflo(c0[1]) * bflo(u0[1]) + w2[2] * bflo(cn[1]) * bflo(un[1]);
      z[3] = w0[3] * bfhi(cp[1]) * bfhi(up[1]) + w1[3] * bfhi(c0[1]) * bfhi(u0[1]) + w2[3] * bfhi(cn[1]) * bfhi(un[1]);
      u32x2 w = {cvtpk(bflo(bg[0]) * z[0], bfhi(bg[0]) * z[1]), cvtpk(bflo(bg[1]) * z[2], bfhi(bg[1]) * z[3])};
      *(u32x2*)(gp + c) = w;
    }
  }
}

__device__ __forceinline__ void moe_prefix(const Params& p, int layer, int* li) {
  if (threadIdx.x == 0) { const int* cnt = (const int*)(p.ws + WS_CNT) + layer * ME; int o = 0, t = 0;
    for (int e = 0; e < ME; ++e) { li[e] = o; li[33 + e] = t; const int c = cnt[e]; o += c; t += (c + 127) >> 7; } li[32] = o; li[65] = t; }
  __syncthreads();
}
__device__ __forceinline__ void phase_moe1(const Params& p, int layer, char* lds) {
  int* li = (int*)(lds + 131072); moe_prefix(p, layer, li);
  char* ws = opaque_ptr(p.ws); const int* cnt = (const int*)(ws + WS_CNT) + layer * ME;
  const int nU = li[65] * 4;
  for (int u = blockIdx.x; u < nU; u += gridDim.x) {
    const int t = u >> 2, ct = u & 3; int e = 0;
    while (li[33 + e + 1] <= t) ++e;
    const int rt = t - li[33 + e], ce = cnt[e], nvalid = min(128, ce - rt * 128);
    const int* list = (const int*)(ws + WS_LIST) + (size_t)e * R + rt * 128;
    ARowGather ar{(const bf16_t*)(ws + WS_ACT), list, nvalid};
    const bf16_t* wgu = (const bf16_t*)(ws + WS_WMOE + (size_t)(layer * ME + e) * MOE_WBYTES);
    EpiMoeGU ep{(bf16_t*)(ws + WS_HID) + (size_t)(li[e] + rt * 128) * FF, ct * 256, nvalid};
    gemm_tile<2, 4>(ar, wgu + (size_t)ct * 256 * D, D, D, lds, ep);
  }
}
__device__ __forceinline__ void phase_moe2(const Params& p, int layer, char* lds) {
  int* li = (int*)(lds + 131072); moe_prefix(p, layer, li);
  char* ws = opaque_ptr(p.ws); const int* cnt = (const int*)(ws + WS_CNT) + layer * ME;
  const int nU = li[65] * 4;
  for (int u = blockIdx.x; u < nU; u += gridDim.x) {
    const int t = u >> 2, ct = u & 3; int e = 0;
    while (li[33 + e + 1] <= t) ++e;
    const int rt = t - li[33 + e], ce = cnt[e], nvalid = min(128, ce - rt * 128);
    const int* list = (const int*)(ws + WS_LIST) + (size_t)e * R + rt * 128;
    ARowLin ar{(const bf16_t*)(ws + WS_HID) + (size_t)(li[e] + rt * 128) * FF, FF};
    const bf16_t* wd = (const bf16_t*)(ws + WS_WMOE + (size_t)(layer * ME + e) * MOE_WBYTES) + 1024 * 1024;
    EpiMoeDown ep{(bf16_t*)(ws + WS_Y), list, (const float*)(ws + WS_WTS), ct * 256, nvalid};
    gemm_tile<2, 4>(ar, wd + (size_t)ct * 256 * FF, FF, FF, lds, ep);
  }
}

__device__ __forceinline__ void phase_attn_mla(const Params& p, bool ctx_out, char* lds) {
  char* ws = opaque_ptr(p.ws);
  const bf16_t* Q = (const bf16_t*)(ws + WS_Q); const bf16_t* KV = (const bf16_t*)(ws + WS_KV); const bf16_t* KPE = (const bf16_t*)(ws + WS_KPE); bf16_t* O = (bf16_t*)(ws + WS_O);
  const int nctx = ctx_out ? NB * MLA_H : 0, nU = nctx + NB * MLA_H * 16;
  for (int u = blockIdx.x; u < nU; u += gridDim.x) {
    int b, h, q0, nkeys; bool rope;
    if (u < nctx) { b = u / MLA_H; h = u % MLA_H; q0 = 0; nkeys = CTX; rope = false; }
    else { const int v = u - nctx; const int qb = v & 15; h = (v >> 4) % MLA_H; b = v / (16 * MLA_H); q0 = CTX + qb * 256; nkeys = RPB; rope = true; }
    const size_t rb = (size_t)b * RPB;
    attn_unit<192, 1536, 2048, 2048, 1024>(Q + (rb + q0) * 1536 + h * 192, KV + rb * 2048 + h * 256, KPE + rb * ROPE, KV + rb * 2048 + h * 256 + 128,
                   O + (rb + q0) * 1024 + h * 128, nkeys, rope, q0 - CTX, nullptr, lds);
  }
}
__device__ __forceinline__ void phase_attn_gqa(const Params& p, char* lds) {
  char* ws = opaque_ptr(p.ws);
  const bf16_t* QKV = (const bf16_t*)(ws + WS_QKV); const bf16_t* KN = (const bf16_t*)(ws + WS_KN); bf16_t* O = (bf16_t*)(ws + WS_OG);
  const int nctx = NB * GH, nU = nctx + NB * GH * 16;
  for (int u = blockIdx.x; u < nU; u += gridDim.x) {
    int b, h, q0, nkeys; bool rope;
    if (u < nctx) { b = u / GH; h = u % GH; q0 = 0; nkeys = CTX; rope = false; }
    else { const int v = u - nctx; const int qb = v & 15; h = (v >> 4) % GH; b = v / (16 * GH); q0 = CTX + qb * 256; nkeys = RPB; rope = true; }
    const size_t rb = (size_t)b * RPB; const int kvh = h >> 1;
    attn_unit<128, 4096, 1024, 4096, 2048>(QKV + (rb + q0) * 4096 + h * 128, KN + rb * 1024 + kvh * 128, nullptr, QKV + rb * 4096 + 3072 + kvh * 128,
                   O + (rb + q0) * 2048 + h * 128, nkeys, rope, q0 - CTX, p.in[I_GQA_QG], lds);
  }
}


__device__ __forceinline__ void dbg_probe(const Params& p) {
  char* ws = opaque_ptr(p.ws);
  size_t off = 0, n = 0; bool is_bf = true;
  switch (DBG_PROBE) {
    case 1: off = WS_MODV; n = (size_t)4 * 5 * NMOD; is_bf = false; break;
    case 2: off = WS_ACT; n = (size_t)R * D; break;
    case 3: off = WS_C1; n = (size_t)R * 896; is_bf = false; break;
    case 4: off = WS_CQ; n = (size_t)R * 512; break;
    case 5: off = WS_CKV; n = (size_t)R * 256; break;
    case 6: off = WS_KPE; n = (size_t)R * 64; break;
    case 7: off = WS_Q; n = (size_t)R * 1536; break;
    case 8: off = WS_KV; n = (size_t)R * 2048; break;
    case 9: off = WS_O; n = (size_t)R * 1024; break;
    case 10: off = WS_X32; n = (size_t)R * D; is_bf = false; break;
    case 11: off = WS_WMLA; n = MLA_WBYTES / 2; break;
    default: break;
  }
  int bad = 0;
  for (size_t i = (size_t)blockIdx.x * NTHR + threadIdx.x; i < n; i += (size_t)gridDim.x * NTHR) {
    float v = is_bf ? bf2f(((const bf16_t*)(ws + off))[i]) : ((const float*)(ws + off))[i];
    if (!(fabsf(v) < 1e30f)) bad = 1;
  }
  if (bad) atomicOr((int*)(ws + WS_CNT) + 1000, 1);
}

struct MkBf16 { bf16_t* C; int ldc; __device__ __forceinline__ EpiBf16 operator()(int m0, int n0) const { return EpiBf16{C + (size_t)m0 * ldc + n0, ldc}; } };
struct MkF32 { float* C; int ldc; __device__ __forceinline__ EpiF32 operator()(int m0, int n0) const { return EpiF32{C + (size_t)m0 * ldc + n0, ldc}; } };
struct MkResid { float* X; const float* gate; __device__ __forceinline__ EpiResid operator()(int m0, int n0) const { return EpiResid{X, gate, m0, n0}; } };

extern __shared__ __attribute__((aligned(16))) char smem[];

__global__ void __launch_bounds__(NTHR, 2) fwd_megakernel(Params p) {
  cg::grid_group grid = cg::this_grid();
  char* lds = smem;
#define WSO() char* ws = opaque_ptr(p.ws)
  int uc = 0, u0 = 0;
  phase_prep(p, lds);
  grid.sync();
  phase_modfin(p);
  grid.sync();
  if (STOP_AFTER == 0) { phase_norm<2, false>(p, 0); return; }
#pragma unroll 1
  for (int layer = 0; layer < DEPTH; ++layer) {
    const int kind = layer % 3, j = layer / 3; const bool ctx_out = layer < DEPTH - 1;
    if (layer == 0) phase_norm<0, false>(p, layer); else phase_norm<0, true>(p, layer);
    grid.sync();
    if (kind == 0) {
      { WSO(); const char* wb = ws + WS_WMLA + j * MLA_WBYTES;
        gemm_phase<4, 2>((const bf16_t*)(ws + WS_ACT), D, (const bf16_t*)(wb + MLA_W1T), R, 896, D, lds, MkF32{(float*)(ws + WS_C1), 896}, 0, uc); }
      grid.sync();
      phase_mla_mid(p, j);
      grid.sync();
      { WSO(); const char* wb = ws + WS_WMLA + j * MLA_WBYTES;
        gemm_phase<2, 4>((const bf16_t*)(ws + WS_CQ), QL, (const bf16_t*)(wb + MLA_WUQT), R, 1536, QL, lds, MkBf16{(bf16_t*)(ws + WS_Q), 1536}, 0, uc);
        u0 = uc % gridDim.x; }
      { WSO(); const char* wb = ws + WS_WMLA + j * MLA_WBYTES;
        gemm_phase<2, 4>((const bf16_t*)(ws + WS_CKV), KVL, (const bf16_t*)(wb + MLA_WUKVT), R, 2048, KVL, lds, MkBf16{(bf16_t*)(ws + WS_KV), 2048}, u0, uc); }
      grid.sync();
      phase_attn_mla(p, ctx_out, lds);
      grid.sync();
      { WSO(); const char* wb = ws + WS_WMLA + j * MLA_WBYTES;
        gemm_phase<2, 4>((const bf16_t*)(ws + WS_O), 1024, (const bf16_t*)(wb + MLA_WOT), R, D, 1024, lds,
                         MkResid{(float*)(ws + WS_X32), (const float*)(ws + WS_MODV) + (size_t)layer * 5 * NMOD + 2 * D}, 0, uc); }
    } else if (kind == 1) {
      { WSO(); gemm_phase<2, 4>((const bf16_t*)(ws + WS_ACT), D, (const bf16_t*)(ws + WS_WCONV_IN), R, 3072, D, lds, MkBf16{(bf16_t*)(ws + WS_BCU), 3072}, 0, uc); }
      grid.sync();
      phase_conv_mid(p);
      grid.sync();
      { WSO(); gemm_phase<2, 4>((const bf16_t*)(ws + WS_G), D, (const bf16_t*)(ws + WS_WCONV_OUT), R, D, D, lds,
                                MkResid{(float*)(ws + WS_X32), (const float*)(ws + WS_MODV) + (size_t)layer * 5 * NMOD + 2 * D}, 0, uc); }
    } else {
      { WSO(); gemm_phase<2, 4>((const bf16_t*)(ws + WS_ACT), D, (const bf16_t*)(ws + WS_WGQA_QKV), R, 4096, D, lds, MkBf16{(bf16_t*)(ws + WS_QKV), 4096}, 0, uc); }
      grid.sync();
      phase_gqa_k(p);
      grid.sync();
      phase_attn_gqa(p, lds);
      grid.sync();
      { WSO(); gemm_phase<2, 4>((const bf16_t*)(ws + WS_OG), 2048, (const bf16_t*)(ws + WS_WGQA_O), R, D, 2048, lds,
                                MkResid{(float*)(ws + WS_X32), (const float*)(ws + WS_MODV) + (size_t)layer * 5 * NMOD + 2 * D}, 0, uc); }
    }
    grid.sync();
    if (STOP_AFTER == 2 * layer + 1) { if (DBG_PROBE) { dbg_probe(p); grid.sync(); } phase_norm<2, false>(p, 0); return; }
    phase_norm<1, false>(p, layer);
    grid.sync();
    phase_moe1(p, layer, lds);
    grid.sync();
    phase_moe2(p, layer, lds);
    grid.sync();
    if (STOP_AFTER == 2 * layer + 2) break;
  }
  phase_norm<2, true>(p, 0);
}

constexpr int DYN_LDS = 135168;

extern "C" void kernel_launch(void* const* d_in, const int* in_sizes, int n_in, void* d_out, int out_size, void* d_ws, size_t ws_size,
                              hipStream_t stream) {
  static int grid_blocks = 0;
  if (!grid_blocks) {
    int dev = 0, cus = 0, per_cu = 0;
    (void)hipGetDevice(&dev);
    (void)hipDeviceGetAttribute(&cus, hipDeviceAttributeMultiprocessorCount, dev);
    (void)hipFuncSetAttribute((const void*)fwd_megakernel, hipFuncAttributeMaxDynamicSharedMemorySize, DYN_LDS);
    (void)hipOccupancyMaxActiveBlocksPerMultiprocessor(&per_cu, fwd_megakernel, NTHR, DYN_LDS);
    grid_blocks = per_cu >= 1 ? cus : 0;
    if (ws_size < WS_END || n_in != N_IN) { fprintf(stderr, "kernel_launch: ws %zu < %zu or n_in %d\n", ws_size, (size_t)WS_END, n_in); grid_blocks = 0; }
    if (!grid_blocks) { fprintf(stderr, "kernel_launch: cannot launch (per_cu %d)\n", per_cu); return; }
  }
  Params p{};
  for (int i = 0; i < N_IN; ++i) p.in[i] = (const float*)d_in[i];
  p.out = (float*)d_out; p.ws = (char*)d_ws;
  {
    char* ws = p.ws; int nj = 0;
    for (int j = 0; j < 2; ++j) {
      char* wb = ws + WS_WMLA + j * MLA_WBYTES;
      p.jobs[nj++] = TJob{p.in[I_MLA_WDQ] + (size_t)j * D * QL, (bf16_t*)(wb + MLA_W1T), D, QL, 1, 0};
      p.jobs[nj++] = TJob{p.in[I_MLA_WDKV] + (size_t)j * D * 320, (bf16_t*)(wb + MLA_W1T), D, 320, 1, 512};
      p.jobs[nj++] = TJob{p.in[I_MLA_WUQ] + (size_t)j * QL * 1536, (bf16_t*)(wb + MLA_WUQT), QL, 1536, 1, 0};
      p.jobs[nj++] = TJob{p.in[I_MLA_WUKV] + (size_t)j * KVL * 2048, (bf16_t*)(wb + MLA_WUKVT), KVL, 2048, 1, 0};
      p.jobs[nj++] = TJob{p.in[I_MLA_WO] + (size_t)j * 1024 * D, (bf16_t*)(wb + MLA_WOT), 1024, D, 1, 0};
    }
    p.jobs[nj++] = TJob{p.in[I_CONV_WIN], (bf16_t*)(ws + WS_WCONV_IN), D, 3072, 1, 0};
    p.jobs[nj++] = TJob{p.in[I_CONV_WOUT], (bf16_t*)(ws + WS_WCONV_OUT), D, D, 1, 0};
    p.jobs[nj++] = TJob{p.in[I_GQA_WQKV], (bf16_t*)(ws + WS_WGQA_QKV), D, 4096, 1, 0};
    p.jobs[nj++] = TJob{p.in[I_GQA_WO], (bf16_t*)(ws + WS_WGQA_O), 2048, D, 1, 0};
  }
  void* args[] = {&p};
  hipError_t e = hipLaunchCooperativeKernel((void*)fwd_megakernel, dim3(grid_blocks), dim3(NTHR), args, DYN_LDS, stream);
  if (e != hipSuccess) fprintf(stderr, "cooperative launch failed: %s (grid %d)\n", hipGetErrorString(e), grid_blocks);
}
```

```cpp
#include <hip/hip_runtime.h>
#include <hip/hip_cooperative_groups.h>
#include <cstdio>
#include <cstdint>
namespace cg = cooperative_groups;

#define SANITIZE 1
#ifndef DBG_PROBE
#define DBG_PROBE 0
#endif
#ifndef STOP_AFTER
#define STOP_AFTER 8
#endif

#define LAS __attribute__((address_space(3)))
typedef unsigned short bf16_t;
typedef short bf16x8 __attribute__((ext_vector_type(8)));
typedef short s16x4 __attribute__((ext_vector_type(4)));
typedef float f32x4 __attribute__((ext_vector_type(4)));
typedef float f32x16 __attribute__((ext_vector_type(16)));
typedef unsigned u32x4 __attribute__((ext_vector_type(4)));
typedef unsigned u32x2 __attribute__((ext_vector_type(2)));

constexpr int D = 1024, NB = 4, SEQ = 4096, CTX = 256, RPB = SEQ + CTX, R = NB * RPB;
constexpr int DEPTH = 4, NMOD = 6 * D;
constexpr int MLA_H = 8, QL = 512, KVL = 256, NOPE = 128, ROPE = 64, MV = 128;
constexpr int GH = 16, GKV = 8, GD = 128;
constexpr int ME = 32, FF = 512;
constexpr float EPS = 1e-6f;
constexpr int NTHR = 512;

enum { I_X = 0, I_C, I_CTX, I_CCTX, I_WMOD, I_BMOD, I_NMG, I_NFG, I_MLA_WDQ, I_MLA_GQ, I_MLA_WUQ, I_MLA_WDKV, I_MLA_GKV, I_MLA_WUKV, I_MLA_WO,
       I_CONV_WIN, I_CONV_W, I_CONV_WOUT, I_GQA_WQKV, I_GQA_QG, I_GQA_KG, I_GQA_WO, I_MOE_WG, I_MOE_BG, I_MOE_WE, I_MOE_BE, I_MOE_GATE, I_MOE_UP, I_MOE_DOWN, I_FG, N_IN };

constexpr size_t al256(size_t x) { return (x + 255) / 256 * 256; }
constexpr size_t WS_BAR = 0;
constexpr size_t WS_CNT = 16384;
constexpr size_t WS_MODP = 16384 + 8192;
constexpr size_t WS_MODV = WS_MODP + (size_t)8 * 4 * 5 * NMOD * 4;
constexpr size_t WS_WTS = WS_MODV + (size_t)4 * 5 * NMOD * 4;
constexpr size_t WS_LIST = al256(WS_WTS + (size_t)2 * R * 4);
constexpr size_t WS_X32 = al256(WS_LIST + (size_t)32 * R * 4);
constexpr size_t WS_ACT = WS_X32 + (size_t)R * D * 4;
constexpr size_t WS_HID = WS_ACT + (size_t)R * D * 2;
constexpr size_t WS_Y = WS_HID + (size_t)(2 * R + 256) * FF * 2;
constexpr size_t WS_MIX = WS_Y + (size_t)2 * R * D * 2;
constexpr size_t MIX_BYTES = (size_t)R * (896 * 4 + 512 * 2 + 256 * 2 + 64 * 2 + 1536 * 2 + 2048 * 2 + 1024 * 2);
constexpr size_t WS_C1 = WS_MIX;
constexpr size_t WS_CQ = WS_C1 + (size_t)R * 896 * 4;
constexpr size_t WS_CKV = WS_CQ + (size_t)R * 512 * 2;
constexpr size_t WS_KPE = WS_CKV + (size_t)R * 256 * 2;
constexpr size_t WS_Q = WS_KPE + (size_t)R * 64 * 2;
constexpr size_t WS_KV = WS_Q + (size_t)R * 1536 * 2;
constexpr size_t WS_O = WS_KV + (size_t)R * 2048 * 2;
constexpr size_t WS_QKV = WS_MIX;
constexpr size_t WS_KN = WS_QKV + (size_t)R * 4096 * 2;
constexpr size_t WS_OG = WS_KN + (size_t)R * 1024 * 2;
constexpr size_t WS_BCU = WS_MIX;
constexpr size_t WS_G = WS_BCU + (size_t)R * 3072 * 2;
static_assert(WS_OG + (size_t)R * 2048 * 2 <= WS_MIX + MIX_BYTES, "gqa scratch");
static_assert(WS_G + (size_t)R * 1024 * 2 <= WS_MIX + MIX_BYTES, "conv scratch");
constexpr size_t WS_WT = al256(WS_MIX + MIX_BYTES);
constexpr size_t MLA_W1T = 0, MLA_WUQT = MLA_W1T + (size_t)896 * 1024 * 2, MLA_WUKVT = MLA_WUQT + (size_t)1536 * 512 * 2, MLA_WOT = MLA_WUKVT + (size_t)2048 * 256 * 2,
                 MLA_WBYTES = MLA_WOT + (size_t)1024 * 1024 * 2;
constexpr size_t WS_WMLA = WS_WT;
constexpr size_t WS_WCONV_IN = WS_WMLA + 2 * MLA_WBYTES;
constexpr size_t WS_WCONV_OUT = WS_WCONV_IN + (size_t)3072 * 1024 * 2;
constexpr size_t WS_WGQA_QKV = WS_WCONV_OUT + (size_t)1024 * 1024 * 2;
constexpr size_t WS_WGQA_O = WS_WGQA_QKV + (size_t)4096 * 1024 * 2;
constexpr size_t WS_WMOE = WS_WGQA_O + (size_t)1024 * 2048 * 2;
constexpr size_t MOE_WBYTES = (size_t)1024 * 1024 * 2 + (size_t)1024 * 512 * 2;
constexpr size_t WS_END = WS_WMOE + (size_t)DEPTH * ME * MOE_WBYTES;
static_assert(WS_END <= (size_t)1073741824, "workspace over 1 GiB");

struct TJob { const float* src; bf16_t* dst; int K, N, rmul, roff; };
struct Params {
  const float* in[N_IN];
  float* out;
  char* ws;
  TJob jobs[14];
};

typedef __bf16 bf16x2_t __attribute__((ext_vector_type(2)));
__device__ __forceinline__ unsigned cvtpk(float lo, float hi) { bf16x2_t v = {(__bf16)lo, (__bf16)hi}; return __builtin_bit_cast(unsigned, v); }
__device__ __forceinline__ float bf2f(unsigned short h) { return __uint_as_float((unsigned)h << 16); }
__device__ __forceinline__ float bflo(unsigned w) { return __uint_as_float(w << 16); }
__device__ __forceinline__ float bfhi(unsigned w) { return __uint_as_float(w & 0xffff0000u); }
__device__ __forceinline__ float wave_sum(float v) {
#pragma unroll
  for (int o = 32; o > 0; o >>= 1) v += __shfl_xor(v, o);
  return v;
}
__device__ __forceinline__ float silu_f(float x) { return x / (1.0f + __expf(-x)); }
__device__ __forceinline__ void glds16(const void* g, char* l) { __builtin_amdgcn_global_load_lds((const unsigned*)g, (LAS unsigned*)l, 16, 0, 0); }
__device__ __forceinline__ char* opaque_ptr(char* q) {
  unsigned lo = __builtin_amdgcn_readfirstlane((unsigned)(uintptr_t)q), hi = __builtin_amdgcn_readfirstlane((unsigned)((uintptr_t)q >> 32));
  asm volatile("" : "+s"(lo), "+s"(hi));
  return (char*)(((uintptr_t)hi << 32) | (uintptr_t)lo); }
__device__ __forceinline__ float rope_invf(int j, int half) { return exp2f(-(float)j * (13.287712379549449f / (float)half)); }


#define XB_TMO      128
#define XB_XCNT(j)  (256  + 64 * (j))
#define XB_XSUB(j)  (1280 + 64 * (j))
#define XB_XGEN(j)  (2304 + 64 * (j))
#define XB_TOP      3328
#define XB_TOPGEN   3392
#define XCD_BAR_WORDS 3456
#define XB_SPIN_CAP (1u << 22)
__device__ __forceinline__ unsigned xb_ld(unsigned* p)              { return __hip_atomic_load(p, __ATOMIC_RELAXED, __HIP_MEMORY_SCOPE_AGENT); }
__device__ __forceinline__ unsigned xb_add(unsigned* p, unsigned v) { return __hip_atomic_fetch_add(p, v, __ATOMIC_RELAXED, __HIP_MEMORY_SCOPE_AGENT); }
__device__ __forceinline__ unsigned xb_xcc_id() { return (unsigned)__builtin_amdgcn_s_getreg((3 << 11) | 20) & 0xFu; }
#define XB_SPIN(cond, bar) do { unsigned _sp = 0; while (cond) { __builtin_amdgcn_s_sleep(1); \
    if ((++_sp & 255u) == 0u) { if (xb_ld(&(bar)[XB_TMO])) break; if (_sp > XB_SPIN_CAP) { atomicAdd(&(bar)[XB_TMO], 1u); break; } } } } while (0)
struct XcdBarrier { unsigned* bar; unsigned x; volatile LAS unsigned* st; };
__device__ __forceinline__ XcdBarrier xcd_barrier_post(unsigned* bar, volatile LAS unsigned* st) {
  XcdBarrier b; b.bar = bar; b.x = xb_xcc_id(); b.st = st;
  if (threadIdx.x == 0) (void)xb_add(&bar[XB_XCNT(b.x)], 1u);
  return b;
}
__device__ __forceinline__ void xcd_barrier_complete(unsigned* bar, unsigned x, unsigned& nloc, unsigned& nx) {
  const unsigned G = gridDim.x * gridDim.y * gridDim.z;
  unsigned sum, cnt, mine, sp = 0u;
  for (;;) {
    sum = 0u; cnt = 0u; mine = 0u;
#pragma unroll
    for (unsigned j = 0; j < 16; ++j) { const unsigned c = xb_ld(&bar[XB_XCNT(j)]); sum += c; cnt += (c > 0u) ? 1u : 0u; mine = (j == x) ? c : mine; }
    if (sum == G) break;
    __builtin_amdgcn_s_sleep(1);
    if ((++sp & 255u) == 0u) { if (xb_ld(&bar[XB_TMO])) break; if (sp > XB_SPIN_CAP) { atomicAdd(&bar[XB_TMO], 1u); break; } }
  }
  nloc = mine > 0u ? mine : 1u; nx = cnt > 0u ? cnt : 1u;
}
__device__ __forceinline__ void xcd_barrier(const XcdBarrier& b) {
  asm volatile("s_waitcnt vmcnt(0)" ::: "memory");
  __syncthreads();
  if (threadIdx.x == 0) {
    unsigned* bar = b.bar;
    __builtin_amdgcn_s_waitcnt(0);
    unsigned nloc = b.st[0], nx = b.st[1];
    if (nloc == 0u) { xcd_barrier_complete(bar, b.x, nloc, nx); b.st[0] = nloc; b.st[1] = nx; }
    const unsigned old = xb_add(&bar[XB_XSUB(b.x)], 1u);
    const unsigned gen = old / nloc;
    if (old + 1u == (gen + 1u) * nloc) {
      __builtin_amdgcn_fence(__ATOMIC_RELEASE, "agent");
      asm volatile("s_waitcnt vmcnt(0)" ::: "memory");
      const unsigned og = xb_add(&bar[XB_TOP], 1u);
      const unsigned tg = og / nx;
      if (og + 1u == (tg + 1u) * nx) xb_add(&bar[XB_TOPGEN], 1u);
      else XB_SPIN(xb_ld(&bar[XB_TOPGEN]) == tg, bar);
      __builtin_amdgcn_fence(__ATOMIC_ACQUIRE, "agent");
      xb_add(&bar[XB_XGEN(b.x)], 1u);
      asm volatile("s_waitcnt vmcnt(0)" ::: "memory");
    } else {
      XB_SPIN(xb_ld(&bar[XB_XGEN(b.x)]) == gen, bar);
      __builtin_amdgcn_fence(__ATOMIC_ACQUIRE, "agent");
      asm volatile("s_waitcnt vmcnt(0)" ::: "memory");
    }
  }
  __syncthreads();
}

template <int WM, int WN> struct GemmCfg { static constexpr int BM = WM * 64, BN = WN * 64, A_BYTES = BM * 128, STAGE = (BM + BN) * 128; };

template <int WM, int WN, class ARow, class Epi>
__device__ __forceinline__ void gemm_tile(const ARow& arow, const bf16_t* __restrict__ Bt, int ldb, int K, char* lds, const Epi& epi) {
  constexpr int BM = WM * 64, BN = WN * 64, A_BYTES = BM * 128, STAGE = (BM + BN) * 128;
  int tid = threadIdx.x; asm volatile("" : "+v"(tid));
  const int wid = tid >> 6, lane = tid & 63, fr = lane & 15, fq = lane >> 4;
  const int wm = wid / WN, wn = wid % WN;
  const int srow = tid >> 3, pc = tid & 7, lc = pc ^ (srow & 7);
  const bf16_t* ap[BM / 64]; const bf16_t* bp[BN / 64];
#pragma unroll
  for (int i = 0; i < BM / 64; ++i) ap[i] = arow(srow + 64 * i) + lc * 8;
#pragma unroll
  for (int i = 0; i < BN / 64; ++i) bp[i] = Bt + (size_t)(srow + 64 * i) * ldb + lc * 8;
  const int a_off = (wm * 64 + fr) * 128, b_off = A_BYTES + (wn * 64 + fr) * 128;
  const int ch0 = ((fq) ^ (fr & 7)) * 16, ch1 = ((4 + fq) ^ (fr & 7)) * 16;
  f32x4 acc[4][4];
#pragma unroll
  for (int m = 0; m < 4; ++m)
#pragma unroll
    for (int n = 0; n < 4; ++n) acc[m][n] = (f32x4){0.f, 0.f, 0.f, 0.f};
  const int nk = K >> 6;
  {
    char* base = lds;
#pragma unroll
    for (int i = 0; i < BM / 64; ++i) glds16(ap[i], base + i * 8192 + tid * 16);
#pragma unroll
    for (int i = 0; i < BN / 64; ++i) glds16(bp[i], base + A_BYTES + i * 8192 + tid * 16);
  }
  for (int kt = 0; kt < nk; ++kt) {
    asm volatile("s_waitcnt vmcnt(0)" ::: "memory");
    __syncthreads();
    if (kt + 1 < nk) {
      char* base = lds + ((kt + 1) & 1) * STAGE; const int ko = (kt + 1) * 64;
#pragma unroll
      for (int i = 0; i < BM / 64; ++i) glds16(ap[i] + ko, base + i * 8192 + tid * 16);
#pragma unroll
      for (int i = 0; i < BN / 64; ++i) glds16(bp[i] + ko, base + A_BYTES + i * 8192 + tid * 16);
    }
    const char* sb = lds + (kt & 1) * STAGE;
#pragma unroll
    for (int kk = 0; kk < 2; ++kk) {
      const int ch = kk ? ch1 : ch0;
      bf16x8 af[4], bfr[4];
#pragma unroll
      for (int m = 0; m < 4; ++m) af[m] = *(const bf16x8*)(sb + a_off + m * 2048 + ch);
#pragma unroll
      for (int n = 0; n < 4; ++n) bfr[n] = *(const bf16x8*)(sb + b_off + n * 2048 + ch);
#pragma unroll
      for (int m = 0; m < 4; ++m)
#pragma unroll
        for (int n = 0; n < 4; ++n) acc[m][n] = __builtin_amdgcn_mfma_f32_16x16x32_bf16(bfr[n], af[m], acc[m][n], 0, 0, 0);
    }
  }
#pragma unroll
  for (int m = 0; m < 4; ++m)
#pragma unroll
    for (int n = 0; n < 4; ++n) epi(wm * 64 + m * 16 + fr, wn * 64 + n * 16 + fq * 4, acc[m][n]);
  __syncthreads();
}

struct ARowLin { const bf16_t* A; int lda; __device__ __forceinline__ const bf16_t* operator()(int r) const { return A + (size_t)r * lda; } };
struct ARowGather { const bf16_t* A; const int* list; int nvalid; __device__ __forceinline__ const bf16_t* operator()(int r) const {
  const int rr = r < nvalid ? r : 0; return A + (size_t)(list[rr] >> 1) * D; } };

struct EpiBf16 { bf16_t* C; int ldc; __device__ __forceinline__ void operator()(int r, int c, f32x4 v) const {
  u32x2 w = {cvtpk(v[0], v[1]), cvtpk(v[2], v[3])}; *(u32x2*)(C + (size_t)r * ldc + c) = w; } };
struct EpiF32 { float* C; int ldc; __device__ __forceinline__ void operator()(int r, int c, f32x4 v) const { *(f32x4*)(C + (size_t)r * ldc + c) = v; } };
struct EpiResid { float* X; const float* gate; int row0, c0; __device__ __forceinline__ void operator()(int r, int c, f32x4 v) const {
  const int row = row0 + r, b = row / RPB, ii = row - b * RPB, bsel = ii < CTX ? 4 : b;
  const f32x4 g = *(const f32x4*)(gate + (size_t)bsel * NMOD + c0 + c);
  float* xp = X + (size_t)row * D + c0 + c; f32x4 x = *(f32x4*)xp; x += g * v; *(f32x4*)xp = x; } };
struct EpiMoeGU { bf16_t* H; int c0, nvalid; __device__ __forceinline__ void operator()(int r, int c, f32x4 v) const {
  if (r < nvalid) { const float h0 = silu_f(v[0]) * v[1], h1 = silu_f(v[2]) * v[3]; *(unsigned*)(H + (size_t)r * FF + ((c0 + c) >> 1)) = cvtpk(h0, h1); } } };
struct EpiMoeDown { bf16_t* Y; const int* list; const float* wts; int c0, nvalid; __device__ __forceinline__ void operator()(int r, int c, f32x4 v) const {
  if (r < nvalid) { const int aid = list[r]; const float w = wts[aid]; u32x2 o = {cvtpk(v[0] * w, v[1] * w), cvtpk(v[2] * w, v[3] * w)};
    *(u32x2*)(Y + (size_t)aid * D + c0 + c) = o; } } };

template <int WM, int WN, class EpiMaker>
__device__ __forceinline__ void gemm_phase(const bf16_t* A, int lda, const bf16_t* Bt, int M, int N, int K, char* lds, const EpiMaker& mk, int unit0, int& ucount) {
  constexpr int BM = WM * 64, BN = WN * 64;
  const int nM = M / BM, nN = N / BN, nT = nM * nN;
  for (int t = blockIdx.x - unit0; t < nT; t += gridDim.x) {
    if (t < 0) continue;
    const int mt = t / nN, nt = t - mt * nN;
    ARowLin ar{A + (size_t)mt * BM * lda, lda};
    gemm_tile<WM, WN>(ar, Bt + (size_t)nt * BN * K, K, K, lds, mk(mt * BM, nt * BN));
  }
  ucount = nT;
}

template <int DK> struct AttnCfg {
  static constexpr int KROW = DK * 2;
  static constexpr int SHM_V = 64 * 128 * 2, SHM_K = 64 * KROW;
  static constexpr int SHM = 2 * SHM_V + 2 * SHM_K + 8 * 64 * 4;
};
#define SBAR() __builtin_amdgcn_sched_barrier(0)
__device__ __forceinline__ int crow(int r, int hi) { return (r & 3) + 8 * (r >> 2) + 4 * hi; }
__device__ __forceinline__ int v_st(int k, int c) { const int kk = (k & ~0xC) | ((k & 4) << 1) | ((k & 8) >> 1); return ((kk >> 3) * 4 + (c >> 5)) * 512 + ((kk & 7) * 32 + (c & 31)) * 2; }
__device__ __forceinline__ int v_rd_base(int lane) { return ((lane & 3) << 3) | (((lane >> 2) & 3) << 6) | (((lane >> 4) & 1) << 5) | (((lane >> 5) & 1) << 8); }
constexpr int v_rd_off(int d0, int ks, int half) { return d0 * 512 + ks * 4096 + half * 2048; }
template <int OFF> __device__ __forceinline__ s16x4 tr_read(int vb) {
  s16x4 r; asm volatile("ds_read_b64_tr_b16 %0, %1 offset:%2" : "=&v"(r) : "v"(vb), "i"(OFF) : "memory"); return r;
}
template <int D0> __device__ __forceinline__ void pv_one(f32x16& od, int vb, bf16x8 pa0, bf16x8 pa1, bf16x8 pa2, bf16x8 pa3) {
  const s16x4 l0 = tr_read<v_rd_off(D0, 0, 0)>(vb), h0 = tr_read<v_rd_off(D0, 0, 1)>(vb), l1 = tr_read<v_rd_off(D0, 1, 0)>(vb), h1 = tr_read<v_rd_off(D0, 1, 1)>(vb);
  const s16x4 l2 = tr_read<v_rd_off(D0, 2, 0)>(vb), h2 = tr_read<v_rd_off(D0, 2, 1)>(vb), l3 = tr_read<v_rd_off(D0, 3, 0)>(vb), h3 = tr_read<v_rd_off(D0, 3, 1)>(vb);
  asm volatile("s_waitcnt lgkmcnt(0)" ::: "memory"); SBAR();
#define PK(L, H) (bf16x8){L[0], L[1], L[2], L[3], H[0], H[1], H[2], H[3]}
  od = __builtin_amdgcn_mfma_f32_32x32x16_bf16(pa0, PK(l0, h0), od, 0, 0, 0);
  od = __builtin_amdgcn_mfma_f32_32x32x16_bf16(pa1, PK(l1, h1), od, 0, 0, 0);
  od = __builtin_amdgcn_mfma_f32_32x32x16_bf16(pa2, PK(l2, h2), od, 0, 0, 0);
  od = __builtin_amdgcn_mfma_f32_32x32x16_bf16(pa3, PK(l3, h3), od, 0, 0, 0);
#undef PK
}
__device__ __forceinline__ void pv_d0(f32x16* o, int vb, bf16x8 pa0, bf16x8 pa1, bf16x8 pa2, bf16x8 pa3) {
  pv_one<0>(o[0], vb, pa0, pa1, pa2, pa3); pv_one<1>(o[1], vb, pa0, pa1, pa2, pa3); pv_one<2>(o[2], vb, pa0, pa1, pa2, pa3); pv_one<3>(o[3], vb, pa0, pa1, pa2, pa3);
}
constexpr float ATT_THR = 8.f;
template <int DK> __device__ __forceinline__ void partialSM(f32x16& p0, f32x16& p1, float& m_reg, float& mn, float& alpha) {
  constexpr float SCALE = DK == 192 ? 0.07216878364870322f : 0.08838834764831845f;
  constexpr float C = SCALE * 1.4426950408889634f;
  float pmax = p0[0];
#pragma unroll
  for (int r = 1; r < 16; ++r) pmax = fmaxf(pmax, p0[r]);
#pragma unroll
  for (int r = 0; r < 16; ++r) pmax = fmaxf(pmax, p1[r]);
  { auto rr = __builtin_amdgcn_permlane32_swap(__float_as_uint(pmax), __float_as_uint(pmax), false, false);
    pmax = fmaxf(__uint_as_float(rr[0]), __uint_as_float(rr[1])); }
  if (__builtin_expect(__all(pmax - m_reg <= ATT_THR / SCALE), 1)) { mn = m_reg; alpha = 1.f; }
  else { mn = fmaxf(m_reg, pmax); alpha = __builtin_amdgcn_exp2f((m_reg - mn) * C); m_reg = mn; }
  const float mnC = -mn * C;
#pragma unroll
  for (int r = 0; r < 16; ++r) p0[r] = fmaf(p0[r], C, mnC);
#pragma unroll
  for (int r = 0; r < 16; ++r) p1[r] = fmaf(p1[r], C, mnC);
#pragma unroll
  for (int r = 0; r < 16; ++r) p0[r] = __builtin_amdgcn_exp2f(p0[r]);
}
__device__ __forceinline__ void finishSM(f32x16& p0, f32x16& p1, float alpha, float& l_reg, bf16x8& pa0, bf16x8& pa1, bf16x8& pa2, bf16x8& pa3) {
#pragma unroll
  for (int r = 0; r < 16; ++r) p1[r] = __builtin_amdgcn_exp2f(p1[r]);
  float ps = 0;
#pragma unroll
  for (int r = 0; r < 16; ++r) ps += p0[r];
#pragma unroll
  for (int r = 0; r < 16; ++r) ps += p1[r];
  { auto rr = __builtin_amdgcn_permlane32_swap(__float_as_uint(ps), __float_as_uint(ps), false, false);
    ps = __uint_as_float(rr[0]) + __uint_as_float(rr[1]); }
  l_reg = l_reg * alpha + ps;
#define PK4(P, BASE, OUT) do { unsigned a0 = cvtpk(P[BASE + 0], P[BASE + 1]), a1 = cvtpk(P[BASE + 2], P[BASE + 3]);   \
    unsigned b0 = cvtpk(P[BASE + 4], P[BASE + 5]), b1 = cvtpk(P[BASE + 6], P[BASE + 7]);                              \
    auto r0 = __builtin_amdgcn_permlane32_swap(a0, b0, false, false); auto r1 = __builtin_amdgcn_permlane32_swap(a1, b1, false, false); \
    u32x4 w = {r0[0], r1[0], r0[1], r1[1]}; OUT = *reinterpret_cast<bf16x8*>(&w); } while (0)
  PK4(p0, 0, pa0); PK4(p0, 8, pa1); PK4(p1, 0, pa2); PK4(p1, 8, pa3);
#undef PK4
}
template <int DK> __device__ __forceinline__ void qkt(f32x16& p0, f32x16& p1, const char* Ks, const bf16x8* qr, const int* kro) {
  constexpr int KROW = DK * 2;
  p0 = f32x16{}; p1 = f32x16{};
#pragma unroll
  for (int d0 = 0; d0 < DK / 16; ++d0) {
    bf16x8 b0 = *reinterpret_cast<const bf16x8*>(Ks + kro[d0 & 3] + (d0 >> 2) * 128);
    bf16x8 b1 = *reinterpret_cast<const bf16x8*>(Ks + kro[d0 & 3] + (d0 >> 2) * 128 + 32 * KROW);
    p0 = __builtin_amdgcn_mfma_f32_32x32x16_bf16(b0, qr[d0], p0, 0, 0, 0);
    p1 = __builtin_amdgcn_mfma_f32_32x32x16_bf16(b1, qr[d0], p1, 0, 0, 0); }
}

template <int DK, int ldq, int ldk, int ldv, int ldo>
__device__ __forceinline__ void attn_unit(const bf16_t* __restrict__ Qb, const bf16_t* __restrict__ Kh, const bf16_t* __restrict__ Kp,
                                          const bf16_t* __restrict__ Vh, bf16_t* __restrict__ Ob, int nkeys, bool rope, int qpos0,
                                          const float* __restrict__ qg, char* lds) {
  using Cfg = AttnCfg<DK>;
  constexpr int KROW = Cfg::KROW, SHM_V = Cfg::SHM_V, SHM_K = Cfg::SHM_K, ND0 = DK / 16;
  int tid = threadIdx.x; asm volatile("" : "+v"(tid));
  const int wid = tid >> 6, lane = tid & 63, r32 = lane & 31, hi = lane >> 5;
  char* V_lds = lds; char* K_lds = lds + 2 * SHM_V;
  float* wsl = (float*)(lds + 2 * SHM_V + 2 * SHM_K) + wid * 64; float* li_l = wsl; float* al_l = wsl + 32;
  float m_reg = -1e30f, l_reg = 0; f32x16 o[4] = {}; bf16x8 qr[ND0];
  {
    const int qrow = wid * 32 + r32;
    const bf16_t* Qw = Qb + (size_t)qrow * ldq + hi * 8;
    float qf[ND0][8];
#pragma unroll
    for (int d0 = 0; d0 < ND0; ++d0) { const u32x4 w = *reinterpret_cast<const u32x4*>(Qw + d0 * 16);
#pragma unroll
      for (int e = 0; e < 4; ++e) { qf[d0][2 * e] = bflo(w[e]); qf[d0][2 * e + 1] = bfhi(w[e]); } }
    const int qpos = qpos0 + qrow; const float prow = (float)(qpos >> 6), pcol = (float)(qpos & 63);
    int hio = hi; asm volatile("" : "+v"(hio));
    if constexpr (DK == 128) {
      float ss = 0.f;
#pragma unroll
      for (int d0 = 0; d0 < 8; ++d0)
#pragma unroll
        for (int e = 0; e < 8; ++e) ss += qf[d0][e] * qf[d0][e];
      ss += __shfl_xor(ss, 32);
      const float rs = rsqrtf(ss * (1.0f / 128.0f) + EPS);
#pragma unroll
      for (int d0 = 0; d0 < 8; ++d0) { const f32x4 g0 = *(const f32x4*)(qg + d0 * 16 + hi * 8), g1 = *(const f32x4*)(qg + d0 * 16 + hi * 8 + 4);
#pragma unroll
        for (int e = 0; e < 4; ++e) { qf[d0][e] *= rs * g0[e]; qf[d0][4 + e] *= rs * g1[e]; } }
      if (rope) {
#pragma unroll
        for (int hf = 0; hf < 2; ++hf) { const float pos = hf ? pcol : prow;
#pragma unroll
          for (int dd = 0; dd < 2; ++dd)
#pragma unroll
            for (int e = 0; e < 8; ++e) { const int j = dd * 16 + hio * 8 + e; const float ang = pos * rope_invf(j, 32); const float cs = __cosf(ang), sn = __sinf(ang);
              const float x1 = qf[hf * 4 + dd][e], x2 = qf[hf * 4 + dd + 2][e]; qf[hf * 4 + dd][e] = x1 * cs - x2 * sn; qf[hf * 4 + dd + 2][e] = x1 * sn + x2 * cs; } }
      }
    } else {
      if (rope) {
#pragma unroll
        for (int hf = 0; hf < 2; ++hf) { const float pos = hf ? pcol : prow;
#pragma unroll
          for (int e = 0; e < 8; ++e) { const int j = hio * 8 + e; const float ang = pos * rope_invf(j, 16); const float cs = __cosf(ang), sn = __sinf(ang);
            const float x1 = qf[8 + hf * 2][e], x2 = qf[9 + hf * 2][e]; qf[8 + hf * 2][e] = x1 * cs - x2 * sn; qf[9 + hf * 2][e] = x1 * sn + x2 * cs; } }
      }
    }
#pragma unroll
    for (int d0 = 0; d0 < ND0; ++d0) { u32x4 w = {cvtpk(qf[d0][0], qf[d0][1]), cvtpk(qf[d0][2], qf[d0][3]), cvtpk(qf[d0][4], qf[d0][5]), cvtpk(qf[d0][6], qf[d0][7])};
      qr[d0] = *reinterpret_cast<bf16x8*>(&w); }
  }
  int kro[4];
#pragma unroll
  for (int bq = 0; bq < 4; ++bq) kro[bq] = r32 * KROW + (((2 * bq + hi) ^ (r32 & 7)) << 4);
  const int sr = tid >> 4, sc = (tid & 15) * 8, vst0 = v_st(sr, sc), vst1 = v_st(32 + sr, sc);
  const int pr = tid >> 3, pcc = (tid & 7) * 8;
  const int vb0 = (int)(uintptr_t)(LAS char*)V_lds + v_rd_base(lane);
  bf16x8 vs0, vs1, ks0, ks1, kp0;
  const unsigned voff = sr * ldv + sc, koff = sr * ldk + sc, poff = pr * ROPE + pcc;
#define SLOAD(k0) do { const bf16_t* Vt = Vh + (size_t)(k0) * ldv; const bf16_t* Kt = Kh + (size_t)(k0) * ldk; \
    vs0 = *(const bf16x8*)(Vt + voff); vs1 = *(const bf16x8*)(Vt + 32 * ldv + voff); \
    ks0 = *(const bf16x8*)(Kt + koff); ks1 = *(const bf16x8*)(Kt + 32 * ldk + koff); \
    if constexpr (DK == 192) kp0 = *(const bf16x8*)(Kp + (size_t)(k0) * ROPE + poff); } while (0)
#define SWRITE(b) do { *(bf16x8*)(V_lds + (b) * SHM_V + vst0) = vs0; *(bf16x8*)(V_lds + (b) * SHM_V + vst1) = vs1; const int kc = sc * 2; \
    *(bf16x8*)(K_lds + (b) * SHM_K + sr * KROW + (kc ^ ((sr & 7) << 4))) = ks0; \
    *(bf16x8*)(K_lds + (b) * SHM_K + (32 + sr) * KROW + (kc ^ ((sr & 7) << 4))) = ks1; \
    if constexpr (DK == 192) *(bf16x8*)(K_lds + (b) * SHM_K + pr * KROW + ((256 + pcc * 2) ^ ((pr & 7) << 4))) = kp0; } while (0)
#define RESC(a) do { if (__any((a) < 1.f)) { if (hi == 0) al_l[r32] = (a); asm volatile("s_waitcnt lgkmcnt(0)" ::: "memory"); \
    for (int d = 0; d < 4; ++d) for (int r = 0; r < 16; ++r) o[d][r] *= al_l[crow(r, hi)]; } } while (0)
  f32x16 pA0, pA1, pB0, pB1; float mnA, mnB, alA, alB; bf16x8 pa0, pa1, pa2, pa3; const int NT = nkeys / 64;
  SLOAD(0); SWRITE(0); __syncthreads();
  qkt<DK>(pA0, pA1, K_lds, qr, kro); partialSM<DK>(pA0, pA1, m_reg, mnA, alA);
  SLOAD(64); SWRITE(1); __syncthreads();
  for (int j = 1; j + 1 < NT; j += 2) {
    SBAR(); qkt<DK>(pB0, pB1, K_lds + SHM_K, qr, kro);
    finishSM(pA0, pA1, alA, l_reg, pa0, pa1, pa2, pa3); SBAR();
    SLOAD((j + 1) * 64); SBAR();
    pv_d0(o, vb0, pa0, pa1, pa2, pa3); partialSM<DK>(pB0, pB1, m_reg, mnB, alB);
    __syncthreads(); SWRITE(0);
    RESC(alB); __syncthreads();
    SBAR(); qkt<DK>(pA0, pA1, K_lds, qr, kro);
    finishSM(pB0, pB1, alB, l_reg, pa0, pa1, pa2, pa3); SBAR();
    SLOAD((j + 2) * 64); SBAR();
    pv_d0(o, vb0 + SHM_V, pa0, pa1, pa2, pa3); partialSM<DK>(pA0, pA1, m_reg, mnA, alA);
    __syncthreads(); SWRITE(1);
    RESC(alA); __syncthreads();
  }
  SBAR(); qkt<DK>(pB0, pB1, K_lds + SHM_K, qr, kro);
  finishSM(pA0, pA1, alA, l_reg, pa0, pa1, pa2, pa3); SBAR();
  pv_d0(o, vb0, pa0, pa1, pa2, pa3); partialSM<DK>(pB0, pB1, m_reg, mnB, alB);
  __syncthreads(); RESC(alB);
  finishSM(pB0, pB1, alB, l_reg, pa0, pa1, pa2, pa3); SBAR();
  pv_d0(o, vb0 + SHM_V, pa0, pa1, pa2, pa3);
  if (hi == 0) li_l[r32] = l_reg; asm volatile("s_waitcnt lgkmcnt(0)" ::: "memory");
  float rli[16];
#pragma unroll
  for (int r = 0; r < 16; ++r) rli[r] = __builtin_amdgcn_rcpf(li_l[crow(r, hi)]);
  bf16_t* Ow = Ob + (size_t)(wid * 32) * ldo;
#pragma unroll
  for (int r = 0; r < 16; ++r) { const int orow = crow(r, hi);
#pragma unroll
    for (int d0 = 0; d0 < 4; ++d0) Ow[(size_t)orow * ldo + d0 * 32 + r32] = (bf16_t)(cvtpk(o[d0][r] * rli[r], 0.f) & 0xffffu); }
  __syncthreads();
#undef SLOAD
#undef SWRITE
#undef RESC
}

__device__ __forceinline__ void tconv_tile(const float* __restrict__ src, int ldn, int k0, int n0, bf16_t* __restrict__ dst, int ldk, int rmul, int roff, float* lw, int lane) {
  const float* s = src + (size_t)k0 * ldn + n0 + lane;
#pragma unroll
  for (int kb = 0; kb < 64; kb += 16) {
    float v[16];
#pragma unroll
    for (int i = 0; i < 16; ++i) v[i] = s[(size_t)(kb + i) * ldn];
#pragma unroll
    for (int i = 0; i < 16; ++i) lw[(kb + i) * 65 + lane] = v[i];
  }
  const int kc = (lane & 7) * 8;
#pragma unroll
  for (int it = 0; it < 8; ++it) {
    const int n = it * 8 + (lane >> 3);
    float v[8];
#pragma unroll
    for (int j = 0; j < 8; ++j) v[j] = lw[(kc + j) * 65 + n];
    u32x4 w = {cvtpk(v[0], v[1]), cvtpk(v[2], v[3]), cvtpk(v[4], v[5]), cvtpk(v[6], v[7])};
    *(u32x4*)(dst + (size_t)((n0 + n) * rmul + roff) * ldk + k0 + kc) = w;
  }
}

__device__ __forceinline__ void phase_prep(const Params& p, char* lds) {
  int tid = threadIdx.x; asm volatile("" : "+v"(tid));
  const int wid = tid >> 6, lane = tid & 63;
  const int gw = blockIdx.x * 8 + wid, nw = gridDim.x * 8;
  char* ws = opaque_ptr(p.ws);
  float* lw = (float*)lds + wid * (64 * 65);
  for (int t = gw; t < DEPTH * ME * 384; t += nw) {
    const int le = t / 384, tt = t - le * 384, which = tt >> 7, ti = tt & 127;
    bf16_t* wgu = (bf16_t*)(ws + WS_WMOE + (size_t)le * MOE_WBYTES); bf16_t* wd = wgu + 1024 * 1024;
    if (which < 2) { const float* src = p.in[which == 0 ? I_MOE_GATE : I_MOE_UP] + (size_t)le * D * FF;
      const int kt = ti >> 3, nt = ti & 7; tconv_tile(src, FF, kt * 64, nt * 64, wgu, D, 2, which, lw, lane); }
    else { const float* src = p.in[I_MOE_DOWN] + (size_t)le * FF * D;
      const int kt = ti >> 4, nt = ti & 15; tconv_tile(src, D, kt * 64, nt * 64, wd, FF, 1, 0, lw, lane); }
  }
  {
    int base = 0;
#pragma unroll 1
    for (int q = 0; q < 14; ++q) {
      const float* jsrc = p.jobs[q].src; bf16_t* jdst = p.jobs[q].dst; const int jK = p.jobs[q].K, jN = p.jobs[q].N, jroff = p.jobs[q].roff;
      const int nnt = jN >> 6, ntile = (jK >> 6) * nnt;
      for (int t = gw - base; t < ntile; t += nw) { if (t < 0) continue; const int kt = t / nnt, nt = t - kt * nnt;
        tconv_tile(jsrc, jN, kt * 64, nt * 64, jdst, jK, 1, jroff, lw, lane); }
      base = (base + ntile) % nw;
    }
  }
  for (int j = 0; j < 2; ++j) { u32x4* z = (u32x4*)(ws + WS_WMLA + j * MLA_WBYTES + MLA_W1T + (size_t)832 * 1024 * 2);
    for (int i = blockIdx.x * NTHR + tid; i < 64 * 1024 * 2 / 16; i += gridDim.x * NTHR) z[i] = (u32x4){0u, 0u, 0u, 0u}; }
  if (blockIdx.x == 0 && tid < DEPTH * ME) ((int*)(ws + WS_CNT))[tid] = 0;
  if (blockIdx.x == 0 && tid == 0) ((int*)(ws + WS_CNT))[1000] = 0;
  for (int r = gw; r < R; r += nw) {
    const int b = r / RPB, ii = r - b * RPB;
    const f32x4* src = (const f32x4*)(ii < CTX ? p.in[I_CTX] + ((size_t)b * CTX + ii) * D : p.in[I_X] + ((size_t)b * SEQ + (ii - CTX)) * D);
    f32x4* dst = (f32x4*)(ws + WS_X32) + (size_t)r * (D / 4);
#pragma unroll
    for (int q = 0; q < 4; ++q) dst[lane + 64 * q] = src[lane + 64 * q];
  }
  {
    float* sc = (float*)lds;
    __syncthreads();
    for (int u = blockIdx.x; u < DEPTH * 12 * 8; u += gridDim.x) {
      const int i = u / 96, rem = u - i * 96, cch = rem >> 3, ks = rem & 7;
      __syncthreads();
      for (int e = tid; e < 5 * 128; e += NTHR) { const int b = e >> 7, k = ks * 128 + (e & 127); const float c = b < 4 ? p.in[I_C][b * D + k] : p.in[I_CCTX][k]; sc[e] = silu_f(c); }
      __syncthreads();
      const int col = cch * 512 + tid;
      const float* w = p.in[I_WMOD] + (size_t)i * D * NMOD + (size_t)(ks * 128) * NMOD + col;
      float a0 = 0, a1 = 0, a2 = 0, a3 = 0, a4 = 0;
#pragma unroll 8
      for (int k = 0; k < 128; ++k) { const float wv = w[(size_t)k * NMOD]; a0 += sc[k] * wv; a1 += sc[128 + k] * wv; a2 += sc[256 + k] * wv; a3 += sc[384 + k] * wv; a4 += sc[512 + k] * wv; }
      float* mp = (float*)(ws + WS_MODP) + ((size_t)(ks * DEPTH + i) * 5) * NMOD + col;
      mp[0] = a0; mp[NMOD] = a1; mp[2 * NMOD] = a2; mp[3 * NMOD] = a3; mp[4 * NMOD] = a4;
    }
    __syncthreads();
  }
}
__device__ __forceinline__ void phase_modfin(const Params& p) {
  const float* mp = (const float*)(p.ws + WS_MODP); float* mv = (float*)(p.ws + WS_MODV);
  for (int e = blockIdx.x * NTHR + threadIdx.x; e < DEPTH * 5 * NMOD; e += gridDim.x * NTHR) {
    const int i = e / (5 * NMOD), col = e % NMOD;
    float s = p.in[I_BMOD][i * NMOD + col];
#pragma unroll
    for (int ks = 0; ks < 8; ++ks) s += mp[(size_t)ks * DEPTH * 5 * NMOD + e];
    mv[e] = s;
  }
}

template <int MODE, bool COMBINE>
__device__ __forceinline__ void phase_norm(const Params& p, int layer) {
  int tid = threadIdx.x; asm volatile("" : "+v"(tid));
  const int wid = tid >> 6, lane = tid & 63;
  const int gw = blockIdx.x * 8 + wid, nw = gridDim.x * 8;
  char* ws = opaque_ptr(p.ws);
  const float* modv = (const float*)(ws + WS_MODV);
  const bf16_t* Y = (const bf16_t*)(ws + WS_Y);
  for (int r = gw; r < R; r += nw) {
    const int b = r / RPB, ii = r - b * RPB; const bool is_ctx = ii < CTX; const int bsel = is_ctx ? 4 : b;
    if (MODE == 2 && is_ctx) continue;
    float* xp = (float*)(ws + WS_X32) + (size_t)r * D;
    f32x4 v[4];
#pragma unroll
    for (int q = 0; q < 4; ++q) v[q] = *(const f32x4*)(xp + (lane + 64 * q) * 4);
    if (COMBINE) {
      const int pl = MODE == 2 ? DEPTH - 1 : layer - 1;
      if (!(pl == DEPTH - 1 && is_ctx)) {
        const float* g2 = modv + ((size_t)pl * 5 + bsel) * NMOD + 5 * D;
#pragma unroll
        for (int q = 0; q < 4; ++q) { const int c = (lane + 64 * q) * 4; const f32x4 g = *(const f32x4*)(g2 + c);
          const u32x2 y0 = *(const u32x2*)(Y + (size_t)(2 * r) * D + c), y1 = *(const u32x2*)(Y + (size_t)(2 * r + 1) * D + c);
          v[q][0] += g[0] * (bflo(y0[0]) + bflo(y1[0])); v[q][1] += g[1] * (bfhi(y0[0]) + bfhi(y1[0]));
          v[q][2] += g[2] * (bflo(y0[1]) + bflo(y1[1])); v[q][3] += g[3] * (bfhi(y0[1]) + bfhi(y1[1])); }
        if (MODE != 2) {
#pragma unroll
          for (int q = 0; q < 4; ++q) *(f32x4*)(xp + (lane + 64 * q) * 4) = v[q];
        }
      }
    }
    float ss = 0.f;
#pragma unroll
    for (int q = 0; q < 4; ++q) ss += v[q][0] * v[q][0] + v[q][1] * v[q][1] + v[q][2] * v[q][2] + v[q][3] * v[q][3];
    ss = wave_sum(ss);
    const float rs = rsqrtf(ss * (1.0f / D) + EPS);
    if (MODE == 2) {
      float* op = p.out + ((size_t)b * SEQ + (ii - CTX)) * D;
#pragma unroll
      for (int q = 0; q < 4; ++q) { const int c = (lane + 64 * q) * 4; const f32x4 g = *(const f32x4*)(p.in[I_FG] + c); f32x4 ov = v[q] * rs * g;
#ifdef SANITIZE
        for (int e = 0; e < 4; ++e) if (!(fabsf(ov[e]) < 1e30f)) ov[e] = DBG_PROBE ? 0.f : 1000.0f;
        if (DBG_PROBE && ((const int*)(ws + WS_CNT))[1000]) ov = (f32x4){1000.f, 1000.f, 1000.f, 1000.f};
#endif
        *(f32x4*)(op + c) = ov; }
      continue;
    }
    const float* ng = p.in[MODE == 0 ? I_NMG : I_NFG] + layer * D;
    const float* sh = modv + ((size_t)layer * 5 + bsel) * NMOD + (MODE == 0 ? 0 : 3) * D;
    const float* scl = sh + D;
    bf16_t* ap = (bf16_t*)(ws + WS_ACT) + (size_t)r * D;
    f32x4 f[4];
#pragma unroll
    for (int q = 0; q < 4; ++q) { const int c = (lane + 64 * q) * 4; const f32x4 g = *(const f32x4*)(ng + c), s1 = *(const f32x4*)(scl + c), s0 = *(const f32x4*)(sh + c);
      f[q] = (v[q] * rs * g) * (1.0f + s1) + s0;
      u32x2 w = {cvtpk(f[q][0], f[q][1]), cvtpk(f[q][2], f[q][3])}; *(u32x2*)(ap + c) = w; }
    if (MODE == 1) {
      if (layer == DEPTH - 1 && is_ctx) continue;
      const float* wg = p.in[I_MOE_WG] + (size_t)layer * D * 4; const float* we = p.in[I_MOE_WE] + (size_t)layer * D * ME;
      float gl[4] = {0.f, 0.f, 0.f, 0.f};
#pragma unroll
      for (int q = 0; q < 4; ++q)
#pragma unroll
        for (int e = 0; e < 4; ++e) { const int c = (lane + 64 * q) * 4 + e; const f32x4 w = *(const f32x4*)(wg + (size_t)c * 4);
          gl[0] += f[q][e] * w[0]; gl[1] += f[q][e] * w[1]; gl[2] += f[q][e] * w[2]; gl[3] += f[q][e] * w[3]; }
#pragma unroll
      for (int k = 0; k < 4; ++k) gl[k] = wave_sum(gl[k]);
      const float gm = fmaxf(fmaxf(gl[0], gl[1]), fmaxf(gl[2], gl[3]));
      float gp[4], gs = 0.f;
#pragma unroll
      for (int k = 0; k < 4; ++k) { gp[k] = __expf(gl[k] - gm); gs += gp[k]; }
      const float gsi = 1.0f / gs;
      int gsel = 0; float gbest = -1e30f, gw_ = 0.f;
#pragma unroll
      for (int k = 0; k < 4; ++k) { const float pr = gp[k] * gsi; const float sc = pr + p.in[I_MOE_BG][layer * 4 + k]; if (sc > gbest) { gbest = sc; gsel = k; gw_ = pr; } }
      gsel = __builtin_amdgcn_readfirstlane(gsel);
      float el[8] = {0.f, 0.f, 0.f, 0.f, 0.f, 0.f, 0.f, 0.f};
#pragma unroll
      for (int q = 0; q < 4; ++q)
#pragma unroll
        for (int e = 0; e < 4; ++e) { const int c = (lane + 64 * q) * 4 + e; const f32x4 w0 = *(const f32x4*)(we + (size_t)c * ME + gsel * 8), w1 = *(const f32x4*)(we + (size_t)c * ME + gsel * 8 + 4);
          el[0] += f[q][e] * w0[0]; el[1] += f[q][e] * w0[1]; el[2] += f[q][e] * w0[2]; el[3] += f[q][e] * w0[3];
          el[4] += f[q][e] * w1[0]; el[5] += f[q][e] * w1[1]; el[6] += f[q][e] * w1[2]; el[7] += f[q][e] * w1[3]; }
#pragma unroll
      for (int k = 0; k < 8; ++k) el[k] = wave_sum(el[k]);
      float em = el[0];
#pragma unroll
      for (int k = 1; k < 8; ++k) em = fmaxf(em, el[k]);
      float ep[8], es = 0.f;
#pragma unroll
      for (int k = 0; k < 8; ++k) { ep[k] = __expf(el[k] - em); es += ep[k]; }
      const float esi = 1.0f / es;
      int t1 = 0, t2 = 0; float b1 = -1e30f, b2 = -1e30f, p1 = 0.f, p2 = 0.f;
#pragma unroll
      for (int k = 0; k < 8; ++k) { const float pr = ep[k] * esi; const float sc = pr + p.in[I_MOE_BE][layer * ME + gsel * 8 + k];
        if (sc > b1) { b2 = b1; t2 = t1; p2 = p1; b1 = sc; t1 = k; p1 = pr; } else if (sc > b2) { b2 = sc; t2 = k; p2 = pr; } }
      if (lane == 0) {
        const float inv = gw_ / (p1 + p2);
        int* cnt = (int*)(ws + WS_CNT) + layer * ME; int* list = (int*)(ws + WS_LIST); float* wts = (float*)(ws + WS_WTS);
        const int e1 = gsel * 8 + t1, e2 = gsel * 8 + t2;
        const int q1 = atomicAdd(cnt + e1, 1); list[(size_t)e1 * R + q1] = 2 * r;     wts[2 * r] = p1 * inv;
        const int q2 = atomicAdd(cnt + e2, 1); list[(size_t)e2 * R + q2] = 2 * r + 1; wts[2 * r + 1] = p2 * inv;
      }
    }
  }
}

__device__ __forceinline__ void phase_mla_mid(const Params& p, int j) {
  int tid = threadIdx.x; asm volatile("" : "+v"(tid));
  const int wid = tid >> 6, lane = tid & 63;
  const int gw = blockIdx.x * 8 + wid, nw = gridDim.x * 8;
  char* ws = opaque_ptr(p.ws);
  const float* gq = p.in[I_MLA_GQ] + j * QL; const float* gkv = p.in[I_MLA_GKV] + j * KVL;
  for (int r = gw; r < R; r += nw) {
    const int b = r / RPB, ii = r - b * RPB; const bool is_ctx = ii < CTX;
    const float* c1 = (const float*)(ws + WS_C1) + (size_t)r * 896;
    const f32x4 q0 = *(const f32x4*)(c1 + lane * 4), q1 = *(const f32x4*)(c1 + 256 + lane * 4), kv = *(const f32x4*)(c1 + 512 + lane * 4);
    const float pe = c1[768 + lane];
    float sq = q0[0] * q0[0] + q0[1] * q0[1] + q0[2] * q0[2] + q0[3] * q0[3] + q1[0] * q1[0] + q1[1] * q1[1] + q1[2] * q1[2] + q1[3] * q1[3];
    float sk = kv[0] * kv[0] + kv[1] * kv[1] + kv[2] * kv[2] + kv[3] * kv[3];
    sq = wave_sum(sq); sk = wave_sum(sk);
    const float rq = rsqrtf(sq * (1.0f / QL) + EPS), rk = rsqrtf(sk * (1.0f / KVL) + EPS);
    bf16_t* cq = (bf16_t*)(ws + WS_CQ) + (size_t)r * QL; bf16_t* ckv = (bf16_t*)(ws + WS_CKV) + (size_t)r * KVL; bf16_t* kpe = (bf16_t*)(ws + WS_KPE) + (size_t)r * ROPE;
    { const f32x4 g = *(const f32x4*)(gq + lane * 4); u32x2 w = {cvtpk(q0[0] * rq * g[0], q0[1] * rq * g[1]), cvtpk(q0[2] * rq * g[2], q0[3] * rq * g[3])}; *(u32x2*)(cq + lane * 4) = w; }
    { const f32x4 g = *(const f32x4*)(gq + 256 + lane * 4); u32x2 w = {cvtpk(q1[0] * rq * g[0], q1[1] * rq * g[1]), cvtpk(q1[2] * rq * g[2], q1[3] * rq * g[3])}; *(u32x2*)(cq + 256 + lane * 4) = w; }
    { const f32x4 g = *(const f32x4*)(gkv + lane * 4); u32x2 w = {cvtpk(kv[0] * rk * g[0], kv[1] * rk * g[1]), cvtpk(kv[2] * rk * g[2], kv[3] * rk * g[3])}; *(u32x2*)(ckv + lane * 4) = w; }
    float outv = pe;
    const float other = __shfl_xor(pe, 16);
    if (!is_ctx) {
      const int s = ii - CTX; const float pos = (lane < 32) ? (float)(s >> 6) : (float)(s & 63);
      const float ang = pos * rope_invf(lane & 15, 16); const float cs = __cosf(ang), sn = __sinf(ang);
      outv = (lane & 16) ? (other * sn + pe * cs) : (pe * cs - other * sn);
    }
    kpe[lane] = (bf16_t)(cvtpk(outv, 0.f) & 0xffffu);
  }
}

__device__ __forceinline__ void phase_gqa_k(const Params& p) {
  int tid = threadIdx.x; asm volatile("" : "+v"(tid));
  const int wid = tid >> 6, lane = tid & 63;
  const int gw = blockIdx.x * 8 + wid, nw = gridDim.x * 8;
  char* ws = opaque_ptr(p.ws); const float* kg = p.in[I_GQA_KG];
  const int sub = lane & 7;
  for (int r = gw; r < R; r += nw) {
    const int b = r / RPB, ii = r - b * RPB; const bool is_ctx = ii < CTX;
    const bf16_t* kp = (const bf16_t*)(ws + WS_QKV) + (size_t)r * 4096 + 2048 + lane * 16;
    const u32x4 w0 = *(const u32x4*)kp, w1 = *(const u32x4*)(kp + 8);
    float v[16];
#pragma unroll
    for (int e = 0; e < 4; ++e) { v[2 * e] = bflo(w0[e]); v[2 * e + 1] = bfhi(w0[e]); v[8 + 2 * e] = bflo(w1[e]); v[9 + 2 * e] = bfhi(w1[e]); }
    float ss = 0.f;
#pragma unroll
    for (int e = 0; e < 16; ++e) ss += v[e] * v[e];
    ss += __shfl_xor(ss, 1); ss += __shfl_xor(ss, 2); ss += __shfl_xor(ss, 4);
    const float rs = rsqrtf(ss * (1.0f / GD) + EPS);
#pragma unroll
    for (int e = 0; e < 16; ++e) v[e] *= rs * kg[sub * 16 + e];
    float o[16];
#pragma unroll
    for (int e = 0; e < 16; ++e) o[e] = __shfl_xor(v[e], 2);
    if (!is_ctx) {
      const int s = ii - CTX; const float pos = (sub < 4) ? (float)(s >> 6) : (float)(s & 63);
#pragma unroll
      for (int e = 0; e < 16; ++e) { const int j = (sub & 1) * 16 + e; const float ang = pos * rope_invf(j, 32); const float cs = __cosf(ang), sn = __sinf(ang);
        v[e] = (sub & 2) ? (o[e] * sn + v[e] * cs) : (v[e] * cs - o[e] * sn); }
    }
    bf16_t* op = (bf16_t*)(ws + WS_KN) + (size_t)r * 1024 + lane * 16;
    u32x4 o0 = {cvtpk(v[0], v[1]), cvtpk(v[2], v[3]), cvtpk(v[4], v[5]), cvtpk(v[6], v[7])}, o1 = {cvtpk(v[8], v[9]), cvtpk(v[10], v[11]), cvtpk(v[12], v[13]), cvtpk(v[14], v[15])};
    *(u32x4*)op = o0; *(u32x4*)(op + 8) = o1;
  }
}

__device__ __forceinline__ void phase_conv_mid(const Params& p) {
  int tid = threadIdx.x; asm volatile("" : "+v"(tid));
  const int wid = tid >> 6, lane = tid & 63;
  const int gw = blockIdx.x * 8 + wid, nw = gridDim.x * 8;
  char* ws = opaque_ptr(p.ws); const float* cw = p.in[I_CONV_W];
  const bf16_t* bcu = (const bf16_t*)(ws + WS_BCU);
  for (int r = gw; r < R; r += nw) {
    const int b = r / RPB, ii = r - b * RPB; const bool is_ctx = ii < CTX;
    const bool hp = is_ctx ? (ii > 0) : (ii > CTX), hn = is_ctx ? (ii < CTX - 1) : (ii < RPB - 1);
    bf16_t* gp = (bf16_t*)(ws + WS_G) + (size_t)r * D;
#pragma unroll
    for (int q = 0; q < 4; ++q) {
      const int c = (lane + 64 * q) * 4;
      const bf16_t* row = bcu + (size_t)r * 3072 + c;
      const u32x2 bg = *(const u32x2*)row, c0 = *(const u32x2*)(row + 1024), u0 = *(const u32x2*)(row + 2048);
      u32x2 cp = {0u, 0u}, up = {0u, 0u}, cn = {0u, 0u}, un = {0u, 0u};
      if (hp) { cp = *(const u32x2*)(row - 3072 + 1024); up = *(const u32x2*)(row - 3072 + 2048); }
      if (hn) { cn = *(const u32x2*)(row + 3072 + 1024); un = *(const u32x2*)(row + 3072 + 2048); }
      const f32x4 w0 = *(const f32x4*)(cw + c), w1 = *(const f32x4*)(cw + D + c), w2 = *(const f32x4*)(cw + 2 * D + c);
      float z[4];
      z[0] = w0[0] * bflo(cp[0]) * bflo(up[0]) + w1[0] * bflo(c0[0]) * bflo(u0[0]) + w2[0] * bflo(cn[0]) * bflo(un[0]);
      z[1] = w0[1] * bfhi(cp[0]) * bfhi(up[0]) + w1[1] * bfhi(c0[0]) * bfhi(u0[0]) + w2[1] * bfhi(cn[0]) * bfhi(un[0]);
      z[2] = w0[2] * bflo(cp[1]) * bflo(up[1]) + w1[2] * bflo(c0[1]) * bflo(u0[1]) + w2[2] * bflo(cn[1]) * bflo(un[1]);
      z[3] = w0[3] * bfhi(cp[1]) * bfhi(up[1]) + w1[3] * bfhi(c0[1]) * bfhi(u0[1]) + w2[3] * bfhi(cn[1]) * bfhi(un[1]);
      u32x2 w = {cvtpk(bflo(bg[0]) * z[0], bfhi(bg[0]) * z[1]), cvtpk(bflo(bg[1]) * z[2], bfhi(bg[1]) * z[3])};
      *(u32x2*)(gp + c) = w;
    }
  }
}

__device__ __forceinline__ void moe_prefix(const Params& p, int layer, int* li) {
  if (threadIdx.x == 0) { const int* cnt = (const int*)(p.ws + WS_CNT) + layer * ME; int o = 0, t = 0;
    for (int e = 0; e < ME; ++e) { li[e] = o; li[33 + e] = t; const int c = cnt[e]; o += c; t += (c + 127) >> 7; } li[32] = o; li[65] = t; }
  __syncthreads();
}
__device__ __forceinline__ void phase_moe1(const Params& p, int layer, char* lds) {
  int* li = (int*)(lds + 131072); moe_prefix(p, layer, li);
  char* ws = opaque_ptr(p.ws); const int* cnt = (const int*)(ws + WS_CNT) + layer * ME;
  const int nU = li[65] * 4;
  for (int u = blockIdx.x; u < nU; u += gridDim.x) {
    const int t = u >> 2, ct = u & 3; int e = 0;
    while (li[33 + e + 1] <= t) ++e;
    const int rt = t - li[33 + e], ce = cnt[e], nvalid = min(128, ce - rt * 128);
    const int* list = (const int*)(ws + WS_LIST) + (size_t)e * R + rt * 128;
    ARowGather ar{(const bf16_t*)(ws + WS_ACT), list, nvalid};
    const bf16_t* wgu = (const bf16_t*)(ws + WS_WMOE + (size_t)(layer * ME + e) * MOE_WBYTES);
    EpiMoeGU ep{(bf16_t*)(ws + WS_HID) + (size_t)(li[e] + rt * 128) * FF, ct * 256, nvalid};
    gemm_tile<2, 4>(ar, wgu + (size_t)ct * 256 * D, D, D, lds, ep);
  }
}
__device__ __forceinline__ void phase_moe2(const Params& p, int layer, char* lds) {
  int* li = (int*)(lds + 131072); moe_prefix(p, layer, li);
  char* ws = opaque_ptr(p.ws); const int* cnt = (const int*)(ws + WS_CNT) + layer * ME;
  const int nU = li[65] * 4;
  for (int u = blockIdx.x; u < nU; u += gridDim.x) {
    const int t = u >> 2, ct = u & 3; int e = 0;
    while (li[33 + e + 1] <= t) ++e;
    const int rt = t - li[33 + e], ce = cnt[e], nvalid = min(128, ce - rt * 128);
    const int* list = (const int*)(ws + WS_LIST) + (size_t)e * R + rt * 128;
    ARowLin ar{(const bf16_t*)(ws + WS_HID) + (size_t)(li[e] + rt * 128) * FF, FF};
    const bf16_t* wd = (const bf16_t*)(ws + WS_WMOE + (size_t)(layer * ME + e) * MOE_WBYTES) + 1024 * 1024;
    EpiMoeDown ep{(bf16_t*)(ws + WS_Y), list, (const float*)(ws + WS_WTS), ct * 256, nvalid};
    gemm_tile<2, 4>(ar, wd + (size_t)ct * 256 * FF, FF, FF, lds, ep);
  }
}

__device__ __forceinline__ void phase_attn_mla(const Params& p, bool ctx_out, char* lds) {
  char* ws = opaque_ptr(p.ws);
  const bf16_t* Q = (const bf16_t*)(ws + WS_Q); const bf16_t* KV = (const bf16_t*)(ws + WS_KV); const bf16_t* KPE = (const bf16_t*)(ws + WS_KPE); bf16_t* O = (bf16_t*)(ws + WS_O);
  const int nctx = ctx_out ? NB * MLA_H : 0, nU = nctx + NB * MLA_H * 16;
  for (int u = blockIdx.x; u < nU; u += gridDim.x) {
    int b, h, q0, nkeys; bool rope;
    if (u < nctx) { b = u / MLA_H; h = u % MLA_H; q0 = 0; nkeys = CTX; rope = false; }
    else { const int v = u - nctx; const int qb = v & 15; h = (v >> 4) % MLA_H; b = v / (16 * MLA_H); q0 = CTX + qb * 256; nkeys = RPB; rope = true; }
    const size_t rb = (size_t)b * RPB;
    attn_unit<192, 1536, 2048, 2048, 1024>(Q + (rb + q0) * 1536 + h * 192, KV + rb * 2048 + h * 256, KPE + rb * ROPE, KV + rb * 2048 + h * 256 + 128,
                   O + (rb + q0) * 1024 + h * 128, nkeys, rope, q0 - CTX, nullptr, lds);
  }
}
__device__ __forceinline__ void phase_attn_gqa(const Params& p, char* lds) {
  char* ws = opaque_ptr(p.ws);
  const bf16_t* QKV = (const bf16_t*)(ws + WS_QKV); const bf16_t* KN = (const bf16_t*)(ws + WS_KN); bf16_t* O = (bf16_t*)(ws + WS_OG);
  const int nctx = NB * GH, nU = nctx + NB * GH * 16;
  for (int u = blockIdx.x; u < nU; u += gridDim.x) {
    int b, h, q0, nkeys; bool rope;
    if (u < nctx) { b = u / GH; h = u % GH; q0 = 0; nkeys = CTX; rope = false; }
    else { const int v = u - nctx; const int qb = v & 15; h = (v >> 4) % GH; b = v / (16 * GH); q0 = CTX + qb * 256; nkeys = RPB; rope = true; }
    const size_t rb = (size_t)b * RPB; const int kvh = h >> 1;
    attn_unit<128, 4096, 1024, 4096, 2048>(QKV + (rb + q0) * 4096 + h * 128, KN + rb * 1024 + kvh * 128, nullptr, QKV + rb * 4096 + 3072 + kvh * 128,
                   O + (rb + q0) * 2048 + h * 128, nkeys, rope, q0 - CTX, p.in[I_GQA_QG], lds);
  }
}


__device__ __forceinline__ void dbg_probe(const Params& p) {
  char* ws = opaque_ptr(p.ws);
  size_t off = 0, n = 0; bool is_bf = true;
  switch (DBG_PROBE) {
    case 1: off = WS_MODV; n = (size_t)4 * 5 * NMOD; is_bf = false; break;
    case 2: off = WS_ACT; n = (size_t)R * D; break;
    case 3: off = WS_C1; n = (size_t)R * 896; is_bf = false; break;
    case 4: off = WS_CQ; n = (size_t)R * 512; break;
    case 5: off = WS_CKV; n = (size_t)R * 256; break;
    case 6: off = WS_KPE; n = (size_t)R * 64; break;
    case 7: off = WS_Q; n = (size_t)R * 1536; break;
    case 8: off = WS_KV; n = (size_t)R * 2048; break;
    case 9: off = WS_O; n = (size_t)R * 1024; break;
    case 10: off = WS_X32; n = (size_t)R * D; is_bf = false; break;
    case 11: off = WS_WMLA; n = MLA_WBYTES / 2; break;
    default: break;
  }
  int bad = 0;
  for (size_t i = (size_t)blockIdx.x * NTHR + threadIdx.x; i < n; i += (size_t)gridDim.x * NTHR) {
    float v = is_bf ? bf2f(((const bf16_t*)(ws + off))[i]) : ((const float*)(ws + off))[i];
    if (!(fabsf(v) < 1e30f)) bad = 1;
  }
  if (bad) atomicOr((int*)(ws + WS_CNT) + 1000, 1);
}

struct MkBf16 { bf16_t* C; int ldc; __device__ __forceinline__ EpiBf16 operator()(int m0, int n0) const { return EpiBf16{C + (size_t)m0 * ldc + n0, ldc}; } };
struct MkF32 { float* C; int ldc; __device__ __forceinline__ EpiF32 operator()(int m0, int n0) const { return EpiF32{C + (size_t)m0 * ldc + n0, ldc}; } };
struct MkResid { float* X; const float* gate; __device__ __forceinline__ EpiResid operator()(int m0, int n0) const { return EpiResid{X, gate, m0, n0}; } };

constexpr int DYN_LDS = 135168;
extern __shared__ __attribute__((aligned(16))) char smem[];

__global__ void __launch_bounds__(NTHR, 2) fwd_megakernel(Params p) {
  cg::grid_group grid = cg::this_grid();
  char* lds = smem;
#define WSO() char* ws = opaque_ptr(p.ws)
  volatile LAS unsigned* xst = (volatile LAS unsigned*)(LAS char*)(smem + DYN_LDS - 16);
  if (threadIdx.x == 0) { xst[0] = 0u; xst[1] = 0u; }
  __syncthreads();
  const XcdBarrier xb = xcd_barrier_post((unsigned*)(p.ws + WS_BAR), xst);
#define GSYNC() xcd_barrier(xb)
  int uc = 0, u0 = 0;
  phase_prep(p, lds);
  grid.sync();
  phase_modfin(p);
  GSYNC();
  if (STOP_AFTER == 0) { phase_norm<2, false>(p, 0); return; }
#pragma unroll 1
  for (int layer = 0; layer < DEPTH; ++layer) {
    const int kind = layer % 3, j = layer / 3; const bool ctx_out = layer < DEPTH - 1;
    if (layer == 0) phase_norm<0, false>(p, layer); else phase_norm<0, true>(p, layer);
    GSYNC();
    if (kind == 0) {
      { WSO(); const char* wb = ws + WS_WMLA + j * MLA_WBYTES;
        gemm_phase<4, 2>((const bf16_t*)(ws + WS_ACT), D, (const bf16_t*)(wb + MLA_W1T), R, 896, D, lds, MkF32{(float*)(ws + WS_C1), 896}, 0, uc); }
      GSYNC();
      phase_mla_mid(p, j);
      GSYNC();
      { WSO(); const char* wb = ws + WS_WMLA + j * MLA_WBYTES;
        gemm_phase<2, 4>((const bf16_t*)(ws + WS_CQ), QL, (const bf16_t*)(wb + MLA_WUQT), R, 1536, QL, lds, MkBf16{(bf16_t*)(ws + WS_Q), 1536}, 0, uc);
        u0 = uc % gridDim.x; }
      { WSO(); const char* wb = ws + WS_WMLA + j * MLA_WBYTES;
        gemm_phase<2, 4>((const bf16_t*)(ws + WS_CKV), KVL, (const bf16_t*)(wb + MLA_WUKVT), R, 2048, KVL, lds, MkBf16{(bf16_t*)(ws + WS_KV), 2048}, u0, uc); }
      GSYNC();
      phase_attn_mla(p, ctx_out, lds);
      GSYNC();
      { WSO(); const char* wb = ws + WS_WMLA + j * MLA_WBYTES;
        gemm_phase<2, 4>((const bf16_t*)(ws + WS_O), 1024, (const bf16_t*)(wb + MLA_WOT), R, D, 1024, lds,
                         MkResid{(float*)(ws + WS_X32), (const float*)(ws + WS_MODV) + (size_t)layer * 5 * NMOD + 2 * D}, 0, uc); }
    } else if (kind == 1) {
      { WSO(); gemm_phase<2, 4>((const bf16_t*)(ws + WS_ACT), D, (const bf16_t*)(ws + WS_WCONV_IN), R, 3072, D, lds, MkBf16{(bf16_t*)(ws + WS_BCU), 3072}, 0, uc); }
      GSYNC();
      phase_conv_mid(p);
      GSYNC();
      { WSO(); gemm_phase<2, 4>((const bf16_t*)(ws + WS_G), D, (const bf16_t*)(ws + WS_WCONV_OUT), R, D, D, lds,
                                MkResid{(float*)(ws + WS_X32), (const float*)(ws + WS_MODV) + (size_t)layer * 5 * NMOD + 2 * D}, 0, uc); }
    } else {
      { WSO(); gemm_phase<2, 4>((const bf16_t*)(ws + WS_ACT), D, (const bf16_t*)(ws + WS_WGQA_QKV), R, 4096, D, lds, MkBf16{(bf16_t*)(ws + WS_QKV), 4096}, 0, uc); }
      GSYNC();
      phase_gqa_k(p);
      GSYNC();
      phase_attn_gqa(p, lds);
      GSYNC();
      { WSO(); gemm_phase<2, 4>((const bf16_t*)(ws + WS_OG), 2048, (const bf16_t*)(ws + WS_WGQA_O), R, D, 2048, lds,
                                MkResid{(float*)(ws + WS_X32), (const float*)(ws + WS_MODV) + (size_t)layer * 5 * NMOD + 2 * D}, 0, uc); }
    }
    GSYNC();
    if (STOP_AFTER == 2 * layer + 1) { if (DBG_PROBE) { dbg_probe(p); GSYNC(); } phase_norm<2, false>(p, 0); return; }
    phase_norm<1, false>(p, layer);
    GSYNC();
    phase_moe1(p, layer, lds);
    GSYNC();
    phase_moe2(p, layer, lds);
    GSYNC();
    if (STOP_AFTER == 2 * layer + 2) break;
  }
  phase_norm<2, true>(p, 0);
}


extern "C" void kernel_launch(void* const* d_in, const int* in_sizes, int n_in, void* d_out, int out_size, void* d_ws, size_t ws_size,
                              hipStream_t stream) {
  static int grid_blocks = 0;
  if (!grid_blocks) {
    int dev = 0, cus = 0, per_cu = 0;
    (void)hipGetDevice(&dev);
    (void)hipDeviceGetAttribute(&cus, hipDeviceAttributeMultiprocessorCount, dev);
    (void)hipFuncSetAttribute((const void*)fwd_megakernel, hipFuncAttributeMaxDynamicSharedMemorySize, DYN_LDS);
    (void)hipOccupancyMaxActiveBlocksPerMultiprocessor(&per_cu, fwd_megakernel, NTHR, DYN_LDS);
    grid_blocks = per_cu >= 1 ? cus : 0;
    if (ws_size < WS_END || n_in != N_IN) { fprintf(stderr, "kernel_launch: ws %zu < %zu or n_in %d\n", ws_size, (size_t)WS_END, n_in); grid_blocks = 0; }
    if (!grid_blocks) { fprintf(stderr, "kernel_launch: cannot launch (per_cu %d)\n", per_cu); return; }
  }
  Params p{};
  for (int i = 0; i < N_IN; ++i) p.in[i] = (const float*)d_in[i];
  p.out = (float*)d_out; p.ws = (char*)d_ws;
  {
    char* ws = p.ws; int nj = 0;
    for (int j = 0; j < 2; ++j) {
      char* wb = ws + WS_WMLA + j * MLA_WBYTES;
      p.jobs[nj++] = TJob{p.in[I_MLA_WDQ] + (size_t)j * D * QL, (bf16_t*)(wb + MLA_W1T), D, QL, 1, 0};
      p.jobs[nj++] = TJob{p.in[I_MLA_WDKV] + (size_t)j * D * 320, (bf16_t*)(wb + MLA_W1T), D, 320, 1, 512};
      p.jobs[nj++] = TJob{p.in[I_MLA_WUQ] + (size_t)j * QL * 1536, (bf16_t*)(wb + MLA_WUQT), QL, 1536, 1, 0};
      p.jobs[nj++] = TJob{p.in[I_MLA_WUKV] + (size_t)j * KVL * 2048, (bf16_t*)(wb + MLA_WUKVT), KVL, 2048, 1, 0};
      p.jobs[nj++] = TJob{p.in[I_MLA_WO] + (size_t)j * 1024 * D, (bf16_t*)(wb + MLA_WOT), 1024, D, 1, 0};
    }
    p.jobs[nj++] = TJob{p.in[I_CONV_WIN], (bf16_t*)(ws + WS_WCONV_IN), D, 3072, 1, 0};
    p.jobs[nj++] = TJob{p.in[I_CONV_WOUT], (bf16_t*)(ws + WS_WCONV_OUT), D, D, 1, 0};
    p.jobs[nj++] = TJob{p.in[I_GQA_WQKV], (bf16_t*)(ws + WS_WGQA_QKV), D, 4096, 1, 0};
    p.jobs[nj++] = TJob{p.in[I_GQA_WO], (bf16_t*)(ws + WS_WGQA_O), 2048, D, 1, 0};
  }
  (void)hipMemsetAsync((char*)d_ws + WS_BAR, 0, XCD_BAR_WORDS * 4, stream);
  void* args[] = {&p};
  hipError_t e = hipLaunchCooperativeKernel((void*)fwd_megakernel, dim3(grid_blocks), dim3(NTHR), args, DYN_LDS, stream);
  if (e != hipSuccess) fprintf(stderr, "cooperative launch failed: %s (grid %d)\n", hipGetErrorString(e), grid_blocks);
}
```

```cpp
#include <hip/hip_runtime.h>
#include <hip/hip_cooperative_groups.h>
#include <cstdio>
#include <cstdint>
namespace cg = cooperative_groups;

#ifndef DUP
#define DUP 0
#endif
#ifndef DBG_TIME
#define DBG_TIME 0
#endif
#ifndef DBG_T1
#define DBG_T1 0
#define DBG_T2 1
#endif
#ifndef DBG_PROBE
#define DBG_PROBE 0
#endif
#ifndef STOP_AFTER
#define STOP_AFTER 8
#endif

#define LAS __attribute__((address_space(3)))
typedef unsigned short bf16_t;
typedef short bf16x8 __attribute__((ext_vector_type(8)));
typedef short s16x4 __attribute__((ext_vector_type(4)));
typedef float f32x4 __attribute__((ext_vector_type(4)));
typedef float f32x16 __attribute__((ext_vector_type(16)));
typedef unsigned u32x4 __attribute__((ext_vector_type(4)));
typedef unsigned u32x2 __attribute__((ext_vector_type(2)));

constexpr int D = 1024, NB = 4, SEQ = 4096, CTX = 256, RPB = SEQ + CTX, R = NB * RPB;
constexpr int DEPTH = 4, NMOD = 6 * D;
constexpr int MLA_H = 8, QL = 512, KVL = 256, NOPE = 128, ROPE = 64, MV = 128;
constexpr int GH = 16, GKV = 8, GD = 128;
constexpr int ME = 32, FF = 512;
constexpr float EPS = 1e-6f;
constexpr int NTHR = 512;

enum { I_X = 0, I_C, I_CTX, I_CCTX, I_WMOD, I_BMOD, I_NMG, I_NFG, I_MLA_WDQ, I_MLA_GQ, I_MLA_WUQ, I_MLA_WDKV, I_MLA_GKV, I_MLA_WUKV, I_MLA_WO,
       I_CONV_WIN, I_CONV_W, I_CONV_WOUT, I_GQA_WQKV, I_GQA_QG, I_GQA_KG, I_GQA_WO, I_MOE_WG, I_MOE_BG, I_MOE_WE, I_MOE_BE, I_MOE_GATE, I_MOE_UP, I_MOE_DOWN, I_FG, N_IN };

constexpr size_t al256(size_t x) { return (x + 255) / 256 * 256; }
constexpr size_t WS_BAR = 0;
constexpr size_t WS_CNT = 16384;
constexpr size_t WS_MODP = 16384 + 8192;
constexpr size_t WS_MODV = WS_MODP + (size_t)8 * 4 * 5 * NMOD * 4;
constexpr size_t WS_WTS = WS_MODV + (size_t)4 * 5 * NMOD * 4;
constexpr size_t WS_LIST = al256(WS_WTS + (size_t)2 * R * 4);
constexpr size_t WS_X32 = al256(WS_LIST + (size_t)32 * R * 4);
constexpr size_t WS_ACT = WS_X32 + (size_t)R * D * 4;
constexpr size_t WS_HID = WS_ACT + (size_t)R * D * 2;
constexpr size_t WS_Y = WS_HID + (size_t)(2 * R + 256) * FF * 2;
constexpr size_t WS_MIX = WS_Y + (size_t)2 * R * D * 2;
constexpr size_t MIX_BYTES = (size_t)R * (1024 * 4 + 512 * 2 + 256 * 2 + 64 * 2 + 1536 * 2 + 2048 * 2 + 1024 * 2);
constexpr size_t WS_C1 = WS_MIX;
constexpr size_t WS_CQ = WS_C1 + (size_t)R * 1024 * 4;
constexpr size_t WS_CKV = WS_CQ + (size_t)R * 512 * 2;
constexpr size_t WS_KPE = WS_CKV + (size_t)R * 256 * 2;
constexpr size_t WS_Q = WS_KPE + (size_t)R * 64 * 2;
constexpr size_t WS_KV = WS_Q + (size_t)R * 1536 * 2;
constexpr size_t WS_O = WS_KV + (size_t)R * 2048 * 2;
constexpr size_t WS_QKV = WS_MIX;
constexpr size_t WS_KN = WS_QKV + (size_t)R * 4096 * 2;
constexpr size_t WS_OG = WS_KN + (size_t)R * 1024 * 2;
constexpr size_t WS_BCU = WS_MIX;
constexpr size_t WS_G = WS_BCU + (size_t)R * 3072 * 2;
static_assert(WS_OG + (size_t)R * 2048 * 2 <= WS_MIX + MIX_BYTES, "gqa scratch");
static_assert(WS_G + (size_t)R * 1024 * 2 <= WS_MIX + MIX_BYTES, "conv scratch");
constexpr size_t WS_WT = al256(WS_MIX + MIX_BYTES);
constexpr size_t MLA_W1T = 0, MLA_WUQT = MLA_W1T + (size_t)1024 * 1024 * 2, MLA_WUKVT = MLA_WUQT + (size_t)1536 * 512 * 2, MLA_WOT = MLA_WUKVT + (size_t)2048 * 256 * 2,
                 MLA_WBYTES = MLA_WOT + (size_t)1024 * 1024 * 2;
constexpr size_t WS_WMLA = WS_WT;
constexpr size_t WS_WCONV_IN = WS_WMLA + 2 * MLA_WBYTES;
constexpr size_t WS_WCONV_OUT = WS_WCONV_IN + (size_t)3072 * 1024 * 2;
constexpr size_t WS_WGQA_QKV = WS_WCONV_OUT + (size_t)1024 * 1024 * 2;
constexpr size_t WS_WGQA_O = WS_WGQA_QKV + (size_t)4096 * 1024 * 2;
constexpr size_t WS_WMOE = WS_WGQA_O + (size_t)1024 * 2048 * 2;
constexpr size_t MOE_WBYTES = (size_t)1024 * 1024 * 2 + (size_t)1024 * 512 * 2;
constexpr size_t WS_END = WS_WMOE + (size_t)DEPTH * ME * MOE_WBYTES;
static_assert(WS_END <= (size_t)1073741824, "workspace over 1 GiB");

struct TJob { const float* src; bf16_t* dst; int K, N, rmul, roff; };
struct Params {
  const float* in[N_IN];
  float* out;
  char* ws;
  TJob jobs[14];
};

typedef __bf16 bf16x2_t __attribute__((ext_vector_type(2)));
__device__ __forceinline__ unsigned cvtpk(float lo, float hi) { bf16x2_t v = {(__bf16)lo, (__bf16)hi}; return __builtin_bit_cast(unsigned, v); }
__device__ __forceinline__ float bf2f(unsigned short h) { return __uint_as_float((unsigned)h << 16); }
__device__ __forceinline__ float bflo(unsigned w) { return __uint_as_float(w << 16); }
__device__ __forceinline__ float bfhi(unsigned w) { return __uint_as_float(w & 0xffff0000u); }
__device__ __forceinline__ float wave_sum(float v) {
#pragma unroll
  for (int o = 32; o > 0; o >>= 1) v += __shfl_xor(v, o);
  return v;
}
__device__ __forceinline__ float silu_f(float x) { return x / (1.0f + __expf(-x)); }
__device__ __forceinline__ void glds16(const void* g, char* l) { __builtin_amdgcn_global_load_lds((const unsigned*)g, (LAS unsigned*)l, 16, 0, 0); }
__device__ __forceinline__ char* opaque_ptr(char* q) {
  unsigned lo = __builtin_amdgcn_readfirstlane((unsigned)(uintptr_t)q), hi = __builtin_amdgcn_readfirstlane((unsigned)((uintptr_t)q >> 32));
  asm volatile("" : "+s"(lo), "+s"(hi));
  return (char*)(((uintptr_t)hi << 32) | (uintptr_t)lo); }
__device__ __forceinline__ float rope_invf(int j, int half) { return exp2f(-(float)j * (13.287712379549449f / (float)half)); }


#define XB_TMO      128
#define XB_XCNT(j)  (256  + 64 * (j))
#define XB_XSUB(j)  (1280 + 64 * (j))
#define XB_XGEN(j)  (2304 + 64 * (j))
#define XB_TOP      3328
#define XB_TOPGEN   3392
#define XCD_BAR_WORDS 3456
#define XB_SPIN_CAP (1u << 22)
__device__ __forceinline__ unsigned xb_ld(unsigned* p)              { return __hip_atomic_load(p, __ATOMIC_RELAXED, __HIP_MEMORY_SCOPE_AGENT); }
__device__ __forceinline__ unsigned xb_add(unsigned* p, unsigned v) { return __hip_atomic_fetch_add(p, v, __ATOMIC_RELAXED, __HIP_MEMORY_SCOPE_AGENT); }
__device__ __forceinline__ unsigned xb_xcc_id() { return (unsigned)__builtin_amdgcn_s_getreg((3 << 11) | 20) & 0xFu; }
#define XB_SPIN(cond, bar) do { unsigned _sp = 0; while (cond) { __builtin_amdgcn_s_sleep(1); \
    if ((++_sp & 255u) == 0u) { if (xb_ld(&(bar)[XB_TMO])) break; if (_sp > XB_SPIN_CAP) { atomicAdd(&(bar)[XB_TMO], 1u); break; } } } } while (0)
struct XcdBarrier { unsigned* bar; unsigned x; volatile LAS unsigned* st; };
__device__ __forceinline__ XcdBarrier xcd_barrier_post(unsigned* bar, volatile LAS unsigned* st) {
  XcdBarrier b; b.bar = bar; b.x = xb_xcc_id(); b.st = st;
  if (threadIdx.x == 0) (void)xb_add(&bar[XB_XCNT(b.x)], 1u);
  return b;
}
__device__ __forceinline__ void xcd_barrier_complete(unsigned* bar, unsigned x, unsigned& nloc, unsigned& nx) {
  const unsigned G = gridDim.x * gridDim.y * gridDim.z;
  unsigned sum, cnt, mine, sp = 0u;
  for (;;) {
    sum = 0u; cnt = 0u; mine = 0u;
#pragma unroll
    for (unsigned j = 0; j < 16; ++j) { const unsigned c = xb_ld(&bar[XB_XCNT(j)]); sum += c; cnt += (c > 0u) ? 1u : 0u; mine = (j == x) ? c : mine; }
    if (sum == G) break;
    __builtin_amdgcn_s_sleep(1);
    if ((++sp & 255u) == 0u) { if (xb_ld(&bar[XB_TMO])) break; if (sp > XB_SPIN_CAP) { atomicAdd(&bar[XB_TMO], 1u); break; } }
  }
  nloc = mine > 0u ? mine : 1u; nx = cnt > 0u ? cnt : 1u;
}
__device__ __forceinline__ void xcd_barrier(const XcdBarrier& b) {
  asm volatile("s_waitcnt vmcnt(0)" ::: "memory");
  __syncthreads();
  if (threadIdx.x == 0) {
    unsigned* bar = b.bar;
    __builtin_amdgcn_s_waitcnt(0);
    unsigned nloc = b.st[0], nx = b.st[1];
    if (nloc == 0u) { xcd_barrier_complete(bar, b.x, nloc, nx); b.st[0] = nloc; b.st[1] = nx; }
    const unsigned old = xb_add(&bar[XB_XSUB(b.x)], 1u);
    const unsigned gen = old / nloc;
    if (old + 1u == (gen + 1u) * nloc) {
      __builtin_amdgcn_fence(__ATOMIC_RELEASE, "agent");
      asm volatile("s_waitcnt vmcnt(0)" ::: "memory");
      const unsigned og = xb_add(&bar[XB_TOP], 1u);
      const unsigned tg = og / nx;
      if (og + 1u == (tg + 1u) * nx) xb_add(&bar[XB_TOPGEN], 1u);
      else XB_SPIN(xb_ld(&bar[XB_TOPGEN]) == tg, bar);
      __builtin_amdgcn_fence(__ATOMIC_ACQUIRE, "agent");
      xb_add(&bar[XB_XGEN(b.x)], 1u);
      asm volatile("s_waitcnt vmcnt(0)" ::: "memory");
    } else {
      XB_SPIN(xb_ld(&bar[XB_XGEN(b.x)]) == gen, bar);
      __builtin_amdgcn_fence(__ATOMIC_ACQUIRE, "agent");
      asm volatile("s_waitcnt vmcnt(0)" ::: "memory");
    }
  }
  __syncthreads();
}

template <int MB, class Prov, int GMODE = 0>
__device__ __forceinline__ void gemm_stream(const Prov& pv, char* lds) {
  constexpr int BM = MB * 16, BN = 256, A_BYTES = BM * 128, STAGE = (BM + BN) * 128, AR = (BM + 63) / 64, BR = BN / 64, MB0 = (MB + 1) / 2, NW = 4;
  static_assert(2 * STAGE <= 135168, "GEMM LDS stages");
  int tid = threadIdx.x; asm volatile("" : "+v"(tid));
  const int wid = tid >> 6, lane = tid & 63, fr = lane & 15, fq = lane >> 4, wm = wid >> 2, wn = wid & 3;
  const int srow = tid >> 3, pc = tid & 7, lc = pc ^ (srow & 7);
  const int lds_base = (int)(uintptr_t)(LAS char*)lds;
  const int a_off = lds_base + (wm * MB0 * 16 + fr) * 128, b_off = lds_base + A_BYTES + (wn * 64 + fr) * 128;
  const int ch0 = (fq ^ (fr & 7)) * 16, ch1 = ((4 + fq) ^ (fr & 7)) * 16;
  const bool lastm = (MB % 2 == 0) || wm == 0;
  typename Prov::Unit u, un;
  int it = 0;
  if (!pv.unit(it, u, srow)) return;
  constexpr int APN = Prov::A_AFFINE ? 1 : AR;
  const bf16_t* ap[APN]; const bf16_t* bp0; int astr = 0, bstr = 0;
#define GS_LOADPTR(U) do { _Pragma("unroll") for (int i = 0; i < APN; ++i) ap[i] = pv.a_row(U, srow + 64 * i) + lc * 8; \
    bp0 = pv.b_row(U, srow) + lc * 8; astr = pv.a_stride(U); bstr = pv.b_stride(U); } while (0)
#define GS_ISSUE(KO, BUF) do { char* base_ = lds + (BUF) * STAGE; \
    _Pragma("unroll") for (int i = 0; i < AR; ++i) if (AR * 64 == BM || srow + 64 * i < BM) glds16((Prov::A_AFFINE ? ap[0] + (size_t)i * astr : ap[i < APN ? i : 0]) + (KO), base_ + i * 8192 + tid * 16); \
    _Pragma("unroll") for (int i = 0; i < BR; ++i) glds16(bp0 + (size_t)i * bstr + (KO), base_ + A_BYTES + i * 8192 + tid * 16); } while (0)
#define GS_DSR(dst, addr) asm volatile("ds_read_b128 %0, %1" : "=v"(dst) : "v"(addr) : "memory")
  GS_LOADPTR(u); GS_ISSUE(0, 0);
  int buf = 0;
  for (;;) {
    const bool have_n = pv.unit(it + 1, un, srow);
    const int nk = pv.nk(u);
    f32x4 acc[MB0][NW];
#pragma unroll
    for (int m = 0; m < MB0; ++m)
#pragma unroll
      for (int n = 0; n < NW; ++n) acc[m][n] = (f32x4){0.f, 0.f, 0.f, 0.f};
    for (int kt = 0; kt < nk; ++kt) {
      asm volatile("s_waitcnt vmcnt(0)" ::: "memory");
      __syncthreads();
      if (GMODE != 2) { if (kt + 1 < nk) { GS_ISSUE((kt + 1) * 64, buf ^ 1); }
      else if (have_n) { GS_LOADPTR(un); GS_ISSUE(0, buf ^ 1); } }
      if (GMODE != 1) {
        constexpr int NI = 2 * MB0, GS = 2, NG = (NI + GS - 1) / GS;
        const int sbo = buf * STAGE;
        const int aa0 = sbo + a_off + ch0, aa1 = sbo + a_off + ch1, bb0 = sbo + b_off + ch0, bb1 = sbo + b_off + ch1;
        bf16x8 fb[2][NW], fa[2][GS];
#pragma unroll
        for (int n = 0; n < NW; ++n) GS_DSR(fb[0][n], bb0 + n * 2048);
#pragma unroll
        for (int j = 0; j < GS; ++j) GS_DSR(fa[0][j], aa0 + j * 2048);
#pragma unroll
        for (int n = 0; n < NW; ++n) GS_DSR(fb[1][n], bb1 + n * 2048);
#pragma unroll
        for (int g = 0; g < NG; ++g) {
          int nnext = 0;
          if (g + 1 < NG) {
#pragma unroll
            for (int j = 0; j < GS; ++j) { const int i = (g + 1) * GS + j; if (i < NI) { GS_DSR(fa[(g + 1) & 1][j], (i / MB0 ? aa1 : aa0) + (i % MB0) * 2048); ++nnext; } }
          }
          if (g == 0) nnext += NW;
          if (nnext == 8) asm volatile("s_waitcnt lgkmcnt(8)" ::: "memory"); else if (nnext == 7) asm volatile("s_waitcnt lgkmcnt(7)" ::: "memory");
          else if (nnext == 6) asm volatile("s_waitcnt lgkmcnt(6)" ::: "memory"); else if (nnext == 5) asm volatile("s_waitcnt lgkmcnt(5)" ::: "memory");
          else if (nnext == 4) asm volatile("s_waitcnt lgkmcnt(4)" ::: "memory"); else if (nnext == 3) asm volatile("s_waitcnt lgkmcnt(3)" ::: "memory");
          else if (nnext == 2) asm volatile("s_waitcnt lgkmcnt(2)" ::: "memory"); else if (nnext == 1) asm volatile("s_waitcnt lgkmcnt(1)" ::: "memory");
          else asm volatile("s_waitcnt lgkmcnt(0)" ::: "memory");
          __builtin_amdgcn_sched_barrier(0);
#pragma unroll
          for (int j = 0; j < GS; ++j) { const int i = g * GS + j;
            if (i < NI) { const int m = i % MB0;
              if (m < MB0 - 1 || lastm) {
#pragma unroll
                for (int n = 0; n < NW; ++n) acc[m][n] = __builtin_amdgcn_mfma_f32_16x16x32_bf16(fb[i / MB0][n], fa[g & 1][j], acc[m][n], 0, 0, 0);
              } } }
          __builtin_amdgcn_sched_barrier(0);
        }
      }
      buf ^= 1;
    }
#pragma unroll
    for (int m = 0; m < MB0; ++m) if (m < MB0 - 1 || lastm) {
#pragma unroll
      for (int n = 0; n < NW; ++n) pv.epi(u, (wm * MB0 + m) * 16 + fr, wn * 64 + n * 16 + fq * 4, acc[m][n]);
    }
    if (!have_n) break;
    u = un; ++it;
  }
  __syncthreads();
#undef GS_LOADPTR
#undef GS_ISSUE
#undef GS_DSR
}

struct EpiBf16 { bf16_t* C; int ldc; __device__ __forceinline__ void operator()(int r, int c, f32x4 v) const {
  u32x2 w = {cvtpk(v[0], v[1]), cvtpk(v[2], v[3])}; *(u32x2*)(C + (size_t)r * ldc + c) = w; } };
struct EpiF32 { float* C; int ldc; __device__ __forceinline__ void operator()(int r, int c, f32x4 v) const { *(f32x4*)(C + (size_t)r * ldc + c) = v; } };
struct EpiResid { float* X; const float* gate; float* dry; __device__ __forceinline__ void operator()(int row, int c, f32x4 v) const {
  const int b = row / RPB, ii = row - b * RPB, bsel = ii < CTX ? 4 : b;
  const f32x4 g = *(const f32x4*)(gate + (size_t)bsel * NMOD + c);
  float* xp = X + (size_t)row * D + c; f32x4 x = *(f32x4*)xp; x += g * v; *(f32x4*)((dry ? dry : X) + (size_t)row * D + c) = x; } };

template <int BM, int BN, bool LATONLY, class Epi>
struct DenseProv {
  const bf16_t* A; int lda; const bf16_t* Bt; int K; int nNt; Epi ep;
  struct Unit { int m0, n0; };
  __device__ __forceinline__ bool unit(int it, Unit& U, int) const {
    const int nloc = gridDim.x >> 3, x = blockIdx.x & 7, loc = (blockIdx.x >> 3) + nloc * it;
    if (loc >= 8 * nNt) return false;
    const int mt = x * 8 + (loc & 7), nt = loc >> 3;
    U.m0 = LATONLY ? (mt >> 4) * RPB + CTX + (mt & 15) * 256 : mt * BM; U.n0 = nt * BN; return true;
  }
  static constexpr bool A_AFFINE = true;
  __device__ __forceinline__ int a_stride(const Unit&) const { return 64 * lda; }
  __device__ __forceinline__ int b_stride(const Unit&) const { return 64 * K; }
  __device__ __forceinline__ const bf16_t* a_row(const Unit& U, int r) const { return A + (size_t)(U.m0 + r) * lda; }
  __device__ __forceinline__ const bf16_t* b_row(const Unit& U, int r) const { return Bt + (size_t)(U.n0 + r) * K; }
  __device__ __forceinline__ int nk(const Unit&) const { return K >> 6; }
  __device__ __forceinline__ void epi(const Unit& U, int r, int c, f32x4 v) const { ep(U.m0 + r, U.n0 + c, v); }
};
template <int MB, int NBW, bool LATONLY, class Epi, int GMODE = 0>
__device__ __forceinline__ void gemm_dense(const bf16_t* A, int lda, const bf16_t* Bt, int N, int K, const Epi& ep, char* lds) {
  static_assert(NBW == 2, "256-column tiles");
  DenseProv<MB * 16, 256, LATONLY, Epi> pv{A, lda, Bt, K, N / 256, ep};
  gemm_stream<MB, DenseProv<MB * 16, 256, LATONLY, Epi>, GMODE>(pv, lds);
}

struct MlaUpProv {
  const bf16_t* CQ; const bf16_t* CKV; const bf16_t* WUQ; const bf16_t* WUKV; bf16_t* Q; bf16_t* KV;
  struct Unit { int m0, n0, which; };
  __device__ __forceinline__ bool unit(int it, Unit& U, int) const {
    const int b = blockIdx.x; int which, t;
    if (b < 128) { if (it > 2) return false; which = it == 2; t = it == 2 ? b : 2 * b + it; }
    else { if (it > 3) return false; which = it != 0; t = it == 0 ? 256 + (b - 128) : 128 + 3 * (b - 128) + (it - 1); }
    U.which = which;
    if (which) { U.m0 = (t >> 3) * 272; U.n0 = (t & 7) * 256; } else { U.m0 = (t / 6) * 272; U.n0 = (t % 6) * 256; }
    return true;
  }
  static constexpr bool A_AFFINE = true;
  __device__ __forceinline__ int a_stride(const Unit& U) const { return U.which ? 64 * KVL : 64 * QL; }
  __device__ __forceinline__ int b_stride(const Unit& U) const { return U.which ? 64 * KVL : 64 * QL; }
  __device__ __forceinline__ const bf16_t* a_row(const Unit& U, int r) const { return U.which ? CKV + (size_t)(U.m0 + r) * KVL : CQ + (size_t)(U.m0 + r) * QL; }
  __device__ __forceinline__ const bf16_t* b_row(const Unit& U, int r) const { return U.which ? WUKV + (size_t)(U.n0 + r) * KVL : WUQ + (size_t)(U.n0 + r) * QL; }
  __device__ __forceinline__ int nk(const Unit& U) const { return U.which ? KVL / 64 : QL / 64; }
  __device__ __forceinline__ void epi(const Unit& U, int r, int c, f32x4 v) const {
    u32x2 w = {cvtpk(v[0], v[1]), cvtpk(v[2], v[3])};
    bf16_t* o = U.which ? KV + (size_t)(U.m0 + r) * 2048 + U.n0 + c : Q + (size_t)(U.m0 + r) * 1536 + U.n0 + c; *(u32x2*)o = w; }
};

template <int DK> struct AttnCfg {
  static constexpr int KROW = DK * 2;
  static constexpr int SHM_V = 64 * 128 * 2, SHM_K = 64 * KROW;
  static constexpr int SHM = 2 * SHM_V + 2 * SHM_K + 8 * 64 * 4;
};
#define SBAR() __builtin_amdgcn_sched_barrier(0)
__device__ __forceinline__ int crow(int r, int hi) { return (r & 3) + 8 * (r >> 2) + 4 * hi; }
__device__ __forceinline__ int v_st(int k, int c) { const int kk = (k & ~0xC) | ((k & 4) << 1) | ((k & 8) >> 1); return ((kk >> 3) * 4 + (c >> 5)) * 512 + ((kk & 7) * 32 + (c & 31)) * 2; }
__device__ __forceinline__ int v_rd_base(int lane) { return ((lane & 3) << 3) | (((lane >> 2) & 3) << 6) | (((lane >> 4) & 1) << 5) | (((lane >> 5) & 1) << 8); }
constexpr int v_rd_off(int d0, int ks, int half) { return d0 * 512 + ks * 4096 + half * 2048; }
template <int OFF> __device__ __forceinline__ s16x4 tr_read(int vb) {
  s16x4 r; asm volatile("ds_read_b64_tr_b16 %0, %1 offset:%2" : "=&v"(r) : "v"(vb), "i"(OFF) : "memory"); return r;
}
template <int D0> __device__ __forceinline__ void pv_one(f32x16& od, int vb, bf16x8 pa0, bf16x8 pa1, bf16x8 pa2, bf16x8 pa3) {
  const s16x4 l0 = tr_read<v_rd_off(D0, 0, 0)>(vb), h0 = tr_read<v_rd_off(D0, 0, 1)>(vb), l1 = tr_read<v_rd_off(D0, 1, 0)>(vb), h1 = tr_read<v_rd_off(D0, 1, 1)>(vb);
  const s16x4 l2 = tr_read<v_rd_off(D0, 2, 0)>(vb), h2 = tr_read<v_rd_off(D0, 2, 1)>(vb), l3 = tr_read<v_rd_off(D0, 3, 0)>(vb), h3 = tr_read<v_rd_off(D0, 3, 1)>(vb);
  asm volatile("s_waitcnt lgkmcnt(0)" ::: "memory"); SBAR();
#define PK(L, H) (bf16x8){L[0], L[1], L[2], L[3], H[0], H[1], H[2], H[3]}
  od = __builtin_amdgcn_mfma_f32_32x32x16_bf16(pa0, PK(l0, h0), od, 0, 0, 0);
  od = __builtin_amdgcn_mfma_f32_32x32x16_bf16(pa1, PK(l1, h1), od, 0, 0, 0);
  od = __builtin_amdgcn_mfma_f32_32x32x16_bf16(pa2, PK(l2, h2), od, 0, 0, 0);
  od = __builtin_amdgcn_mfma_f32_32x32x16_bf16(pa3, PK(l3, h3), od, 0, 0, 0);
#undef PK
}
__device__ __forceinline__ void pv_d0(f32x16* o, int vb, bf16x8 pa0, bf16x8 pa1, bf16x8 pa2, bf16x8 pa3) {
  pv_one<0>(o[0], vb, pa0, pa1, pa2, pa3); pv_one<1>(o[1], vb, pa0, pa1, pa2, pa3); pv_one<2>(o[2], vb, pa0, pa1, pa2, pa3); pv_one<3>(o[3], vb, pa0, pa1, pa2, pa3);
}
constexpr float ATT_THR = 8.f;
template <int DK> __device__ __forceinline__ void partialSM(f32x16& p0, f32x16& p1, float& m_reg, float& mn, float& alpha) {
  constexpr float SCALE = DK == 192 ? 0.07216878364870322f : 0.08838834764831845f;
  constexpr float C = SCALE * 1.4426950408889634f;
  float pmax = p0[0];
#pragma unroll
  for (int r = 1; r < 16; ++r) pmax = fmaxf(pmax, p0[r]);
#pragma unroll
  for (int r = 0; r < 16; ++r) pmax = fmaxf(pmax, p1[r]);
  { auto rr = __builtin_amdgcn_permlane32_swap(__float_as_uint(pmax), __float_as_uint(pmax), false, false);
    pmax = fmaxf(__uint_as_float(rr[0]), __uint_as_float(rr[1])); }
  if (__builtin_expect(__all(pmax - m_reg <= ATT_THR / SCALE), 1)) { mn = m_reg; alpha = 1.f; }
  else { mn = fmaxf(m_reg, pmax); alpha = __builtin_amdgcn_exp2f((m_reg - mn) * C); m_reg = mn; }
  const float mnC = -mn * C;
#pragma unroll
  for (int r = 0; r < 16; ++r) p0[r] = fmaf(p0[r], C, mnC);
#pragma unroll
  for (int r = 0; r < 16; ++r) p1[r] = fmaf(p1[r], C, mnC);
#pragma unroll
  for (int r = 0; r < 16; ++r) p0[r] = __builtin_amdgcn_exp2f(p0[r]);
}
__device__ __forceinline__ void finishSM(f32x16& p0, f32x16& p1, float alpha, float& l_reg, bf16x8& pa0, bf16x8& pa1, bf16x8& pa2, bf16x8& pa3) {
#pragma unroll
  for (int r = 0; r < 16; ++r) p1[r] = __builtin_amdgcn_exp2f(p1[r]);
  float ps = 0;
#pragma unroll
  for (int r = 0; r < 16; ++r) ps += p0[r];
#pragma unroll
  for (int r = 0; r < 16; ++r) ps += p1[r];
  { auto rr = __builtin_amdgcn_permlane32_swap(__float_as_uint(ps), __float_as_uint(ps), false, false);
    ps = __uint_as_float(rr[0]) + __uint_as_float(rr[1]); }
  l_reg = l_reg * alpha + ps;
#define PK4(P, BASE, OUT) do { unsigned a0 = cvtpk(P[BASE + 0], P[BASE + 1]), a1 = cvtpk(P[BASE + 2], P[BASE + 3]);   \
    unsigned b0 = cvtpk(P[BASE + 4], P[BASE + 5]), b1 = cvtpk(P[BASE + 6], P[BASE + 7]);                              \
    auto r0 = __builtin_amdgcn_permlane32_swap(a0, b0, false, false); auto r1 = __builtin_amdgcn_permlane32_swap(a1, b1, false, false); \
    u32x4 w = {r0[0], r1[0], r0[1], r1[1]}; OUT = *reinterpret_cast<bf16x8*>(&w); } while (0)
  PK4(p0, 0, pa0); PK4(p0, 8, pa1); PK4(p1, 0, pa2); PK4(p1, 8, pa3);
#undef PK4
}
template <int DK> __device__ __forceinline__ void qkt(f32x16& p0, f32x16& p1, const char* Ks, const bf16x8* qr, const int* kro) {
  constexpr int KROW = DK * 2;
  p0 = f32x16{}; p1 = f32x16{};
#pragma unroll
  for (int d0 = 0; d0 < DK / 16; ++d0) {
    bf16x8 b0 = *reinterpret_cast<const bf16x8*>(Ks + kro[d0 & 3] + (d0 >> 2) * 128);
    bf16x8 b1 = *reinterpret_cast<const bf16x8*>(Ks + kro[d0 & 3] + (d0 >> 2) * 128 + 32 * KROW);
    p0 = __builtin_amdgcn_mfma_f32_32x32x16_bf16(b0, qr[d0], p0, 0, 0, 0);
    p1 = __builtin_amdgcn_mfma_f32_32x32x16_bf16(b1, qr[d0], p1, 0, 0, 0); }
}

template <int DK, int ldq, int ldk, int ldv, int ldo>
__device__ __forceinline__ void attn_unit(const bf16_t* __restrict__ Qb, const bf16_t* __restrict__ Kh, const bf16_t* __restrict__ Kp,
                                          const bf16_t* __restrict__ Vh, bf16_t* __restrict__ Ob, int nkeys, bool rope, int qpos0,
                                          const float* __restrict__ qg, char* lds) {
  using Cfg = AttnCfg<DK>;
  constexpr int KROW = Cfg::KROW, SHM_V = Cfg::SHM_V, SHM_K = Cfg::SHM_K, ND0 = DK / 16;
  int tid = threadIdx.x; asm volatile("" : "+v"(tid));
  const int wid = tid >> 6, lane = tid & 63, r32 = lane & 31, hi = lane >> 5;
  char* V_lds = lds; char* K_lds = lds + 2 * SHM_V;
  float* wsl = (float*)(lds + 2 * SHM_V + 2 * SHM_K) + wid * 64; float* li_l = wsl; float* al_l = wsl + 32;
  float m_reg = -1e30f, l_reg = 0; f32x16 o[4] = {}; bf16x8 qr[ND0];
  {
    const int qrow = wid * 32 + r32;
    const bf16_t* Qw = Qb + (size_t)qrow * ldq + hi * 8;
    float qf[ND0][8];
#pragma unroll
    for (int d0 = 0; d0 < ND0; ++d0) { const u32x4 w = *reinterpret_cast<const u32x4*>(Qw + d0 * 16);
#pragma unroll
      for (int e = 0; e < 4; ++e) { qf[d0][2 * e] = bflo(w[e]); qf[d0][2 * e + 1] = bfhi(w[e]); } }
    const int qpos = qpos0 + qrow; const float prow = (float)(qpos >> 6), pcol = (float)(qpos & 63);
    int hio = hi; asm volatile("" : "+v"(hio));
    if constexpr (DK == 128) {
      float ss = 0.f;
#pragma unroll
      for (int d0 = 0; d0 < 8; ++d0)
#pragma unroll
        for (int e = 0; e < 8; ++e) ss += qf[d0][e] * qf[d0][e];
      ss += __shfl_xor(ss, 32);
      const float rs = rsqrtf(ss * (1.0f / 128.0f) + EPS);
#pragma unroll
      for (int d0 = 0; d0 < 8; ++d0) { const f32x4 g0 = *(const f32x4*)(qg + d0 * 16 + hi * 8), g1 = *(const f32x4*)(qg + d0 * 16 + hi * 8 + 4);
#pragma unroll
        for (int e = 0; e < 4; ++e) { qf[d0][e] *= rs * g0[e]; qf[d0][4 + e] *= rs * g1[e]; } }
      if (rope) {
#pragma unroll
        for (int hf = 0; hf < 2; ++hf) { const float pos = hf ? pcol : prow;
#pragma unroll
          for (int dd = 0; dd < 2; ++dd)
#pragma unroll
            for (int e = 0; e < 8; ++e) { const int j = dd * 16 + hio * 8 + e; const float ang = pos * rope_invf(j, 32); const float cs = __cosf(ang), sn = __sinf(ang);
              const float x1 = qf[hf * 4 + dd][e], x2 = qf[hf * 4 + dd + 2][e]; qf[hf * 4 + dd][e] = x1 * cs - x2 * sn; qf[hf * 4 + dd + 2][e] = x1 * sn + x2 * cs; } }
      }
    } else {
      if (rope) {
#pragma unroll
        for (int hf = 0; hf < 2; ++hf) { const float pos = hf ? pcol : prow;
#pragma unroll
          for (int e = 0; e < 8; ++e) { const int j = hio * 8 + e; const float ang = pos * rope_invf(j, 16); const float cs = __cosf(ang), sn = __sinf(ang);
            const float x1 = qf[8 + hf * 2][e], x2 = qf[9 + hf * 2][e]; qf[8 + hf * 2][e] = x1 * cs - x2 * sn; qf[9 + hf * 2][e] = x1 * sn + x2 * cs; } }
      }
    }
#pragma unroll
    for (int d0 = 0; d0 < ND0; ++d0) { u32x4 w = {cvtpk(qf[d0][0], qf[d0][1]), cvtpk(qf[d0][2], qf[d0][3]), cvtpk(qf[d0][4], qf[d0][5]), cvtpk(qf[d0][6], qf[d0][7])};
      qr[d0] = *reinterpret_cast<bf16x8*>(&w); }
  }
  int kro[4];
#pragma unroll
  for (int bq = 0; bq < 4; ++bq) kro[bq] = r32 * KROW + (((2 * bq + hi) ^ (r32 & 7)) << 4);
  const int sr = tid >> 4, sc = (tid & 15) * 8, vst0 = v_st(sr, sc), vst1 = v_st(32 + sr, sc);
  const int pr = tid >> 3, pcc = (tid & 7) * 8;
  const int vb0 = (int)(uintptr_t)(LAS char*)V_lds + v_rd_base(lane);
  bf16x8 vs0, vs1, ks0, ks1, kp0;
  const unsigned voff = sr * ldv + sc, koff = sr * ldk + sc, poff = pr * ROPE + pcc;
#define SLOAD(k0) do { const bf16_t* Vt = Vh + (size_t)(k0) * ldv; const bf16_t* Kt = Kh + (size_t)(k0) * ldk; \
    vs0 = *(const bf16x8*)(Vt + voff); vs1 = *(const bf16x8*)(Vt + 32 * ldv + voff); \
    ks0 = *(const bf16x8*)(Kt + koff); ks1 = *(const bf16x8*)(Kt + 32 * ldk + koff); \
    if constexpr (DK == 192) kp0 = *(const bf16x8*)(Kp + (size_t)(k0) * ROPE + poff); } while (0)
#define SWRITE(b) do { *(bf16x8*)(V_lds + (b) * SHM_V + vst0) = vs0; *(bf16x8*)(V_lds + (b) * SHM_V + vst1) = vs1; const int kc = sc * 2; \
    *(bf16x8*)(K_lds + (b) * SHM_K + sr * KROW + (kc ^ ((sr & 7) << 4))) = ks0; \
    *(bf16x8*)(K_lds + (b) * SHM_K + (32 + sr) * KROW + (kc ^ ((sr & 7) << 4))) = ks1; \
    if constexpr (DK == 192) *(bf16x8*)(K_lds + (b) * SHM_K + pr * KROW + ((256 + pcc * 2) ^ ((pr & 7) << 4))) = kp0; } while (0)
#define RESC(a) do { if (__any((a) < 1.f)) { if (hi == 0) al_l[r32] = (a); asm volatile("s_waitcnt lgkmcnt(0)" ::: "memory"); \
    for (int d = 0; d < 4; ++d) for (int r = 0; r < 16; ++r) o[d][r] *= al_l[crow(r, hi)]; } } while (0)
  f32x16 pA0, pA1, pB0, pB1; float mnA, mnB, alA, alB; bf16x8 pa0, pa1, pa2, pa3; const int NT = nkeys / 64;
  SLOAD(0); SWRITE(0); __syncthreads();
  qkt<DK>(pA0, pA1, K_lds, qr, kro); partialSM<DK>(pA0, pA1, m_reg, mnA, alA);
  SLOAD(64); SWRITE(1); __syncthreads();
  for (int j = 1; j + 1 < NT; j += 2) {
    SBAR(); qkt<DK>(pB0, pB1, K_lds + SHM_K, qr, kro);
    finishSM(pA0, pA1, alA, l_reg, pa0, pa1, pa2, pa3); SBAR();
    SLOAD((j + 1) * 64); SBAR();
    pv_d0(o, vb0, pa0, pa1, pa2, pa3); partialSM<DK>(pB0, pB1, m_reg, mnB, alB);
    __syncthreads(); SWRITE(0);
    RESC(alB); __syncthreads();
    SBAR(); qkt<DK>(pA0, pA1, K_lds, qr, kro);
    finishSM(pB0, pB1, alB, l_reg, pa0, pa1, pa2, pa3); SBAR();
    SLOAD((j + 2) * 64); SBAR();
    pv_d0(o, vb0 + SHM_V, pa0, pa1, pa2, pa3); partialSM<DK>(pA0, pA1, m_reg, mnA, alA);
    __syncthreads(); SWRITE(1);
    RESC(alA); __syncthreads();
  }
  SBAR(); qkt<DK>(pB0, pB1, K_lds + SHM_K, qr, kro);
  finishSM(pA0, pA1, alA, l_reg, pa0, pa1, pa2, pa3); SBAR();
  pv_d0(o, vb0, pa0, pa1, pa2, pa3); partialSM<DK>(pB0, pB1, m_reg, mnB, alB);
  __syncthreads(); RESC(alB);
  finishSM(pB0, pB1, alB, l_reg, pa0, pa1, pa2, pa3); SBAR();
  pv_d0(o, vb0 + SHM_V, pa0, pa1, pa2, pa3);
  if (hi == 0) li_l[r32] = l_reg; asm volatile("s_waitcnt lgkmcnt(0)" ::: "memory");
  float rli[16];
#pragma unroll
  for (int r = 0; r < 16; ++r) rli[r] = __builtin_amdgcn_rcpf(li_l[crow(r, hi)]);
  bf16_t* Ow = Ob + (size_t)(wid * 32) * ldo;
#pragma unroll
  for (int r = 0; r < 16; ++r) { const int orow = crow(r, hi);
#pragma unroll
    for (int d0 = 0; d0 < 4; ++d0) Ow[(size_t)orow * ldo + d0 * 32 + r32] = (bf16_t)(cvtpk(o[d0][r] * rli[r], 0.f) & 0xffffu); }
  __syncthreads();
#undef SLOAD
#undef SWRITE
#undef RESC
}

__device__ __forceinline__ void tconv_tile(const float* __restrict__ src, int ldn, int k0, int n0, bf16_t* __restrict__ dst, int ldk, int rmul, int roff, float* lw, int lane) {
  const float* s = src + (size_t)k0 * ldn + n0 + lane;
  float v[64];
#pragma unroll
  for (int i = 0; i < 64; ++i) v[i] = __builtin_nontemporal_load(s + (size_t)i * ldn);
#pragma unroll
  for (int i = 0; i < 64; ++i) lw[i * 65 + lane] = v[i];
  const int kc = (lane & 7) * 8;
#pragma unroll
  for (int it = 0; it < 8; ++it) {
    const int n = it * 8 + (lane >> 3);
    float v[8];
#pragma unroll
    for (int j = 0; j < 8; ++j) v[j] = lw[(kc + j) * 65 + n];
    u32x4 w = {cvtpk(v[0], v[1]), cvtpk(v[2], v[3]), cvtpk(v[4], v[5]), cvtpk(v[6], v[7])};
    __builtin_nontemporal_store(w, (u32x4*)(dst + (size_t)((n0 + n) * rmul + roff) * ldk + k0 + kc));
  }
}

__device__ __forceinline__ void phase_prep(const Params& p, char* lds) {
  int tid = threadIdx.x; asm volatile("" : "+v"(tid));
  const int wid = tid >> 6, lane = tid & 63;
  const int gw = blockIdx.x * 8 + wid, nw = gridDim.x * 8;
  char* ws = opaque_ptr(p.ws);
  float* lw = (float*)lds + wid * (64 * 65);
  for (int t = gw; t < DEPTH * ME * 384; t += nw) {
    const int le = t / 384, tt = t - le * 384, which = tt >> 7, ti = tt & 127;
    bf16_t* wgu = (bf16_t*)(ws + WS_WMOE + (size_t)le * MOE_WBYTES); bf16_t* wd = wgu + 1024 * 1024;
    if (which < 2) { const float* src = p.in[which == 0 ? I_MOE_GATE : I_MOE_UP] + (size_t)le * D * FF;
      const int kt = ti >> 3, nt = ti & 7; tconv_tile(src, FF, kt * 64, nt * 64, wgu, D, 2, which, lw, lane); }
    else { const float* src = p.in[I_MOE_DOWN] + (size_t)le * FF * D;
      const int kt = ti >> 4, nt = ti & 15; tconv_tile(src, D, kt * 64, nt * 64, wd, FF, 1, 0, lw, lane); }
  }
  {
    int base = 0;
#pragma unroll 1
    for (int q = 0; q < 14; ++q) {
      const float* jsrc = p.jobs[q].src; bf16_t* jdst = p.jobs[q].dst; const int jK = p.jobs[q].K, jN = p.jobs[q].N, jroff = p.jobs[q].roff;
      const int nnt = jN >> 6, ntile = (jK >> 6) * nnt;
      for (int t = gw - base; t < ntile; t += nw) { if (t < 0) continue; const int kt = t / nnt, nt = t - kt * nnt;
        tconv_tile(jsrc, jN, kt * 64, nt * 64, jdst, jK, 1, jroff, lw, lane); }
      base = (base + ntile) % nw;
    }
  }
  for (int j = 0; j < 2; ++j) { u32x4* z = (u32x4*)(ws + WS_WMLA + j * MLA_WBYTES + MLA_W1T + (size_t)832 * 1024 * 2);
    for (int i = blockIdx.x * NTHR + tid; i < 192 * 1024 * 2 / 16; i += gridDim.x * NTHR) z[i] = (u32x4){0u, 0u, 0u, 0u}; }
  if (blockIdx.x == 0 && tid < DEPTH * ME) ((int*)(ws + WS_CNT))[tid] = 0;
  if (blockIdx.x == 0 && tid == 0) ((int*)(ws + WS_CNT))[1000] = 0;
  for (int r = gw; r < R; r += nw) {
    const int b = r / RPB, ii = r - b * RPB;
    const f32x4* src = (const f32x4*)(ii < CTX ? p.in[I_CTX] + ((size_t)b * CTX + ii) * D : p.in[I_X] + ((size_t)b * SEQ + (ii - CTX)) * D);
    f32x4* dst = (f32x4*)(ws + WS_X32) + (size_t)r * (D / 4);
#pragma unroll
    for (int q = 0; q < 4; ++q) dst[lane + 64 * q] = src[lane + 64 * q];
  }
  {
    float* sc = (float*)lds;
    __syncthreads();
    for (int u = blockIdx.x; u < DEPTH * 12 * 8; u += gridDim.x) {
      const int i = u / 96, rem = u - i * 96, cch = rem >> 3, ks = rem & 7;
      __syncthreads();
      for (int e = tid; e < 5 * 128; e += NTHR) { const int b = e >> 7, k = ks * 128 + (e & 127); const float c = b < 4 ? p.in[I_C][b * D + k] : p.in[I_CCTX][k]; sc[e] = silu_f(c); }
      __syncthreads();
      const int col = cch * 512 + tid;
      const float* w = p.in[I_WMOD] + (size_t)i * D * NMOD + (size_t)(ks * 128) * NMOD + col;
      float a0 = 0, a1 = 0, a2 = 0, a3 = 0, a4 = 0;
#pragma unroll 8
      for (int k = 0; k < 128; ++k) { const float wv = w[(size_t)k * NMOD]; a0 += sc[k] * wv; a1 += sc[128 + k] * wv; a2 += sc[256 + k] * wv; a3 += sc[384 + k] * wv; a4 += sc[512 + k] * wv; }
      float* mp = (float*)(ws + WS_MODP) + ((size_t)(ks * DEPTH + i) * 5) * NMOD + col;
      mp[0] = a0; mp[NMOD] = a1; mp[2 * NMOD] = a2; mp[3 * NMOD] = a3; mp[4 * NMOD] = a4;
    }
    __syncthreads();
  }
}
__device__ __forceinline__ void phase_modfin(const Params& p) {
  const float* mp = (const float*)(p.ws + WS_MODP); float* mv = (float*)(p.ws + WS_MODV);
  for (int e = blockIdx.x * NTHR + threadIdx.x; e < DEPTH * 5 * NMOD; e += gridDim.x * NTHR) {
    const int i = e / (5 * NMOD), col = e % NMOD;
    float s = p.in[I_BMOD][i * NMOD + col];
#pragma unroll
    for (int ks = 0; ks < 8; ++ks) s += mp[(size_t)ks * DEPTH * 5 * NMOD + e];
    mv[e] = s;
  }
}

template <int MODE, bool COMBINE, bool DRY = false>
__device__ __forceinline__ void phase_norm(const Params& p, int layer) {
  int tid = threadIdx.x; asm volatile("" : "+v"(tid));
  const int wid = tid >> 6, lane = tid & 63;
  const int gw = blockIdx.x * 8 + wid, nw = gridDim.x * 8;
  char* ws = opaque_ptr(p.ws);
  const float* modv = (const float*)(ws + WS_MODV);
  const bf16_t* Y = (const bf16_t*)(ws + WS_Y);
  for (int r = gw; r < R; r += nw) {
    const int b = r / RPB, ii = r - b * RPB; const bool is_ctx = ii < CTX; const int bsel = is_ctx ? 4 : b;
    if (MODE == 2 && is_ctx) continue;
    float* xp = (float*)(ws + WS_X32) + (size_t)r * D;
    f32x4 v[4];
#pragma unroll
    for (int q = 0; q < 4; ++q) v[q] = *(const f32x4*)(xp + (lane + 64 * q) * 4);
    if (COMBINE) {
      const int pl = MODE == 2 ? DEPTH - 1 : layer - 1;
      if (!(pl == DEPTH - 1 && is_ctx)) {
        const float* g2 = modv + ((size_t)pl * 5 + bsel) * NMOD + 5 * D;
#pragma unroll
        for (int q = 0; q < 4; ++q) { const int c = (lane + 64 * q) * 4; const f32x4 g = *(const f32x4*)(g2 + c);
          const u32x2 y0 = *(const u32x2*)(Y + (size_t)(2 * r) * D + c), y1 = *(const u32x2*)(Y + (size_t)(2 * r + 1) * D + c);
          v[q][0] += g[0] * (bflo(y0[0]) + bflo(y1[0])); v[q][1] += g[1] * (bfhi(y0[0]) + bfhi(y1[0]));
          v[q][2] += g[2] * (bflo(y0[1]) + bflo(y1[1])); v[q][3] += g[3] * (bfhi(y0[1]) + bfhi(y1[1])); }
        if (MODE != 2 && !DRY) {
#pragma unroll
          for (int q = 0; q < 4; ++q) *(f32x4*)(xp + (lane + 64 * q) * 4) = v[q];
        }
      }
    }
    float ss = 0.f;
#pragma unroll
    for (int q = 0; q < 4; ++q) ss += v[q][0] * v[q][0] + v[q][1] * v[q][1] + v[q][2] * v[q][2] + v[q][3] * v[q][3];
    ss = wave_sum(ss);
    const float rs = rsqrtf(ss * (1.0f / D) + EPS);
    if (MODE == 2) {
      float* op = p.out + ((size_t)b * SEQ + (ii - CTX)) * D;
#pragma unroll
      for (int q = 0; q < 4; ++q) { const int c = (lane + 64 * q) * 4; const f32x4 g = *(const f32x4*)(p.in[I_FG] + c); f32x4 ov = v[q] * rs * g;
#if DBG_TIME
        { const unsigned long long* d = (const unsigned long long*)(ws + WS_CNT + 4096); const float t1 = (float)d[DBG_T1] * 0.01f, t2 = (float)d[DBG_T2] * 0.01f;
          const float a = sqrtf(t1 * 0.01f); ov = (f32x4){a, a, a, a}; if (r == CTX && c == 0) ov[0] = t2 * 0.002f; }
#endif
        if (DBG_PROBE == 20 && ((const int*)(ws + WS_CNT))[1000]) ov = (f32x4){1000.f, 1000.f, 1000.f, 1000.f};
#ifdef SANITIZE
        for (int e = 0; e < 4; ++e) if (!(fabsf(ov[e]) < 1e30f)) ov[e] = DBG_PROBE ? 0.f : 1000.0f;
        if (DBG_PROBE && ((const int*)(ws + WS_CNT))[1000]) ov = (f32x4){1000.f, 1000.f, 1000.f, 1000.f};
#endif
        *(f32x4*)(op + c) = ov; }
      continue;
    }
    const float* ng = p.in[MODE == 0 ? I_NMG : I_NFG] + layer * D;
    const float* sh = modv + ((size_t)layer * 5 + bsel) * NMOD + (MODE == 0 ? 0 : 3) * D;
    const float* scl = sh + D;
    bf16_t* ap = (bf16_t*)(ws + WS_ACT) + (size_t)r * D;
    f32x4 f[4];
#pragma unroll
    for (int q = 0; q < 4; ++q) { const int c = (lane + 64 * q) * 4; const f32x4 g = *(const f32x4*)(ng + c), s1 = *(const f32x4*)(scl + c), s0 = *(const f32x4*)(sh + c);
      f[q] = (v[q] * rs * g) * (1.0f + s1) + s0;
      u32x2 w = {cvtpk(f[q][0], f[q][1]), cvtpk(f[q][2], f[q][3])}; *(u32x2*)(ap + c) = w; }
    if (MODE == 1) {
      if (layer == DEPTH - 1 && is_ctx) continue;
      const float* wg = p.in[I_MOE_WG] + (size_t)layer * D * 4; const float* we = p.in[I_MOE_WE] + (size_t)layer * D * ME;
      float gl[4] = {0.f, 0.f, 0.f, 0.f};
#pragma unroll
      for (int q = 0; q < 4; ++q)
#pragma unroll
        for (int e = 0; e < 4; ++e) { const int c = (lane + 64 * q) * 4 + e; const f32x4 w = *(const f32x4*)(wg + (size_t)c * 4);
          gl[0] += f[q][e] * w[0]; gl[1] += f[q][e] * w[1]; gl[2] += f[q][e] * w[2]; gl[3] += f[q][e] * w[3]; }
#pragma unroll
      for (int k = 0; k < 4; ++k) gl[k] = wave_sum(gl[k]);
      const float gm = fmaxf(fmaxf(gl[0], gl[1]), fmaxf(gl[2], gl[3]));
      float gp[4], gs = 0.f;
#pragma unroll
      for (int k = 0; k < 4; ++k) { gp[k] = __expf(gl[k] - gm); gs += gp[k]; }
      const float gsi = 1.0f / gs;
      int gsel = 0; float gbest = -1e30f, gw_ = 0.f;
#pragma unroll
      for (int k = 0; k < 4; ++k) { const float pr = gp[k] * gsi; const float sc = pr + p.in[I_MOE_BG][layer * 4 + k]; if (sc > gbest) { gbest = sc; gsel = k; gw_ = pr; } }
      gsel = __builtin_amdgcn_readfirstlane(gsel);
      float el[8] = {0.f, 0.f, 0.f, 0.f, 0.f, 0.f, 0.f, 0.f};
#pragma unroll
      for (int q = 0; q < 4; ++q)
#pragma unroll
        for (int e = 0; e < 4; ++e) { const int c = (lane + 64 * q) * 4 + e; const f32x4 w0 = *(const f32x4*)(we + (size_t)c * ME + gsel * 8), w1 = *(const f32x4*)(we + (size_t)c * ME + gsel * 8 + 4);
          el[0] += f[q][e] * w0[0]; el[1] += f[q][e] * w0[1]; el[2] += f[q][e] * w0[2]; el[3] += f[q][e] * w0[3];
          el[4] += f[q][e] * w1[0]; el[5] += f[q][e] * w1[1]; el[6] += f[q][e] * w1[2]; el[7] += f[q][e] * w1[3]; }
#pragma unroll
      for (int k = 0; k < 8; ++k) el[k] = wave_sum(el[k]);
      float em = el[0];
#pragma unroll
      for (int k = 1; k < 8; ++k) em = fmaxf(em, el[k]);
      float ep[8], es = 0.f;
#pragma unroll
      for (int k = 0; k < 8; ++k) { ep[k] = __expf(el[k] - em); es += ep[k]; }
      const float esi = 1.0f / es;
      int t1 = 0, t2 = 0; float b1 = -1e30f, b2 = -1e30f, p1 = 0.f, p2 = 0.f;
#pragma unroll
      for (int k = 0; k < 8; ++k) { const float pr = ep[k] * esi; const float sc = pr + p.in[I_MOE_BE][layer * ME + gsel * 8 + k];
        if (sc > b1) { b2 = b1; t2 = t1; p2 = p1; b1 = sc; t1 = k; p1 = pr; } else if (sc > b2) { b2 = sc; t2 = k; p2 = pr; } }
      if (lane == 0 && !DRY) {
        const float inv = gw_ / (p1 + p2);
        int* cnt = (int*)(ws + WS_CNT) + layer * ME; int* list = (int*)(ws + WS_LIST); float* wts = (float*)(ws + WS_WTS);
        const int e1 = gsel * 8 + t1, e2 = gsel * 8 + t2;
        const int q1 = atomicAdd(cnt + e1, 1); list[(size_t)e1 * R + q1] = 2 * r;     wts[2 * r] = p1 * inv;
        const int q2 = atomicAdd(cnt + e2, 1); list[(size_t)e2 * R + q2] = 2 * r + 1; wts[2 * r + 1] = p2 * inv;
      }
    }
  }
}

__device__ __forceinline__ void phase_mla_mid(const Params& p, int j) {
  int tid = threadIdx.x; asm volatile("" : "+v"(tid));
  const int wid = tid >> 6, lane = tid & 63;
  const int gw = blockIdx.x * 8 + wid, nw = gridDim.x * 8;
  char* ws = opaque_ptr(p.ws);
  const float* gq = p.in[I_MLA_GQ] + j * QL; const float* gkv = p.in[I_MLA_GKV] + j * KVL;
  for (int r = gw; r < R; r += nw) {
    const int b = r / RPB, ii = r - b * RPB; const bool is_ctx = ii < CTX;
    const bf16_t* c1 = (const bf16_t*)(ws + WS_C1) + (size_t)r * 1024;
    const u32x2 q0w = *(const u32x2*)(c1 + lane * 4), q1w = *(const u32x2*)(c1 + 256 + lane * 4), kvw = *(const u32x2*)(c1 + 512 + lane * 4);
    const f32x4 q0 = {bflo(q0w[0]), bfhi(q0w[0]), bflo(q0w[1]), bfhi(q0w[1])}, q1 = {bflo(q1w[0]), bfhi(q1w[0]), bflo(q1w[1]), bfhi(q1w[1])},
                kv = {bflo(kvw[0]), bfhi(kvw[0]), bflo(kvw[1]), bfhi(kvw[1])};
    const float pe = bf2f(c1[768 + lane]);
    float sq = q0[0] * q0[0] + q0[1] * q0[1] + q0[2] * q0[2] + q0[3] * q0[3] + q1[0] * q1[0] + q1[1] * q1[1] + q1[2] * q1[2] + q1[3] * q1[3];
    float sk = kv[0] * kv[0] + kv[1] * kv[1] + kv[2] * kv[2] + kv[3] * kv[3];
    sq = wave_sum(sq); sk = wave_sum(sk);
    const float rq = rsqrtf(sq * (1.0f / QL) + EPS), rk = rsqrtf(sk * (1.0f / KVL) + EPS);
    bf16_t* cq = (bf16_t*)(ws + WS_CQ) + (size_t)r * QL; bf16_t* ckv = (bf16_t*)(ws + WS_CKV) + (size_t)r * KVL; bf16_t* kpe = (bf16_t*)(ws + WS_KPE) + (size_t)r * ROPE;
    { const f32x4 g = *(const f32x4*)(gq + lane * 4); u32x2 w = {cvtpk(q0[0] * rq * g[0], q0[1] * rq * g[1]), cvtpk(q0[2] * rq * g[2], q0[3] * rq * g[3])}; *(u32x2*)(cq + lane * 4) = w; }
    { const f32x4 g = *(const f32x4*)(gq + 256 + lane * 4); u32x2 w = {cvtpk(q1[0] * rq * g[0], q1[1] * rq * g[1]), cvtpk(q1[2] * rq * g[2], q1[3] * rq * g[3])}; *(u32x2*)(cq + 256 + lane * 4) = w; }
    { const f32x4 g = *(const f32x4*)(gkv + lane * 4); u32x2 w = {cvtpk(kv[0] * rk * g[0], kv[1] * rk * g[1]), cvtpk(kv[2] * rk * g[2], kv[3] * rk * g[3])}; *(u32x2*)(ckv + lane * 4) = w; }
    float outv = pe;
    const float other = __shfl_xor(pe, 16);
    if (!is_ctx) {
      const int s = ii - CTX; const float pos = (lane < 32) ? (float)(s >> 6) : (float)(s & 63);
      const float ang = pos * rope_invf(lane & 15, 16); const float cs = __cosf(ang), sn = __sinf(ang);
      outv = (lane & 16) ? (other * sn + pe * cs) : (pe * cs - other * sn);
    }
    kpe[lane] = (bf16_t)(cvtpk(outv, 0.f) & 0xffffu);
  }
}

__device__ __forceinline__ void phase_gqa_k(const Params& p) {
  int tid = threadIdx.x; asm volatile("" : "+v"(tid));
  const int wid = tid >> 6, lane = tid & 63;
  const int gw = blockIdx.x * 8 + wid, nw = gridDim.x * 8;
  char* ws = opaque_ptr(p.ws); const float* kg = p.in[I_GQA_KG];
  const int sub = lane & 7;
  for (int r = gw; r < R; r += nw) {
    const int b = r / RPB, ii = r - b * RPB; const bool is_ctx = ii < CTX;
    const bf16_t* kp = (const bf16_t*)(ws + WS_QKV) + (size_t)r * 4096 + 2048 + lane * 16;
    const u32x4 w0 = *(const u32x4*)kp, w1 = *(const u32x4*)(kp + 8);
    float v[16];
#pragma unroll
    for (int e = 0; e < 4; ++e) { v[2 * e] = bflo(w0[e]); v[2 * e + 1] = bfhi(w0[e]); v[8 + 2 * e] = bflo(w1[e]); v[9 + 2 * e] = bfhi(w1[e]); }
    float ss = 0.f;
#pragma unroll
    for (int e = 0; e < 16; ++e) ss += v[e] * v[e];
    ss += __shfl_xor(ss, 1); ss += __shfl_xor(ss, 2); ss += __shfl_xor(ss, 4);
    const float rs = rsqrtf(ss * (1.0f / GD) + EPS);
#pragma unroll
    for (int e = 0; e < 16; ++e) v[e] *= rs * kg[sub * 16 + e];
    float o[16];
#pragma unroll
    for (int e = 0; e < 16; ++e) o[e] = __shfl_xor(v[e], 2);
    if (!is_ctx) {
      const int s = ii - CTX; const float pos = (sub < 4) ? (float)(s >> 6) : (float)(s & 63);
#pragma unroll
      for (int e = 0; e < 16; ++e) { const int j = (sub & 1) * 16 + e; const float ang = pos * rope_invf(j, 32); const float cs = __cosf(ang), sn = __sinf(ang);
        v[e] = (sub & 2) ? (o[e] * sn + v[e] * cs) : (v[e] * cs - o[e] * sn); }
    }
    bf16_t* op = (bf16_t*)(ws + WS_KN) + (size_t)r * 1024 + lane * 16;
    u32x4 o0 = {cvtpk(v[0], v[1]), cvtpk(v[2], v[3]), cvtpk(v[4], v[5]), cvtpk(v[6], v[7])}, o1 = {cvtpk(v[8], v[9]), cvtpk(v[10], v[11]), cvtpk(v[12], v[13]), cvtpk(v[14], v[15])};
    *(u32x4*)op = o0; *(u32x4*)(op + 8) = o1;
  }
}

__device__ __forceinline__ void phase_conv_mid(const Params& p) {
  int tid = threadIdx.x; asm volatile("" : "+v"(tid));
  const int wid = tid >> 6, lane = tid & 63;
  const int gw = blockIdx.x * 8 + wid, nw = gridDim.x * 8;
  char* ws = opaque_ptr(p.ws); const float* cw = p.in[I_CONV_W];
  const bf16_t* bcu = (const bf16_t*)(ws + WS_BCU);
  for (int r = gw; r < R; r += nw) {
    const int b = r / RPB, ii = r - b * RPB; const bool is_ctx = ii < CTX;
    const bool hp = is_ctx ? (ii > 0) : (ii > CTX), hn = is_ctx ? (ii < CTX - 1) : (ii < RPB - 1);
    bf16_t* gp = (bf16_t*)(ws + WS_G) + (size_t)r * D;
#pragma unroll
    for (int q = 0; q < 4; ++q) {
      const int c = (lane + 64 * q) * 4;
      const bf16_t* row = bcu + (size_t)r * 3072 + c;
      const u32x2 bg = *(const u32x2*)row, c0 = *(const u32x2*)(row + 1024), u0 = *(const u32x2*)(row + 2048);
      u32x2 cp = {0u, 0u}, up = {0u, 0u}, cn = {0u, 0u}, un = {0u, 0u};
      if (hp) { cp = *(const u32x2*)(row - 3072 + 1024); up = *(const u32x2*)(row - 3072 + 2048); }
      if (hn) { cn = *(const u32x2*)(row + 3072 + 1024); un = *(const u32x2*)(row + 3072 + 2048); }
      const f32x4 w0 = *(const f32x4*)(cw + c), w1 = *(const f32x4*)(cw + D + c), w2 = *(const f32x4*)(cw + 2 * D + c);
      float z[4];
      z[0] = w0[0] * bflo(cp[0]) * bflo(up[0]) + w1[0] * bflo(c0[0]) * bflo(u0[0]) + w2[0] * bflo(cn[0]) * bflo(un[0]);
      z[1] = w0[1] * bfhi(cp[0]) * bfhi(up[0]) + w1[1] * bfhi(c0[0]) * bfhi(u0[0]) + w2[1] * bfhi(cn[0]) * bfhi(un[0]);
      z[2] = w0[2] * bflo(cp[1]) * bflo(up[1]) + w1[2] * bflo(c0[1]) * bflo(u0[1]) + w2[2] * bflo(cn[1]) * bflo(un[1]);
      z[3] = w0[3] * bfhi(cp[1]) * bfhi(up[1]) + w1[3] * bfhi(c0[1]) * bfhi(u0[1]) + w2[3] * bfhi(cn[1]) * bfhi(un[1]);
      u32x2 w = {cvtpk(bflo(bg[0]) * z[0], bfhi(bg[0]) * z[1]), cvtpk(bflo(bg[1]) * z[2], bfhi(bg[1]) * z[3])};
      *(u32x2*)(gp + c) = w;
    }
  }
}

constexpr int LI_OFF = 135168;
__device__ __forceinline__ void moe_prefix(const Params& p, int layer, int* li) {
  if (threadIdx.x == 0) { const int* cnt = (const int*)(p.ws + WS_CNT) + layer * ME; int o = 0, t = 0;
    for (int e = 0; e < ME; ++e) { li[e] = o; li[33 + e] = t; const int c = cnt[e]; o += c; t += (c + 127) >> 7; } li[32] = o; li[65] = t; }
  __syncthreads();
}
struct MoeUnit { int e, ct, nvalid, slot0, lbase, ri0, ri1; };
template <bool DOWN>
struct MoeProv {
  char* ws; const int* li; const int* cnt; int layer;
  typedef MoeUnit Unit;
  __device__ __forceinline__ bool unit(int it, Unit& U, int srow) const {
    const int un = blockIdx.x + it * gridDim.x;
    if (un >= li[65] * 4) return false;
    const int t = un >> 2; int e = 0;
    while (li[33 + e + 1] <= t) ++e;
    const int rt = t - li[33 + e];
    U.e = e; U.ct = un & 3; U.nvalid = min(128, cnt[e] - rt * 128); U.slot0 = li[e] + rt * 128; U.lbase = e * R + rt * 128;
    if (!DOWN) { const int* list = (const int*)(ws + WS_LIST) + U.lbase;
      U.ri0 = list[srow < U.nvalid ? srow : 0] >> 1; U.ri1 = list[srow + 64 < U.nvalid ? srow + 64 : 0] >> 1; }
    return true;
  }
  static constexpr bool A_AFFINE = DOWN;
  __device__ __forceinline__ int a_stride(const Unit&) const { return 64 * FF; }
  __device__ __forceinline__ int b_stride(const Unit&) const { return DOWN ? 64 * FF : 64 * D; }
  __device__ __forceinline__ const bf16_t* a_row(const Unit& U, int r) const {
    if (DOWN) return (const bf16_t*)(ws + WS_HID) + (size_t)(U.slot0 + r) * FF;
    return (const bf16_t*)(ws + WS_ACT) + (size_t)(r < 64 ? U.ri0 : U.ri1) * D;
  }
  __device__ __forceinline__ const bf16_t* b_row(const Unit& U, int r) const {
    const bf16_t* w = (const bf16_t*)(ws + WS_WMOE + (size_t)(layer * ME + U.e) * MOE_WBYTES);
    return DOWN ? w + 1024 * 1024 + (size_t)(U.ct * 256 + r) * FF : w + (size_t)(U.ct * 256 + r) * D;
  }
  __device__ __forceinline__ int nk(const Unit&) const { return DOWN ? FF / 64 : D / 64; }
  __device__ __forceinline__ void epi(const Unit& U, int r, int c, f32x4 v) const {
    if (r >= U.nvalid) return;
    if (!DOWN) {
      const float h0 = silu_f(v[0]) * v[1], h1 = silu_f(v[2]) * v[3];
      *(unsigned*)((bf16_t*)(ws + WS_HID) + (size_t)(U.slot0 + r) * FF + ((U.ct * 256 + c) >> 1)) = cvtpk(h0, h1);
    } else {
      const int aid = ((const int*)(ws + WS_LIST))[U.lbase + r]; const float w = ((const float*)(ws + WS_WTS))[aid];
      u32x2 o = {cvtpk(v[0] * w, v[1] * w), cvtpk(v[2] * w, v[3] * w)};
      *(u32x2*)((bf16_t*)(ws + WS_Y) + (size_t)aid * D + U.ct * 256 + c) = o;
    }
  }
};
template <bool DOWN>
__device__ __forceinline__ void phase_moe(const Params& p, int layer, char* lds) {
  int* li = (int*)(lds + LI_OFF); moe_prefix(p, layer, li);
  char* ws = opaque_ptr(p.ws);
  MoeProv<DOWN> pv{ws, li, (const int*)(ws + WS_CNT) + layer * ME, layer};
  gemm_stream<8>(pv, lds);
}

__device__ __forceinline__ void phase_attn_mla(const Params& p, bool ctx_out, char* lds) {
  char* ws = opaque_ptr(p.ws);
  const bf16_t* Q = (const bf16_t*)(ws + WS_Q); const bf16_t* KV = (const bf16_t*)(ws + WS_KV); const bf16_t* KPE = (const bf16_t*)(ws + WS_KPE); bf16_t* O = (bf16_t*)(ws + WS_O);
  const int x = blockIdx.x & 7, nloc = gridDim.x >> 3, nlat = NB * MLA_H * 2  , nctx = ctx_out ? 4 : 0;
  for (int lu = (blockIdx.x >> 3); lu < nlat + nctx; lu += nloc) {
    int b, h, q0, nkeys; bool rope;
    if (lu < nlat) { const int pair = x * 4 + (lu >> 4), qb = lu & 15; b = pair / MLA_H; h = pair % MLA_H; q0 = CTX + qb * 256; nkeys = RPB; rope = true; }
    else { const int pair = x * 4 + (lu - nlat); b = pair / MLA_H; h = pair % MLA_H; q0 = 0; nkeys = CTX; rope = false; }
    const size_t rb = (size_t)b * RPB;
    attn_unit<192, 1536, 2048, 2048, 1024>(Q + (rb + q0) * 1536 + h * 192, KV + rb * 2048 + h * 256, KPE + rb * ROPE, KV + rb * 2048 + h * 256 + 128,
                   O + (rb + q0) * 1024 + h * 128, nkeys, rope, q0 - CTX, nullptr, lds);
  }
}
__device__ __forceinline__ void phase_attn_gqa(const Params& p, char* lds) {
  char* ws = opaque_ptr(p.ws);
  const bf16_t* QKV = (const bf16_t*)(ws + WS_QKV); const bf16_t* KN = (const bf16_t*)(ws + WS_KN); bf16_t* O = (bf16_t*)(ws + WS_OG);
  const int x = blockIdx.x & 7, nloc = gridDim.x >> 3, nlat = 128, nctx = 8;
  for (int lu = (blockIdx.x >> 3); lu < nlat + nctx; lu += nloc) {
    int b, h, q0, nkeys; bool rope;
    if (lu < nlat) { const int pair = x * 8 + (lu >> 4), qb = lu & 15; b = pair / GH; h = pair % GH; q0 = CTX + qb * 256; nkeys = RPB; rope = true; }
    else { const int pair = x * 8 + (lu - nlat); b = pair / GH; h = pair % GH; q0 = 0; nkeys = CTX; rope = false; }
    const size_t rb = (size_t)b * RPB; const int kvh = h >> 1;
    attn_unit<128, 4096, 1024, 4096, 2048>(QKV + (rb + q0) * 4096 + h * 128, KN + rb * 1024 + kvh * 128, nullptr, QKV + rb * 4096 + 3072 + kvh * 128,
                   O + (rb + q0) * 2048 + h * 128, nkeys, rope, q0 - CTX, p.in[I_GQA_QG], lds);
  }
}


__device__ __forceinline__ void dbg_probe(const Params& p) {
  char* ws = opaque_ptr(p.ws);
  size_t off = 0, n = 0; bool is_bf = true;
  switch (DBG_PROBE) {
    case 1: off = WS_MODV; n = (size_t)4 * 5 * NMOD; is_bf = false; break;
    case 2: off = WS_ACT; n = (size_t)R * D; break;
    case 3: off = WS_C1; n = (size_t)R * 1024; is_bf = false; break;
    case 4: off = WS_CQ; n = (size_t)R * 512; break;
    case 5: off = WS_CKV; n = (size_t)R * 256; break;
    case 6: off = WS_KPE; n = (size_t)R * 64; break;
    case 7: off = WS_Q; n = (size_t)R * 1536; break;
    case 8: off = WS_KV; n = (size_t)R * 2048; break;
    case 9: off = WS_O; n = (size_t)R * 1024; break;
    case 10: off = WS_X32; n = (size_t)R * D; is_bf = false; break;
    case 11: off = WS_WMLA; n = MLA_WBYTES / 2; break;
    default: break;
  }
  int bad = 0;
  for (size_t i = (size_t)blockIdx.x * NTHR + threadIdx.x; i < n; i += (size_t)gridDim.x * NTHR) {
    float v = is_bf ? bf2f(((const bf16_t*)(ws + off))[i]) : ((const float*)(ws + off))[i];
    if (!(fabsf(v) < 1e30f)) bad = 1;
  }
  if (bad) atomicOr((int*)(ws + WS_CNT) + 1000, 1);
}

constexpr int DYN_LDS = 139264;
extern __shared__ __attribute__((aligned(16))) char smem[];

__global__ void __launch_bounds__(NTHR, 2) fwd_megakernel(Params p) {
  cg::grid_group grid = cg::this_grid();
  char* lds = smem;
#define WSO() char* ws = opaque_ptr(p.ws)
  volatile LAS unsigned* xst = (volatile LAS unsigned*)(LAS char*)(smem + DYN_LDS - 16);
  if (threadIdx.x == 0) { xst[0] = 0u; xst[1] = 0u; }
  __syncthreads();
  const XcdBarrier xb = xcd_barrier_post((unsigned*)(p.ws + WS_BAR), xst);
#if DBG_TIME
  unsigned long long tc_prep = 0, tc_norm = 0, tc_gemm = 0, tc_mid = 0, tc_amla = 0, tc_agqa = 0, tc_moe1 = 0, tc_moe2 = 0, tc_sync = 0, tA, tB, tC;
#define PH(cat, ...) do { tA = __builtin_amdgcn_s_memrealtime(); __VA_ARGS__; tB = __builtin_amdgcn_s_memrealtime(); xcd_barrier(xb); tC = __builtin_amdgcn_s_memrealtime(); \
    tc_##cat += tC - tA; tc_sync += tC - tB; } while (0)
#else
#define PH(cat, ...) do { __VA_ARGS__; xcd_barrier(xb); } while (0)
#endif
#define PHD(cat, id, ...) do { PH(cat, __VA_ARGS__); if (DUP == id) PH(cat, __VA_ARGS__); } while (0)
#define PHR(...) do { if (DUP == 15) { float* const DRYP = (float*)(p.ws + WS_Y); PH(gemm, __VA_ARGS__); } { float* const DRYP = nullptr; PH(gemm, __VA_ARGS__); } } while (0)
#if DBG_TIME
  tA = __builtin_amdgcn_s_memrealtime();
#endif
#pragma unroll 1
  for (int rep_ = 0; rep_ < (DUP == 18 ? 2 : 1); ++rep_) {
  if (rep_ == 1) xcd_barrier(xb);
  if (DBG_PROBE == 20 && threadIdx.x == 0) ((int*)(p.ws + WS_CNT))[1024 + blockIdx.x] = (int)xb.x;
  phase_prep(p, lds);
  if (p.out == nullptr) grid.sync();
  xcd_barrier(xb);
#if DBG_TIME
  tc_prep += __builtin_amdgcn_s_memrealtime() - tA;
#endif
  if (DUP == 12) { xcd_barrier(xb); phase_prep(p, lds); xcd_barrier(xb); }
  if (DBG_PROBE == 20 && blockIdx.x == 0 && threadIdx.x == 0) { const int* t = (const int*)(p.ws + WS_CNT) + 1024; int bad = 0, seen = 0;
    for (int i = 0; i < (int)gridDim.x; ++i) { if (t[i] != t[i & 7]) bad = 1; }
    for (int i = 0; i < 8; ++i) seen |= 1 << t[i];
    if (bad || seen != 0xff) ((int*)(p.ws + WS_CNT))[1000] = 1; }
  PH(prep, phase_modfin(p));
  if (DUP == 14) { for (int q = 0; q < 40; ++q) xcd_barrier(xb); }
  if (STOP_AFTER == 0) { phase_norm<2, false>(p, 0); return; }
#pragma unroll 1
  for (int layer = 0; layer < DEPTH; ++layer) {
    const int kind = layer % 3, j = layer / 3; const bool ctx_out = layer < DEPTH - 1;
    if (DUP == 17 && layer > 0) PH(norm, phase_norm<0, true, true>(p, layer));
    PH(norm, if (layer == 0) phase_norm<0, false>(p, layer); else phase_norm<0, true>(p, layer));
    if (DUP == 13 && layer == 0) { for (int q = 0; q < 4; ++q) PH(norm, phase_norm<0, false>(p, layer)); }
    if (kind == 0) {
      PHD(gemm, 1, { WSO(); const char* wb = ws + WS_WMLA + j * MLA_WBYTES;
        gemm_dense<17, 2, false>((const bf16_t*)(ws + WS_ACT), D, (const bf16_t*)(wb + MLA_W1T), 1024, D, EpiBf16{(bf16_t*)(ws + WS_C1), 1024}, lds); });
      PHD(mid, 2, phase_mla_mid(p, j));
      PHD(gemm, 3, { WSO(); const char* wb = ws + WS_WMLA + j * MLA_WBYTES;
        MlaUpProv pv{(const bf16_t*)(ws + WS_CQ), (const bf16_t*)(ws + WS_CKV), (const bf16_t*)(wb + MLA_WUQT), (const bf16_t*)(wb + MLA_WUKVT), (bf16_t*)(ws + WS_Q), (bf16_t*)(ws + WS_KV)};
        gemm_stream<17>(pv, lds); });
      PHD(amla, 4, phase_attn_mla(p, ctx_out, lds));
      PHR({ WSO(); const char* wb = ws + WS_WMLA + j * MLA_WBYTES;
        const EpiResid er{(float*)(ws + WS_X32), (const float*)(ws + WS_MODV) + (size_t)layer * 5 * NMOD + 2 * D, DRYP};
        if (ctx_out) gemm_dense<17, 2, false>((const bf16_t*)(ws + WS_O), 1024, (const bf16_t*)(wb + MLA_WOT), D, 1024, er, lds);
        else gemm_dense<16, 2, true>((const bf16_t*)(ws + WS_O), 1024, (const bf16_t*)(wb + MLA_WOT), D, 1024, er, lds); });
    } else if (kind == 1) {
      PHD(gemm, 5, { WSO(); gemm_dense<17, 2, false>((const bf16_t*)(ws + WS_ACT), D, (const bf16_t*)(ws + WS_WCONV_IN), 3072, D, EpiBf16{(bf16_t*)(ws + WS_BCU), 3072}, lds); });
      if (DUP == 21) PH(gemm, { WSO(); gemm_dense<17, 2, false, EpiBf16, 1>((const bf16_t*)(ws + WS_ACT), D, (const bf16_t*)(ws + WS_WCONV_IN), 3072, D, EpiBf16{(bf16_t*)(ws + WS_G + (size_t)R * 1024 * 2), 3072}, lds); });
      if (DUP == 22) PH(gemm, { WSO(); gemm_dense<17, 2, false, EpiBf16, 2>((const bf16_t*)(ws + WS_ACT), D, (const bf16_t*)(ws + WS_WCONV_IN), 3072, D, EpiBf16{(bf16_t*)(ws + WS_G + (size_t)R * 1024 * 2), 3072}, lds); });
      if (DUP == 23) PH(gemm, { WSO(); gemm_dense<17, 2, false, EpiBf16, 0>((const bf16_t*)(ws + WS_ACT), D, (const bf16_t*)(ws + WS_WCONV_IN), 3072, D, EpiBf16{(bf16_t*)(ws + WS_G + (size_t)R * 1024 * 2), 3072}, lds); });
      PHD(mid, 6, phase_conv_mid(p));
      PHR({ WSO(); gemm_dense<17, 2, false>((const bf16_t*)(ws + WS_G), D, (const bf16_t*)(ws + WS_WCONV_OUT), D, D,
                                EpiResid{(float*)(ws + WS_X32), (const float*)(ws + WS_MODV) + (size_t)layer * 5 * NMOD + 2 * D, DRYP}, lds); });
    } else {
      PHD(gemm, 7, { WSO(); gemm_dense<17, 2, false>((const bf16_t*)(ws + WS_ACT), D, (const bf16_t*)(ws + WS_WGQA_QKV), 4096, D, EpiBf16{(bf16_t*)(ws + WS_QKV), 4096}, lds); });
      PHD(mid, 8, phase_gqa_k(p));
      PHD(agqa, 9, phase_attn_gqa(p, lds));
      PHR({ WSO(); gemm_dense<17, 2, false>((const bf16_t*)(ws + WS_OG), 2048, (const bf16_t*)(ws + WS_WGQA_O), D, 2048,
                                EpiResid{(float*)(ws + WS_X32), (const float*)(ws + WS_MODV) + (size_t)layer * 5 * NMOD + 2 * D, DRYP}, lds); });
    }
    if (STOP_AFTER == 2 * layer + 1) { if (DBG_PROBE) { dbg_probe(p); xcd_barrier(xb); } phase_norm<2, false>(p, 0); return; }
    if (DUP == 16) PH(norm, phase_norm<1, false, true>(p, layer));
    PH(norm, phase_norm<1, false>(p, layer));
    PHD(moe1, 10, phase_moe<false>(p, layer, lds));
    PHD(moe2, 11, phase_moe<true>(p, layer, lds));
    if (STOP_AFTER == 2 * layer + 2) break;
  }
  }
#if DBG_TIME
  if (blockIdx.x == 0 && threadIdx.x == 0) {
    unsigned long long* d = (unsigned long long*)(p.ws + WS_CNT + 4096);
    d[0] = tc_prep; d[1] = tc_norm; d[2] = tc_gemm; d[3] = tc_mid; d[4] = tc_amla; d[5] = tc_agqa; d[6] = tc_moe1; d[7] = tc_moe2; d[8] = tc_sync;
  }
  xcd_barrier(xb);
#endif
  phase_norm<2, true>(p, 0);
}

extern "C" void kernel_launch(void* const* d_in, const int* in_sizes, int n_in, void* d_out, int out_size, void* d_ws, size_t ws_size,
                              hipStream_t stream) {
  static int grid_blocks = 0;
  if (!grid_blocks) {
    int dev = 0, cus = 0, per_cu = 0;
    (void)hipGetDevice(&dev);
    (void)hipDeviceGetAttribute(&cus, hipDeviceAttributeMultiprocessorCount, dev);
    (void)hipFuncSetAttribute((const void*)fwd_megakernel, hipFuncAttributeMaxDynamicSharedMemorySize, DYN_LDS);
    (void)hipOccupancyMaxActiveBlocksPerMultiprocessor(&per_cu, fwd_megakernel, NTHR, DYN_LDS);
    grid_blocks = per_cu >= 1 ? cus : 0;
    if (ws_size < WS_END || n_in != N_IN) { fprintf(stderr, "kernel_launch: ws %zu < %zu or n_in %d\n", ws_size, (size_t)WS_END, n_in); grid_blocks = 0; }
    if (!grid_blocks) { fprintf(stderr, "kernel_launch: cannot launch (per_cu %d)\n", per_cu); return; }
  }
  Params p{};
  for (int i = 0; i < N_IN; ++i) p.in[i] = (const float*)d_in[i];
  p.out = (float*)d_out; p.ws = (char*)d_ws;
  {
    char* ws = p.ws; int nj = 0;
    for (int j = 0; j < 2; ++j) {
      char* wb = ws + WS_WMLA + j * MLA_WBYTES;
      p.jobs[nj++] = TJob{p.in[I_MLA_WDQ] + (size_t)j * D * QL, (bf16_t*)(wb + MLA_W1T), D, QL, 1, 0};
      p.jobs[nj++] = TJob{p.in[I_MLA_WDKV] + (size_t)j * D * 320, (bf16_t*)(wb + MLA_W1T), D, 320, 1, 512};
      p.jobs[nj++] = TJob{p.in[I_MLA_WUQ] + (size_t)j * QL * 1536, (bf16_t*)(wb + MLA_WUQT), QL, 1536, 1, 0};
      p.jobs[nj++] = TJob{p.in[I_MLA_WUKV] + (size_t)j * KVL * 2048, (bf16_t*)(wb + MLA_WUKVT), KVL, 2048, 1, 0};
      p.jobs[nj++] = TJob{p.in[I_MLA_WO] + (size_t)j * 1024 * D, (bf16_t*)(wb + MLA_WOT), 1024, D, 1, 0};
    }
    p.jobs[nj++] = TJob{p.in[I_CONV_WIN], (bf16_t*)(ws + WS_WCONV_IN), D, 3072, 1, 0};
    p.jobs[nj++] = TJob{p.in[I_CONV_WOUT], (bf16_t*)(ws + WS_WCONV_OUT), D, D, 1, 0};
    p.jobs[nj++] = TJob{p.in[I_GQA_WQKV], (bf16_t*)(ws + WS_WGQA_QKV), D, 4096, 1, 0};
    p.jobs[nj++] = TJob{p.in[I_GQA_WO], (bf16_t*)(ws + WS_WGQA_O), 2048, D, 1, 0};
  }
  (void)hipMemsetAsync((char*)d_ws + WS_BAR, 0, XCD_BAR_WORDS * 4, stream);
  void* args[] = {&p};
  hipError_t e = hipLaunchCooperativeKernel((void*)fwd_megakernel, dim3(grid_blocks), dim3(NTHR), args, DYN_LDS, stream);
  if (e != hipSuccess) fprintf(stderr, "cooperative launch failed: %s (grid %d)\n", hipGetErrorString(e), grid_blocks);
}
```

```cpp
#include <hip/hip_runtime.h>
#include <hip/hip_cooperative_groups.h>
#include <cstdio>
#include <cstdint>
namespace cg = cooperative_groups;

#ifndef DUP
#define DUP 0
#endif
#ifndef DBG_TIME
#define DBG_TIME 0
#endif
#ifndef DBG_T1
#define DBG_T1 0
#define DBG_T2 1
#endif
#ifndef DBG_PROBE
#define DBG_PROBE 0
#endif
#ifndef STOP_AFTER
#define STOP_AFTER 8
#endif

#define LAS __attribute__((address_space(3)))
typedef unsigned short bf16_t;
typedef short bf16x8 __attribute__((ext_vector_type(8)));
typedef short s16x4 __attribute__((ext_vector_type(4)));
typedef float f32x4 __attribute__((ext_vector_type(4)));
typedef float f32x16 __attribute__((ext_vector_type(16)));
typedef unsigned u32x4 __attribute__((ext_vector_type(4)));
typedef unsigned u32x2 __attribute__((ext_vector_type(2)));

constexpr int D = 1024, NB = 4, SEQ = 4096, CTX = 256, RPB = SEQ + CTX, R = NB * RPB;
constexpr int DEPTH = 4, NMOD = 6 * D;
constexpr int MLA_H = 8, QL = 512, KVL = 256, NOPE = 128, ROPE = 64, MV = 128;
constexpr int GH = 16, GKV = 8, GD = 128;
constexpr int ME = 32, FF = 512;
constexpr float EPS = 1e-6f;
constexpr int NTHR = 512;

enum { I_X = 0, I_C, I_CTX, I_CCTX, I_WMOD, I_BMOD, I_NMG, I_NFG, I_MLA_WDQ, I_MLA_GQ, I_MLA_WUQ, I_MLA_WDKV, I_MLA_GKV, I_MLA_WUKV, I_MLA_WO,
       I_CONV_WIN, I_CONV_W, I_CONV_WOUT, I_GQA_WQKV, I_GQA_QG, I_GQA_KG, I_GQA_WO, I_MOE_WG, I_MOE_BG, I_MOE_WE, I_MOE_BE, I_MOE_GATE, I_MOE_UP, I_MOE_DOWN, I_FG, N_IN };

constexpr size_t al256(size_t x) { return (x + 255) / 256 * 256; }
constexpr size_t WS_BAR = 0;
constexpr size_t WS_CNT = 16384;
constexpr size_t WS_MODP = 16384 + 8192;
constexpr size_t WS_MODV = WS_MODP + (size_t)8 * 4 * 5 * NMOD * 4;
constexpr size_t WS_WTS = WS_MODV + (size_t)4 * 5 * NMOD * 4;
constexpr size_t WS_LIST = al256(WS_WTS + (size_t)2 * R * 4);
#ifndef XBF16
#define XBF16 1
#endif
constexpr size_t WS_X32 = al256(WS_LIST + (size_t)32 * R * 4);
constexpr size_t WS_ACT = WS_X32 + (size_t)R * D * (XBF16 ? 2 : 4);
constexpr size_t WS_HID = WS_ACT + (size_t)R * D * 2;
constexpr size_t WS_Y = WS_HID + (size_t)(2 * R + 256) * FF * 2;
constexpr size_t WS_MIX = WS_Y + (size_t)2 * R * D * 2;
constexpr size_t MIX_BYTES = (size_t)R * (1024 * 4 + 512 * 2 + 256 * 2 + 64 * 2 + 1536 * 2 + 2048 * 2 + 1024 * 2);
constexpr size_t WS_C1 = WS_MIX;
constexpr size_t WS_CQ = WS_C1 + (size_t)R * 1024 * 4;
constexpr size_t WS_CKV = WS_CQ + (size_t)R * 512 * 2;
constexpr size_t WS_KPE = WS_CKV + (size_t)R * 256 * 2;
constexpr size_t WS_Q = WS_KPE + (size_t)R * 64 * 2;
constexpr size_t WS_KV = WS_Q + (size_t)R * 1536 * 2;
constexpr size_t WS_O = WS_KV + (size_t)R * 2048 * 2;
constexpr size_t WS_QKV = WS_MIX;
constexpr size_t WS_KN = WS_QKV + (size_t)R * 4096 * 2;
constexpr size_t WS_OG = WS_KN + (size_t)R * 1024 * 2;
constexpr size_t WS_BCU = WS_MIX;
constexpr size_t WS_G = WS_BCU + (size_t)R * 3072 * 2;
static_assert(WS_OG + (size_t)R * 2048 * 2 <= WS_MIX + MIX_BYTES, "gqa scratch");
static_assert(WS_G + (size_t)R * 1024 * 2 <= WS_MIX + MIX_BYTES, "conv scratch");
constexpr size_t WS_WT = al256(WS_MIX + MIX_BYTES);
constexpr size_t MLA_W1T = 0, MLA_WUQT = MLA_W1T + (size_t)1024 * 1024 * 2, MLA_WUKVT = MLA_WUQT + (size_t)1536 * 512 * 2, MLA_WOT = MLA_WUKVT + (size_t)2048 * 256 * 2,
                 MLA_WBYTES = MLA_WOT + (size_t)1024 * 1024 * 2;
constexpr size_t WS_WMLA = WS_WT;
constexpr size_t WS_WCONV_IN = WS_WMLA + 2 * MLA_WBYTES;
constexpr size_t WS_WCONV_OUT = WS_WCONV_IN + (size_t)3072 * 1024 * 2;
constexpr size_t WS_WGQA_QKV = WS_WCONV_OUT + (size_t)1024 * 1024 * 2;
constexpr size_t WS_WGQA_O = WS_WGQA_QKV + (size_t)4096 * 1024 * 2;
constexpr size_t WS_WMOE = WS_WGQA_O + (size_t)1024 * 2048 * 2;
constexpr size_t MOE_WBYTES = (size_t)1024 * 1024 * 2 + (size_t)1024 * 512 * 2;
constexpr size_t WS_END = WS_WMOE + (size_t)DEPTH * ME * MOE_WBYTES;
static_assert(WS_END <= (size_t)1073741824, "workspace over 1 GiB");

struct TJob { const float* src; bf16_t* dst; int K, N, rmul, roff; };
struct Params {
  const float* in[N_IN];
  float* out;
  char* ws;
  TJob jobs[14];
};

typedef __bf16 bf16x2_t __attribute__((ext_vector_type(2)));
__device__ __forceinline__ unsigned cvtpk(float lo, float hi) { bf16x2_t v = {(__bf16)lo, (__bf16)hi}; return __builtin_bit_cast(unsigned, v); }
__device__ __forceinline__ float bf2f(unsigned short h) { return __uint_as_float((unsigned)h << 16); }
__device__ __forceinline__ float bflo(unsigned w) { return __uint_as_float(w << 16); }
__device__ __forceinline__ float bfhi(unsigned w) { return __uint_as_float(w & 0xffff0000u); }
#if XBF16
typedef bf16_t xres_t;
__device__ __forceinline__ f32x4 xload4(const xres_t* q) { const u32x2 w = *(const u32x2*)q; return (f32x4){bflo(w[0]), bfhi(w[0]), bflo(w[1]), bfhi(w[1])}; }
__device__ __forceinline__ void xstore4(xres_t* q, f32x4 v) { u32x2 w = {cvtpk(v[0], v[1]), cvtpk(v[2], v[3])}; *(u32x2*)q = w; }
#else
typedef float xres_t;
__device__ __forceinline__ f32x4 xload4(const xres_t* q) { return *(const f32x4*)q; }
__device__ __forceinline__ void xstore4(xres_t* q, f32x4 v) { *(f32x4*)q = v; }
#endif
__device__ __forceinline__ float wave_sum(float v) {
#pragma unroll
  for (int o = 32; o > 0; o >>= 1) v += __shfl_xor(v, o);
  return v;
}
__device__ __forceinline__ float silu_f(float x) { return x / (1.0f + __expf(-x)); }
__device__ __forceinline__ void glds16(const void* g, char* l) { __builtin_amdgcn_global_load_lds((const unsigned*)g, (LAS unsigned*)l, 16, 0, 0); }
__device__ __forceinline__ char* opaque_ptr(char* q) {
  unsigned lo = __builtin_amdgcn_readfirstlane((unsigned)(uintptr_t)q), hi = __builtin_amdgcn_readfirstlane((unsigned)((uintptr_t)q >> 32));
  asm volatile("" : "+s"(lo), "+s"(hi));
  return (char*)(((uintptr_t)hi << 32) | (uintptr_t)lo); }
__device__ __forceinline__ float rope_invf(int j, int half) { return exp2f(-(float)j * (13.287712379549449f / (float)half)); }


#define XB_TMO      128
#define XB_XCNT(j)  (256  + 64 * (j))
#define XB_XSUB(j)  (1280 + 64 * (j))
#define XB_XGEN(j)  (2304 + 64 * (j))
#define XB_TOP      3328
#define XB_TOPGEN   3392
#define XCD_BAR_WORDS 3456
#define XB_SPIN_CAP (1u << 22)
__device__ __forceinline__ unsigned xb_ld(unsigned* p)              { return __hip_atomic_load(p, __ATOMIC_RELAXED, __HIP_MEMORY_SCOPE_AGENT); }
__device__ __forceinline__ unsigned xb_add(unsigned* p, unsigned v) { return __hip_atomic_fetch_add(p, v, __ATOMIC_RELAXED, __HIP_MEMORY_SCOPE_AGENT); }
__device__ __forceinline__ unsigned xb_xcc_id() { return (unsigned)__builtin_amdgcn_s_getreg((3 << 11) | 20) & 0xFu; }
#define XB_SPIN(cond, bar) do { unsigned _sp = 0; while (cond) { __builtin_amdgcn_s_sleep(1); \
    if ((++_sp & 255u) == 0u) { if (xb_ld(&(bar)[XB_TMO])) break; if (_sp > XB_SPIN_CAP) { atomicAdd(&(bar)[XB_TMO], 1u); break; } } } } while (0)
struct XcdBarrier { unsigned* bar; unsigned x; volatile LAS unsigned* st; };
__device__ __forceinline__ XcdBarrier xcd_barrier_post(unsigned* bar, volatile LAS unsigned* st) {
  XcdBarrier b; b.bar = bar; b.x = xb_xcc_id(); b.st = st;
  if (threadIdx.x == 0) (void)xb_add(&bar[XB_XCNT(b.x)], 1u);
  return b;
}
__device__ __forceinline__ void xcd_barrier_complete(unsigned* bar, unsigned x, unsigned& nloc, unsigned& nx) {
  const unsigned G = gridDim.x * gridDim.y * gridDim.z;
  unsigned sum, cnt, mine, sp = 0u;
  for (;;) {
    sum = 0u; cnt = 0u; mine = 0u;
#pragma unroll
    for (unsigned j = 0; j < 16; ++j) { const unsigned c = xb_ld(&bar[XB_XCNT(j)]); sum += c; cnt += (c > 0u) ? 1u : 0u; mine = (j == x) ? c : mine; }
    if (sum == G) break;
    __builtin_amdgcn_s_sleep(1);
    if ((++sp & 255u) == 0u) { if (xb_ld(&bar[XB_TMO])) break; if (sp > XB_SPIN_CAP) { atomicAdd(&bar[XB_TMO], 1u); break; } }
  }
  nloc = mine > 0u ? mine : 1u; nx = cnt > 0u ? cnt : 1u;
}
__device__ __forceinline__ void xcd_barrier(const XcdBarrier& b) {
  asm volatile("s_waitcnt vmcnt(0)" ::: "memory");
  __syncthreads();
  if (threadIdx.x == 0) {
    unsigned* bar = b.bar;
    __builtin_amdgcn_s_waitcnt(0);
    unsigned nloc = b.st[0], nx = b.st[1];
    if (nloc == 0u) { xcd_barrier_complete(bar, b.x, nloc, nx); b.st[0] = nloc; b.st[1] = nx; }
    const unsigned old = xb_add(&bar[XB_XSUB(b.x)], 1u);
    const unsigned gen = old / nloc;
    if (old + 1u == (gen + 1u) * nloc) {
      __builtin_amdgcn_fence(__ATOMIC_RELEASE, "agent");
      asm volatile("s_waitcnt vmcnt(0)" ::: "memory");
      const unsigned og = xb_add(&bar[XB_TOP], 1u);
      const unsigned tg = og / nx;
      if (og + 1u == (tg + 1u) * nx) xb_add(&bar[XB_TOPGEN], 1u);
      else XB_SPIN(xb_ld(&bar[XB_TOPGEN]) == tg, bar);
      __builtin_amdgcn_fence(__ATOMIC_ACQUIRE, "agent");
      xb_add(&bar[XB_XGEN(b.x)], 1u);
      asm volatile("s_waitcnt vmcnt(0)" ::: "memory");
    } else {
      XB_SPIN(xb_ld(&bar[XB_XGEN(b.x)]) == gen, bar);
      __builtin_amdgcn_fence(__ATOMIC_ACQUIRE, "agent");
      asm volatile("s_waitcnt vmcnt(0)" ::: "memory");
    }
  }
  __syncthreads();
}

template <int MB, class Prov, int GMODE = 0>
__device__ __forceinline__ void gemm_stream(const Prov& pv, char* lds) {
  constexpr int BM = MB * 16, BN = 256, A_BYTES = BM * 128, STAGE = (BM + BN) * 128, AR = (BM + 63) / 64, BR = BN / 64, MB0 = (MB + 1) / 2, NW = 4;
  static_assert(2 * STAGE <= 135168, "GEMM LDS stages");
  int tid = threadIdx.x; asm volatile("" : "+v"(tid));
  const int wid = tid >> 6, lane = tid & 63, fr = lane & 15, fq = lane >> 4, wm = wid >> 2, wn = wid & 3;
  const int srow = tid >> 3, pc = tid & 7, lc = pc ^ (srow & 7);
  const int lds_base = (int)(uintptr_t)(LAS char*)lds;
  const int a_off = lds_base + (wm * MB0 * 16 + fr) * 128, b_off = lds_base + A_BYTES + (wn * 64 + fr) * 128;
  const int ch0 = (fq ^ (fr & 7)) * 16, ch1 = ((4 + fq) ^ (fr & 7)) * 16;
  const bool lastm = (MB % 2 == 0) || wm == 0;
  typename Prov::Unit u, un;
  int it = 0;
  if (!pv.unit(it, u, srow)) return;
  constexpr int APN = Prov::A_AFFINE ? 1 : AR;
  const bf16_t* ap[APN]; const bf16_t* bp0; int astr = 0, bstr = 0;
#define GS_LOADPTR(U) do { _Pragma("unroll") for (int i = 0; i < APN; ++i) ap[i] = pv.a_row(U, srow + 64 * i) + lc * 8; \
    bp0 = pv.b_row(U, srow) + lc * 8; astr = pv.a_stride(U); bstr = pv.b_stride(U); } while (0)
#define GS_ISSUE(KO, BUF) do { char* base_ = lds + (BUF) * STAGE; \
    _Pragma("unroll") for (int i = 0; i < AR; ++i) if (AR * 64 == BM || srow + 64 * i < BM) glds16((Prov::A_AFFINE ? ap[0] + (size_t)i * astr : ap[i < APN ? i : 0]) + (KO), base_ + i * 8192 + tid * 16); \
    _Pragma("unroll") for (int i = 0; i < BR; ++i) glds16(bp0 + (size_t)i * bstr + (KO), base_ + A_BYTES + i * 8192 + tid * 16); } while (0)
#define GS_DSR(dst, addr) asm volatile("ds_read_b128 %0, %1" : "=v"(dst) : "v"(addr) : "memory")
  GS_LOADPTR(u); GS_ISSUE(0, 0);
  int buf = 0;
  for (;;) {
    const bool have_n = pv.unit(it + 1, un, srow);
    const int nk = pv.nk(u);
    f32x4 acc[MB0][NW];
#pragma unroll
    for (int m = 0; m < MB0; ++m)
#pragma unroll
      for (int n = 0; n < NW; ++n) acc[m][n] = (f32x4){0.f, 0.f, 0.f, 0.f};
    for (int kt = 0; kt < nk; ++kt) {
      asm volatile("s_waitcnt vmcnt(0)" ::: "memory");
      __syncthreads();
      if (GMODE != 2) { if (kt + 1 < nk) { GS_ISSUE((kt + 1) * 64, buf ^ 1); }
      else if (have_n) { GS_LOADPTR(un); GS_ISSUE(0, buf ^ 1); } }
      if (GMODE != 1) {
        constexpr int NI = 2 * MB0, GS = 2, NG = (NI + GS - 1) / GS;
        const int sbo = buf * STAGE;
        const int aa0 = sbo + a_off + ch0, aa1 = sbo + a_off + ch1, bb0 = sbo + b_off + ch0, bb1 = sbo + b_off + ch1;
        bf16x8 fb[2][NW], fa[2][GS];
#pragma unroll
        for (int n = 0; n < NW; ++n) GS_DSR(fb[0][n], bb0 + n * 2048);
#pragma unroll
        for (int j = 0; j < GS; ++j) GS_DSR(fa[0][j], aa0 + j * 2048);
#pragma unroll
        for (int n = 0; n < NW; ++n) GS_DSR(fb[1][n], bb1 + n * 2048);
#pragma unroll
        for (int g = 0; g < NG; ++g) {
          int nnext = 0;
          if (g + 1 < NG) {
#pragma unroll
            for (int j = 0; j < GS; ++j) { const int i = (g + 1) * GS + j; if (i < NI) { GS_DSR(fa[(g + 1) & 1][j], (i / MB0 ? aa1 : aa0) + (i % MB0) * 2048); ++nnext; } }
          }
          if (g == 0) nnext += NW;
          if (nnext == 8) asm volatile("s_waitcnt lgkmcnt(8)" ::: "memory"); else if (nnext == 7) asm volatile("s_waitcnt lgkmcnt(7)" ::: "memory");
          else if (nnext == 6) asm volatile("s_waitcnt lgkmcnt(6)" ::: "memory"); else if (nnext == 5) asm volatile("s_waitcnt lgkmcnt(5)" ::: "memory");
          else if (nnext == 4) asm volatile("s_waitcnt lgkmcnt(4)" ::: "memory"); else if (nnext == 3) asm volatile("s_waitcnt lgkmcnt(3)" ::: "memory");
          else if (nnext == 2) asm volatile("s_waitcnt lgkmcnt(2)" ::: "memory"); else if (nnext == 1) asm volatile("s_waitcnt lgkmcnt(1)" ::: "memory");
          else asm volatile("s_waitcnt lgkmcnt(0)" ::: "memory");
          __builtin_amdgcn_sched_barrier(0);
#pragma unroll
          for (int j = 0; j < GS; ++j) { const int i = g * GS + j;
            if (i < NI) { const int m = i % MB0;
              if (m < MB0 - 1 || lastm) {
#pragma unroll
                for (int n = 0; n < NW; ++n) acc[m][n] = __builtin_amdgcn_mfma_f32_16x16x32_bf16(fb[i / MB0][n], fa[g & 1][j], acc[m][n], 0, 0, 0);
              } } }
          __builtin_amdgcn_sched_barrier(0);
        }
      }
      buf ^= 1;
    }
#pragma unroll
    for (int m = 0; m < MB0; ++m) if (m < MB0 - 1 || lastm) {
#pragma unroll
      for (int n = 0; n < NW; ++n) pv.epi(u, (wm * MB0 + m) * 16 + fr, wn * 64 + n * 16 + fq * 4, acc[m][n]);
    }
    if (!have_n) break;
    u = un; ++it;
  }
  __syncthreads();
#undef GS_LOADPTR
#undef GS_ISSUE
#undef GS_DSR
}

struct EpiBf16 { bf16_t* C; int ldc; __device__ __forceinline__ void operator()(int r, int c, f32x4 v) const {
  u32x2 w = {cvtpk(v[0], v[1]), cvtpk(v[2], v[3])}; *(u32x2*)(C + (size_t)r * ldc + c) = w; } };
struct EpiF32 { float* C; int ldc; __device__ __forceinline__ void operator()(int r, int c, f32x4 v) const { *(f32x4*)(C + (size_t)r * ldc + c) = v; } };
struct EpiResid { xres_t* X; const float* gate; xres_t* dry; __device__ __forceinline__ void operator()(int row, int c, f32x4 v) const {
  const int b = row / RPB, ii = row - b * RPB, bsel = ii < CTX ? 4 : b;
  const f32x4 g = *(const f32x4*)(gate + (size_t)bsel * NMOD + c);
  f32x4 x = xload4(X + (size_t)row * D + c); x += g * v; xstore4((dry ? dry : X) + (size_t)row * D + c, x); } };

template <int BM, int BN, bool LATONLY, class Epi>
struct DenseProv {
  const bf16_t* A; int lda; const bf16_t* Bt; int K; int nNt; Epi ep;
  struct Unit { int m0, n0; };
  __device__ __forceinline__ bool unit(int it, Unit& U, int) const {
    const int nloc = gridDim.x >> 3, x = blockIdx.x & 7, loc = (blockIdx.x >> 3) + nloc * it;
    if (loc >= 8 * nNt) return false;
    const int mt = x * 8 + (loc & 7), nt = loc >> 3;
    U.m0 = LATONLY ? (mt >> 4) * RPB + CTX + (mt & 15) * 256 : mt * BM; U.n0 = nt * BN; return true;
  }
  static constexpr bool A_AFFINE = true;
  __device__ __forceinline__ int a_stride(const Unit&) const { return 64 * lda; }
  __device__ __forceinline__ int b_stride(const Unit&) const { return 64 * K; }
  __device__ __forceinline__ const bf16_t* a_row(const Unit& U, int r) const { return A + (size_t)(U.m0 + r) * lda; }
  __device__ __forceinline__ const bf16_t* b_row(const Unit& U, int r) const { return Bt + (size_t)(U.n0 + r) * K; }
  __device__ __forceinline__ int nk(const Unit&) const { return K >> 6; }
  __device__ __forceinline__ void epi(const Unit& U, int r, int c, f32x4 v) const { ep(U.m0 + r, U.n0 + c, v); }
};
template <int MB, int NBW, bool LATONLY, class Epi, int GMODE = 0>
__device__ __forceinline__ void gemm_dense(const bf16_t* A, int lda, const bf16_t* Bt, int N, int K, const Epi& ep, char* lds) {
  static_assert(NBW == 2, "256-column tiles");
  DenseProv<MB * 16, 256, LATONLY, Epi> pv{A, lda, Bt, K, N / 256, ep};
  gemm_stream<MB, DenseProv<MB * 16, 256, LATONLY, Epi>, GMODE>(pv, lds);
}

struct MlaUpProv {
  const bf16_t* CQ; const bf16_t* CKV; const bf16_t* WUQ; const bf16_t* WUKV; bf16_t* Q; bf16_t* KV;
  struct Unit { int m0, n0, which; };
  __device__ __forceinline__ bool unit(int it, Unit& U, int) const {
    const int b = blockIdx.x; int which, t;
    if (b < 128) { if (it > 2) return false; which = it == 2; t = it == 2 ? b : 2 * b + it; }
    else { if (it > 3) return false; which = it != 0; t = it == 0 ? 256 + (b - 128) : 128 + 3 * (b - 128) + (it - 1); }
    U.which = which;
    if (which) { U.m0 = (t >> 3) * 272; U.n0 = (t & 7) * 256; } else { U.m0 = (t / 6) * 272; U.n0 = (t % 6) * 256; }
    return true;
  }
  static constexpr bool A_AFFINE = true;
  __device__ __forceinline__ int a_stride(const Unit& U) const { return U.which ? 64 * KVL : 64 * QL; }
  __device__ __forceinline__ int b_stride(const Unit& U) const { return U.which ? 64 * KVL : 64 * QL; }
  __device__ __forceinline__ const bf16_t* a_row(const Unit& U, int r) const { return U.which ? CKV + (size_t)(U.m0 + r) * KVL : CQ + (size_t)(U.m0 + r) * QL; }
  __device__ __forceinline__ const bf16_t* b_row(const Unit& U, int r) const { return U.which ? WUKV + (size_t)(U.n0 + r) * KVL : WUQ + (size_t)(U.n0 + r) * QL; }
  __device__ __forceinline__ int nk(const Unit& U) const { return U.which ? KVL / 64 : QL / 64; }
  __device__ __forceinline__ void epi(const Unit& U, int r, int c, f32x4 v) const {
    u32x2 w = {cvtpk(v[0], v[1]), cvtpk(v[2], v[3])};
    bf16_t* o = U.which ? KV + (size_t)(U.m0 + r) * 2048 + U.n0 + c : Q + (size_t)(U.m0 + r) * 1536 + U.n0 + c; *(u32x2*)o = w; }
};

template <int DK> struct AttnCfg {
  static constexpr int KROW = DK * 2;
  static constexpr int SHM_V = 64 * 128 * 2, SHM_K = 64 * KROW;
  static constexpr int SHM = 2 * SHM_V + 2 * SHM_K + 8 * 64 * 4;
};
#define SBAR() __builtin_amdgcn_sched_barrier(0)
__device__ __forceinline__ int crow(int r, int hi) { return (r & 3) + 8 * (r >> 2) + 4 * hi; }
__device__ __forceinline__ int v_st(int k, int c) { const int kk = (k & ~0xC) | ((k & 4) << 1) | ((k & 8) >> 1); return ((kk >> 3) * 4 + (c >> 5)) * 512 + ((kk & 7) * 32 + (c & 31)) * 2; }
__device__ __forceinline__ int v_rd_base(int lane) { return ((lane & 3) << 3) | (((lane >> 2) & 3) << 6) | (((lane >> 4) & 1) << 5) | (((lane >> 5) & 1) << 8); }
constexpr int v_rd_off(int d0, int ks, int half) { return d0 * 512 + ks * 4096 + half * 2048; }
template <int OFF> __device__ __forceinline__ s16x4 tr_read(int vb) {
  s16x4 r; asm volatile("ds_read_b64_tr_b16 %0, %1 offset:%2" : "=&v"(r) : "v"(vb), "i"(OFF) : "memory"); return r;
}
template <int D0> __device__ __forceinline__ void pv_one(f32x16& od, int vb, bf16x8 pa0, bf16x8 pa1, bf16x8 pa2, bf16x8 pa3) {
  const s16x4 l0 = tr_read<v_rd_off(D0, 0, 0)>(vb), h0 = tr_read<v_rd_off(D0, 0, 1)>(vb), l1 = tr_read<v_rd_off(D0, 1, 0)>(vb), h1 = tr_read<v_rd_off(D0, 1, 1)>(vb);
  const s16x4 l2 = tr_read<v_rd_off(D0, 2, 0)>(vb), h2 = tr_read<v_rd_off(D0, 2, 1)>(vb), l3 = tr_read<v_rd_off(D0, 3, 0)>(vb), h3 = tr_read<v_rd_off(D0, 3, 1)>(vb);
  asm volatile("s_waitcnt lgkmcnt(0)" ::: "memory"); SBAR();
#define PK(L, H) (bf16x8){L[0], L[1], L[2], L[3], H[0], H[1], H[2], H[3]}
  od = __builtin_amdgcn_mfma_f32_32x32x16_bf16(pa0, PK(l0, h0), od, 0, 0, 0);
  od = __builtin_amdgcn_mfma_f32_32x32x16_bf16(pa1, PK(l1, h1), od, 0, 0, 0);
  od = __builtin_amdgcn_mfma_f32_32x32x16_bf16(pa2, PK(l2, h2), od, 0, 0, 0);
  od = __builtin_amdgcn_mfma_f32_32x32x16_bf16(pa3, PK(l3, h3), od, 0, 0, 0);
#undef PK
}
__device__ __forceinline__ void pv_d0(f32x16* o, int vb, bf16x8 pa0, bf16x8 pa1, bf16x8 pa2, bf16x8 pa3) {
  pv_one<0>(o[0], vb, pa0, pa1, pa2, pa3); pv_one<1>(o[1], vb, pa0, pa1, pa2, pa3); pv_one<2>(o[2], vb, pa0, pa1, pa2, pa3); pv_one<3>(o[3], vb, pa0, pa1, pa2, pa3);
}
constexpr float ATT_THR = 8.f;
template <int DK> __device__ __forceinline__ void partialSM(f32x16& p0, f32x16& p1, float& m_reg, float& mn, float& alpha) {
  constexpr float SCALE = DK == 192 ? 0.07216878364870322f : 0.08838834764831845f;
  constexpr float C = SCALE * 1.4426950408889634f;
  float pmax = p0[0];
#pragma unroll
  for (int r = 1; r < 16; ++r) pmax = fmaxf(pmax, p0[r]);
#pragma unroll
  for (int r = 0; r < 16; ++r) pmax = fmaxf(pmax, p1[r]);
  { auto rr = __builtin_amdgcn_permlane32_swap(__float_as_uint(pmax), __float_as_uint(pmax), false, false);
    pmax = fmaxf(__uint_as_float(rr[0]), __uint_as_float(rr[1])); }
  if (__builtin_expect(__all(pmax - m_reg <= ATT_THR / SCALE), 1)) { mn = m_reg; alpha = 1.f; }
  else { mn = fmaxf(m_reg, pmax); alpha = __builtin_amdgcn_exp2f((m_reg - mn) * C); m_reg = mn; }
  const float mnC = -mn * C;
#pragma unroll
  for (int r = 0; r < 16; ++r) p0[r] = fmaf(p0[r], C, mnC);
#pragma unroll
  for (int r = 0; r < 16; ++r) p1[r] = fmaf(p1[r], C, mnC);
#pragma unroll
  for (int r = 0; r < 16; ++r) p0[r] = __builtin_amdgcn_exp2f(p0[r]);
}
__device__ __forceinline__ void finishSM(f32x16& p0, f32x16& p1, float alpha, float& l_reg, bf16x8& pa0, bf16x8& pa1, bf16x8& pa2, bf16x8& pa3) {
#pragma unroll
  for (int r = 0; r < 16; ++r) p1[r] = __builtin_amdgcn_exp2f(p1[r]);
  float ps = 0;
#pragma unroll
  for (int r = 0; r < 16; ++r) ps += p0[r];
#pragma unroll
  for (int r = 0; r < 16; ++r) ps += p1[r];
  { auto rr = __builtin_amdgcn_permlane32_swap(__float_as_uint(ps), __float_as_uint(ps), false, false);
    ps = __uint_as_float(rr[0]) + __uint_as_float(rr[1]); }
  l_reg = l_reg * alpha + ps;
#define PK4(P, BASE, OUT) do { unsigned a0 = cvtpk(P[BASE + 0], P[BASE + 1]), a1 = cvtpk(P[BASE + 2], P[BASE + 3]);   \
    unsigned b0 = cvtpk(P[BASE + 4], P[BASE + 5]), b1 = cvtpk(P[BASE + 6], P[BASE + 7]);                              \
    auto r0 = __builtin_amdgcn_permlane32_swap(a0, b0, false, false); auto r1 = __builtin_amdgcn_permlane32_swap(a1, b1, false, false); \
    u32x4 w = {r0[0], r1[0], r0[1], r1[1]}; OUT = *reinterpret_cast<bf16x8*>(&w); } while (0)
  PK4(p0, 0, pa0); PK4(p0, 8, pa1); PK4(p1, 0, pa2); PK4(p1, 8, pa3);
#undef PK4
}
template <int DK> __device__ __forceinline__ void qkt(f32x16& p0, f32x16& p1, const char* Ks, const bf16x8* qr, const int* kro) {
  constexpr int KROW = DK * 2;
  p0 = f32x16{}; p1 = f32x16{};
#pragma unroll
  for (int d0 = 0; d0 < DK / 16; ++d0) {
    bf16x8 b0 = *reinterpret_cast<const bf16x8*>(Ks + kro[d0 & 3] + (d0 >> 2) * 128);
    bf16x8 b1 = *reinterpret_cast<const bf16x8*>(Ks + kro[d0 & 3] + (d0 >> 2) * 128 + 32 * KROW);
    p0 = __builtin_amdgcn_mfma_f32_32x32x16_bf16(b0, qr[d0], p0, 0, 0, 0);
    p1 = __builtin_amdgcn_mfma_f32_32x32x16_bf16(b1, qr[d0], p1, 0, 0, 0); }
}

template <int DK, int ldq, int ldk, int ldv, int ldo>
__device__ __forceinline__ void attn_unit(const bf16_t* __restrict__ Qb, const bf16_t* __restrict__ Kh, const bf16_t* __restrict__ Kp,
                                          const bf16_t* __restrict__ Vh, bf16_t* __restrict__ Ob, int nkeys, bool rope, int qpos0,
                                          const float* __restrict__ qg, char* lds) {
  using Cfg = AttnCfg<DK>;
  constexpr int KROW = Cfg::KROW, SHM_V = Cfg::SHM_V, SHM_K = Cfg::SHM_K, ND0 = DK / 16;
  int tid = threadIdx.x; asm volatile("" : "+v"(tid));
  const int wid = tid >> 6, lane = tid & 63, r32 = lane & 31, hi = lane >> 5;
  char* V_lds = lds; char* K_lds = lds + 2 * SHM_V;
  float* wsl = (float*)(lds + 2 * SHM_V + 2 * SHM_K) + wid * 64; float* li_l = wsl; float* al_l = wsl + 32;
  float m_reg = -1e30f, l_reg = 0; f32x16 o[4] = {}; bf16x8 qr[ND0];
  {
    const int qrow = wid * 32 + r32;
    const bf16_t* Qw = Qb + (size_t)qrow * ldq + hi * 8;
    float qf[ND0][8];
#pragma unroll
    for (int d0 = 0; d0 < ND0; ++d0) { const u32x4 w = *reinterpret_cast<const u32x4*>(Qw + d0 * 16);
#pragma unroll
      for (int e = 0; e < 4; ++e) { qf[d0][2 * e] = bflo(w[e]); qf[d0][2 * e + 1] = bfhi(w[e]); } }
    const int qpos = qpos0 + qrow; const float prow = (float)(qpos >> 6), pcol = (float)(qpos & 63);
    int hio = hi; asm volatile("" : "+v"(hio));
    if constexpr (DK == 128) {
      float ss = 0.f;
#pragma unroll
      for (int d0 = 0; d0 < 8; ++d0)
#pragma unroll
        for (int e = 0; e < 8; ++e) ss += qf[d0][e] * qf[d0][e];
      ss += __shfl_xor(ss, 32);
      const float rs = rsqrtf(ss * (1.0f / 128.0f) + EPS);
#pragma unroll
      for (int d0 = 0; d0 < 8; ++d0) { const f32x4 g0 = *(const f32x4*)(qg + d0 * 16 + hi * 8), g1 = *(const f32x4*)(qg + d0 * 16 + hi * 8 + 4);
#pragma unroll
        for (int e = 0; e < 4; ++e) { qf[d0][e] *= rs * g0[e]; qf[d0][4 + e] *= rs * g1[e]; } }
      if (rope) {
#pragma unroll
        for (int hf = 0; hf < 2; ++hf) { const float pos = hf ? pcol : prow;
#pragma unroll
          for (int dd = 0; dd < 2; ++dd)
#pragma unroll
            for (int e = 0; e < 8; ++e) { const int j = dd * 16 + hio * 8 + e; const float ang = pos * rope_invf(j, 32); const float cs = __cosf(ang), sn = __sinf(ang);
              const float x1 = qf[hf * 4 + dd][e], x2 = qf[hf * 4 + dd + 2][e]; qf[hf * 4 + dd][e] = x1 * cs - x2 * sn; qf[hf * 4 + dd + 2][e] = x1 * sn + x2 * cs; } }
      }
    } else {
      if (rope) {
#pragma unroll
        for (int hf = 0; hf < 2; ++hf) { const float pos = hf ? pcol : prow;
#pragma unroll
          for (int e = 0; e < 8; ++e) { const int j = hio * 8 + e; const float ang = pos * rope_invf(j, 16); const float cs = __cosf(ang), sn = __sinf(ang);
            const float x1 = qf[8 + hf * 2][e], x2 = qf[9 + hf * 2][e]; qf[8 + hf * 2][e] = x1 * cs - x2 * sn; qf[9 + hf * 2][e] = x1 * sn + x2 * cs; } }
      }
    }
#pragma unroll
    for (int d0 = 0; d0 < ND0; ++d0) { u32x4 w = {cvtpk(qf[d0][0], qf[d0][1]), cvtpk(qf[d0][2], qf[d0][3]), cvtpk(qf[d0][4], qf[d0][5]), cvtpk(qf[d0][6], qf[d0][7])};
      qr[d0] = *reinterpret_cast<bf16x8*>(&w); }
  }
  int kro[4];
#pragma unroll
  for (int bq = 0; bq < 4; ++bq) kro[bq] = r32 * KROW + (((2 * bq + hi) ^ (r32 & 7)) << 4);
  const int sr = tid >> 4, sc = (tid & 15) * 8, vst0 = v_st(sr, sc), vst1 = v_st(32 + sr, sc);
  const int pr = tid >> 3, pcc = (tid & 7) * 8;
  const int vb0 = (int)(uintptr_t)(LAS char*)V_lds + v_rd_base(lane);
  bf16x8 vs0, vs1, ks0, ks1, kp0;
  const unsigned voff = sr * ldv + sc, koff = sr * ldk + sc, poff = pr * ROPE + pcc;
#define SLOAD(k0) do { const bf16_t* Vt = Vh + (size_t)(k0) * ldv; const bf16_t* Kt = Kh + (size_t)(k0) * ldk; \
    vs0 = *(const bf16x8*)(Vt + voff); vs1 = *(const bf16x8*)(Vt + 32 * ldv + voff); \
    ks0 = *(const bf16x8*)(Kt + koff); ks1 = *(const bf16x8*)(Kt + 32 * ldk + koff); \
    if constexpr (DK == 192) kp0 = *(const bf16x8*)(Kp + (size_t)(k0) * ROPE + poff); } while (0)
#define SWRITE(b) do { *(bf16x8*)(V_lds + (b) * SHM_V + vst0) = vs0; *(bf16x8*)(V_lds + (b) * SHM_V + vst1) = vs1; const int kc = sc * 2; \
    *(bf16x8*)(K_lds + (b) * SHM_K + sr * KROW + (kc ^ ((sr & 7) << 4))) = ks0; \
    *(bf16x8*)(K_lds + (b) * SHM_K + (32 + sr) * KROW + (kc ^ ((sr & 7) << 4))) = ks1; \
    if constexpr (DK == 192) *(bf16x8*)(K_lds + (b) * SHM_K + pr * KROW + ((256 + pcc * 2) ^ ((pr & 7) << 4))) = kp0; } while (0)
#define RESC(a) do { if (__any((a) < 1.f)) { if (hi == 0) al_l[r32] = (a); asm volatile("s_waitcnt lgkmcnt(0)" ::: "memory"); \
    for (int d = 0; d < 4; ++d) for (int r = 0; r < 16; ++r) o[d][r] *= al_l[crow(r, hi)]; } } while (0)
  f32x16 pA0, pA1, pB0, pB1; float mnA, mnB, alA, alB; bf16x8 pa0, pa1, pa2, pa3; const int NT = nkeys / 64;
  SLOAD(0); SWRITE(0); __syncthreads();
  qkt<DK>(pA0, pA1, K_lds, qr, kro); partialSM<DK>(pA0, pA1, m_reg, mnA, alA);
  SLOAD(64); SWRITE(1); __syncthreads();
  for (int j = 1; j + 1 < NT; j += 2) {
    SBAR(); qkt<DK>(pB0, pB1, K_lds + SHM_K, qr, kro);
    finishSM(pA0, pA1, alA, l_reg, pa0, pa1, pa2, pa3); SBAR();
    SLOAD((j + 1) * 64); SBAR();
    pv_d0(o, vb0, pa0, pa1, pa2, pa3); partialSM<DK>(pB0, pB1, m_reg, mnB, alB);
    __syncthreads(); SWRITE(0);
    RESC(alB); __syncthreads();
    SBAR(); qkt<DK>(pA0, pA1, K_lds, qr, kro);
    finishSM(pB0, pB1, alB, l_reg, pa0, pa1, pa2, pa3); SBAR();
    SLOAD((j + 2) * 64); SBAR();
    pv_d0(o, vb0 + SHM_V, pa0, pa1, pa2, pa3); partialSM<DK>(pA0, pA1, m_reg, mnA, alA);
    __syncthreads(); SWRITE(1);
    RESC(alA); __syncthreads();
  }
  SBAR(); qkt<DK>(pB0, pB1, K_lds + SHM_K, qr, kro);
  finishSM(pA0, pA1, alA, l_reg, pa0, pa1, pa2, pa3); SBAR();
  pv_d0(o, vb0, pa0, pa1, pa2, pa3); partialSM<DK>(pB0, pB1, m_reg, mnB, alB);
  __syncthreads(); RESC(alB);
  finishSM(pB0, pB1, alB, l_reg, pa0, pa1, pa2, pa3); SBAR();
  pv_d0(o, vb0 + SHM_V, pa0, pa1, pa2, pa3);
  if (hi == 0) li_l[r32] = l_reg; asm volatile("s_waitcnt lgkmcnt(0)" ::: "memory");
  float rli[16];
#pragma unroll
  for (int r = 0; r < 16; ++r) rli[r] = __builtin_amdgcn_rcpf(li_l[crow(r, hi)]);
  bf16_t* Ow = Ob + (size_t)(wid * 32) * ldo;
#pragma unroll
  for (int r = 0; r < 16; ++r) { const int orow = crow(r, hi);
#pragma unroll
    for (int d0 = 0; d0 < 4; ++d0) Ow[(size_t)orow * ldo + d0 * 32 + r32] = (bf16_t)(cvtpk(o[d0][r] * rli[r], 0.f) & 0xffffu); }
  __syncthreads();
#undef SLOAD
#undef SWRITE
#undef RESC
}

__device__ __forceinline__ void tconv_tile(const float* __restrict__ src, int ldn, int k0, int n0, bf16_t* __restrict__ dst, int ldk, int rmul, int roff, float* lw, int lane) {
  const float* s = src + (size_t)k0 * ldn + n0 + lane;
  float v[64];
#pragma unroll
  for (int i = 0; i < 64; ++i) v[i] = __builtin_nontemporal_load(s + (size_t)i * ldn);
#pragma unroll
  for (int i = 0; i < 64; ++i) lw[i * 65 + lane] = v[i];
  const int kc = (lane & 7) * 8;
#pragma unroll
  for (int it = 0; it < 8; ++it) {
    const int n = it * 8 + (lane >> 3);
    float v[8];
#pragma unroll
    for (int j = 0; j < 8; ++j) v[j] = lw[(kc + j) * 65 + n];
    u32x4 w = {cvtpk(v[0], v[1]), cvtpk(v[2], v[3]), cvtpk(v[4], v[5]), cvtpk(v[6], v[7])};
    *(u32x4*)(dst + (size_t)((n0 + n) * rmul + roff) * ldk + k0 + kc) = w;
  }
}

#ifndef MOE_JIT
#define MOE_JIT 1
#endif
__device__ __forceinline__ void phase_conv_moe(const Params& p, int layer, char* lds) {
  int tid = threadIdx.x; asm volatile("" : "+v"(tid));
  const int wid = tid >> 6, lane = tid & 63;
  const int gw = blockIdx.x * 8 + wid, nw = gridDim.x * 8;
  char* ws = opaque_ptr(p.ws);
  float* lw = (float*)lds + wid * (64 * 65);
  for (int t = gw; t < ME * 384; t += nw) {
    const int le = layer * ME + t / 384, tt = t % 384, which = tt >> 7, ti = tt & 127;
    bf16_t* wgu = (bf16_t*)(ws + WS_WMOE + (size_t)le * MOE_WBYTES); bf16_t* wd = wgu + 1024 * 1024;
    if (which < 2) { const float* src = p.in[which == 0 ? I_MOE_GATE : I_MOE_UP] + (size_t)le * D * FF;
      const int kt = ti >> 3, nt = ti & 7; tconv_tile(src, FF, kt * 64, nt * 64, wgu, D, 2, which, lw, lane); }
    else { const float* src = p.in[I_MOE_DOWN] + (size_t)le * FF * D;
      const int kt = ti >> 4, nt = ti & 15; tconv_tile(src, D, kt * 64, nt * 64, wd, FF, 1, 0, lw, lane); }
  }
}
__device__ __forceinline__ void phase_prep(const Params& p, char* lds) {
  int tid = threadIdx.x; asm volatile("" : "+v"(tid));
  const int wid = tid >> 6, lane = tid & 63;
  const int gw = blockIdx.x * 8 + wid, nw = gridDim.x * 8;
  char* ws = opaque_ptr(p.ws);
  float* lw = (float*)lds + wid * (64 * 65);
  for (int t = gw + (MOE_JIT ? DEPTH * ME * 384 : 0); t < DEPTH * ME * 384; t += nw) {
    const int le = t / 384, tt = t - le * 384, which = tt >> 7, ti = tt & 127;
    bf16_t* wgu = (bf16_t*)(ws + WS_WMOE + (size_t)le * MOE_WBYTES); bf16_t* wd = wgu + 1024 * 1024;
    if (which < 2) { const float* src = p.in[which == 0 ? I_MOE_GATE : I_MOE_UP] + (size_t)le * D * FF;
      const int kt = ti >> 3, nt = ti & 7; tconv_tile(src, FF, kt * 64, nt * 64, wgu, D, 2, which, lw, lane); }
    else { const float* src = p.in[I_MOE_DOWN] + (size_t)le * FF * D;
      const int kt = ti >> 4, nt = ti & 15; tconv_tile(src, D, kt * 64, nt * 64, wd, FF, 1, 0, lw, lane); }
  }
  {
    int base = 0;
#pragma unroll 1
    for (int q = 0; q < 14; ++q) {
      const float* jsrc = p.jobs[q].src; bf16_t* jdst = p.jobs[q].dst; const int jK = p.jobs[q].K, jN = p.jobs[q].N, jroff = p.jobs[q].roff;
      const int nnt = jN >> 6, ntile = (jK >> 6) * nnt;
      for (int t = gw - base; t < ntile; t += nw) { if (t < 0) continue; const int kt = t / nnt, nt = t - kt * nnt;
        tconv_tile(jsrc, jN, kt * 64, nt * 64, jdst, jK, 1, jroff, lw, lane); }
      base = (base + ntile) % nw;
    }
  }
  for (int j = 0; j < 2; ++j) { u32x4* z = (u32x4*)(ws + WS_WMLA + j * MLA_WBYTES + MLA_W1T + (size_t)832 * 1024 * 2);
    for (int i = blockIdx.x * NTHR + tid; i < 192 * 1024 * 2 / 16; i += gridDim.x * NTHR) z[i] = (u32x4){0u, 0u, 0u, 0u}; }
  if (blockIdx.x == 0 && tid < DEPTH * ME) ((int*)(ws + WS_CNT))[tid] = 0;
  if (blockIdx.x == 0 && tid == 0) ((int*)(ws + WS_CNT))[1000] = 0;
  for (int r = gw; r < R; r += nw) {
    const int b = r / RPB, ii = r - b * RPB;
    const f32x4* src = (const f32x4*)(ii < CTX ? p.in[I_CTX] + ((size_t)b * CTX + ii) * D : p.in[I_X] + ((size_t)b * SEQ + (ii - CTX)) * D);
    xres_t* dst = (xres_t*)(ws + WS_X32) + (size_t)r * D;
#pragma unroll
    for (int q = 0; q < 4; ++q) xstore4(dst + (lane + 64 * q) * 4, src[lane + 64 * q]);
  }
  {
    float* sc = (float*)lds;
    __syncthreads();
    for (int u = blockIdx.x; u < DEPTH * 12 * 8; u += gridDim.x) {
      const int i = u / 96, rem = u - i * 96, cch = rem >> 3, ks = rem & 7;
      __syncthreads();
      for (int e = tid; e < 5 * 128; e += NTHR) { const int b = e >> 7, k = ks * 128 + (e & 127); const float c = b < 4 ? p.in[I_C][b * D + k] : p.in[I_CCTX][k]; sc[e] = silu_f(c); }
      __syncthreads();
      const int col = cch * 512 + tid;
      const float* w = p.in[I_WMOD] + (size_t)i * D * NMOD + (size_t)(ks * 128) * NMOD + col;
      float a0 = 0, a1 = 0, a2 = 0, a3 = 0, a4 = 0;
#pragma unroll 8
      for (int k = 0; k < 128; ++k) { const float wv = w[(size_t)k * NMOD]; a0 += sc[k] * wv; a1 += sc[128 + k] * wv; a2 += sc[256 + k] * wv; a3 += sc[384 + k] * wv; a4 += sc[512 + k] * wv; }
      float* mp = (float*)(ws + WS_MODP) + ((size_t)(ks * DEPTH + i) * 5) * NMOD + col;
      mp[0] = a0; mp[NMOD] = a1; mp[2 * NMOD] = a2; mp[3 * NMOD] = a3; mp[4 * NMOD] = a4;
    }
    __syncthreads();
  }
}
__device__ __forceinline__ void phase_modfin(const Params& p) {
  const float* mp = (const float*)(p.ws + WS_MODP); float* mv = (float*)(p.ws + WS_MODV);
  for (int e = blockIdx.x * NTHR + threadIdx.x; e < DEPTH * 5 * NMOD; e += gridDim.x * NTHR) {
    const int i = e / (5 * NMOD), col = e % NMOD;
    float s = p.in[I_BMOD][i * NMOD + col];
#pragma unroll
    for (int ks = 0; ks < 8; ++ks) s += mp[(size_t)ks * DEPTH * 5 * NMOD + e];
    mv[e] = s;
  }
}

template <int MODE, bool COMBINE, bool DRY = false>
__device__ __forceinline__ void phase_norm(const Params& p, int layer) {
  int tid = threadIdx.x; asm volatile("" : "+v"(tid));
  const int wid = tid >> 6, lane = tid & 63;
  const int gw = blockIdx.x * 8 + wid, nw = gridDim.x * 8;
  char* ws = opaque_ptr(p.ws);
  const float* modv = (const float*)(ws + WS_MODV);
  const bf16_t* Y = (const bf16_t*)(ws + WS_Y);
  for (int r = gw; r < R; r += nw) {
    const int b = r / RPB, ii = r - b * RPB; const bool is_ctx = ii < CTX; const int bsel = is_ctx ? 4 : b;
    if (MODE == 2 && is_ctx) continue;
    xres_t* xp = (xres_t*)(ws + WS_X32) + (size_t)r * D;
    f32x4 v[4];
#pragma unroll
    for (int q = 0; q < 4; ++q) v[q] = xload4(xp + (lane + 64 * q) * 4);
    if (COMBINE) {
      const int pl = MODE == 2 ? DEPTH - 1 : layer - 1;
      if (!(pl == DEPTH - 1 && is_ctx)) {
        const float* g2 = modv + ((size_t)pl * 5 + bsel) * NMOD + 5 * D;
#pragma unroll
        for (int q = 0; q < 4; ++q) { const int c = (lane + 64 * q) * 4; const f32x4 g = *(const f32x4*)(g2 + c);
          const u32x2 y0 = *(const u32x2*)(Y + (size_t)(2 * r) * D + c), y1 = *(const u32x2*)(Y + (size_t)(2 * r + 1) * D + c);
          v[q][0] += g[0] * (bflo(y0[0]) + bflo(y1[0])); v[q][1] += g[1] * (bfhi(y0[0]) + bfhi(y1[0]));
          v[q][2] += g[2] * (bflo(y0[1]) + bflo(y1[1])); v[q][3] += g[3] * (bfhi(y0[1]) + bfhi(y1[1])); }
        if (MODE != 2 && !DRY) {
#pragma unroll
          for (int q = 0; q < 4; ++q) xstore4(xp + (lane + 64 * q) * 4, v[q]);
        }
      }
    }
    float ss = 0.f;
#pragma unroll
    for (int q = 0; q < 4; ++q) ss += v[q][0] * v[q][0] + v[q][1] * v[q][1] + v[q][2] * v[q][2] + v[q][3] * v[q][3];
    ss = wave_sum(ss);
    const float rs = rsqrtf(ss * (1.0f / D) + EPS);
    if (MODE == 2) {
      float* op = p.out + ((size_t)b * SEQ + (ii - CTX)) * D;
#pragma unroll
      for (int q = 0; q < 4; ++q) { const int c = (lane + 64 * q) * 4; const f32x4 g = *(const f32x4*)(p.in[I_FG] + c); f32x4 ov = v[q] * rs * g;
#if DBG_TIME
        { const unsigned long long* d = (const unsigned long long*)(ws + WS_CNT + 4096); const float t1 = (float)d[DBG_T1] * 0.01f, t2 = (float)d[DBG_T2] * 0.01f;
          const float a = sqrtf(t1 * 0.01f); ov = (f32x4){a, a, a, a}; if (r == CTX && c == 0) ov[0] = t2 * 0.002f; }
#endif
        if (DBG_PROBE == 20 && ((const int*)(ws + WS_CNT))[1000]) ov = (f32x4){1000.f, 1000.f, 1000.f, 1000.f};
#ifdef SANITIZE
        for (int e = 0; e < 4; ++e) if (!(fabsf(ov[e]) < 1e30f)) ov[e] = DBG_PROBE ? 0.f : 1000.0f;
        if (DBG_PROBE && ((const int*)(ws + WS_CNT))[1000]) ov = (f32x4){1000.f, 1000.f, 1000.f, 1000.f};
#endif
        *(f32x4*)(op + c) = ov; }
      continue;
    }
    const float* ng = p.in[MODE == 0 ? I_NMG : I_NFG] + layer * D;
    const float* sh = modv + ((size_t)layer * 5 + bsel) * NMOD + (MODE == 0 ? 0 : 3) * D;
    const float* scl = sh + D;
    bf16_t* ap = (bf16_t*)(ws + WS_ACT) + (size_t)r * D;
    f32x4 f[4];
#pragma unroll
    for (int q = 0; q < 4; ++q) { const int c = (lane + 64 * q) * 4; const f32x4 g = *(const f32x4*)(ng + c), s1 = *(const f32x4*)(scl + c), s0 = *(const f32x4*)(sh + c);
      f[q] = (v[q] * rs * g) * (1.0f + s1) + s0;
      u32x2 w = {cvtpk(f[q][0], f[q][1]), cvtpk(f[q][2], f[q][3])}; *(u32x2*)(ap + c) = w; }
    if (MODE == 1) {
      if (layer == DEPTH - 1 && is_ctx) continue;
      const float* wg = p.in[I_MOE_WG] + (size_t)layer * D * 4; const float* we = p.in[I_MOE_WE] + (size_t)layer * D * ME;
      float gl[4] = {0.f, 0.f, 0.f, 0.f};
#pragma unroll
      for (int q = 0; q < 4; ++q)
#pragma unroll
        for (int e = 0; e < 4; ++e) { const int c = (lane + 64 * q) * 4 + e; const f32x4 w = *(const f32x4*)(wg + (size_t)c * 4);
          gl[0] += f[q][e] * w[0]; gl[1] += f[q][e] * w[1]; gl[2] += f[q][e] * w[2]; gl[3] += f[q][e] * w[3]; }
#pragma unroll
      for (int k = 0; k < 4; ++k) gl[k] = wave_sum(gl[k]);
      const float gm = fmaxf(fmaxf(gl[0], gl[1]), fmaxf(gl[2], gl[3]));
      float gp[4], gs = 0.f;
#pragma unroll
      for (int k = 0; k < 4; ++k) { gp[k] = __expf(gl[k] - gm); gs += gp[k]; }
      const float gsi = 1.0f / gs;
      int gsel = 0; float gbest = -1e30f, gw_ = 0.f;
#pragma unroll
      for (int k = 0; k < 4; ++k) { const float pr = gp[k] * gsi; const float sc = pr + p.in[I_MOE_BG][layer * 4 + k]; if (sc > gbest) { gbest = sc; gsel = k; gw_ = pr; } }
      gsel = __builtin_amdgcn_readfirstlane(gsel);
      float el[8] = {0.f, 0.f, 0.f, 0.f, 0.f, 0.f, 0.f, 0.f};
#pragma unroll
      for (int q = 0; q < 4; ++q)
#pragma unroll
        for (int e = 0; e < 4; ++e) { const int c = (lane + 64 * q) * 4 + e; const f32x4 w0 = *(const f32x4*)(we + (size_t)c * ME + gsel * 8), w1 = *(const f32x4*)(we + (size_t)c * ME + gsel * 8 + 4);
          el[0] += f[q][e] * w0[0]; el[1] += f[q][e] * w0[1]; el[2] += f[q][e] * w0[2]; el[3] += f[q][e] * w0[3];
          el[4] += f[q][e] * w1[0]; el[5] += f[q][e] * w1[1]; el[6] += f[q][e] * w1[2]; el[7] += f[q][e] * w1[3]; }
#pragma unroll
      for (int k = 0; k < 8; ++k) el[k] = wave_sum(el[k]);
      float em = el[0];
#pragma unroll
      for (int k = 1; k < 8; ++k) em = fmaxf(em, el[k]);
      float ep[8], es = 0.f;
#pragma unroll
      for (int k = 0; k < 8; ++k) { ep[k] = __expf(el[k] - em); es += ep[k]; }
      const float esi = 1.0f / es;
      int t1 = 0, t2 = 0; float b1 = -1e30f, b2 = -1e30f, p1 = 0.f, p2 = 0.f;
#pragma unroll
      for (int k = 0; k < 8; ++k) { const float pr = ep[k] * esi; const float sc = pr + p.in[I_MOE_BE][layer * ME + gsel * 8 + k];
        if (sc > b1) { b2 = b1; t2 = t1; p2 = p1; b1 = sc; t1 = k; p1 = pr; } else if (sc > b2) { b2 = sc; t2 = k; p2 = pr; } }
      if (lane == 0 && !DRY) {
        const float inv = gw_ / (p1 + p2);
        int* cnt = (int*)(ws + WS_CNT) + layer * ME; int* list = (int*)(ws + WS_LIST); float* wts = (float*)(ws + WS_WTS);
        const int e1 = gsel * 8 + t1, e2 = gsel * 8 + t2;
        const int q1 = atomicAdd(cnt + e1, 1); list[(size_t)e1 * R + q1] = 2 * r;     wts[2 * r] = p1 * inv;
        const int q2 = atomicAdd(cnt + e2, 1); list[(size_t)e2 * R + q2] = 2 * r + 1; wts[2 * r + 1] = p2 * inv;
      }
    }
  }
}

__device__ __forceinline__ void phase_mla_mid(const Params& p, int j) {
  int tid = threadIdx.x; asm volatile("" : "+v"(tid));
  const int wid = tid >> 6, lane = tid & 63;
  const int gw = blockIdx.x * 8 + wid, nw = gridDim.x * 8;
  char* ws = opaque_ptr(p.ws);
  const float* gq = p.in[I_MLA_GQ] + j * QL; const float* gkv = p.in[I_MLA_GKV] + j * KVL;
  for (int r = gw; r < R; r += nw) {
    const int b = r / RPB, ii = r - b * RPB; const bool is_ctx = ii < CTX;
    const bf16_t* c1 = (const bf16_t*)(ws + WS_C1) + (size_t)r * 1024;
    const u32x2 q0w = *(const u32x2*)(c1 + lane * 4), q1w = *(const u32x2*)(c1 + 256 + lane * 4), kvw = *(const u32x2*)(c1 + 512 + lane * 4);
    const f32x4 q0 = {bflo(q0w[0]), bfhi(q0w[0]), bflo(q0w[1]), bfhi(q0w[1])}, q1 = {bflo(q1w[0]), bfhi(q1w[0]), bflo(q1w[1]), bfhi(q1w[1])},
                kv = {bflo(kvw[0]), bfhi(kvw[0]), bflo(kvw[1]), bfhi(kvw[1])};
    const float pe = bf2f(c1[768 + lane]);
    float sq = q0[0] * q0[0] + q0[1] * q0[1] + q0[2] * q0[2] + q0[3] * q0[3] + q1[0] * q1[0] + q1[1] * q1[1] + q1[2] * q1[2] + q1[3] * q1[3];
    float sk = kv[0] * kv[0] + kv[1] * kv[1] + kv[2] * kv[2] + kv[3] * kv[3];
    sq = wave_sum(sq); sk = wave_sum(sk);
    const float rq = rsqrtf(sq * (1.0f / QL) + EPS), rk = rsqrtf(sk * (1.0f / KVL) + EPS);
    bf16_t* cq = (bf16_t*)(ws + WS_CQ) + (size_t)r * QL; bf16_t* ckv = (bf16_t*)(ws + WS_CKV) + (size_t)r * KVL; bf16_t* kpe = (bf16_t*)(ws + WS_KPE) + (size_t)r * ROPE;
    { const f32x4 g = *(const f32x4*)(gq + lane * 4); u32x2 w = {cvtpk(q0[0] * rq * g[0], q0[1] * rq * g[1]), cvtpk(q0[2] * rq * g[2], q0[3] * rq * g[3])}; *(u32x2*)(cq + lane * 4) = w; }
    { const f32x4 g = *(const f32x4*)(gq + 256 + lane * 4); u32x2 w = {cvtpk(q1[0] * rq * g[0], q1[1] * rq * g[1]), cvtpk(q1[2] * rq * g[2], q1[3] * rq * g[3])}; *(u32x2*)(cq + 256 + lane * 4) = w; }
    { const f32x4 g = *(const f32x4*)(gkv + lane * 4); u32x2 w = {cvtpk(kv[0] * rk * g[0], kv[1] * rk * g[1]), cvtpk(kv[2] * rk * g[2], kv[3] * rk * g[3])}; *(u32x2*)(ckv + lane * 4) = w; }
    float outv = pe;
    const float other = __shfl_xor(pe, 16);
    if (!is_ctx) {
      const int s = ii - CTX; const float pos = (lane < 32) ? (float)(s >> 6) : (float)(s & 63);
      const float ang = pos * rope_invf(lane & 15, 16); const float cs = __cosf(ang), sn = __sinf(ang);
      outv = (lane & 16) ? (other * sn + pe * cs) : (pe * cs - other * sn);
    }
    kpe[lane] = (bf16_t)(cvtpk(outv, 0.f) & 0xffffu);
  }
}

__device__ __forceinline__ void phase_gqa_k(const Params& p) {
  int tid = threadIdx.x; asm volatile("" : "+v"(tid));
  const int wid = tid >> 6, lane = tid & 63;
  const int gw = blockIdx.x * 8 + wid, nw = gridDim.x * 8;
  char* ws = opaque_ptr(p.ws); const float* kg = p.in[I_GQA_KG];
  const int sub = lane & 7;
  for (int r = gw; r < R; r += nw) {
    const int b = r / RPB, ii = r - b * RPB; const bool is_ctx = ii < CTX;
    const bf16_t* kp = (const bf16_t*)(ws + WS_QKV) + (size_t)r * 4096 + 2048 + lane * 16;
    const u32x4 w0 = *(const u32x4*)kp, w1 = *(const u32x4*)(kp + 8);
    float v[16];
#pragma unroll
    for (int e = 0; e < 4; ++e) { v[2 * e] = bflo(w0[e]); v[2 * e + 1] = bfhi(w0[e]); v[8 + 2 * e] = bflo(w1[e]); v[9 + 2 * e] = bfhi(w1[e]); }
    float ss = 0.f;
#pragma unroll
    for (int e = 0; e < 16; ++e) ss += v[e] * v[e];
    ss += __shfl_xor(ss, 1); ss += __shfl_xor(ss, 2); ss += __shfl_xor(ss, 4);
    const float rs = rsqrtf(ss * (1.0f / GD) + EPS);
#pragma unroll
    for (int e = 0; e < 16; ++e) v[e] *= rs * kg[sub * 16 + e];
    float o[16];
#pragma unroll
    for (int e = 0; e < 16; ++e) o[e] = __shfl_xor(v[e], 2);
    if (!is_ctx) {
      const int s = ii - CTX; const float pos = (sub < 4) ? (float)(s >> 6) : (float)(s & 63);
#pragma unroll
      for (int e = 0; e < 16; ++e) { const int j = (sub & 1) * 16 + e; const float ang = pos * rope_invf(j, 32); const float cs = __cosf(ang), sn = __sinf(ang);
        v[e] = (sub & 2) ? (o[e] * sn + v[e] * cs) : (v[e] * cs - o[e] * sn); }
    }
    bf16_t* op = (bf16_t*)(ws + WS_KN) + (size_t)r * 1024 + lane * 16;
    u32x4 o0 = {cvtpk(v[0], v[1]), cvtpk(v[2], v[3]), cvtpk(v[4], v[5]), cvtpk(v[6], v[7])}, o1 = {cvtpk(v[8], v[9]), cvtpk(v[10], v[11]), cvtpk(v[12], v[13]), cvtpk(v[14], v[15])};
    *(u32x4*)op = o0; *(u32x4*)(op + 8) = o1;
  }
}

__device__ __forceinline__ void phase_conv_mid(const Params& p) {
  int tid = threadIdx.x; asm volatile("" : "+v"(tid));
  const int wid = tid >> 6, lane = tid & 63;
  const int gw = blockIdx.x * 8 + wid, nw = gridDim.x * 8;
  char* ws = opaque_ptr(p.ws); const float* cw = p.in[I_CONV_W];
  const bf16_t* bcu = (const bf16_t*)(ws + WS_BCU);
  for (int r = gw; r < R; r += nw) {
    const int b = r / RPB, ii = r - b * RPB; const bool is_ctx = ii < CTX;
    const bool hp = is_ctx ? (ii > 0) : (ii > CTX), hn = is_ctx ? (ii < CTX - 1) : (ii < RPB - 1);
    bf16_t* gp = (bf16_t*)(ws + WS_G) + (size_t)r * D;
#pragma unroll
    for (int q = 0; q < 4; ++q) {
      const int c = (lane + 64 * q) * 4;
      const bf16_t* row = bcu + (size_t)r * 3072 + c;
      const u32x2 bg = *(const u32x2*)row, c0 = *(const u32x2*)(row + 1024), u0 = *(const u32x2*)(row + 2048);
      u32x2 cp = {0u, 0u}, up = {0u, 0u}, cn = {0u, 0u}, un = {0u, 0u};
      if (hp) { cp = *(const u32x2*)(row - 3072 + 1024); up = *(const u32x2*)(row - 3072 + 2048); }
      if (hn) { cn = *(const u32x2*)(row + 3072 + 1024); un = *(const u32x2*)(row + 3072 + 2048); }
      const f32x4 w0 = *(const f32x4*)(cw + c), w1 = *(const f32x4*)(cw + D + c), w2 = *(const f32x4*)(cw + 2 * D + c);
      float z[4];
      z[0] = w0[0] * bflo(cp[0]) * bflo(up[0]) + w1[0] * bflo(c0[0]) * bflo(u0[0]) + w2[0] * bflo(cn[0]) * bflo(un[0]);
      z[1] = w0[1] * bfhi(cp[0]) * bfhi(up[0]) + w1[1] * bfhi(c0[0]) * bfhi(u0[0]) + w2[1] * bfhi(cn[0]) * bfhi(un[0]);
      z[2] = w0[2] * bflo(cp[1]) * bflo(up[1]) + w1[2] * bflo(c0[1]) * bflo(u0[1]) + w2[2] * bflo(cn[1]) * bflo(un[1]);
      z[3] = w0[3] * bfhi(cp[1]) * bfhi(up[1]) + w1[3] * bfhi(c0[1]) * bfhi(u0[1]) + w2[3] * bfhi(cn[1]) * bfhi(un[1]);
      u32x2 w = {cvtpk(bflo(bg[0]) * z[0], bfhi(bg[0]) * z[1]), cvtpk(bflo(bg[1]) * z[2], bfhi(bg[1]) * z[3])};
      *(u32x2*)(gp + c) = w;
    }
  }
}

constexpr int LI_OFF = 135168;
__device__ __forceinline__ void moe_prefix(const Params& p, int layer, int* li) {
  if (threadIdx.x == 0) { const int* cnt = (const int*)(p.ws + WS_CNT) + layer * ME; int o = 0, t = 0;
    for (int e = 0; e < ME; ++e) { li[e] = o; li[33 + e] = t; const int c = cnt[e]; o += c; t += (c + 127) >> 7; } li[32] = o; li[65] = t; }
  __syncthreads();
}
struct MoeUnit { int e, ct, nvalid, slot0, lbase, ri0, ri1, par; };
template <bool DOWN>
struct MoeProv {
  char* ws; const int* li; const int* cnt; int layer; int* etab;
  typedef MoeUnit Unit;
  __device__ __forceinline__ bool unit(int it, Unit& U, int srow) const {
    const int un = blockIdx.x + it * gridDim.x;
    if (un >= li[65] * 4) return false;
    const int t = un >> 2; int e = 0;
    while (li[33 + e + 1] <= t) ++e;
    const int rt = t - li[33 + e];
    U.e = e; U.ct = un & 3; U.nvalid = min(128, cnt[e] - rt * 128); U.slot0 = li[e] + rt * 128; U.lbase = e * R + rt * 128;
    if (!DOWN) { const int* list = (const int*)(ws + WS_LIST) + U.lbase;
      U.ri0 = list[srow < U.nvalid ? srow : 0] >> 1; U.ri1 = list[srow + 64 < U.nvalid ? srow + 64 : 0] >> 1; }
    U.par = it % 3;
    if (DOWN) { const int t_ = threadIdx.x;
      if (t_ < 128) { const int aid = ((const int*)(ws + WS_LIST))[U.lbase + (t_ < U.nvalid ? t_ : 0)];
        etab[(U.par * 128 + t_) * 2] = aid; etab[(U.par * 128 + t_) * 2 + 1] = __float_as_int(((const float*)(ws + WS_WTS))[aid]); } }
    return true;
  }
  static constexpr bool A_AFFINE = DOWN;
  __device__ __forceinline__ int a_stride(const Unit&) const { return 64 * FF; }
  __device__ __forceinline__ int b_stride(const Unit&) const { return DOWN ? 64 * FF : 64 * D; }
  __device__ __forceinline__ const bf16_t* a_row(const Unit& U, int r) const {
    if (DOWN) return (const bf16_t*)(ws + WS_HID) + (size_t)(U.slot0 + r) * FF;
    return (const bf16_t*)(ws + WS_ACT) + (size_t)(r < 64 ? U.ri0 : U.ri1) * D;
  }
  __device__ __forceinline__ const bf16_t* b_row(const Unit& U, int r) const {
    const bf16_t* w = (const bf16_t*)(ws + WS_WMOE + (size_t)(layer * ME + U.e) * MOE_WBYTES);
    return DOWN ? w + 1024 * 1024 + (size_t)(U.ct * 256 + r) * FF : w + (size_t)(U.ct * 256 + r) * D;
  }
  __device__ __forceinline__ int nk(const Unit&) const { return DOWN ? FF / 64 : D / 64; }
  __device__ __forceinline__ void epi(const Unit& U, int r, int c, f32x4 v) const {
    if (r >= U.nvalid) return;
    if (!DOWN) {
      const float h0 = silu_f(v[0]) * v[1], h1 = silu_f(v[2]) * v[3];
      *(unsigned*)((bf16_t*)(ws + WS_HID) + (size_t)(U.slot0 + r) * FF + ((U.ct * 256 + c) >> 1)) = cvtpk(h0, h1);
    } else {
      const int aid = etab[(U.par * 128 + r) * 2]; const float w = __int_as_float(etab[(U.par * 128 + r) * 2 + 1]);
      u32x2 o = {cvtpk(v[0] * w, v[1] * w), cvtpk(v[2] * w, v[3] * w)};
      *(u32x2*)((bf16_t*)(ws + WS_Y) + (size_t)aid * D + U.ct * 256 + c) = o;
    }
  }
};
template <bool DOWN>
__device__ __forceinline__ void phase_moe(const Params& p, int layer, char* lds) {
  int* li = (int*)(lds + LI_OFF); moe_prefix(p, layer, li);
  char* ws = opaque_ptr(p.ws);
  MoeProv<DOWN> pv{ws, li, (const int*)(ws + WS_CNT) + layer * ME, layer, (int*)(lds + LI_OFF + 1024)};
  gemm_stream<8>(pv, lds);
}

__device__ __forceinline__ void phase_attn_mla(const Params& p, bool ctx_out, char* lds) {
  char* ws = opaque_ptr(p.ws);
  const bf16_t* Q = (const bf16_t*)(ws + WS_Q); const bf16_t* KV = (const bf16_t*)(ws + WS_KV); const bf16_t* KPE = (const bf16_t*)(ws + WS_KPE); bf16_t* O = (bf16_t*)(ws + WS_O);
  const int x = blockIdx.x & 7, nloc = gridDim.x >> 3, nlat = NB * MLA_H * 2  , nctx = ctx_out ? 4 : 0;
  for (int lu = (blockIdx.x >> 3); lu < nlat + nctx; lu += nloc) {
    int b, h, q0, nkeys; bool rope;
    if (lu < nlat) { const int pair = x * 4 + (lu >> 4), qb = lu & 15; b = pair / MLA_H; h = pair % MLA_H; q0 = CTX + qb * 256; nkeys = RPB; rope = true; }
    else { const int pair = x * 4 + (lu - nlat); b = pair / MLA_H; h = pair % MLA_H; q0 = 0; nkeys = CTX; rope = false; }
    const size_t rb = (size_t)b * RPB;
    attn_unit<192, 1536, 2048, 2048, 1024>(Q + (rb + q0) * 1536 + h * 192, KV + rb * 2048 + h * 256, KPE + rb * ROPE, KV + rb * 2048 + h * 256 + 128,
                   O + (rb + q0) * 1024 + h * 128, nkeys, rope, q0 - CTX, nullptr, lds);
  }
}
__device__ __forceinline__ void phase_attn_gqa(const Params& p, char* lds) {
  char* ws = opaque_ptr(p.ws);
  const bf16_t* QKV = (const bf16_t*)(ws + WS_QKV); const bf16_t* KN = (const bf16_t*)(ws + WS_KN); bf16_t* O = (bf16_t*)(ws + WS_OG);
  const int x = blockIdx.x & 7, nloc = gridDim.x >> 3, nlat = 128, nctx = 8;
  for (int lu = (blockIdx.x >> 3); lu < nlat + nctx; lu += nloc) {
    int b, h, q0, nkeys; bool rope;
    if (lu < nlat) { const int pair = x * 8 + (lu >> 4), qb = lu & 15; b = pair / GH; h = pair % GH; q0 = CTX + qb * 256; nkeys = RPB; rope = true; }
    else { const int pair = x * 8 + (lu - nlat); b = pair / GH; h = pair % GH; q0 = 0; nkeys = CTX; rope = false; }
    const size_t rb = (size_t)b * RPB; const int kvh = h >> 1;
    attn_unit<128, 4096, 1024, 4096, 2048>(QKV + (rb + q0) * 4096 + h * 128, KN + rb * 1024 + kvh * 128, nullptr, QKV + rb * 4096 + 3072 + kvh * 128,
                   O + (rb + q0) * 2048 + h * 128, nkeys, rope, q0 - CTX, p.in[I_GQA_QG], lds);
  }
}


__device__ __forceinline__ void dbg_probe(const Params& p) {
  char* ws = opaque_ptr(p.ws);
  size_t off = 0, n = 0; bool is_bf = true;
  switch (DBG_PROBE) {
    case 1: off = WS_MODV; n = (size_t)4 * 5 * NMOD; is_bf = false; break;
    case 2: off = WS_ACT; n = (size_t)R * D; break;
    case 3: off = WS_C1; n = (size_t)R * 1024; is_bf = false; break;
    case 4: off = WS_CQ; n = (size_t)R * 512; break;
    case 5: off = WS_CKV; n = (size_t)R * 256; break;
    case 6: off = WS_KPE; n = (size_t)R * 64; break;
    case 7: off = WS_Q; n = (size_t)R * 1536; break;
    case 8: off = WS_KV; n = (size_t)R * 2048; break;
    case 9: off = WS_O; n = (size_t)R * 1024; break;
    case 10: off = WS_X32; n = (size_t)R * D; is_bf = XBF16; break;
    case 11: off = WS_WMLA; n = MLA_WBYTES / 2; break;
    default: break;
  }
  int bad = 0;
  for (size_t i = (size_t)blockIdx.x * NTHR + threadIdx.x; i < n; i += (size_t)gridDim.x * NTHR) {
    float v = is_bf ? bf2f(((const bf16_t*)(ws + off))[i]) : ((const float*)(ws + off))[i];
    if (!(fabsf(v) < 1e30f)) bad = 1;
  }
  if (bad) atomicOr((int*)(ws + WS_CNT) + 1000, 1);
}

constexpr int DYN_LDS = 143360;
extern __shared__ __attribute__((aligned(16))) char smem[];

__global__ void __launch_bounds__(NTHR, 2) fwd_megakernel(Params p) {
  cg::grid_group grid = cg::this_grid();
  char* lds = smem;
#define WSO() char* ws = opaque_ptr(p.ws)
  volatile LAS unsigned* xst = (volatile LAS unsigned*)(LAS char*)(smem + DYN_LDS - 16);
  if (threadIdx.x == 0) { xst[0] = 0u; xst[1] = 0u; }
  __syncthreads();
  const XcdBarrier xb = xcd_barrier_post((unsigned*)(p.ws + WS_BAR), xst);
#if DBG_TIME
  unsigned long long tc_prep = 0, tc_norm = 0, tc_gemm = 0, tc_mid = 0, tc_amla = 0, tc_agqa = 0, tc_moe1 = 0, tc_moe2 = 0, tc_sync = 0, tA, tB, tC;
#define PH(cat, ...) do { tA = __builtin_amdgcn_s_memrealtime(); __VA_ARGS__; tB = __builtin_amdgcn_s_memrealtime(); xcd_barrier(xb); tC = __builtin_amdgcn_s_memrealtime(); \
    tc_##cat += tC - tA; tc_sync += tC - tB; } while (0)
#else
#define PH(cat, ...) do { __VA_ARGS__; xcd_barrier(xb); } while (0)
#endif
#define PHD(cat, id, ...) do { PH(cat, __VA_ARGS__); if (DUP == id) PH(cat, __VA_ARGS__); } while (0)
#define PHR(...) do { if (DUP == 15) { xres_t* const DRYP = (xres_t*)(p.ws + WS_Y); PH(gemm, __VA_ARGS__); } { xres_t* const DRYP = nullptr; PH(gemm, __VA_ARGS__); } } while (0)
#if DBG_TIME
  tA = __builtin_amdgcn_s_memrealtime();
#endif
#pragma unroll 1
  for (int rep_ = 0; rep_ < (DUP == 18 ? 2 : 1); ++rep_) {
  if (rep_ == 1) xcd_barrier(xb);
  if (DBG_PROBE == 20 && threadIdx.x == 0) ((int*)(p.ws + WS_CNT))[1024 + blockIdx.x] = (int)xb.x;
  phase_prep(p, lds);
  if (p.out == nullptr) grid.sync();
  xcd_barrier(xb);
#if DBG_TIME
  tc_prep += __builtin_amdgcn_s_memrealtime() - tA;
#endif
  if (DUP == 12) { xcd_barrier(xb); phase_prep(p, lds); xcd_barrier(xb); }
  if (DBG_PROBE == 20 && blockIdx.x == 0 && threadIdx.x == 0) { const int* t = (const int*)(p.ws + WS_CNT) + 1024; int bad = 0, seen = 0;
    for (int i = 0; i < (int)gridDim.x; ++i) { if (t[i] != t[i & 7]) bad = 1; }
    for (int i = 0; i < 8; ++i) seen |= 1 << t[i];
    if (bad || seen != 0xff) ((int*)(p.ws + WS_CNT))[1000] = 1; }
  PH(prep, phase_modfin(p));
  if (DUP == 14) { for (int q = 0; q < 40; ++q) xcd_barrier(xb); }
  if (STOP_AFTER == 0) { phase_norm<2, false>(p, 0); return; }
#pragma unroll 1
  for (int layer = 0; layer < DEPTH; ++layer) {
    const int kind = layer % 3, j = layer / 3; const bool ctx_out = layer < DEPTH - 1;
    if (DUP == 17 && layer > 0) PH(norm, phase_norm<0, true, true>(p, layer));
    PH(norm, if (layer == 0) phase_norm<0, false>(p, layer); else phase_norm<0, true>(p, layer));
    if (DUP == 13 && layer == 0) { for (int q = 0; q < 4; ++q) PH(norm, phase_norm<0, false>(p, layer)); }
    if (kind == 0) {
      PHD(gemm, 1, { WSO(); const char* wb = ws + WS_WMLA + j * MLA_WBYTES;
        gemm_dense<17, 2, false>((const bf16_t*)(ws + WS_ACT), D, (const bf16_t*)(wb + MLA_W1T), 1024, D, EpiBf16{(bf16_t*)(ws + WS_C1), 1024}, lds); });
      PHD(mid, 2, phase_mla_mid(p, j));
      PHD(gemm, 3, { WSO(); const char* wb = ws + WS_WMLA + j * MLA_WBYTES;
        MlaUpProv pv{(const bf16_t*)(ws + WS_CQ), (const bf16_t*)(ws + WS_CKV), (const bf16_t*)(wb + MLA_WUQT), (const bf16_t*)(wb + MLA_WUKVT), (bf16_t*)(ws + WS_Q), (bf16_t*)(ws + WS_KV)};
        gemm_stream<17>(pv, lds); });
      PHD(amla, 4, phase_attn_mla(p, ctx_out, lds));
      PHR({ WSO(); const char* wb = ws + WS_WMLA + j * MLA_WBYTES;
        const EpiResid er{(xres_t*)(ws + WS_X32), (const float*)(ws + WS_MODV) + (size_t)layer * 5 * NMOD + 2 * D, DRYP};
        if (ctx_out) gemm_dense<17, 2, false>((const bf16_t*)(ws + WS_O), 1024, (const bf16_t*)(wb + MLA_WOT), D, 1024, er, lds);
        else gemm_dense<16, 2, true>((const bf16_t*)(ws + WS_O), 1024, (const bf16_t*)(wb + MLA_WOT), D, 1024, er, lds); });
    } else if (kind == 1) {
      PHD(gemm, 5, { WSO(); gemm_dense<17, 2, false>((const bf16_t*)(ws + WS_ACT), D, (const bf16_t*)(ws + WS_WCONV_IN), 3072, D, EpiBf16{(bf16_t*)(ws + WS_BCU), 3072}, lds); });
      if (DUP == 21) PH(gemm, { WSO(); gemm_dense<17, 2, false, EpiBf16, 1>((const bf16_t*)(ws + WS_ACT), D, (const bf16_t*)(ws + WS_WCONV_IN), 3072, D, EpiBf16{(bf16_t*)(ws + WS_G + (size_t)R * 1024 * 2), 3072}, lds); });
      if (DUP == 22) PH(gemm, { WSO(); gemm_dense<17, 2, false, EpiBf16, 2>((const bf16_t*)(ws + WS_ACT), D, (const bf16_t*)(ws + WS_WCONV_IN), 3072, D, EpiBf16{(bf16_t*)(ws + WS_G + (size_t)R * 1024 * 2), 3072}, lds); });
      if (DUP == 23) PH(gemm, { WSO(); gemm_dense<17, 2, false, EpiBf16, 0>((const bf16_t*)(ws + WS_ACT), D, (const bf16_t*)(ws + WS_WCONV_IN), 3072, D, EpiBf16{(bf16_t*)(ws + WS_G + (size_t)R * 1024 * 2), 3072}, lds); });
      PHD(mid, 6, phase_conv_mid(p));
      PHR({ WSO(); gemm_dense<17, 2, false>((const bf16_t*)(ws + WS_G), D, (const bf16_t*)(ws + WS_WCONV_OUT), D, D,
                                EpiResid{(xres_t*)(ws + WS_X32), (const float*)(ws + WS_MODV) + (size_t)layer * 5 * NMOD + 2 * D, DRYP}, lds); });
    } else {
      PHD(gemm, 7, { WSO(); gemm_dense<17, 2, false>((const bf16_t*)(ws + WS_ACT), D, (const bf16_t*)(ws + WS_WGQA_QKV), 4096, D, EpiBf16{(bf16_t*)(ws + WS_QKV), 4096}, lds); });
      PHD(mid, 8, phase_gqa_k(p));
      PHD(agqa, 9, phase_attn_gqa(p, lds));
      PHR({ WSO(); gemm_dense<17, 2, false>((const bf16_t*)(ws + WS_OG), 2048, (const bf16_t*)(ws + WS_WGQA_O), D, 2048,
                                EpiResid{(xres_t*)(ws + WS_X32), (const float*)(ws + WS_MODV) + (size_t)layer * 5 * NMOD + 2 * D, DRYP}, lds); });
    }
    if (STOP_AFTER == 2 * layer + 1) { if (DBG_PROBE) { dbg_probe(p); xcd_barrier(xb); } phase_norm<2, false>(p, 0); return; }
    if (DUP == 16) PH(norm, phase_norm<1, false, true>(p, layer));
    PH(norm, { if (MOE_JIT) phase_conv_moe(p, layer, lds); phase_norm<1, false>(p, layer); });
    PHD(moe1, 10, phase_moe<false>(p, layer, lds));
    PHD(moe2, 11, phase_moe<true>(p, layer, lds));
    if (STOP_AFTER == 2 * layer + 2) break;
  }
  }
#if DBG_TIME
  if (blockIdx.x == 0 && threadIdx.x == 0) {
    unsigned long long* d = (unsigned long long*)(p.ws + WS_CNT + 4096);
    d[0] = tc_prep; d[1] = tc_norm; d[2] = tc_gemm; d[3] = tc_mid; d[4] = tc_amla; d[5] = tc_agqa; d[6] = tc_moe1; d[7] = tc_moe2; d[8] = tc_sync;
  }
  xcd_barrier(xb);
#endif
  phase_norm<2, true>(p, 0);
}

extern "C" void kernel_launch(void* const* d_in, const int* in_sizes, int n_in, void* d_out, int out_size, void* d_ws, size_t ws_size,
                              hipStream_t stream) {
  static int grid_blocks = 0;
  if (!grid_blocks) {
    int dev = 0, cus = 0, per_cu = 0;
    (void)hipGetDevice(&dev);
    (void)hipDeviceGetAttribute(&cus, hipDeviceAttributeMultiprocessorCount, dev);
    (void)hipFuncSetAttribute((const void*)fwd_megakernel, hipFuncAttributeMaxDynamicSharedMemorySize, DYN_LDS);
    (void)hipOccupancyMaxActiveBlocksPerMultiprocessor(&per_cu, fwd_megakernel, NTHR, DYN_LDS);
    grid_blocks = per_cu >= 1 ? cus : 0;
    if (ws_size < WS_END || n_in != N_IN) { fprintf(stderr, "kernel_launch: ws %zu < %zu or n_in %d\n", ws_size, (size_t)WS_END, n_in); grid_blocks = 0; }
    if (!grid_blocks) { fprintf(stderr, "kernel_launch: cannot launch (per_cu %d)\n", per_cu); return; }
  }
  Params p{};
  for (int i = 0; i < N_IN; ++i) p.in[i] = (const float*)d_in[i];
  p.out = (float*)d_out; p.ws = (char*)d_ws;
  {
    char* ws = p.ws; int nj = 0;
    for (int j = 0; j < 2; ++j) {
      char* wb = ws + WS_WMLA + j * MLA_WBYTES;
      p.jobs[nj++] = TJob{p.in[I_MLA_WDQ] + (size_t)j * D * QL, (bf16_t*)(wb + MLA_W1T), D, QL, 1, 0};
      p.jobs[nj++] = TJob{p.in[I_MLA_WDKV] + (size_t)j * D * 320, (bf16_t*)(wb + MLA_W1T), D, 320, 1, 512};
      p.jobs[nj++] = TJob{p.in[I_MLA_WUQ] + (size_t)j * QL * 1536, (bf16_t*)(wb + MLA_WUQT), QL, 1536, 1, 0};
      p.jobs[nj++] = TJob{p.in[I_MLA_WUKV] + (size_t)j * KVL * 2048, (bf16_t*)(wb + MLA_WUKVT), KVL, 2048, 1, 0};
      p.jobs[nj++] = TJob{p.in[I_MLA_WO] + (size_t)j * 1024 * D, (bf16_t*)(wb + MLA_WOT), 1024, D, 1, 0};
    }
    p.jobs[nj++] = TJob{p.in[I_CONV_WIN], (bf16_t*)(ws + WS_WCONV_IN), D, 3072, 1, 0};
    p.jobs[nj++] = TJob{p.in[I_CONV_WOUT], (bf16_t*)(ws + WS_WCONV_OUT), D, D, 1, 0};
    p.jobs[nj++] = TJob{p.in[I_GQA_WQKV], (bf16_t*)(ws + WS_WGQA_QKV), D, 4096, 1, 0};
    p.jobs[nj++] = TJob{p.in[I_GQA_WO], (bf16_t*)(ws + WS_WGQA_O), 2048, D, 1, 0};
  }
  (void)hipMemsetAsync((char*)d_ws + WS_BAR, 0, XCD_BAR_WORDS * 4, stream);
  void* args[] = {&p};
  hipError_t e = hipLaunchCooperativeKernel((void*)fwd_megakernel, dim3(grid_blocks), dim3(NTHR), args, DYN_LDS, stream);
  if (e != hipSuccess) fprintf(stderr, "cooperative launch failed: %s (grid %d)\n", hipGetErrorString(e), grid_blocks);
}
```

```cpp
#include <hip/hip_runtime.h>
#include <hip/hip_cooperative_groups.h>
#include <cstdio>
#include <cstdint>
namespace cg = cooperative_groups;

#ifndef DUP
#define DUP 0
#endif
#ifndef DBG_TIME
#define DBG_TIME 0
#endif
#ifndef DBG_T1
#define DBG_T1 0
#define DBG_T2 1
#endif
#ifndef DBG_PROBE
#define DBG_PROBE 0
#endif
#ifndef STOP_AFTER
#define STOP_AFTER 8
#endif

#ifndef MIX_F8
#define MIX_F8 1
#endif
#ifndef MOE_F8
#define MOE_F8 2
#endif
#define LAS __attribute__((address_space(3)))
typedef unsigned short bf16_t;
typedef short bf16x8 __attribute__((ext_vector_type(8)));
typedef short s16x4 __attribute__((ext_vector_type(4)));
typedef float f32x4 __attribute__((ext_vector_type(4)));
typedef float f32x16 __attribute__((ext_vector_type(16)));
typedef unsigned u32x4 __attribute__((ext_vector_type(4)));
typedef unsigned u32x2 __attribute__((ext_vector_type(2)));
typedef int i32x8 __attribute__((ext_vector_type(8)));

constexpr int D = 1024, NB = 4, SEQ = 4096, CTX = 256, RPB = SEQ + CTX, R = NB * RPB;
constexpr int DEPTH = 4, NMOD = 6 * D;
constexpr int MLA_H = 8, QL = 512, KVL = 256, NOPE = 128, ROPE = 64, MV = 128;
constexpr int GH = 16, GKV = 8, GD = 128;
constexpr int ME = 32, FF = 512;
constexpr float EPS = 1e-6f;
constexpr int NTHR = 512;

enum { I_X = 0, I_C, I_CTX, I_CCTX, I_WMOD, I_BMOD, I_NMG, I_NFG, I_MLA_WDQ, I_MLA_GQ, I_MLA_WUQ, I_MLA_WDKV, I_MLA_GKV, I_MLA_WUKV, I_MLA_WO,
       I_CONV_WIN, I_CONV_W, I_CONV_WOUT, I_GQA_WQKV, I_GQA_QG, I_GQA_KG, I_GQA_WO, I_MOE_WG, I_MOE_BG, I_MOE_WE, I_MOE_BE, I_MOE_GATE, I_MOE_UP, I_MOE_DOWN, I_FG, N_IN };

constexpr size_t al256(size_t x) { return (x + 255) / 256 * 256; }
constexpr size_t WS_BAR = 0;
constexpr size_t WS_CNT = 16384;
constexpr size_t WS_MODP = 16384 + 8192;
constexpr size_t WS_MODV = WS_MODP + (size_t)8 * 4 * 5 * NMOD * 4;
constexpr size_t WS_WTS = WS_MODV + (size_t)4 * 5 * NMOD * 4;
constexpr size_t WS_LIST = al256(WS_WTS + (size_t)2 * R * 4);
#ifndef XBF16
#define XBF16 1
#endif
constexpr size_t WS_X32 = al256(WS_LIST + (size_t)32 * R * 4);
constexpr size_t WS_ACT = WS_X32 + (size_t)R * D * (XBF16 ? 2 : 4);
constexpr size_t WS_HID = WS_ACT + (size_t)R * D * 2;
constexpr size_t WS_Y = WS_HID + (size_t)(2 * R + 256) * FF * 2;
constexpr size_t WS_MIX = WS_Y + (size_t)2 * R * D * 2;
constexpr size_t MIX_BYTES = (size_t)R * (1024 * 4 + 512 * 2 + 256 * 2 + 64 * 2 + 1536 * 2 + 2048 * 2 + 1024 * 2);
constexpr size_t WS_C1 = WS_MIX;
constexpr size_t WS_CQ = WS_C1 + (size_t)R * 1024 * 4;
constexpr size_t WS_CKV = WS_CQ + (size_t)R * 512 * 2;
constexpr size_t WS_KPE = WS_CKV + (size_t)R * 256 * 2;
constexpr size_t WS_Q = WS_KPE + (size_t)R * 64 * 2;
constexpr size_t WS_KV = WS_Q + (size_t)R * 1536 * 2;
constexpr size_t WS_O = WS_KV + (size_t)R * 2048 * 2;
constexpr size_t WS_QKV = WS_MIX;
constexpr size_t WS_KN = WS_QKV + (size_t)R * 4096 * 2;
constexpr size_t WS_OG = WS_KN + (size_t)R * 1024 * 2;
constexpr size_t WS_BCU = WS_MIX;
constexpr size_t WS_G = WS_BCU + (size_t)R * 3072 * 2;
static_assert(WS_OG + (size_t)R * 2048 * 2 <= WS_MIX + MIX_BYTES, "gqa scratch");
static_assert(WS_G + (size_t)R * 1024 * 2 <= WS_MIX + MIX_BYTES, "conv scratch");
constexpr size_t WS_WT = al256(WS_MIX + MIX_BYTES);
constexpr size_t MLA_W1T = 0, MLA_WUQT = MLA_W1T + (size_t)1024 * 1024 * 2, MLA_WUKVT = MLA_WUQT + (size_t)1536 * 512 * 2, MLA_WOT = MLA_WUKVT + (size_t)2048 * 256 * 2,
                 MLA_WBYTES = MLA_WOT + (size_t)1024 * 1024 * 2;
constexpr size_t WS_WMLA = WS_WT;
constexpr size_t WS_WCONV_IN = WS_WMLA + 2 * MLA_WBYTES;
constexpr size_t WS_WCONV_OUT = WS_WCONV_IN + (size_t)3072 * 1024 * 2;
constexpr size_t WS_WGQA_QKV = WS_WCONV_OUT + (size_t)1024 * 1024 * 2;
constexpr size_t WS_WGQA_O = WS_WGQA_QKV + (size_t)4096 * 1024 * 2;
constexpr size_t WS_WMOE = WS_WGQA_O + (size_t)1024 * 2048 * 2;
constexpr size_t MOE_WBYTES = (size_t)1024 * 1024 * 2 + (size_t)1024 * 512 * 2;
constexpr size_t WS_END = WS_WMOE + (size_t)DEPTH * ME * MOE_WBYTES;
static_assert(WS_END <= (size_t)1073741824, "workspace over 1 GiB");

struct TJob { const float* src; bf16_t* dst; int K, N, rmul, roff; };
struct Params {
  const float* in[N_IN];
  float* out;
  char* ws;
  TJob jobs[14];
};

typedef __bf16 bf16x2_t __attribute__((ext_vector_type(2)));
__device__ __forceinline__ unsigned cvtpk(float lo, float hi) { bf16x2_t v = {(__bf16)lo, (__bf16)hi}; return __builtin_bit_cast(unsigned, v); }
__device__ __forceinline__ float bf2f(unsigned short h) { return __uint_as_float((unsigned)h << 16); }
__device__ __forceinline__ float bflo(unsigned w) { return __uint_as_float(w << 16); }
__device__ __forceinline__ float bfhi(unsigned w) { return __uint_as_float(w & 0xffff0000u); }
#if XBF16
typedef bf16_t xres_t;
__device__ __forceinline__ f32x4 xload4(const xres_t* q) { const u32x2 w = *(const u32x2*)q; return (f32x4){bflo(w[0]), bfhi(w[0]), bflo(w[1]), bfhi(w[1])}; }
__device__ __forceinline__ void xstore4(xres_t* q, f32x4 v) { u32x2 w = {cvtpk(v[0], v[1]), cvtpk(v[2], v[3])}; *(u32x2*)q = w; }
#else
typedef float xres_t;
__device__ __forceinline__ f32x4 xload4(const xres_t* q) { return *(const f32x4*)q; }
__device__ __forceinline__ void xstore4(xres_t* q, f32x4 v) { *(f32x4*)q = v; }
#endif
__device__ __forceinline__ float wave_sum(float v) {
#pragma unroll
  for (int o = 32; o > 0; o >>= 1) v += __shfl_xor(v, o);
  return v;
}
__device__ __forceinline__ float silu_f(float x) { return x / (1.0f + __expf(-x)); }
__device__ __forceinline__ void glds16(const void* g, char* l) { __builtin_amdgcn_global_load_lds((const unsigned*)g, (LAS unsigned*)l, 16, 0, 0); }
__device__ __forceinline__ char* opaque_ptr(char* q) {
  unsigned lo = __builtin_amdgcn_readfirstlane((unsigned)(uintptr_t)q), hi = __builtin_amdgcn_readfirstlane((unsigned)((uintptr_t)q >> 32));
  asm volatile("" : "+s"(lo), "+s"(hi));
  return (char*)(((uintptr_t)hi << 32) | (uintptr_t)lo); }
__device__ __forceinline__ float rope_invf(int j, int half) { return exp2f(-(float)j * (13.287712379549449f / (float)half)); }


#define XB_TMO      128
#define XB_XCNT(j)  (256  + 64 * (j))
#define XB_XSUB(j)  (1280 + 64 * (j))
#define XB_XGEN(j)  (2304 + 64 * (j))
#define XB_TOP      3328
#define XB_TOPGEN   3392
#define XCD_BAR_WORDS 3456
#define XB_SPIN_CAP (1u << 22)
__device__ __forceinline__ unsigned xb_ld(unsigned* p)              { return __hip_atomic_load(p, __ATOMIC_RELAXED, __HIP_MEMORY_SCOPE_AGENT); }
__device__ __forceinline__ unsigned xb_add(unsigned* p, unsigned v) { return __hip_atomic_fetch_add(p, v, __ATOMIC_RELAXED, __HIP_MEMORY_SCOPE_AGENT); }
__device__ __forceinline__ unsigned xb_xcc_id() { return (unsigned)__builtin_amdgcn_s_getreg((3 << 11) | 20) & 0xFu; }
#define XB_SPIN(cond, bar) do { unsigned _sp = 0; while (cond) { __builtin_amdgcn_s_sleep(1); \
    if ((++_sp & 255u) == 0u) { if (xb_ld(&(bar)[XB_TMO])) break; if (_sp > XB_SPIN_CAP) { atomicAdd(&(bar)[XB_TMO], 1u); break; } } } } while (0)
struct XcdBarrier { unsigned* bar; unsigned x; volatile LAS unsigned* st; };
__device__ __forceinline__ XcdBarrier xcd_barrier_post(unsigned* bar, volatile LAS unsigned* st) {
  XcdBarrier b; b.bar = bar; b.x = xb_xcc_id(); b.st = st;
  if (threadIdx.x == 0) (void)xb_add(&bar[XB_XCNT(b.x)], 1u);
  return b;
}
__device__ __forceinline__ void xcd_barrier_complete(unsigned* bar, unsigned x, unsigned& nloc, unsigned& nx) {
  const unsigned G = gridDim.x * gridDim.y * gridDim.z;
  unsigned sum, cnt, mine, sp = 0u;
  for (;;) {
    sum = 0u; cnt = 0u; mine = 0u;
#pragma unroll
    for (unsigned j = 0; j < 16; ++j) { const unsigned c = xb_ld(&bar[XB_XCNT(j)]); sum += c; cnt += (c > 0u) ? 1u : 0u; mine = (j == x) ? c : mine; }
    if (sum == G) break;
    __builtin_amdgcn_s_sleep(1);
    if ((++sp & 255u) == 0u) { if (xb_ld(&bar[XB_TMO])) break; if (sp > XB_SPIN_CAP) { atomicAdd(&bar[XB_TMO], 1u); break; } }
  }
  nloc = mine > 0u ? mine : 1u; nx = cnt > 0u ? cnt : 1u;
}
__device__ __forceinline__ void xcd_barrier(const XcdBarrier& b) {
  asm volatile("s_waitcnt vmcnt(0)" ::: "memory");
  __syncthreads();
  if (threadIdx.x == 0) {
    unsigned* bar = b.bar;
    __builtin_amdgcn_s_waitcnt(0);
    unsigned nloc = b.st[0], nx = b.st[1];
    if (nloc == 0u) { xcd_barrier_complete(bar, b.x, nloc, nx); b.st[0] = nloc; b.st[1] = nx; }
    const unsigned old = xb_add(&bar[XB_XSUB(b.x)], 1u);
    const unsigned gen = old / nloc;
    if (old + 1u == (gen + 1u) * nloc) {
      __builtin_amdgcn_fence(__ATOMIC_RELEASE, "agent");
      asm volatile("s_waitcnt vmcnt(0)" ::: "memory");
      const unsigned og = xb_add(&bar[XB_TOP], 1u);
      const unsigned tg = og / nx;
      if (og + 1u == (tg + 1u) * nx) xb_add(&bar[XB_TOPGEN], 1u);
      else XB_SPIN(xb_ld(&bar[XB_TOPGEN]) == tg, bar);
      __builtin_amdgcn_fence(__ATOMIC_ACQUIRE, "agent");
      xb_add(&bar[XB_XGEN(b.x)], 1u);
      asm volatile("s_waitcnt vmcnt(0)" ::: "memory");
    } else {
      XB_SPIN(xb_ld(&bar[XB_XGEN(b.x)]) == gen, bar);
      __builtin_amdgcn_fence(__ATOMIC_ACQUIRE, "agent");
      asm volatile("s_waitcnt vmcnt(0)" ::: "memory");
    }
  }
  __syncthreads();
}

template <int MB, class Prov, int GMODE = 0, bool F8 = false>
__device__ __forceinline__ void gemm_stream(const Prov& pv, char* lds) {
  constexpr int BM = MB * 16, BN = 256, A_BYTES = BM * 128, STAGE = (BM + BN) * 128, AR = (BM + 63) / 64, BR = BN / 64, MB0 = (MB + 1) / 2, NW = 4;
  static_assert(2 * STAGE <= 135168, "GEMM LDS stages");
  int tid = threadIdx.x; asm volatile("" : "+v"(tid));
  const int wid = tid >> 6, lane = tid & 63, fr = lane & 15, fq = lane >> 4, wm = wid >> 2, wn = wid & 3;
  const int srow = tid >> 3, pc = tid & 7, lc = pc ^ (srow & 7);
  const int lds_base = (int)(uintptr_t)(LAS char*)lds;
  const int a_off = lds_base + (wm * MB0 * 16 + fr) * 128, b_off = lds_base + A_BYTES + (wn * 64 + fr) * 128;
  const int ch0 = (fq ^ (fr & 7)) * 16, ch1 = ((4 + fq) ^ (fr & 7)) * 16;
  const int bsrc = 16 * ((srow >> 2) & 3) + 4 * (srow >> 4) + (srow & 3);
  const bool lastm = (MB % 2 == 0) || wm == 0;
  typename Prov::Unit u, un;
  int it = 0;
  if (!pv.unit(it, u, srow)) return;
  constexpr int APN = Prov::A_AFFINE ? 1 : AR;
  const bf16_t* ap[APN]; const bf16_t* bp0; int astr = 0, bstr = 0;
#define GS_LOADPTR(U) do { _Pragma("unroll") for (int i = 0; i < APN; ++i) ap[i] = pv.a_row(U, srow + 64 * i) + lc * 8; \
    bp0 = pv.b_row(U, bsrc) + lc * 8; astr = pv.a_stride(U); bstr = pv.b_stride(U); } while (0)
#define GS_ISSUE(KO, BUF) do { char* base_ = lds + (BUF) * STAGE; \
    _Pragma("unroll") for (int i = 0; i < AR; ++i) if (AR * 64 == BM || srow + 64 * i < BM) glds16((Prov::A_AFFINE ? ap[0] + (size_t)i * astr : ap[i < APN ? i : 0]) + (KO), base_ + i * 8192 + tid * 16); \
    _Pragma("unroll") for (int i = 0; i < BR; ++i) glds16(bp0 + (size_t)i * bstr + (KO), base_ + A_BYTES + i * 8192 + tid * 16); } while (0)
#define GS_DSR(dst, addr) asm volatile("ds_read_b128 %0, %1" : "=v"(dst) : "v"(addr) : "memory")
  GS_LOADPTR(u); GS_ISSUE(0, 0);
  int buf = 0;
  for (;;) {
    const bool have_n = pv.unit(it + 1, un, srow);
    const int nk = pv.nk(u);
    f32x4 acc[MB0][NW];
#pragma unroll
    for (int m = 0; m < MB0; ++m)
#pragma unroll
      for (int n = 0; n < NW; ++n) acc[m][n] = (f32x4){0.f, 0.f, 0.f, 0.f};
#pragma unroll 1
    for (int kt = 0; kt < nk; ++kt) {
      asm volatile("s_waitcnt vmcnt(0)" ::: "memory");
      __syncthreads();
      if (GMODE != 2) { if (kt + 1 < nk) { GS_ISSUE((kt + 1) * 64, buf ^ 1); }
      else if (have_n) { GS_LOADPTR(un); GS_ISSUE(0, buf ^ 1); } }
      if (GMODE != 1 && F8) {
        constexpr int GS = MB0 > 4 ? 1 : 2, NG = (MB0 + GS - 1) / GS;
        const int sbo = buf * STAGE;
        const int cl = ((2 * fq) ^ (fr & 7)) * 16, chh = ((2 * fq + 1) ^ (fr & 7)) * 16;
        const int aaL = sbo + a_off + cl, aaH = sbo + a_off + chh, bbL = sbo + b_off + cl, bbH = sbo + b_off + chh;
        u32x4 fbl[NW], fbh[NW], fal[2][GS], fah[2][GS];
#define GS_DSR8(dst, addr) asm volatile("ds_read_b128 %0, %1" : "=v"(dst) : "v"(addr) : "memory")
#pragma unroll
        for (int n = 0; n < NW; ++n) { GS_DSR8(fbl[n], bbL + n * 2048); GS_DSR8(fbh[n], bbH + n * 2048); }
#pragma unroll
        for (int j = 0; j < GS; ++j) if (j < MB0) { GS_DSR8(fal[0][j], aaL + j * 2048); GS_DSR8(fah[0][j], aaH + j * 2048); }
#pragma unroll
        for (int g = 0; g < NG; ++g) {
          int nnext = 0;
          if (g + 1 < NG) {
#pragma unroll
            for (int j = 0; j < GS; ++j) { const int i = (g + 1) * GS + j; if (i < MB0) { GS_DSR8(fal[(g + 1) & 1][j], aaL + i * 2048); GS_DSR8(fah[(g + 1) & 1][j], aaH + i * 2048); nnext += 2; } }
          }
          if (nnext == 4) asm volatile("s_waitcnt lgkmcnt(4)" ::: "memory"); else if (nnext == 2) asm volatile("s_waitcnt lgkmcnt(2)" ::: "memory");
          else asm volatile("s_waitcnt lgkmcnt(0)" ::: "memory");
          __builtin_amdgcn_sched_barrier(0);
#pragma unroll
          for (int j = 0; j < GS; ++j) { const int m = g * GS + j;
            if (m < MB0 && (m < MB0 - 1 || lastm)) {
              const i32x8 av = {(int)fal[g & 1][j][0], (int)fal[g & 1][j][1], (int)fal[g & 1][j][2], (int)fal[g & 1][j][3], (int)fah[g & 1][j][0], (int)fah[g & 1][j][1], (int)fah[g & 1][j][2], (int)fah[g & 1][j][3]};
#pragma unroll
              for (int n = 0; n < NW; ++n) { const i32x8 bv = {(int)fbl[n][0], (int)fbl[n][1], (int)fbl[n][2], (int)fbl[n][3], (int)fbh[n][0], (int)fbh[n][1], (int)fbh[n][2], (int)fbh[n][3]};
                acc[m][n] = __builtin_amdgcn_mfma_scale_f32_16x16x128_f8f6f4(bv, av, acc[m][n], 0, 0, 0, 0x7f7f7f7f, 0, 0x7f7f7f7f); }
#pragma unroll
              for (int n = 0; n < NW; ++n) asm volatile("" : "+v"(acc[m][n]));
            } }
          __builtin_amdgcn_sched_barrier(0);
        }
#undef GS_DSR8
      }
      if (GMODE != 1 && !F8) {
        constexpr int NI = 2 * MB0, GS = 2, NG = (NI + GS - 1) / GS;
        const int sbo = buf * STAGE;
        const int aa0 = sbo + a_off + ch0, aa1 = sbo + a_off + ch1, bb0 = sbo + b_off + ch0, bb1 = sbo + b_off + ch1;
        bf16x8 fb[2][NW], fa[2][GS];
#pragma unroll
        for (int n = 0; n < NW; ++n) GS_DSR(fb[0][n], bb0 + n * 2048);
#pragma unroll
        for (int j = 0; j < GS; ++j) GS_DSR(fa[0][j], aa0 + j * 2048);
#pragma unroll
        for (int n = 0; n < NW; ++n) GS_DSR(fb[1][n], bb1 + n * 2048);
#pragma unroll
        for (int g = 0; g < NG; ++g) {
          int nnext = 0;
          if (g + 1 < NG) {
#pragma unroll
            for (int j = 0; j < GS; ++j) { const int i = (g + 1) * GS + j; if (i < NI) { GS_DSR(fa[(g + 1) & 1][j], (i / MB0 ? aa1 : aa0) + (i % MB0) * 2048); ++nnext; } }
          }
          if (g == 0) nnext += NW;
          if (nnext == 8) asm volatile("s_waitcnt lgkmcnt(8)" ::: "memory"); else if (nnext == 7) asm volatile("s_waitcnt lgkmcnt(7)" ::: "memory");
          else if (nnext == 6) asm volatile("s_waitcnt lgkmcnt(6)" ::: "memory"); else if (nnext == 5) asm volatile("s_waitcnt lgkmcnt(5)" ::: "memory");
          else if (nnext == 4) asm volatile("s_waitcnt lgkmcnt(4)" ::: "memory"); else if (nnext == 3) asm volatile("s_waitcnt lgkmcnt(3)" ::: "memory");
          else if (nnext == 2) asm volatile("s_waitcnt lgkmcnt(2)" ::: "memory"); else if (nnext == 1) asm volatile("s_waitcnt lgkmcnt(1)" ::: "memory");
          else asm volatile("s_waitcnt lgkmcnt(0)" ::: "memory");
          __builtin_amdgcn_sched_barrier(0);
#pragma unroll
          for (int j = 0; j < GS; ++j) { const int i = g * GS + j;
            if (i < NI) { const int m = i % MB0;
              if (m < MB0 - 1 || lastm) {
#pragma unroll
                for (int n = 0; n < NW; ++n) acc[m][n] = __builtin_amdgcn_mfma_f32_16x16x32_bf16(fb[i / MB0][n], fa[g & 1][j], acc[m][n], 0, 0, 0);
              } } }
          __builtin_amdgcn_sched_barrier(0);
        }
      }
      buf ^= 1;
    }
#pragma unroll
    for (int m = 0; m < MB0; ++m) if (m < MB0 - 1 || lastm) {
      pv.epi(u, (wm * MB0 + m) * 16 + fr, wn * 64 + fq * 16, acc[m][0], acc[m][1], acc[m][2], acc[m][3]);
    }
    if (!have_n) break;
    u = un; ++it;
  }
  __syncthreads();
#undef GS_LOADPTR
#undef GS_ISSUE
#undef GS_DSR
}

__device__ __forceinline__ u32x4 pack8(f32x4 a, f32x4 b) { return (u32x4){cvtpk(a[0], a[1]), cvtpk(a[2], a[3]), cvtpk(b[0], b[1]), cvtpk(b[2], b[3])}; }
struct EpiBf16 { bf16_t* C; int ldc; float sc = 1.0f; __device__ __forceinline__ void operator()(int r, int c, f32x4 v0, f32x4 v1, f32x4 v2, f32x4 v3) const {
  bf16_t* o = C + (size_t)r * ldc + c; *(u32x4*)o = pack8(v0 * sc, v1 * sc); *(u32x4*)(o + 8) = pack8(v2 * sc, v3 * sc); } };
struct EpiResid { xres_t* X; const float* gate; xres_t* dry;
  __device__ __forceinline__ void half8(int row, int c, int bsel, f32x4 v0, f32x4 v1) const {
    const f32x4 g0 = *(const f32x4*)(gate + (size_t)bsel * NMOD + c), g1 = *(const f32x4*)(gate + (size_t)bsel * NMOD + c + 4);
#if XBF16
    const u32x4 xw = *(const u32x4*)(X + (size_t)row * D + c);
    f32x4 x0 = {bflo(xw[0]), bfhi(xw[0]), bflo(xw[1]), bfhi(xw[1])}, x1 = {bflo(xw[2]), bfhi(xw[2]), bflo(xw[3]), bfhi(xw[3])};
    x0 += g0 * v0; x1 += g1 * v1;
    *(u32x4*)((dry ? dry : X) + (size_t)row * D + c) = pack8(x0, x1);
#else
    f32x4 x0 = xload4(X + (size_t)row * D + c), x1 = xload4(X + (size_t)row * D + c + 4); x0 += g0 * v0; x1 += g1 * v1;
    xstore4((dry ? dry : X) + (size_t)row * D + c, x0); xstore4((dry ? dry : X) + (size_t)row * D + c + 4, x1);
#endif
  }
  __device__ __forceinline__ void operator()(int row, int c, f32x4 v0, f32x4 v1, f32x4 v2, f32x4 v3) const {
    const int b = row / RPB, ii = row - b * RPB, bsel = ii < CTX ? 4 : b;
    half8(row, c, bsel, v0, v1); half8(row, c + 8, bsel, v2, v3); } };

template <int BM, int BN, bool LATONLY, class Epi>
struct DenseProv {
  const bf16_t* A; int lda; const bf16_t* Bt; int K; int nNt; Epi ep;
  struct Unit { int m0, n0; };
  __device__ __forceinline__ bool unit(int it, Unit& U, int) const {
    const int nloc = gridDim.x >> 3, x = blockIdx.x & 7, loc = (blockIdx.x >> 3) + nloc * it;
    if (loc >= 8 * nNt) return false;
    const int mt = x * 8 + (loc & 7), nt = loc >> 3;
    U.m0 = LATONLY ? (mt >> 4) * RPB + CTX + (mt & 15) * 256 : mt * BM; U.n0 = nt * BN; return true;
  }
  static constexpr bool A_AFFINE = true;
  __device__ __forceinline__ int a_stride(const Unit&) const { return 64 * lda; }
  __device__ __forceinline__ int b_stride(const Unit&) const { return 64 * K; }
  __device__ __forceinline__ const bf16_t* a_row(const Unit& U, int r) const { return A + (size_t)(U.m0 + r) * lda; }
  __device__ __forceinline__ const bf16_t* b_row(const Unit& U, int r) const { return Bt + (size_t)(U.n0 + r) * K; }
  __device__ __forceinline__ int nk(const Unit&) const { return K >> 6; }
  __device__ __forceinline__ void epi(const Unit& U, int r, int c, f32x4 v0, f32x4 v1, f32x4 v2, f32x4 v3) const { ep(U.m0 + r, U.n0 + c, v0, v1, v2, v3); }
};
template <int MB, int NBW, bool LATONLY, class Epi, int GMODE = 0, bool F8 = false>
__device__ __forceinline__ void gemm_dense(const bf16_t* A, int lda, const bf16_t* Bt, int N, int K, const Epi& ep, char* lds) {
  static_assert(NBW == 2, "256-column tiles");
  DenseProv<MB * 16, 256, LATONLY, Epi> pv{A, lda, Bt, K, N / 256, ep};
  gemm_stream<MB, DenseProv<MB * 16, 256, LATONLY, Epi>, GMODE, F8>(pv, lds);
}

template <bool F8>
struct MlaUpProv {
  const bf16_t* CQ; const bf16_t* CKV; const bf16_t* WUQ; const bf16_t* WUKV; bf16_t* Q; bf16_t* KV;
  static constexpr int QU = F8 ? QL / 2 : QL, KU = F8 ? KVL / 2 : KVL;
  struct Unit { int m0, n0, which; };
  __device__ __forceinline__ bool unit(int it, Unit& U, int) const {
    const int b = blockIdx.x; int which, t;
    if (b < 128) { if (it > 2) return false; which = it == 2; t = it == 2 ? b : 2 * b + it; }
    else { if (it > 3) return false; which = it != 0; t = it == 0 ? 256 + (b - 128) : 128 + 3 * (b - 128) + (it - 1); }
    U.which = which;
    if (which) { U.m0 = (t >> 3) * 272; U.n0 = (t & 7) * 256; } else { U.m0 = (t / 6) * 272; U.n0 = (t % 6) * 256; }
    return true;
  }
  static constexpr bool A_AFFINE = true;
  __device__ __forceinline__ int a_stride(const Unit& U) const { return U.which ? 64 * KU : 64 * QU; }
  __device__ __forceinline__ int b_stride(const Unit& U) const { return U.which ? 64 * KU : 64 * QU; }
  __device__ __forceinline__ const bf16_t* a_row(const Unit& U, int r) const { return U.which ? CKV + (size_t)(U.m0 + r) * KU : CQ + (size_t)(U.m0 + r) * QU; }
  __device__ __forceinline__ const bf16_t* b_row(const Unit& U, int r) const { return U.which ? WUKV + (size_t)(U.n0 + r) * KU : WUQ + (size_t)(U.n0 + r) * QU; }
  __device__ __forceinline__ int nk(const Unit& U) const { return U.which ? KU / 64 : QU / 64; }
  __device__ __forceinline__ void epi(const Unit& U, int r, int c, f32x4 v0, f32x4 v1, f32x4 v2, f32x4 v3) const {
    if (F8) { constexpr float is = 1.0f / 512.0f; v0 *= is; v1 *= is; v2 *= is; v3 *= is; }
    bf16_t* o = U.which ? KV + (size_t)(U.m0 + r) * 2048 + U.n0 + c : Q + (size_t)(U.m0 + r) * 1536 + U.n0 + c; *(u32x4*)o = pack8(v0, v1); *(u32x4*)(o + 8) = pack8(v2, v3); }
};

template <int DK> struct AttnCfg {
  static constexpr int KROW = DK * 2;
  static constexpr int SHM_V = 64 * 128 * 2, SHM_K = 64 * KROW;
  static constexpr int SHM = 2 * SHM_V + 2 * SHM_K + 8 * 64 * 4;
};
#define SBAR() __builtin_amdgcn_sched_barrier(0)
__device__ __forceinline__ int crow(int r, int hi) { return (r & 3) + 8 * (r >> 2) + 4 * hi; }
__device__ __forceinline__ int v_st(int k, int c) { const int kk = (k & ~0xC) | ((k & 4) << 1) | ((k & 8) >> 1); return ((kk >> 3) * 4 + (c >> 5)) * 512 + ((kk & 7) * 32 + (c & 31)) * 2; }
__device__ __forceinline__ int v_rd_base(int lane) { return ((lane & 3) << 3) | (((lane >> 2) & 3) << 6) | (((lane >> 4) & 1) << 5) | (((lane >> 5) & 1) << 8); }
constexpr int v_rd_off(int d0, int ks, int half) { return d0 * 512 + ks * 4096 + half * 2048; }
template <int OFF> __device__ __forceinline__ s16x4 tr_read(int vb) {
  s16x4 r; asm volatile("ds_read_b64_tr_b16 %0, %1 offset:%2" : "=&v"(r) : "v"(vb), "i"(OFF) : "memory"); return r;
}
template <int D0> __device__ __forceinline__ void pv_one(f32x16& od, int vb, bf16x8 pa0, bf16x8 pa1, bf16x8 pa2, bf16x8 pa3) {
  const s16x4 l0 = tr_read<v_rd_off(D0, 0, 0)>(vb), h0 = tr_read<v_rd_off(D0, 0, 1)>(vb), l1 = tr_read<v_rd_off(D0, 1, 0)>(vb), h1 = tr_read<v_rd_off(D0, 1, 1)>(vb);
  const s16x4 l2 = tr_read<v_rd_off(D0, 2, 0)>(vb), h2 = tr_read<v_rd_off(D0, 2, 1)>(vb), l3 = tr_read<v_rd_off(D0, 3, 0)>(vb), h3 = tr_read<v_rd_off(D0, 3, 1)>(vb);
  asm volatile("s_waitcnt lgkmcnt(0)" ::: "memory"); SBAR();
#define PK(L, H) (bf16x8){L[0], L[1], L[2], L[3], H[0], H[1], H[2], H[3]}
  od = __builtin_amdgcn_mfma_f32_32x32x16_bf16(pa0, PK(l0, h0), od, 0, 0, 0);
  od = __builtin_amdgcn_mfma_f32_32x32x16_bf16(pa1, PK(l1, h1), od, 0, 0, 0);
  od = __builtin_amdgcn_mfma_f32_32x32x16_bf16(pa2, PK(l2, h2), od, 0, 0, 0);
  od = __builtin_amdgcn_mfma_f32_32x32x16_bf16(pa3, PK(l3, h3), od, 0, 0, 0);
#undef PK
}
__device__ __forceinline__ void pv_d0(f32x16* o, int vb, bf16x8 pa0, bf16x8 pa1, bf16x8 pa2, bf16x8 pa3) {
  pv_one<0>(o[0], vb, pa0, pa1, pa2, pa3); pv_one<1>(o[1], vb, pa0, pa1, pa2, pa3); pv_one<2>(o[2], vb, pa0, pa1, pa2, pa3); pv_one<3>(o[3], vb, pa0, pa1, pa2, pa3);
}
constexpr float ATT_THR = 8.f;
template <int DK> __device__ __forceinline__ void partialSM(f32x16& p0, f32x16& p1, float& m_reg, float& mn, float& alpha) {
  constexpr float SCALE = DK == 192 ? 0.07216878364870322f : 0.08838834764831845f;
  constexpr float C = SCALE * 1.4426950408889634f;
  float pmax = p0[0];
#pragma unroll
  for (int r = 1; r < 16; ++r) pmax = fmaxf(pmax, p0[r]);
#pragma unroll
  for (int r = 0; r < 16; ++r) pmax = fmaxf(pmax, p1[r]);
  { auto rr = __builtin_amdgcn_permlane32_swap(__float_as_uint(pmax), __float_as_uint(pmax), false, false);
    pmax = fmaxf(__uint_as_float(rr[0]), __uint_as_float(rr[1])); }
  if (__builtin_expect(__all(pmax - m_reg <= ATT_THR / SCALE), 1)) { mn = m_reg; alpha = 1.f; }
  else { mn = fmaxf(m_reg, pmax); alpha = __builtin_amdgcn_exp2f((m_reg - mn) * C); m_reg = mn; }
  const float mnC = -mn * C;
#pragma unroll
  for (int r = 0; r < 16; ++r) p0[r] = fmaf(p0[r], C, mnC);
#pragma unroll
  for (int r = 0; r < 16; ++r) p1[r] = fmaf(p1[r], C, mnC);
#pragma unroll
  for (int r = 0; r < 16; ++r) p0[r] = __builtin_amdgcn_exp2f(p0[r]);
}
__device__ __forceinline__ void finishSM(f32x16& p0, f32x16& p1, float alpha, float& l_reg, bf16x8& pa0, bf16x8& pa1, bf16x8& pa2, bf16x8& pa3) {
#pragma unroll
  for (int r = 0; r < 16; ++r) p1[r] = __builtin_amdgcn_exp2f(p1[r]);
  float ps = 0;
#pragma unroll
  for (int r = 0; r < 16; ++r) ps += p0[r];
#pragma unroll
  for (int r = 0; r < 16; ++r) ps += p1[r];
  { auto rr = __builtin_amdgcn_permlane32_swap(__float_as_uint(ps), __float_as_uint(ps), false, false);
    ps = __uint_as_float(rr[0]) + __uint_as_float(rr[1]); }
  l_reg = l_reg * alpha + ps;
#define PK4(P, BASE, OUT) do { unsigned a0 = cvtpk(P[BASE + 0], P[BASE + 1]), a1 = cvtpk(P[BASE + 2], P[BASE + 3]);   \
    unsigned b0 = cvtpk(P[BASE + 4], P[BASE + 5]), b1 = cvtpk(P[BASE + 6], P[BASE + 7]);                              \
    auto r0 = __builtin_amdgcn_permlane32_swap(a0, b0, false, false); auto r1 = __builtin_amdgcn_permlane32_swap(a1, b1, false, false); \
    u32x4 w = {r0[0], r1[0], r0[1], r1[1]}; OUT = *reinterpret_cast<bf16x8*>(&w); } while (0)
  PK4(p0, 0, pa0); PK4(p0, 8, pa1); PK4(p1, 0, pa2); PK4(p1, 8, pa3);
#undef PK4
}
template <int DK> __device__ __forceinline__ void qkt(f32x16& p0, f32x16& p1, const char* Ks, const bf16x8* qr, const int* kro) {
  constexpr int KROW = DK * 2;
  p0 = f32x16{}; p1 = f32x16{};
#pragma unroll
  for (int d0 = 0; d0 < DK / 16; ++d0) {
    bf16x8 b0 = *reinterpret_cast<const bf16x8*>(Ks + kro[d0 & 3] + (d0 >> 2) * 128);
    bf16x8 b1 = *reinterpret_cast<const bf16x8*>(Ks + kro[d0 & 3] + (d0 >> 2) * 128 + 32 * KROW);
    p0 = __builtin_amdgcn_mfma_f32_32x32x16_bf16(b0, qr[d0], p0, 0, 0, 0);
    p1 = __builtin_amdgcn_mfma_f32_32x32x16_bf16(b1, qr[d0], p1, 0, 0, 0); }
}

template <int DK, int ldq, int ldk, int ldv, int ldo>
__device__ __forceinline__ void attn_unit(const bf16_t* __restrict__ Qb, const bf16_t* __restrict__ Kh, const bf16_t* __restrict__ Kp,
                                          const bf16_t* __restrict__ Vh, bf16_t* __restrict__ Ob, int nkeys, bool rope, int qpos0,
                                          const float* __restrict__ qg, char* lds) {
  using Cfg = AttnCfg<DK>;
  constexpr int KROW = Cfg::KROW, SHM_V = Cfg::SHM_V, SHM_K = Cfg::SHM_K, ND0 = DK / 16;
  int tid = threadIdx.x; asm volatile("" : "+v"(tid));
  const int wid = tid >> 6, lane = tid & 63, r32 = lane & 31, hi = lane >> 5;
  char* V_lds = lds; char* K_lds = lds + 2 * SHM_V;
  float* wsl = (float*)(lds + 2 * SHM_V + 2 * SHM_K) + wid * 64; float* li_l = wsl; float* al_l = wsl + 32;
  float m_reg = -1e30f, l_reg = 0; f32x16 o[4] = {}; bf16x8 qr[ND0];
  {
    const int qrow = wid * 32 + r32;
    const bf16_t* Qw = Qb + (size_t)qrow * ldq + hi * 8;
    float qf[ND0][8];
#pragma unroll
    for (int d0 = 0; d0 < ND0; ++d0) { const u32x4 w = *reinterpret_cast<const u32x4*>(Qw + d0 * 16);
#pragma unroll
      for (int e = 0; e < 4; ++e) { qf[d0][2 * e] = bflo(w[e]); qf[d0][2 * e + 1] = bfhi(w[e]); } }
    const int qpos = qpos0 + qrow; const float prow = (float)(qpos >> 6), pcol = (float)(qpos & 63);
    int hio = hi; asm volatile("" : "+v"(hio));
    if constexpr (DK == 128) {
      float ss = 0.f;
#pragma unroll
      for (int d0 = 0; d0 < 8; ++d0)
#pragma unroll
        for (int e = 0; e < 8; ++e) ss += qf[d0][e] * qf[d0][e];
      ss += __shfl_xor(ss, 32);
      const float rs = rsqrtf(ss * (1.0f / 128.0f) + EPS);
#pragma unroll
      for (int d0 = 0; d0 < 8; ++d0) { const f32x4 g0 = *(const f32x4*)(qg + d0 * 16 + hi * 8), g1 = *(const f32x4*)(qg + d0 * 16 + hi * 8 + 4);
#pragma unroll
        for (int e = 0; e < 4; ++e) { qf[d0][e] *= rs * g0[e]; qf[d0][4 + e] *= rs * g1[e]; } }
      if (rope) {
#pragma unroll
        for (int hf = 0; hf < 2; ++hf) { const float pos = hf ? pcol : prow;
#pragma unroll
          for (int dd = 0; dd < 2; ++dd)
#pragma unroll
            for (int e = 0; e < 8; ++e) { const int j = dd * 16 + hio * 8 + e; const float ang = pos * rope_invf(j, 32); const float cs = __cosf(ang), sn = __sinf(ang);
              const float x1 = qf[hf * 4 + dd][e], x2 = qf[hf * 4 + dd + 2][e]; qf[hf * 4 + dd][e] = x1 * cs - x2 * sn; qf[hf * 4 + dd + 2][e] = x1 * sn + x2 * cs; } }
      }
    } else {
      if (rope) {
#pragma unroll
        for (int hf = 0; hf < 2; ++hf) { const float pos = hf ? pcol : prow;
#pragma unroll
          for (int e = 0; e < 8; ++e) { const int j = hio * 8 + e; const float ang = pos * rope_invf(j, 16); const float cs = __cosf(ang), sn = __sinf(ang);
            const float x1 = qf[8 + hf * 2][e], x2 = qf[9 + hf * 2][e]; qf[8 + hf * 2][e] = x1 * cs - x2 * sn; qf[9 + hf * 2][e] = x1 * sn + x2 * cs; } }
      }
    }
#pragma unroll
    for (int d0 = 0; d0 < ND0; ++d0) { u32x4 w = {cvtpk(qf[d0][0], qf[d0][1]), cvtpk(qf[d0][2], qf[d0][3]), cvtpk(qf[d0][4], qf[d0][5]), cvtpk(qf[d0][6], qf[d0][7])};
      qr[d0] = *reinterpret_cast<bf16x8*>(&w); }
  }
  int kro[4];
#pragma unroll
  for (int bq = 0; bq < 4; ++bq) kro[bq] = r32 * KROW + (((2 * bq + hi) ^ (r32 & 7)) << 4);
  const int sr = tid >> 4, sc = (tid & 15) * 8, vst0 = v_st(sr, sc), vst1 = v_st(32 + sr, sc);
  const int pr = tid >> 3, pcc = (tid & 7) * 8;
  const int vb0 = (int)(uintptr_t)(LAS char*)V_lds + v_rd_base(lane);
  bf16x8 vs0, vs1, ks0, ks1, kp0;
  const unsigned voff = sr * ldv + sc, koff = sr * ldk + sc, poff = pr * ROPE + pcc;
#define SLOAD(k0) do { const bf16_t* Vt = Vh + (size_t)(k0) * ldv; const bf16_t* Kt = Kh + (size_t)(k0) * ldk; \
    vs0 = *(const bf16x8*)(Vt + voff); vs1 = *(const bf16x8*)(Vt + 32 * ldv + voff); \
    ks0 = *(const bf16x8*)(Kt + koff); ks1 = *(const bf16x8*)(Kt + 32 * ldk + koff); \
    if constexpr (DK == 192) kp0 = *(const bf16x8*)(Kp + (size_t)(k0) * ROPE + poff); } while (0)
#define SWRITE(b) do { *(bf16x8*)(V_lds + (b) * SHM_V + vst0) = vs0; *(bf16x8*)(V_lds + (b) * SHM_V + vst1) = vs1; const int kc = sc * 2; \
    *(bf16x8*)(K_lds + (b) * SHM_K + sr * KROW + (kc ^ ((sr & 7) << 4))) = ks0; \
    *(bf16x8*)(K_lds + (b) * SHM_K + (32 + sr) * KROW + (kc ^ ((sr & 7) << 4))) = ks1; \
    if constexpr (DK == 192) *(bf16x8*)(K_lds + (b) * SHM_K + pr * KROW + ((256 + pcc * 2) ^ ((pr & 7) << 4))) = kp0; } while (0)
#define RESC(a) do { if (__any((a) < 1.f)) { if (hi == 0) al_l[r32] = (a); asm volatile("s_waitcnt lgkmcnt(0)" ::: "memory"); \
    for (int d = 0; d < 4; ++d) for (int r = 0; r < 16; ++r) o[d][r] *= al_l[crow(r, hi)]; } } while (0)
  f32x16 pA0, pA1, pB0, pB1; float mnA, mnB, alA, alB; bf16x8 pa0, pa1, pa2, pa3; const int NT = nkeys / 64;
  SLOAD(0); SWRITE(0); __syncthreads();
  qkt<DK>(pA0, pA1, K_lds, qr, kro); partialSM<DK>(pA0, pA1, m_reg, mnA, alA);
  SLOAD(64); SWRITE(1); __syncthreads();
  for (int j = 1; j + 1 < NT; j += 2) {
    SBAR(); qkt<DK>(pB0, pB1, K_lds + SHM_K, qr, kro);
    finishSM(pA0, pA1, alA, l_reg, pa0, pa1, pa2, pa3); SBAR();
    SLOAD((j + 1) * 64); SBAR();
    pv_d0(o, vb0, pa0, pa1, pa2, pa3); partialSM<DK>(pB0, pB1, m_reg, mnB, alB);
    __syncthreads(); SWRITE(0);
    RESC(alB); __syncthreads();
    SBAR(); qkt<DK>(pA0, pA1, K_lds, qr, kro);
    finishSM(pB0, pB1, alB, l_reg, pa0, pa1, pa2, pa3); SBAR();
    SLOAD((j + 2) * 64); SBAR();
    pv_d0(o, vb0 + SHM_V, pa0, pa1, pa2, pa3); partialSM<DK>(pA0, pA1, m_reg, mnA, alA);
    __syncthreads(); SWRITE(1);
    RESC(alA); __syncthreads();
  }
  SBAR(); qkt<DK>(pB0, pB1, K_lds + SHM_K, qr, kro);
  finishSM(pA0, pA1, alA, l_reg, pa0, pa1, pa2, pa3); SBAR();
  pv_d0(o, vb0, pa0, pa1, pa2, pa3); partialSM<DK>(pB0, pB1, m_reg, mnB, alB);
  __syncthreads(); RESC(alB);
  finishSM(pB0, pB1, alB, l_reg, pa0, pa1, pa2, pa3); SBAR();
  pv_d0(o, vb0 + SHM_V, pa0, pa1, pa2, pa3);
  if (hi == 0) li_l[r32] = l_reg; asm volatile("s_waitcnt lgkmcnt(0)" ::: "memory");
  float rli[16];
#pragma unroll
  for (int r = 0; r < 16; ++r) rli[r] = __builtin_amdgcn_rcpf(li_l[crow(r, hi)]);
  bf16_t* Ow = Ob + (size_t)(wid * 32) * ldo;
#pragma unroll
  for (int r = 0; r < 16; ++r) { const int orow = crow(r, hi);
#pragma unroll
    for (int d0 = 0; d0 < 4; ++d0) Ow[(size_t)orow * ldo + d0 * 32 + r32] = (bf16_t)(cvtpk(o[d0][r] * rli[r], 0.f) & 0xffffu); }
  __syncthreads();
#undef SLOAD
#undef SWRITE
#undef RESC
}

__device__ __forceinline__ void tconv_tile(const float* __restrict__ src, int ldn, int k0, int n0, bf16_t* __restrict__ dst, int ldk, int rmul, int roff, float* lw, int lane) {
  const float* s = src + (size_t)k0 * ldn + n0 + lane;
  float v[64];
#pragma unroll
  for (int i = 0; i < 64; ++i) v[i] = __builtin_nontemporal_load(s + (size_t)i * ldn);
#pragma unroll
  for (int i = 0; i < 64; ++i) lw[i * 65 + lane] = v[i];
  const int kc = (lane & 7) * 8;
#pragma unroll
  for (int it = 0; it < 8; ++it) {
    const int n = it * 8 + (lane >> 3);
    float v[8];
#pragma unroll
    for (int j = 0; j < 8; ++j) v[j] = lw[(kc + j) * 65 + n];
    u32x4 w = {cvtpk(v[0], v[1]), cvtpk(v[2], v[3]), cvtpk(v[4], v[5]), cvtpk(v[6], v[7])};
    *(u32x4*)(dst + (size_t)((n0 + n) * rmul + roff) * ldk + k0 + kc) = w;
  }
}

#ifndef MOE_JIT
#define MOE_JIT 1
#endif
constexpr float F8_SH = 8.0f, F8_SWD = 32.0f;
constexpr float F8_SA = 8.0f, F8_SW = 64.0f;
__device__ __forceinline__ unsigned pack4_f8(float a, float b, float c, float d) {
  int w = __builtin_amdgcn_cvt_pk_fp8_f32(fminf(fmaxf(a, -448.f), 448.f), fminf(fmaxf(b, -448.f), 448.f), 0, false);
  w = __builtin_amdgcn_cvt_pk_fp8_f32(fminf(fmaxf(c, -448.f), 448.f), fminf(fmaxf(d, -448.f), 448.f), w, true); return (unsigned)w; }
__device__ __forceinline__ void tconv_tile_f8(const float* __restrict__ src, int ldn, int k0, int n0, unsigned char* __restrict__ dst, int ldk, int rmul, int roff, float scale, float* lw, int lane) {
  const float* s = src + (size_t)k0 * ldn + n0 + lane;
  float v[64];
#pragma unroll
  for (int i = 0; i < 64; ++i) v[i] = __builtin_nontemporal_load(s + (size_t)i * ldn);
#pragma unroll
  for (int i = 0; i < 64; ++i) lw[i * 65 + lane] = v[i];
  const int kc = (lane & 3) * 16;
#pragma unroll
  for (int it = 0; it < 4; ++it) {
    const int n = it * 16 + (lane >> 2);
    float x[16];
#pragma unroll
    for (int j = 0; j < 16; ++j) x[j] = lw[(kc + j) * 65 + n] * scale;
    u32x4 w = {pack4_f8(x[0], x[1], x[2], x[3]), pack4_f8(x[4], x[5], x[6], x[7]), pack4_f8(x[8], x[9], x[10], x[11]), pack4_f8(x[12], x[13], x[14], x[15])};
    *(u32x4*)(dst + (size_t)((n0 + n) * rmul + roff) * ldk + k0 + kc) = w;
  }
}
__device__ __forceinline__ void phase_conv_moe(const Params& p, int layer, char* lds) {
  int tid = threadIdx.x; asm volatile("" : "+v"(tid));
  const int wid = tid >> 6, lane = tid & 63;
  const int gw = blockIdx.x * 8 + wid, nw = gridDim.x * 8;
  char* ws = opaque_ptr(p.ws);
  float* lw = (float*)lds + wid * (64 * 65);
  for (int t = gw; t < ME * 384; t += nw) {
    const int le = layer * ME + t / 384, tt = t % 384, which = tt >> 7, ti = tt & 127;
    bf16_t* wgu = (bf16_t*)(ws + WS_WMOE + (size_t)le * MOE_WBYTES); bf16_t* wd = wgu + 1024 * 1024;
    if (which < 2) { const float* src = p.in[which == 0 ? I_MOE_GATE : I_MOE_UP] + (size_t)le * D * FF;
      const int kt = ti >> 3, nt = ti & 7;
      if (MOE_F8) tconv_tile_f8(src, FF, kt * 64, nt * 64, (unsigned char*)wgu, D, 2, which, F8_SW, lw, lane);
      else tconv_tile(src, FF, kt * 64, nt * 64, wgu, D, 2, which, lw, lane); }
    else { const float* src = p.in[I_MOE_DOWN] + (size_t)le * FF * D;
      const int kt = ti >> 4, nt = ti & 15;
      if (MOE_F8 >= 2) tconv_tile_f8(src, D, kt * 64, nt * 64, (unsigned char*)wd, FF, 1, 0, F8_SWD, lw, lane);
      else tconv_tile(src, D, kt * 64, nt * 64, wd, FF, 1, 0, lw, lane); }
  }
}
__device__ __forceinline__ void phase_prep(const Params& p, char* lds) {
  int tid = threadIdx.x; asm volatile("" : "+v"(tid));
  const int wid = tid >> 6, lane = tid & 63;
  const int gw = blockIdx.x * 8 + wid, nw = gridDim.x * 8;
  char* ws = opaque_ptr(p.ws);
  float* lw = (float*)lds + wid * (64 * 65);
  for (int t = gw + (MOE_JIT ? DEPTH * ME * 384 : 0); t < DEPTH * ME * 384; t += nw) {
    const int le = t / 384, tt = t - le * 384, which = tt >> 7, ti = tt & 127;
    bf16_t* wgu = (bf16_t*)(ws + WS_WMOE + (size_t)le * MOE_WBYTES); bf16_t* wd = wgu + 1024 * 1024;
    if (which < 2) { const float* src = p.in[which == 0 ? I_MOE_GATE : I_MOE_UP] + (size_t)le * D * FF;
      const int kt = ti >> 3, nt = ti & 7; tconv_tile(src, FF, kt * 64, nt * 64, wgu, D, 2, which, lw, lane); }
    else { const float* src = p.in[I_MOE_DOWN] + (size_t)le * FF * D;
      const int kt = ti >> 4, nt = ti & 15; tconv_tile(src, D, kt * 64, nt * 64, wd, FF, 1, 0, lw, lane); }
  }
  {
    int base = 0;
#pragma unroll 1
    for (int q = 0; q < 14; ++q) {
      const float* jsrc = p.jobs[q].src; bf16_t* jdst = p.jobs[q].dst; const int jK = p.jobs[q].K, jN = p.jobs[q].N, jroff = p.jobs[q].roff;
      const int nnt = jN >> 6, ntile = (jK >> 6) * nnt;
      for (int t = gw - base; t < ntile; t += nw) { if (t < 0) continue; const int kt = t / nnt, nt = t - kt * nnt;
        if (p.jobs[q].rmul == 8) tconv_tile_f8(jsrc, jN, kt * 64, nt * 64, (unsigned char*)jdst, jK, 1, jroff, F8_SW, lw, lane);
        else tconv_tile(jsrc, jN, kt * 64, nt * 64, jdst, jK, 1, jroff, lw, lane); }
      base = (base + ntile) % nw;
    }
  }
  for (int j = 0; j < 2; ++j) { constexpr int ES = MIX_F8 ? 1 : 2; u32x4* z = (u32x4*)(ws + WS_WMLA + j * MLA_WBYTES + MLA_W1T + (size_t)832 * 1024 * ES);
    for (int i = blockIdx.x * NTHR + tid; i < 192 * 1024 * ES / 16; i += gridDim.x * NTHR) z[i] = (u32x4){0u, 0u, 0u, 0u}; }
  if (blockIdx.x == 0 && tid < DEPTH * ME) ((int*)(ws + WS_CNT))[tid] = 0;
  if (blockIdx.x == 0 && tid == 0) ((int*)(ws + WS_CNT))[1000] = 0;
  for (int r = gw; r < R; r += nw) {
    const int b = r / RPB, ii = r - b * RPB;
    const f32x4* src = (const f32x4*)(ii < CTX ? p.in[I_CTX] + ((size_t)b * CTX + ii) * D : p.in[I_X] + ((size_t)b * SEQ + (ii - CTX)) * D);
    xres_t* dst = (xres_t*)(ws + WS_X32) + (size_t)r * D;
#pragma unroll
    for (int q = 0; q < 4; ++q) xstore4(dst + (lane + 64 * q) * 4, src[lane + 64 * q]);
  }
  {
    float* sc = (float*)lds;
    __syncthreads();
    for (int u = blockIdx.x; u < DEPTH * 12 * 8; u += gridDim.x) {
      const int i = u / 96, rem = u - i * 96, cch = rem >> 3, ks = rem & 7;
      __syncthreads();
      for (int e = tid; e < 5 * 128; e += NTHR) { const int b = e >> 7, k = ks * 128 + (e & 127); const float c = b < 4 ? p.in[I_C][b * D + k] : p.in[I_CCTX][k]; sc[e] = silu_f(c); }
      __syncthreads();
      const int col = cch * 512 + tid;
      const float* w = p.in[I_WMOD] + (size_t)i * D * NMOD + (size_t)(ks * 128) * NMOD + col;
      float a0 = 0, a1 = 0, a2 = 0, a3 = 0, a4 = 0;
#pragma unroll 8
      for (int k = 0; k < 128; ++k) { const float wv = w[(size_t)k * NMOD]; a0 += sc[k] * wv; a1 += sc[128 + k] * wv; a2 += sc[256 + k] * wv; a3 += sc[384 + k] * wv; a4 += sc[512 + k] * wv; }
      float* mp = (float*)(ws + WS_MODP) + ((size_t)(ks * DEPTH + i) * 5) * NMOD + col;
      mp[0] = a0; mp[NMOD] = a1; mp[2 * NMOD] = a2; mp[3 * NMOD] = a3; mp[4 * NMOD] = a4;
    }
    __syncthreads();
  }
}
__device__ __forceinline__ void phase_modfin(const Params& p) {
  const float* mp = (const float*)(p.ws + WS_MODP); float* mv = (float*)(p.ws + WS_MODV);
  for (int e = blockIdx.x * NTHR + threadIdx.x; e < DEPTH * 5 * NMOD; e += gridDim.x * NTHR) {
    const int i = e / (5 * NMOD), col = e % NMOD;
    float s = p.in[I_BMOD][i * NMOD + col];
#pragma unroll
    for (int ks = 0; ks < 8; ++ks) s += mp[(size_t)ks * DEPTH * 5 * NMOD + e];
    mv[e] = s;
  }
}

template <int MODE, bool COMBINE, bool DRY = false>
__device__ __forceinline__ void phase_norm(const Params& p, int layer) {
  int tid = threadIdx.x; asm volatile("" : "+v"(tid));
  const int wid = tid >> 6, lane = tid & 63;
  const int gw = blockIdx.x * 8 + wid, nw = gridDim.x * 8;
  char* ws = opaque_ptr(p.ws);
  const float* modv = (const float*)(ws + WS_MODV);
  const bf16_t* Y = (const bf16_t*)(ws + WS_Y);
  for (int r = gw; r < R; r += nw) {
    const int b = r / RPB, ii = r - b * RPB; const bool is_ctx = ii < CTX; const int bsel = is_ctx ? 4 : b;
    if (MODE == 2 && is_ctx) continue;
    xres_t* xp = (xres_t*)(ws + WS_X32) + (size_t)r * D;
    f32x4 v[4];
#pragma unroll
    for (int q = 0; q < 4; ++q) v[q] = xload4(xp + (lane + 64 * q) * 4);
    if (COMBINE) {
      const int pl = MODE == 2 ? DEPTH - 1 : layer - 1;
      if (!(pl == DEPTH - 1 && is_ctx)) {
        const float* g2 = modv + ((size_t)pl * 5 + bsel) * NMOD + 5 * D;
#pragma unroll
        for (int q = 0; q < 4; ++q) { const int c = (lane + 64 * q) * 4; const f32x4 g = *(const f32x4*)(g2 + c);
          const u32x2 y0 = *(const u32x2*)(Y + (size_t)(2 * r) * D + c), y1 = *(const u32x2*)(Y + (size_t)(2 * r + 1) * D + c);
          v[q][0] += g[0] * (bflo(y0[0]) + bflo(y1[0])); v[q][1] += g[1] * (bfhi(y0[0]) + bfhi(y1[0]));
          v[q][2] += g[2] * (bflo(y0[1]) + bflo(y1[1])); v[q][3] += g[3] * (bfhi(y0[1]) + bfhi(y1[1])); }
        if (MODE != 2 && !DRY) {
#pragma unroll
          for (int q = 0; q < 4; ++q) xstore4(xp + (lane + 64 * q) * 4, v[q]);
        }
      }
    }
    float ss = 0.f;
#pragma unroll
    for (int q = 0; q < 4; ++q) ss += v[q][0] * v[q][0] + v[q][1] * v[q][1] + v[q][2] * v[q][2] + v[q][3] * v[q][3];
    ss = wave_sum(ss);
    const float rs = rsqrtf(ss * (1.0f / D) + EPS);
    if (MODE == 2) {
      float* op = p.out + ((size_t)b * SEQ + (ii - CTX)) * D;
#pragma unroll
      for (int q = 0; q < 4; ++q) { const int c = (lane + 64 * q) * 4; const f32x4 g = *(const f32x4*)(p.in[I_FG] + c); f32x4 ov = v[q] * rs * g;
#if DBG_TIME
        { const unsigned long long* d = (const unsigned long long*)(ws + WS_CNT + 4096); const float t1 = (float)d[DBG_T1] * 0.01f, t2 = (float)d[DBG_T2] * 0.01f;
          const float a = sqrtf(t1 * 0.01f); ov = (f32x4){a, a, a, a}; if (r == CTX && c == 0) ov[0] = t2 * 0.002f; }
#endif
        if (DBG_PROBE == 20 && ((const int*)(ws + WS_CNT))[1000]) ov = (f32x4){1000.f, 1000.f, 1000.f, 1000.f};
#ifdef SANITIZE
        for (int e = 0; e < 4; ++e) if (!(fabsf(ov[e]) < 1e30f)) ov[e] = DBG_PROBE ? 0.f : 1000.0f;
        if (DBG_PROBE && ((const int*)(ws + WS_CNT))[1000]) ov = (f32x4){1000.f, 1000.f, 1000.f, 1000.f};
#endif
        *(f32x4*)(op + c) = ov; }
      continue;
    }
    const float* ng = p.in[MODE == 0 ? I_NMG : I_NFG] + layer * D;
    const float* sh = modv + ((size_t)layer * 5 + bsel) * NMOD + (MODE == 0 ? 0 : 3) * D;
    const float* scl = sh + D;
    bf16_t* ap = (bf16_t*)(ws + WS_ACT) + (size_t)r * D;
    f32x4 f[4];
#pragma unroll
    for (int q = 0; q < 4; ++q) { const int c = (lane + 64 * q) * 4; const f32x4 g = *(const f32x4*)(ng + c), s1 = *(const f32x4*)(scl + c), s0 = *(const f32x4*)(sh + c);
      f[q] = (v[q] * rs * g) * (1.0f + s1) + s0;
      if ((MODE == 1 && MOE_F8) || (MODE == 0 && MIX_F8 && layer % 3 != 1)) ((unsigned*)(ws + WS_ACT))[((size_t)r * D + c) >> 2] = pack4_f8(f[q][0] * F8_SA, f[q][1] * F8_SA, f[q][2] * F8_SA, f[q][3] * F8_SA);
      else { u32x2 w = {cvtpk(f[q][0], f[q][1]), cvtpk(f[q][2], f[q][3])}; *(u32x2*)(ap + c) = w; } }
    if (MODE == 1) {
      if (layer == DEPTH - 1 && is_ctx) continue;
      const float* wg = p.in[I_MOE_WG] + (size_t)layer * D * 4; const float* we = p.in[I_MOE_WE] + (size_t)layer * D * ME;
      float gl[4] = {0.f, 0.f, 0.f, 0.f};
#pragma unroll
      for (int q = 0; q < 4; ++q)
#pragma unroll
        for (int e = 0; e < 4; ++e) { const int c = (lane + 64 * q) * 4 + e; const f32x4 w = *(const f32x4*)(wg + (size_t)c * 4);
          gl[0] += f[q][e] * w[0]; gl[1] += f[q][e] * w[1]; gl[2] += f[q][e] * w[2]; gl[3] += f[q][e] * w[3]; }
#pragma unroll
      for (int k = 0; k < 4; ++k) gl[k] = wave_sum(gl[k]);
      const float gm = fmaxf(fmaxf(gl[0], gl[1]), fmaxf(gl[2], gl[3]));
      float gp[4], gs = 0.f;
#pragma unroll
      for (int k = 0; k < 4; ++k) { gp[k] = __expf(gl[k] - gm); gs += gp[k]; }
      const float gsi = 1.0f / gs;
      int gsel = 0; float gbest = -1e30f, gw_ = 0.f;
#pragma unroll
      for (int k = 0; k < 4; ++k) { const float pr = gp[k] * gsi; const float sc = pr + p.in[I_MOE_BG][layer * 4 + k]; if (sc > gbest) { gbest = sc; gsel = k; gw_ = pr; } }
      gsel = __builtin_amdgcn_readfirstlane(gsel);
      float el[8] = {0.f, 0.f, 0.f, 0.f, 0.f, 0.f, 0.f, 0.f};
#pragma unroll
      for (int q = 0; q < 4; ++q)
#pragma unroll
        for (int e = 0; e < 4; ++e) { const int c = (lane + 64 * q) * 4 + e; const f32x4 w0 = *(const f32x4*)(we + (size_t)c * ME + gsel * 8), w1 = *(const f32x4*)(we + (size_t)c * ME + gsel * 8 + 4);
          el[0] += f[q][e] * w0[0]; el[1] += f[q][e] * w0[1]; el[2] += f[q][e] * w0[2]; el[3] += f[q][e] * w0[3];
          el[4] += f[q][e] * w1[0]; el[5] += f[q][e] * w1[1]; el[6] += f[q][e] * w1[2]; el[7] += f[q][e] * w1[3]; }
#pragma unroll
      for (int k = 0; k < 8; ++k) el[k] = wave_sum(el[k]);
      float em = el[0];
#pragma unroll
      for (int k = 1; k < 8; ++k) em = fmaxf(em, el[k]);
      float ep[8], es = 0.f;
#pragma unroll
      for (int k = 0; k < 8; ++k) { ep[k] = __expf(el[k] - em); es += ep[k]; }
      const float esi = 1.0f / es;
      int t1 = 0, t2 = 0; float b1 = -1e30f, b2 = -1e30f, p1 = 0.f, p2 = 0.f;
#pragma unroll
      for (int k = 0; k < 8; ++k) { const float pr = ep[k] * esi; const float sc = pr + p.in[I_MOE_BE][layer * ME + gsel * 8 + k];
        if (sc > b1) { b2 = b1; t2 = t1; p2 = p1; b1 = sc; t1 = k; p1 = pr; } else if (sc > b2) { b2 = sc; t2 = k; p2 = pr; } }
      if (lane == 0 && !DRY) {
        const float inv = gw_ / (p1 + p2);
        int* cnt = (int*)(ws + WS_CNT) + layer * ME; int* list = (int*)(ws + WS_LIST); float* wts = (float*)(ws + WS_WTS);
        const int e1 = gsel * 8 + t1, e2 = gsel * 8 + t2;
        const int q1 = atomicAdd(cnt + e1, 1); list[(size_t)e1 * R + q1] = 2 * r;     wts[2 * r] = p1 * inv;
        const int q2 = atomicAdd(cnt + e2, 1); list[(size_t)e2 * R + q2] = 2 * r + 1; wts[2 * r + 1] = p2 * inv;
      }
    }
  }
}

__device__ __forceinline__ void phase_mla_mid(const Params& p, int j) {
  int tid = threadIdx.x; asm volatile("" : "+v"(tid));
  const int wid = tid >> 6, lane = tid & 63;
  const int gw = blockIdx.x * 8 + wid, nw = gridDim.x * 8;
  char* ws = opaque_ptr(p.ws);
  const float* gq = p.in[I_MLA_GQ] + j * QL; const float* gkv = p.in[I_MLA_GKV] + j * KVL;
  for (int r = gw; r < R; r += nw) {
    const int b = r / RPB, ii = r - b * RPB; const bool is_ctx = ii < CTX;
    const bf16_t* c1 = (const bf16_t*)(ws + WS_C1) + (size_t)r * 1024;
    const u32x2 q0w = *(const u32x2*)(c1 + lane * 4), q1w = *(const u32x2*)(c1 + 256 + lane * 4), kvw = *(const u32x2*)(c1 + 512 + lane * 4);
    const f32x4 q0 = {bflo(q0w[0]), bfhi(q0w[0]), bflo(q0w[1]), bfhi(q0w[1])}, q1 = {bflo(q1w[0]), bfhi(q1w[0]), bflo(q1w[1]), bfhi(q1w[1])},
                kv = {bflo(kvw[0]), bfhi(kvw[0]), bflo(kvw[1]), bfhi(kvw[1])};
    const float pe = bf2f(c1[768 + lane]);
    float sq = q0[0] * q0[0] + q0[1] * q0[1] + q0[2] * q0[2] + q0[3] * q0[3] + q1[0] * q1[0] + q1[1] * q1[1] + q1[2] * q1[2] + q1[3] * q1[3];
    float sk = kv[0] * kv[0] + kv[1] * kv[1] + kv[2] * kv[2] + kv[3] * kv[3];
    sq = wave_sum(sq); sk = wave_sum(sk);
    const float rq = rsqrtf(sq * (1.0f / QL) + EPS), rk = rsqrtf(sk * (1.0f / KVL) + EPS);
    bf16_t* cq = (bf16_t*)(ws + WS_CQ) + (size_t)r * QL; bf16_t* ckv = (bf16_t*)(ws + WS_CKV) + (size_t)r * KVL; bf16_t* kpe = (bf16_t*)(ws + WS_KPE) + (size_t)r * ROPE;
    if (MIX_F8) {
      unsigned char* cq8 = (unsigned char*)(ws + WS_CQ) + (size_t)r * QL; unsigned char* ckv8 = (unsigned char*)(ws + WS_CKV) + (size_t)r * KVL; const float sq8 = rq * F8_SA, sk8 = rk * F8_SA;
      { const f32x4 g = *(const f32x4*)(gq + lane * 4); *(unsigned*)(cq8 + lane * 4) = pack4_f8(q0[0] * sq8 * g[0], q0[1] * sq8 * g[1], q0[2] * sq8 * g[2], q0[3] * sq8 * g[3]); }
      { const f32x4 g = *(const f32x4*)(gq + 256 + lane * 4); *(unsigned*)(cq8 + 256 + lane * 4) = pack4_f8(q1[0] * sq8 * g[0], q1[1] * sq8 * g[1], q1[2] * sq8 * g[2], q1[3] * sq8 * g[3]); }
      { const f32x4 g = *(const f32x4*)(gkv + lane * 4); *(unsigned*)(ckv8 + lane * 4) = pack4_f8(kv[0] * sk8 * g[0], kv[1] * sk8 * g[1], kv[2] * sk8 * g[2], kv[3] * sk8 * g[3]); }
    } else {
    { const f32x4 g = *(const f32x4*)(gq + lane * 4); u32x2 w = {cvtpk(q0[0] * rq * g[0], q0[1] * rq * g[1]), cvtpk(q0[2] * rq * g[2], q0[3] * rq * g[3])}; *(u32x2*)(cq + lane * 4) = w; }
    { const f32x4 g = *(const f32x4*)(gq + 256 + lane * 4); u32x2 w = {cvtpk(q1[0] * rq * g[0], q1[1] * rq * g[1]), cvtpk(q1[2] * rq * g[2], q1[3] * rq * g[3])}; *(u32x2*)(cq + 256 + lane * 4) = w; }
    { const f32x4 g = *(const f32x4*)(gkv + lane * 4); u32x2 w = {cvtpk(kv[0] * rk * g[0], kv[1] * rk * g[1]), cvtpk(kv[2] * rk * g[2], kv[3] * rk * g[3])}; *(u32x2*)(ckv + lane * 4) = w; }
    }
    float outv = pe;
    const float other = __shfl_xor(pe, 16);
    if (!is_ctx) {
      const int s = ii - CTX; const float pos = (lane < 32) ? (float)(s >> 6) : (float)(s & 63);
      const float ang = pos * rope_invf(lane & 15, 16); const float cs = __cosf(ang), sn = __sinf(ang);
      outv = (lane & 16) ? (other * sn + pe * cs) : (pe * cs - other * sn);
    }
    kpe[lane] = (bf16_t)(cvtpk(outv, 0.f) & 0xffffu);
  }
}

__device__ __forceinline__ void phase_gqa_k(const Params& p) {
  int tid = threadIdx.x; asm volatile("" : "+v"(tid));
  const int wid = tid >> 6, lane = tid & 63;
  const int gw = blockIdx.x * 8 + wid, nw = gridDim.x * 8;
  char* ws = opaque_ptr(p.ws); const float* kg = p.in[I_GQA_KG];
  const int sub = lane & 7;
  for (int r = gw; r < R; r += nw) {
    const int b = r / RPB, ii = r - b * RPB; const bool is_ctx = ii < CTX;
    const bf16_t* kp = (const bf16_t*)(ws + WS_QKV) + (size_t)r * 4096 + 2048 + lane * 16;
    const u32x4 w0 = *(const u32x4*)kp, w1 = *(const u32x4*)(kp + 8);
    float v[16];
#pragma unroll
    for (int e = 0; e < 4; ++e) { v[2 * e] = bflo(w0[e]); v[2 * e + 1] = bfhi(w0[e]); v[8 + 2 * e] = bflo(w1[e]); v[9 + 2 * e] = bfhi(w1[e]); }
    float ss = 0.f;
#pragma unroll
    for (int e = 0; e < 16; ++e) ss += v[e] * v[e];
    ss += __shfl_xor(ss, 1); ss += __shfl_xor(ss, 2); ss += __shfl_xor(ss, 4);
    const float rs = rsqrtf(ss * (1.0f / GD) + EPS);
#pragma unroll
    for (int e = 0; e < 16; ++e) v[e] *= rs * kg[sub * 16 + e];
    float o[16];
#pragma unroll
    for (int e = 0; e < 16; ++e) o[e] = __shfl_xor(v[e], 2);
    if (!is_ctx) {
      const int s = ii - CTX; const float pos = (sub < 4) ? (float)(s >> 6) : (float)(s & 63);
#pragma unroll
      for (int e = 0; e < 16; ++e) { const int j = (sub & 1) * 16 + e; const float ang = pos * rope_invf(j, 32); const float cs = __cosf(ang), sn = __sinf(ang);
        v[e] = (sub & 2) ? (o[e] * sn + v[e] * cs) : (v[e] * cs - o[e] * sn); }
    }
    bf16_t* op = (bf16_t*)(ws + WS_KN) + (size_t)r * 1024 + lane * 16;
    u32x4 o0 = {cvtpk(v[0], v[1]), cvtpk(v[2], v[3]), cvtpk(v[4], v[5]), cvtpk(v[6], v[7])}, o1 = {cvtpk(v[8], v[9]), cvtpk(v[10], v[11]), cvtpk(v[12], v[13]), cvtpk(v[14], v[15])};
    *(u32x4*)op = o0; *(u32x4*)(op + 8) = o1;
  }
}

__device__ __forceinline__ void phase_conv_mid(const Params& p) {
  int tid = threadIdx.x; asm volatile("" : "+v"(tid));
  const int wid = tid >> 6, lane = tid & 63;
  const int gw = blockIdx.x * 8 + wid, nw = gridDim.x * 8;
  char* ws = opaque_ptr(p.ws); const float* cw = p.in[I_CONV_W];
  const bf16_t* bcu = (const bf16_t*)(ws + WS_BCU);
  for (int r = gw; r < R; r += nw) {
    const int b = r / RPB, ii = r - b * RPB; const bool is_ctx = ii < CTX;
    const bool hp = is_ctx ? (ii > 0) : (ii > CTX), hn = is_ctx ? (ii < CTX - 1) : (ii < RPB - 1);
    bf16_t* gp = (bf16_t*)(ws + WS_G) + (size_t)r * D;
#pragma unroll
    for (int q = 0; q < 4; ++q) {
      const int c = (lane + 64 * q) * 4;
      const bf16_t* row = bcu + (size_t)r * 3072 + c;
      const u32x2 bg = *(const u32x2*)row, c0 = *(const u32x2*)(row + 1024), u0 = *(const u32x2*)(row + 2048);
      u32x2 cp = {0u, 0u}, up = {0u, 0u}, cn = {0u, 0u}, un = {0u, 0u};
      if (hp) { cp = *(const u32x2*)(row - 3072 + 1024); up = *(const u32x2*)(row - 3072 + 2048); }
      if (hn) { cn = *(const u32x2*)(row + 3072 + 1024); un = *(const u32x2*)(row + 3072 + 2048); }
      const f32x4 w0 = *(const f32x4*)(cw + c), w1 = *(const f32x4*)(cw + D + c), w2 = *(const f32x4*)(cw + 2 * D + c);
      float z[4];
      z[0] = w0[0] * bflo(cp[0]) * bflo(up[0]) + w1[0] * bflo(c0[0]) * bflo(u0[0]) + w2[0] * bflo(cn[0]) * bflo(un[0]);
      z[1] = w0[1] * bfhi(cp[0]) * bfhi(up[0]) + w1[1] * bfhi(c0[0]) * bfhi(u0[0]) + w2[1] * bfhi(cn[0]) * bfhi(un[0]);
      z[2] = w0[2] * bflo(cp[1]) * bflo(up[1]) + w1[2] * bflo(c0[1]) * bflo(u0[1]) + w2[2] * bflo(cn[1]) * bflo(un[1]);
      z[3] = w0[3] * bfhi(cp[1]) * bfhi(up[1]) + w1[3] * bfhi(c0[1]) * bfhi(u0[1]) + w2[3] * bfhi(cn[1]) * bfhi(un[1]);
      u32x2 w = {cvtpk(bflo(bg[0]) * z[0], bfhi(bg[0]) * z[1]), cvtpk(bflo(bg[1]) * z[2], bfhi(bg[1]) * z[3])};
      *(u32x2*)(gp + c) = w;
    }
  }
}

constexpr int LI_OFF = 135168;
__device__ __forceinline__ void moe_prefix(const Params& p, int layer, int* li) {
  if (threadIdx.x == 0) { const int* cnt = (const int*)(p.ws + WS_CNT) + layer * ME; int o = 0, t = 0;
    for (int e = 0; e < ME; ++e) { li[e] = o; li[33 + e] = t; const int c = cnt[e]; o += c; t += (c + 127) >> 7; } li[32] = o; li[65] = t; }
  __syncthreads();
  { int t = threadIdx.x; asm volatile("" : "+v"(t));
    if (t < li[65]) { int e = 0;
#pragma unroll 1
      while (li[33 + e + 1] <= t) ++e;
      li[1024 + t] = e; } }
  __syncthreads();
}
struct MoeUnit { int e, ct, nvalid, slot0, lbase, ri0, ri1, par; };
template <bool DOWN>
struct MoeProv {
  char* ws; const int* li; const int* cnt; int layer; int* etab;
  typedef MoeUnit Unit;
  __device__ __forceinline__ bool unit(int it, Unit& U, int srow) const {
    const int un = blockIdx.x + it * gridDim.x;
    if (un >= li[65] * 4) return false;
    const int t = un >> 2, e = li[1024 + t];
    const int rt = t - li[33 + e];
    U.e = e; U.ct = un & 3; U.nvalid = min(128, cnt[e] - rt * 128); U.slot0 = li[e] + rt * 128; U.lbase = e * R + rt * 128;
    if (!DOWN) { const int* list = (const int*)(ws + WS_LIST) + U.lbase;
      U.ri0 = list[srow < U.nvalid ? srow : 0] >> 1; U.ri1 = list[srow + 64 < U.nvalid ? srow + 64 : 0] >> 1; }
    U.par = it % 3;
    if (DOWN) { int t_ = threadIdx.x; asm volatile("" : "+v"(t_));
      if (t_ < 128) { const int aid = ((const int*)(ws + WS_LIST))[U.lbase + (t_ < U.nvalid ? t_ : 0)];
        etab[(U.par * 128 + t_) * 2] = aid; etab[(U.par * 128 + t_) * 2 + 1] = __float_as_int(((const float*)(ws + WS_WTS))[aid]); } }
    return true;
  }
  static constexpr bool A_AFFINE = DOWN;
  static constexpr bool F8 = DOWN ? (MOE_F8 >= 2) : (MOE_F8 >= 1);
  static constexpr int KU = DOWN ? (F8 ? FF / 2 : FF) : (F8 ? D / 2 : D);
  __device__ __forceinline__ int a_stride(const Unit&) const { return 64 * KU; }
  __device__ __forceinline__ int b_stride(const Unit&) const { return 64 * KU; }
  __device__ __forceinline__ const bf16_t* a_row(const Unit& U, int r) const {
    if (DOWN) return (const bf16_t*)(ws + WS_HID) + (size_t)(U.slot0 + r) * KU;
    return (const bf16_t*)(ws + WS_ACT) + (size_t)(r < 64 ? U.ri0 : U.ri1) * KU;
  }
  __device__ __forceinline__ const bf16_t* b_row(const Unit& U, int r) const {
    const bf16_t* w = (const bf16_t*)(ws + WS_WMOE + (size_t)(layer * ME + U.e) * MOE_WBYTES);
    return (DOWN ? w + 1024 * 1024 : w) + (size_t)(U.ct * 256 + r) * KU;
  }
  __device__ __forceinline__ int nk(const Unit&) const { return KU / 64; }
  __device__ __forceinline__ void epi(const Unit& U, int r, int c, f32x4 v0, f32x4 v1, f32x4 v2, f32x4 v3) const {
    if (r >= U.nvalid) return;
    if (!DOWN) {
      if (F8) { constexpr float is = 1.0f / (F8_SA * F8_SW); v0 *= is; v1 *= is; v2 *= is; v3 *= is; }
      const float h0 = silu_f(v0[0]) * v0[1], h1 = silu_f(v0[2]) * v0[3], h2 = silu_f(v1[0]) * v1[1], h3 = silu_f(v1[2]) * v1[3],
                  h4 = silu_f(v2[0]) * v2[1], h5 = silu_f(v2[2]) * v2[3], h6 = silu_f(v3[0]) * v3[1], h7 = silu_f(v3[2]) * v3[3];
      if (MOE_F8 >= 2) {
        u32x2 o = {pack4_f8(h0 * F8_SH, h1 * F8_SH, h2 * F8_SH, h3 * F8_SH), pack4_f8(h4 * F8_SH, h5 * F8_SH, h6 * F8_SH, h7 * F8_SH)};
        *(u32x2*)((unsigned char*)(ws + WS_HID) + (size_t)(U.slot0 + r) * FF + ((U.ct * 256 + c) >> 1)) = o;
      } else {
        u32x4 o = {cvtpk(h0, h1), cvtpk(h2, h3), cvtpk(h4, h5), cvtpk(h6, h7)};
        *(u32x4*)((bf16_t*)(ws + WS_HID) + (size_t)(U.slot0 + r) * FF + ((U.ct * 256 + c) >> 1)) = o;
      }
    } else {
      const int aid = etab[(U.par * 128 + r) * 2]; float w = __int_as_float(etab[(U.par * 128 + r) * 2 + 1]);
      if (F8) w *= 1.0f / (F8_SH * F8_SWD);
      bf16_t* o = (bf16_t*)(ws + WS_Y) + (size_t)aid * D + U.ct * 256 + c;
      *(u32x4*)o = pack8(v0 * w, v1 * w); *(u32x4*)(o + 8) = pack8(v2 * w, v3 * w);
    }
  }
};
template <bool DOWN>
__device__ __forceinline__ void phase_moe(const Params& p, int layer, char* lds) {
  int* li = (int*)(lds + LI_OFF); moe_prefix(p, layer, li);
  char* ws = opaque_ptr(p.ws);
  MoeProv<DOWN> pv{ws, li, (const int*)(ws + WS_CNT) + layer * ME, layer, (int*)(lds + LI_OFF + 1024)};
  gemm_stream<8, MoeProv<DOWN>, 0, MoeProv<DOWN>::F8>(pv, lds);
}

__device__ __forceinline__ void phase_attn_mla(const Params& p, bool ctx_out, char* lds) {
  char* ws = opaque_ptr(p.ws);
  const bf16_t* Q = (const bf16_t*)(ws + WS_Q); const bf16_t* KV = (const bf16_t*)(ws + WS_KV); const bf16_t* KPE = (const bf16_t*)(ws + WS_KPE); bf16_t* O = (bf16_t*)(ws + WS_O);
  const int x = blockIdx.x & 7, nloc = gridDim.x >> 3, nlat = NB * MLA_H * 2  , nctx = ctx_out ? 4 : 0;
  for (int lu = (blockIdx.x >> 3); lu < nlat + nctx; lu += nloc) {
    int b, h, q0, nkeys; bool rope;
    if (lu < nlat) { const int pair = x * 4 + (lu >> 4), qb = lu & 15; b = pair / MLA_H; h = pair % MLA_H; q0 = CTX + qb * 256; nkeys = RPB; rope = true; }
    else { const int pair = x * 4 + (lu - nlat); b = pair / MLA_H; h = pair % MLA_H; q0 = 0; nkeys = CTX; rope = false; }
    const size_t rb = (size_t)b * RPB;
    attn_unit<192, 1536, 2048, 2048, 1024>(Q + (rb + q0) * 1536 + h * 192, KV + rb * 2048 + h * 256, KPE + rb * ROPE, KV + rb * 2048 + h * 256 + 128,
                   O + (rb + q0) * 1024 + h * 128, nkeys, rope, q0 - CTX, nullptr, lds);
  }
}
__device__ __forceinline__ void phase_attn_gqa(const Params& p, char* lds) {
  char* ws = opaque_ptr(p.ws);
  const bf16_t* QKV = (const bf16_t*)(ws + WS_QKV); const bf16_t* KN = (const bf16_t*)(ws + WS_KN); bf16_t* O = (bf16_t*)(ws + WS_OG);
  const int x = blockIdx.x & 7, nloc = gridDim.x >> 3, nlat = 128, nctx = 8;
  for (int lu = (blockIdx.x >> 3); lu < nlat + nctx; lu += nloc) {
    int b, h, q0, nkeys; bool rope;
    if (lu < nlat) { const int pair = x * 8 + (lu >> 4), qb = lu & 15; b = pair / GH; h = pair % GH; q0 = CTX + qb * 256; nkeys = RPB; rope = true; }
    else { const int pair = x * 8 + (lu - nlat); b = pair / GH; h = pair % GH; q0 = 0; nkeys = CTX; rope = false; }
    const size_t rb = (size_t)b * RPB; const int kvh = h >> 1;
    attn_unit<128, 4096, 1024, 4096, 2048>(QKV + (rb + q0) * 4096 + h * 128, KN + rb * 1024 + kvh * 128, nullptr, QKV + rb * 4096 + 3072 + kvh * 128,
                   O + (rb + q0) * 2048 + h * 128, nkeys, rope, q0 - CTX, p.in[I_GQA_QG], lds);
  }
}


__device__ __forceinline__ void dbg_probe(const Params& p) {
  char* ws = opaque_ptr(p.ws);
  size_t off = 0, n = 0; bool is_bf = true;
  switch (DBG_PROBE) {
    case 1: off = WS_MODV; n = (size_t)4 * 5 * NMOD; is_bf = false; break;
    case 2: off = WS_ACT; n = (size_t)R * D; break;
    case 3: off = WS_C1; n = (size_t)R * 1024; is_bf = false; break;
    case 4: off = WS_CQ; n = (size_t)R * 512; break;
    case 5: off = WS_CKV; n = (size_t)R * 256; break;
    case 6: off = WS_KPE; n = (size_t)R * 64; break;
    case 7: off = WS_Q; n = (size_t)R * 1536; break;
    case 8: off = WS_KV; n = (size_t)R * 2048; break;
    case 9: off = WS_O; n = (size_t)R * 1024; break;
    case 10: off = WS_X32; n = (size_t)R * D; is_bf = XBF16; break;
    case 11: off = WS_WMLA; n = MLA_WBYTES / 2; break;
    default: break;
  }
  int bad = 0;
  for (size_t i = (size_t)blockIdx.x * NTHR + threadIdx.x; i < n; i += (size_t)gridDim.x * NTHR) {
    float v = is_bf ? bf2f(((const bf16_t*)(ws + off))[i]) : ((const float*)(ws + off))[i];
    if (!(fabsf(v) < 1e30f)) bad = 1;
  }
  if (bad) atomicOr((int*)(ws + WS_CNT) + 1000, 1);
}

constexpr int DYN_LDS = 143360;
extern __shared__ __attribute__((aligned(16))) char smem[];

__global__ void __launch_bounds__(NTHR, 2) fwd_megakernel(Params p) {
  cg::grid_group grid = cg::this_grid();
  char* lds = smem;
#define WSO() char* ws = opaque_ptr(p.ws)
  volatile LAS unsigned* xst = (volatile LAS unsigned*)(LAS char*)(smem + DYN_LDS - 16);
  if (threadIdx.x == 0) { xst[0] = 0u; xst[1] = 0u; }
  __syncthreads();
  const XcdBarrier xb = xcd_barrier_post((unsigned*)(p.ws + WS_BAR), xst);
#if DBG_TIME
  unsigned long long tc_prep = 0, tc_norm = 0, tc_gemm = 0, tc_mid = 0, tc_amla = 0, tc_agqa = 0, tc_moe1 = 0, tc_moe2 = 0, tc_sync = 0, tA, tB, tC;
#define PH(cat, ...) do { tA = __builtin_amdgcn_s_memrealtime(); __VA_ARGS__; tB = __builtin_amdgcn_s_memrealtime(); xcd_barrier(xb); tC = __builtin_amdgcn_s_memrealtime(); \
    tc_##cat += tC - tA; tc_sync += tC - tB; } while (0)
#else
#define PH(cat, ...) do { __VA_ARGS__; xcd_barrier(xb); } while (0)
#endif
#define PHD(cat, id, ...) do { PH(cat, __VA_ARGS__); if (DUP == id) PH(cat, __VA_ARGS__); } while (0)
#define PHR(...) do { if (DUP == 15) { xres_t* const DRYP = (xres_t*)(p.ws + WS_Y); PH(gemm, __VA_ARGS__); } { xres_t* const DRYP = nullptr; PH(gemm, __VA_ARGS__); } } while (0)
#if DBG_TIME
  tA = __builtin_amdgcn_s_memrealtime();
#endif
#pragma unroll 1
  for (int rep_ = 0; rep_ < (DUP == 18 ? 2 : 1); ++rep_) {
  if (rep_ == 1) xcd_barrier(xb);
  if (DBG_PROBE == 20 && threadIdx.x == 0) ((int*)(p.ws + WS_CNT))[1024 + blockIdx.x] = (int)xb.x;
  phase_prep(p, lds);
  if (p.out == nullptr) grid.sync();
  xcd_barrier(xb);
#if DBG_TIME
  tc_prep += __builtin_amdgcn_s_memrealtime() - tA;
#endif
  if (DUP == 12) { xcd_barrier(xb); phase_prep(p, lds); xcd_barrier(xb); }
  if (DBG_PROBE == 20 && blockIdx.x == 0 && threadIdx.x == 0) { const int* t = (const int*)(p.ws + WS_CNT) + 1024; int bad = 0, seen = 0;
    for (int i = 0; i < (int)gridDim.x; ++i) { if (t[i] != t[i & 7]) bad = 1; }
    for (int i = 0; i < 8; ++i) seen |= 1 << t[i];
    if (bad || seen != 0xff) ((int*)(p.ws + WS_CNT))[1000] = 1; }
  PH(prep, phase_modfin(p));
  if (DUP == 14) { for (int q = 0; q < 40; ++q) xcd_barrier(xb); }
  if (STOP_AFTER == 0) { phase_norm<2, false>(p, 0); return; }
#pragma unroll 1
  for (int layer = 0; layer < DEPTH; ++layer) {
    const int kind = layer % 3, j = layer / 3; const bool ctx_out = layer < DEPTH - 1;
    if (DUP == 17 && layer > 0) PH(norm, phase_norm<0, true, true>(p, layer));
    PH(norm, if (layer == 0) phase_norm<0, false>(p, layer); else phase_norm<0, true>(p, layer));
    if (DUP == 13 && layer == 0) { for (int q = 0; q < 4; ++q) PH(norm, phase_norm<0, false>(p, layer)); }
    if (kind == 0) {
      PHD(gemm, 1, { WSO(); const char* wb = ws + WS_WMLA + j * MLA_WBYTES;
        if (MIX_F8) gemm_dense<17, 2, false, EpiBf16, 0, true>((const bf16_t*)(ws + WS_ACT), D / 2, (const bf16_t*)(wb + MLA_W1T), 1024, D / 2, EpiBf16{(bf16_t*)(ws + WS_C1), 1024, 1.0f / 512.0f}, lds);
        else gemm_dense<17, 2, false>((const bf16_t*)(ws + WS_ACT), D, (const bf16_t*)(wb + MLA_W1T), 1024, D, EpiBf16{(bf16_t*)(ws + WS_C1), 1024}, lds); });
      PHD(mid, 2, phase_mla_mid(p, j));
      PHD(gemm, 3, { WSO(); const char* wb = ws + WS_WMLA + j * MLA_WBYTES;
        MlaUpProv<(MIX_F8 != 0)> pv{(const bf16_t*)(ws + WS_CQ), (const bf16_t*)(ws + WS_CKV), (const bf16_t*)(wb + MLA_WUQT), (const bf16_t*)(wb + MLA_WUKVT), (bf16_t*)(ws + WS_Q), (bf16_t*)(ws + WS_KV)};
        gemm_stream<17, MlaUpProv<(MIX_F8 != 0)>, 0, (MIX_F8 != 0)>(pv, lds); });
      PHD(amla, 4, phase_attn_mla(p, ctx_out, lds));
      PHR({ WSO(); const char* wb = ws + WS_WMLA + j * MLA_WBYTES;
        const EpiResid er{(xres_t*)(ws + WS_X32), (const float*)(ws + WS_MODV) + (size_t)layer * 5 * NMOD + 2 * D, DRYP};
        if (ctx_out) gemm_dense<17, 2, false>((const bf16_t*)(ws + WS_O), 1024, (const bf16_t*)(wb + MLA_WOT), D, 1024, er, lds);
        else gemm_dense<16, 2, true>((const bf16_t*)(ws + WS_O), 1024, (const bf16_t*)(wb + MLA_WOT), D, 1024, er, lds); });
    } else if (kind == 1) {
      PHD(gemm, 5, { WSO(); gemm_dense<17, 2, false>((const bf16_t*)(ws + WS_ACT), D, (const bf16_t*)(ws + WS_WCONV_IN), 3072, D, EpiBf16{(bf16_t*)(ws + WS_BCU), 3072}, lds); });
      if (DUP == 21) PH(gemm, { WSO(); gemm_dense<17, 2, false, EpiBf16, 1>((const bf16_t*)(ws + WS_ACT), D, (const bf16_t*)(ws + WS_WCONV_IN), 3072, D, EpiBf16{(bf16_t*)(ws + WS_G + (size_t)R * 1024 * 2), 3072}, lds); });
      if (DUP == 22) PH(gemm, { WSO(); gemm_dense<17, 2, false, EpiBf16, 2>((const bf16_t*)(ws + WS_ACT), D, (const bf16_t*)(ws + WS_WCONV_IN), 3072, D, EpiBf16{(bf16_t*)(ws + WS_G + (size_t)R * 1024 * 2), 3072}, lds); });
      if (DUP == 23) PH(gemm, { WSO(); gemm_dense<17, 2, false, EpiBf16, 0>((const bf16_t*)(ws + WS_ACT), D, (const bf16_t*)(ws + WS_WCONV_IN), 3072, D, EpiBf16{(bf16_t*)(ws + WS_G + (size_t)R * 1024 * 2), 3072}, lds); });
      PHD(mid, 6, phase_conv_mid(p));
      PHR({ WSO(); gemm_dense<17, 2, false>((const bf16_t*)(ws + WS_G), D, (const bf16_t*)(ws + WS_WCONV_OUT), D, D,
                                EpiResid{(xres_t*)(ws + WS_X32), (const float*)(ws + WS_MODV) + (size_t)layer * 5 * NMOD + 2 * D, DRYP}, lds); });
    } else {
      PHD(gemm, 7, { WSO(); if (MIX_F8) gemm_dense<17, 2, false, EpiBf16, 0, true>((const bf16_t*)(ws + WS_ACT), D / 2, (const bf16_t*)(ws + WS_WGQA_QKV), 4096, D / 2, EpiBf16{(bf16_t*)(ws + WS_QKV), 4096, 1.0f / 512.0f}, lds);
        else gemm_dense<17, 2, false>((const bf16_t*)(ws + WS_ACT), D, (const bf16_t*)(ws + WS_WGQA_QKV), 4096, D, EpiBf16{(bf16_t*)(ws + WS_QKV), 4096}, lds); });
      PHD(mid, 8, phase_gqa_k(p));
      PHD(agqa, 9, phase_attn_gqa(p, lds));
      PHR({ WSO(); gemm_dense<17, 2, false>((const bf16_t*)(ws + WS_OG), 2048, (const bf16_t*)(ws + WS_WGQA_O), D, 2048,
                                EpiResid{(xres_t*)(ws + WS_X32), (const float*)(ws + WS_MODV) + (size_t)layer * 5 * NMOD + 2 * D, DRYP}, lds); });
    }
    if (STOP_AFTER == 2 * layer + 1) { if (DBG_PROBE) { dbg_probe(p); xcd_barrier(xb); } phase_norm<2, false>(p, 0); return; }
    if (DUP == 16) PH(norm, phase_norm<1, false, true>(p, layer));
    PH(norm, { if (MOE_JIT) phase_conv_moe(p, layer, lds); phase_norm<1, false>(p, layer); });
    PHD(moe1, 10, phase_moe<false>(p, layer, lds));
    PHD(moe2, 11, phase_moe<true>(p, layer, lds));
    if (STOP_AFTER == 2 * layer + 2) break;
  }
  }
#if DBG_TIME
  if (blockIdx.x == 0 && threadIdx.x == 0) {
    unsigned long long* d = (unsigned long long*)(p.ws + WS_CNT + 4096);
    d[0] = tc_prep; d[1] = tc_norm; d[2] = tc_gemm; d[3] = tc_mid; d[4] = tc_amla; d[5] = tc_agqa; d[6] = tc_moe1; d[7] = tc_moe2; d[8] = tc_sync;
  }
  xcd_barrier(xb);
#endif
  phase_norm<2, true>(p, 0);
}

extern "C" void kernel_launch(void* const* d_in, const int* in_sizes, int n_in, void* d_out, int out_size, void* d_ws, size_t ws_size,
                              hipStream_t stream) {
  static int grid_blocks = 0;
  if (!grid_blocks) {
    int dev = 0, cus = 0, per_cu = 0;
    (void)hipGetDevice(&dev);
    (void)hipDeviceGetAttribute(&cus, hipDeviceAttributeMultiprocessorCount, dev);
    (void)hipFuncSetAttribute((const void*)fwd_megakernel, hipFuncAttributeMaxDynamicSharedMemorySize, DYN_LDS);
    (void)hipOccupancyMaxActiveBlocksPerMultiprocessor(&per_cu, fwd_megakernel, NTHR, DYN_LDS);
    grid_blocks = per_cu >= 1 ? cus : 0;
    if (ws_size < WS_END || n_in != N_IN) { fprintf(stderr, "kernel_launch: ws %zu < %zu or n_in %d\n", ws_size, (size_t)WS_END, n_in); grid_blocks = 0; }
    if (!grid_blocks) { fprintf(stderr, "kernel_launch: cannot launch (per_cu %d)\n", per_cu); return; }
  }
  Params p{};
  for (int i = 0; i < N_IN; ++i) p.in[i] = (const float*)d_in[i];
  p.out = (float*)d_out; p.ws = (char*)d_ws;
  {
    char* ws = p.ws; int nj = 0;
    for (int j = 0; j < 2; ++j) {
      char* wb = ws + WS_WMLA + j * MLA_WBYTES;
      p.jobs[nj++] = TJob{p.in[I_MLA_WDQ] + (size_t)j * D * QL, (bf16_t*)(wb + MLA_W1T), D, QL, MIX_F8 ? 8 : 1, 0};
      p.jobs[nj++] = TJob{p.in[I_MLA_WDKV] + (size_t)j * D * 320, (bf16_t*)(wb + MLA_W1T), D, 320, MIX_F8 ? 8 : 1, 512};
      p.jobs[nj++] = TJob{p.in[I_MLA_WUQ] + (size_t)j * QL * 1536, (bf16_t*)(wb + MLA_WUQT), QL, 1536, MIX_F8 ? 8 : 1, 0};
      p.jobs[nj++] = TJob{p.in[I_MLA_WUKV] + (size_t)j * KVL * 2048, (bf16_t*)(wb + MLA_WUKVT), KVL, 2048, MIX_F8 ? 8 : 1, 0};
      p.jobs[nj++] = TJob{p.in[I_MLA_WO] + (size_t)j * 1024 * D, (bf16_t*)(wb + MLA_WOT), 1024, D, 1, 0};
    }
    p.jobs[nj++] = TJob{p.in[I_CONV_WIN], (bf16_t*)(ws + WS_WCONV_IN), D, 3072, 1, 0};
    p.jobs[nj++] = TJob{p.in[I_CONV_WOUT], (bf16_t*)(ws + WS_WCONV_OUT), D, D, 1, 0};
    p.jobs[nj++] = TJob{p.in[I_GQA_WQKV], (bf16_t*)(ws + WS_WGQA_QKV), D, 4096, MIX_F8 ? 8 : 1, 0};
    p.jobs[nj++] = TJob{p.in[I_GQA_WO], (bf16_t*)(ws + WS_WGQA_O), 2048, D, 1, 0};
  }
  (void)hipMemsetAsync((char*)d_ws + WS_BAR, 0, XCD_BAR_WORDS * 4, stream);
  void* args[] = {&p};
  hipError_t e = hipLaunchCooperativeKernel((void*)fwd_megakernel, dim3(grid_blocks), dim3(NTHR), args, DYN_LDS, stream);
  if (e != hipSuccess) fprintf(stderr, "cooperative launch failed: %s (grid %d)\n", hipGetErrorString(e), grid_blocks);
}
```

```cpp
#include <hip/hip_runtime.h>
#include <hip/hip_cooperative_groups.h>
#include <cstdio>
#include <cstdint>
namespace cg = cooperative_groups;

#ifndef DUP
#define DUP 0
#endif
#ifndef DBG_TIME
#define DBG_TIME 0
#endif
#ifndef DBG_T1
#define DBG_T1 0
#define DBG_T2 1
#endif
#ifndef DBG_PROBE
#define DBG_PROBE 0
#endif
#ifndef STOP_AFTER
#define STOP_AFTER 8
#endif

#ifndef QK_F8
#define QK_F8 1
#endif
#ifndef WO_F8
#define WO_F8 1
#endif
#ifndef MIX_F8
#define MIX_F8 1
#endif
#ifndef MOE_F8
#define MOE_F8 2
#endif
constexpr float F8_SO = 64.0f;
constexpr float F8_SQK = 16.0f;
#define LAS __attribute__((address_space(3)))
typedef unsigned short bf16_t;
typedef short bf16x8 __attribute__((ext_vector_type(8)));
typedef short s16x4 __attribute__((ext_vector_type(4)));
typedef float f32x4 __attribute__((ext_vector_type(4)));
typedef float f32x16 __attribute__((ext_vector_type(16)));
typedef unsigned u32x4 __attribute__((ext_vector_type(4)));
typedef unsigned u32x2 __attribute__((ext_vector_type(2)));
typedef int i32x8 __attribute__((ext_vector_type(8)));

constexpr int D = 1024, NB = 4, SEQ = 4096, CTX = 256, RPB = SEQ + CTX, R = NB * RPB;
constexpr int DEPTH = 4, NMOD = 6 * D;
constexpr int MLA_H = 8, QL = 512, KVL = 256, NOPE = 128, ROPE = 64, MV = 128;
constexpr int GH = 16, GKV = 8, GD = 128;
constexpr int ME = 32, FF = 512;
constexpr float EPS = 1e-6f;
constexpr int NTHR = 512;

enum { I_X = 0, I_C, I_CTX, I_CCTX, I_WMOD, I_BMOD, I_NMG, I_NFG, I_MLA_WDQ, I_MLA_GQ, I_MLA_WUQ, I_MLA_WDKV, I_MLA_GKV, I_MLA_WUKV, I_MLA_WO,
       I_CONV_WIN, I_CONV_W, I_CONV_WOUT, I_GQA_WQKV, I_GQA_QG, I_GQA_KG, I_GQA_WO, I_MOE_WG, I_MOE_BG, I_MOE_WE, I_MOE_BE, I_MOE_GATE, I_MOE_UP, I_MOE_DOWN, I_FG, N_IN };

constexpr size_t al256(size_t x) { return (x + 255) / 256 * 256; }
constexpr size_t WS_BAR = 0;
constexpr size_t WS_CNT = 16384;
constexpr size_t WS_MODP = 16384 + 8192;
constexpr size_t WS_MODV = WS_MODP + (size_t)8 * 4 * 5 * NMOD * 4;
constexpr size_t WS_WTS = WS_MODV + (size_t)4 * 5 * NMOD * 4;
constexpr size_t WS_LIST = al256(WS_WTS + (size_t)2 * R * 4);
#ifndef XBF16
#define XBF16 1
#endif
constexpr size_t WS_X32 = al256(WS_LIST + (size_t)32 * R * 4);
constexpr size_t WS_ACT = WS_X32 + (size_t)R * D * (XBF16 ? 2 : 4);
constexpr size_t WS_HID = WS_ACT + (size_t)R * D * 2;
constexpr size_t WS_Y = WS_HID + (size_t)(2 * R + 256) * FF * 2;
constexpr size_t WS_MIX = WS_Y + (size_t)2 * R * D * 2;
constexpr size_t MIX_BYTES = (size_t)R * (1024 * 4 + 512 * 2 + 256 * 2 + 64 * 2 + 1536 * 2 + 2048 * 2 + 1024 * 2);
constexpr size_t WS_C1 = WS_MIX;
constexpr size_t WS_K8 = WS_C1 + (size_t)R * 2048;
constexpr size_t WS_KPE8 = WS_K8 + (size_t)R * 1024;
constexpr size_t WS_CQ = WS_C1 + (size_t)R * 1024 * 4;
constexpr size_t WS_CKV = WS_CQ + (size_t)R * 512 * 2;
constexpr size_t WS_KPE = WS_CKV + (size_t)R * 256 * 2;
constexpr size_t WS_Q = WS_KPE + (size_t)R * 64 * 2;
constexpr size_t WS_KV = WS_Q + (size_t)R * 1536 * 2;
constexpr size_t WS_O = WS_KV + (size_t)R * 2048 * 2;
constexpr size_t WS_QKV = WS_MIX;
constexpr size_t WS_KN = WS_QKV + (size_t)R * 4096 * 2;
constexpr size_t WS_OG = WS_KN + (size_t)R * 1024 * 2;
constexpr size_t WS_BCU = WS_MIX;
constexpr size_t WS_G = WS_BCU + (size_t)R * 3072 * 2;
static_assert(WS_OG + (size_t)R * 2048 * 2 <= WS_MIX + MIX_BYTES, "gqa scratch");
static_assert(WS_G + (size_t)R * 1024 * 2 <= WS_MIX + MIX_BYTES, "conv scratch");
constexpr size_t WS_WT = al256(WS_MIX + MIX_BYTES);
constexpr size_t MLA_W1T = 0, MLA_WUQT = MLA_W1T + (size_t)1024 * 1024 * 2, MLA_WUKVT = MLA_WUQT + (size_t)1536 * 512 * 2, MLA_WOT = MLA_WUKVT + (size_t)2048 * 256 * 2,
                 MLA_WBYTES = MLA_WOT + (size_t)1024 * 1024 * 2;
constexpr size_t WS_WMLA = WS_WT;
constexpr size_t WS_WCONV_IN = WS_WMLA + 2 * MLA_WBYTES;
constexpr size_t WS_WCONV_OUT = WS_WCONV_IN + (size_t)3072 * 1024 * 2;
constexpr size_t WS_WGQA_QKV = WS_WCONV_OUT + (size_t)1024 * 1024 * 2;
constexpr size_t WS_WGQA_O = WS_WGQA_QKV + (size_t)4096 * 1024 * 2;
constexpr size_t WS_WMOE = WS_WGQA_O + (size_t)1024 * 2048 * 2;
constexpr size_t MOE_WBYTES = (size_t)1024 * 1024 * 2 + (size_t)1024 * 512 * 2;
constexpr size_t WS_END = WS_WMOE + (size_t)DEPTH * ME * MOE_WBYTES;
static_assert(WS_END <= (size_t)1073741824, "workspace over 1 GiB");

struct TJob { const float* src; bf16_t* dst; int K, N, rmul, roff; };
struct Params {
  const float* in[N_IN];
  float* out;
  char* ws;
  TJob jobs[14];
};

typedef __bf16 bf16x2_t __attribute__((ext_vector_type(2)));
__device__ __forceinline__ unsigned cvtpk(float lo, float hi) { bf16x2_t v = {(__bf16)lo, (__bf16)hi}; return __builtin_bit_cast(unsigned, v); }
__device__ __forceinline__ unsigned pack4_f8(float a, float b, float c, float d) {
  int w = __builtin_amdgcn_cvt_pk_fp8_f32(fminf(fmaxf(a, -448.f), 448.f), fminf(fmaxf(b, -448.f), 448.f), 0, false);
  w = __builtin_amdgcn_cvt_pk_fp8_f32(fminf(fmaxf(c, -448.f), 448.f), fminf(fmaxf(d, -448.f), 448.f), w, true); return (unsigned)w; }
__device__ __forceinline__ float bf2f(unsigned short h) { return __uint_as_float((unsigned)h << 16); }
__device__ __forceinline__ float bflo(unsigned w) { return __uint_as_float(w << 16); }
__device__ __forceinline__ float bfhi(unsigned w) { return __uint_as_float(w & 0xffff0000u); }
#if XBF16
typedef bf16_t xres_t;
__device__ __forceinline__ f32x4 xload4(const xres_t* q) { const u32x2 w = *(const u32x2*)q; return (f32x4){bflo(w[0]), bfhi(w[0]), bflo(w[1]), bfhi(w[1])}; }
__device__ __forceinline__ void xstore4(xres_t* q, f32x4 v) { u32x2 w = {cvtpk(v[0], v[1]), cvtpk(v[2], v[3])}; *(u32x2*)q = w; }
#else
typedef float xres_t;
__device__ __forceinline__ f32x4 xload4(const xres_t* q) { return *(const f32x4*)q; }
__device__ __forceinline__ void xstore4(xres_t* q, f32x4 v) { *(f32x4*)q = v; }
#endif
__device__ __forceinline__ float wave_sum(float v) {
#pragma unroll
  for (int o = 32; o > 0; o >>= 1) v += __shfl_xor(v, o);
  return v;
}
__device__ __forceinline__ float silu_f(float x) { return x / (1.0f + __expf(-x)); }
__device__ __forceinline__ void glds16(const void* g, char* l) { __builtin_amdgcn_global_load_lds((const unsigned*)g, (LAS unsigned*)l, 16, 0, 0); }
__device__ __forceinline__ char* opaque_ptr(char* q) {
  unsigned lo = __builtin_amdgcn_readfirstlane((unsigned)(uintptr_t)q), hi = __builtin_amdgcn_readfirstlane((unsigned)((uintptr_t)q >> 32));
  asm volatile("" : "+s"(lo), "+s"(hi));
  return (char*)(((uintptr_t)hi << 32) | (uintptr_t)lo); }
__device__ __forceinline__ float rope_invf(int j, int half) { return exp2f(-(float)j * (13.287712379549449f / (float)half)); }


#define XB_TMO      128
#define XB_XCNT(j)  (256  + 64 * (j))
#define XB_XSUB(j)  (1280 + 64 * (j))
#define XB_XGEN(j)  (2304 + 64 * (j))
#define XB_TOP      3328
#define XB_TOPGEN   3392
#define XCD_BAR_WORDS 3456
#define XB_SPIN_CAP (1u << 22)
__device__ __forceinline__ unsigned xb_ld(unsigned* p)              { return __hip_atomic_load(p, __ATOMIC_RELAXED, __HIP_MEMORY_SCOPE_AGENT); }
__device__ __forceinline__ unsigned xb_add(unsigned* p, unsigned v) { return __hip_atomic_fetch_add(p, v, __ATOMIC_RELAXED, __HIP_MEMORY_SCOPE_AGENT); }
__device__ __forceinline__ unsigned xb_xcc_id() { return (unsigned)__builtin_amdgcn_s_getreg((3 << 11) | 20) & 0xFu; }
#define XB_SPIN(cond, bar) do { unsigned _sp = 0; while (cond) { __builtin_amdgcn_s_sleep(1); \
    if ((++_sp & 255u) == 0u) { if (xb_ld(&(bar)[XB_TMO])) break; if (_sp > XB_SPIN_CAP) { atomicAdd(&(bar)[XB_TMO], 1u); break; } } } } while (0)
struct XcdBarrier { unsigned* bar; unsigned x; volatile LAS unsigned* st; };
__device__ __forceinline__ XcdBarrier xcd_barrier_post(unsigned* bar, volatile LAS unsigned* st) {
  XcdBarrier b; b.bar = bar; b.x = xb_xcc_id(); b.st = st;
  if (threadIdx.x == 0) (void)xb_add(&bar[XB_XCNT(b.x)], 1u);
  return b;
}
__device__ __forceinline__ void xcd_barrier_complete(unsigned* bar, unsigned x, unsigned& nloc, unsigned& nx) {
  const unsigned G = gridDim.x * gridDim.y * gridDim.z;
  unsigned sum, cnt, mine, sp = 0u;
  for (;;) {
    sum = 0u; cnt = 0u; mine = 0u;
#pragma unroll
    for (unsigned j = 0; j < 16; ++j) { const unsigned c = xb_ld(&bar[XB_XCNT(j)]); sum += c; cnt += (c > 0u) ? 1u : 0u; mine = (j == x) ? c : mine; }
    if (sum == G) break;
    __builtin_amdgcn_s_sleep(1);
    if ((++sp & 255u) == 0u) { if (xb_ld(&bar[XB_TMO])) break; if (sp > XB_SPIN_CAP) { atomicAdd(&bar[XB_TMO], 1u); break; } }
  }
  nloc = mine > 0u ? mine : 1u; nx = cnt > 0u ? cnt : 1u;
}
__device__ __forceinline__ void xcd_barrier(const XcdBarrier& b) {
  asm volatile("s_waitcnt vmcnt(0)" ::: "memory");
  __syncthreads();
  if (threadIdx.x == 0) {
    unsigned* bar = b.bar;
    __builtin_amdgcn_s_waitcnt(0);
    unsigned nloc = b.st[0], nx = b.st[1];
    if (nloc == 0u) { xcd_barrier_complete(bar, b.x, nloc, nx); b.st[0] = nloc; b.st[1] = nx; }
    const unsigned old = xb_add(&bar[XB_XSUB(b.x)], 1u);
    const unsigned gen = old / nloc;
    if (old + 1u == (gen + 1u) * nloc) {
      __builtin_amdgcn_fence(__ATOMIC_RELEASE, "agent");
      asm volatile("s_waitcnt vmcnt(0)" ::: "memory");
      const unsigned og = xb_add(&bar[XB_TOP], 1u);
      const unsigned tg = og / nx;
      if (og + 1u == (tg + 1u) * nx) xb_add(&bar[XB_TOPGEN], 1u);
      else XB_SPIN(xb_ld(&bar[XB_TOPGEN]) == tg, bar);
      __builtin_amdgcn_fence(__ATOMIC_ACQUIRE, "agent");
      xb_add(&bar[XB_XGEN(b.x)], 1u);
      asm volatile("s_waitcnt vmcnt(0)" ::: "memory");
    } else {
      XB_SPIN(xb_ld(&bar[XB_XGEN(b.x)]) == gen, bar);
      __builtin_amdgcn_fence(__ATOMIC_ACQUIRE, "agent");
      asm volatile("s_waitcnt vmcnt(0)" ::: "memory");
    }
  }
  __syncthreads();
}

template <int MB, class Prov, int GMODE = 0, bool F8 = false>
__device__ __forceinline__ void gemm_stream(const Prov& pv, char* lds) {
  constexpr int BM = MB * 16, BN = 256, A_BYTES = BM * 128, STAGE = (BM + BN) * 128, AR = (BM + 63) / 64, BR = BN / 64, MB0 = (MB + 1) / 2, NW = 4;
  static_assert(2 * STAGE <= 135168, "GEMM LDS stages");
  int tid = threadIdx.x; asm volatile("" : "+v"(tid));
  const int wid = tid >> 6, lane = tid & 63, fr = lane & 15, fq = lane >> 4, wm = wid >> 2, wn = wid & 3;
  const int srow = tid >> 3, pc = tid & 7, lc = pc ^ (srow & 7);
  const int lds_base = (int)(uintptr_t)(LAS char*)lds;
  const int a_off = lds_base + (wm * MB0 * 16 + fr) * 128, b_off = lds_base + A_BYTES + (wn * 64 + fr) * 128;
  const int ch0 = (fq ^ (fr & 7)) * 16, ch1 = ((4 + fq) ^ (fr & 7)) * 16;
  const int bsrc = 16 * ((srow >> 2) & 3) + 4 * (srow >> 4) + (srow & 3);
  const bool lastm = (MB % 2 == 0) || wm == 0;
  typename Prov::Unit u, un;
  int it = 0;
  if (!pv.unit(it, u, srow)) return;
  constexpr int APN = Prov::A_AFFINE ? 1 : AR;
  const bf16_t* ap[APN]; const bf16_t* bp0; int astr = 0, bstr = 0;
#define GS_LOADPTR(U) do { _Pragma("unroll") for (int i = 0; i < APN; ++i) ap[i] = pv.a_row(U, srow + 64 * i) + lc * 8; \
    bp0 = pv.b_row(U, bsrc) + lc * 8; astr = pv.a_stride(U); bstr = pv.b_stride(U); } while (0)
#define GS_ISSUE(KO, BUF) do { char* base_ = lds + (BUF) * STAGE; \
    _Pragma("unroll") for (int i = 0; i < AR; ++i) if (AR * 64 == BM || srow + 64 * i < BM) glds16((Prov::A_AFFINE ? ap[0] + (size_t)i * astr : ap[i < APN ? i : 0]) + (KO), base_ + i * 8192 + tid * 16); \
    _Pragma("unroll") for (int i = 0; i < BR; ++i) glds16(bp0 + (size_t)i * bstr + (KO), base_ + A_BYTES + i * 8192 + tid * 16); } while (0)
#define GS_DSR(dst, addr) asm volatile("ds_read_b128 %0, %1" : "=v"(dst) : "v"(addr) : "memory")
  GS_LOADPTR(u); GS_ISSUE(0, 0);
  int buf = 0;
  for (;;) {
    const bool have_n = pv.unit(it + 1, un, srow);
    const int nk = pv.nk(u);
    f32x4 acc[MB0][NW];
#pragma unroll
    for (int m = 0; m < MB0; ++m)
#pragma unroll
      for (int n = 0; n < NW; ++n) acc[m][n] = (f32x4){0.f, 0.f, 0.f, 0.f};
#pragma unroll 1
    for (int kt = 0; kt < nk; ++kt) {
      asm volatile("s_waitcnt vmcnt(0)" ::: "memory");
      __syncthreads();
      if (GMODE != 2) { if (kt + 1 < nk) { GS_ISSUE((kt + 1) * 64, buf ^ 1); }
      else if (have_n) { GS_LOADPTR(un); GS_ISSUE(0, buf ^ 1); } }
      if (GMODE != 1 && F8) {
        constexpr int GS = MB0 > 4 ? 1 : 2, NG = (MB0 + GS - 1) / GS;
        const int sbo = buf * STAGE;
        const int cl = ((2 * fq) ^ (fr & 7)) * 16, chh = ((2 * fq + 1) ^ (fr & 7)) * 16;
        const int aaL = sbo + a_off + cl, aaH = sbo + a_off + chh, bbL = sbo + b_off + cl, bbH = sbo + b_off + chh;
        u32x4 fbl[NW], fbh[NW], fal[2][GS], fah[2][GS];
#define GS_DSR8(dst, addr) asm volatile("ds_read_b128 %0, %1" : "=v"(dst) : "v"(addr) : "memory")
#pragma unroll
        for (int n = 0; n < NW; ++n) { GS_DSR8(fbl[n], bbL + n * 2048); GS_DSR8(fbh[n], bbH + n * 2048); }
#pragma unroll
        for (int j = 0; j < GS; ++j) if (j < MB0) { GS_DSR8(fal[0][j], aaL + j * 2048); GS_DSR8(fah[0][j], aaH + j * 2048); }
#pragma unroll
        for (int g = 0; g < NG; ++g) {
          int nnext = 0;
          if (g + 1 < NG) {
#pragma unroll
            for (int j = 0; j < GS; ++j) { const int i = (g + 1) * GS + j; if (i < MB0) { GS_DSR8(fal[(g + 1) & 1][j], aaL + i * 2048); GS_DSR8(fah[(g + 1) & 1][j], aaH + i * 2048); nnext += 2; } }
          }
          if (nnext == 4) asm volatile("s_waitcnt lgkmcnt(4)" ::: "memory"); else if (nnext == 2) asm volatile("s_waitcnt lgkmcnt(2)" ::: "memory");
          else asm volatile("s_waitcnt lgkmcnt(0)" ::: "memory");
          __builtin_amdgcn_sched_barrier(0);
#pragma unroll
          for (int j = 0; j < GS; ++j) { const int m = g * GS + j;
            if (m < MB0 && (m < MB0 - 1 || lastm)) {
              const i32x8 av = {(int)fal[g & 1][j][0], (int)fal[g & 1][j][1], (int)fal[g & 1][j][2], (int)fal[g & 1][j][3], (int)fah[g & 1][j][0], (int)fah[g & 1][j][1], (int)fah[g & 1][j][2], (int)fah[g & 1][j][3]};
#pragma unroll
              for (int n = 0; n < NW; ++n) { const i32x8 bv = {(int)fbl[n][0], (int)fbl[n][1], (int)fbl[n][2], (int)fbl[n][3], (int)fbh[n][0], (int)fbh[n][1], (int)fbh[n][2], (int)fbh[n][3]};
                acc[m][n] = __builtin_amdgcn_mfma_scale_f32_16x16x128_f8f6f4(bv, av, acc[m][n], 0, 0, 0, 0x7f7f7f7f, 0, 0x7f7f7f7f); }
#pragma unroll
              for (int n = 0; n < NW; ++n) asm volatile("" : "+v"(acc[m][n]));
            } }
          __builtin_amdgcn_sched_barrier(0);
        }
#undef GS_DSR8
      }
      if (GMODE != 1 && !F8) {
        constexpr int NI = 2 * MB0, GS = 2, NG = (NI + GS - 1) / GS;
        const int sbo = buf * STAGE;
        const int aa0 = sbo + a_off + ch0, aa1 = sbo + a_off + ch1, bb0 = sbo + b_off + ch0, bb1 = sbo + b_off + ch1;
        bf16x8 fb[2][NW], fa[2][GS];
#pragma unroll
        for (int n = 0; n < NW; ++n) GS_DSR(fb[0][n], bb0 + n * 2048);
#pragma unroll
        for (int j = 0; j < GS; ++j) GS_DSR(fa[0][j], aa0 + j * 2048);
#pragma unroll
        for (int n = 0; n < NW; ++n) GS_DSR(fb[1][n], bb1 + n * 2048);
#pragma unroll
        for (int g = 0; g < NG; ++g) {
          int nnext = 0;
          if (g + 1 < NG) {
#pragma unroll
            for (int j = 0; j < GS; ++j) { const int i = (g + 1) * GS + j; if (i < NI) { GS_DSR(fa[(g + 1) & 1][j], (i / MB0 ? aa1 : aa0) + (i % MB0) * 2048); ++nnext; } }
          }
          if (g == 0) nnext += NW;
          if (nnext == 8) asm volatile("s_waitcnt lgkmcnt(8)" ::: "memory"); else if (nnext == 7) asm volatile("s_waitcnt lgkmcnt(7)" ::: "memory");
          else if (nnext == 6) asm volatile("s_waitcnt lgkmcnt(6)" ::: "memory"); else if (nnext == 5) asm volatile("s_waitcnt lgkmcnt(5)" ::: "memory");
          else if (nnext == 4) asm volatile("s_waitcnt lgkmcnt(4)" ::: "memory"); else if (nnext == 3) asm volatile("s_waitcnt lgkmcnt(3)" ::: "memory");
          else if (nnext == 2) asm volatile("s_waitcnt lgkmcnt(2)" ::: "memory"); else if (nnext == 1) asm volatile("s_waitcnt lgkmcnt(1)" ::: "memory");
          else asm volatile("s_waitcnt lgkmcnt(0)" ::: "memory");
          __builtin_amdgcn_sched_barrier(0);
#pragma unroll
          for (int j = 0; j < GS; ++j) { const int i = g * GS + j;
            if (i < NI) { const int m = i % MB0;
              if (m < MB0 - 1 || lastm) {
#pragma unroll
                for (int n = 0; n < NW; ++n) acc[m][n] = __builtin_amdgcn_mfma_f32_16x16x32_bf16(fb[i / MB0][n], fa[g & 1][j], acc[m][n], 0, 0, 0);
              } } }
          __builtin_amdgcn_sched_barrier(0);
        }
      }
      buf ^= 1;
    }
#pragma unroll
    for (int m = 0; m < MB0; ++m) if (m < MB0 - 1 || lastm) {
      pv.epi(u, (wm * MB0 + m) * 16 + fr, wn * 64 + fq * 16, acc[m][0], acc[m][1], acc[m][2], acc[m][3]);
    }
    if (!have_n) break;
    u = un; ++it;
  }
  __syncthreads();
#undef GS_LOADPTR
#undef GS_ISSUE
#undef GS_DSR
}

__device__ __forceinline__ u32x4 pack8(f32x4 a, f32x4 b) { return (u32x4){cvtpk(a[0], a[1]), cvtpk(a[2], a[3]), cvtpk(b[0], b[1]), cvtpk(b[2], b[3])}; }
struct EpiBf16 { bf16_t* C; int ldc; float sc = 1.0f; __device__ __forceinline__ void operator()(int r, int c, f32x4 v0, f32x4 v1, f32x4 v2, f32x4 v3) const {
  bf16_t* o = C + (size_t)r * ldc + c; *(u32x4*)o = pack8(v0 * sc, v1 * sc); *(u32x4*)(o + 8) = pack8(v2 * sc, v3 * sc); } };
struct EpiResid { xres_t* X; const float* gate; xres_t* dry; float sc = 1.0f;
  __device__ __forceinline__ void half8(int row, int c, int bsel, f32x4 v0, f32x4 v1) const {
    const f32x4 g0 = *(const f32x4*)(gate + (size_t)bsel * NMOD + c), g1 = *(const f32x4*)(gate + (size_t)bsel * NMOD + c + 4);
#if XBF16
    const u32x4 xw = *(const u32x4*)(X + (size_t)row * D + c);
    f32x4 x0 = {bflo(xw[0]), bfhi(xw[0]), bflo(xw[1]), bfhi(xw[1])}, x1 = {bflo(xw[2]), bfhi(xw[2]), bflo(xw[3]), bfhi(xw[3])};
    x0 += g0 * v0; x1 += g1 * v1;
    *(u32x4*)((dry ? dry : X) + (size_t)row * D + c) = pack8(x0, x1);
#else
    f32x4 x0 = xload4(X + (size_t)row * D + c), x1 = xload4(X + (size_t)row * D + c + 4); x0 += g0 * v0; x1 += g1 * v1;
    xstore4((dry ? dry : X) + (size_t)row * D + c, x0); xstore4((dry ? dry : X) + (size_t)row * D + c + 4, x1);
#endif
  }
  __device__ __forceinline__ void operator()(int row, int c, f32x4 v0, f32x4 v1, f32x4 v2, f32x4 v3) const {
    const int b = row / RPB, ii = row - b * RPB, bsel = ii < CTX ? 4 : b;
    half8(row, c, bsel, v0 * sc, v1 * sc); half8(row, c + 8, bsel, v2 * sc, v3 * sc); } };

template <int BM, int BN, bool LATONLY, class Epi>
struct DenseProv {
  const bf16_t* A; int lda; const bf16_t* Bt; int K; int nNt; Epi ep;
  struct Unit { int m0, n0; };
  __device__ __forceinline__ bool unit(int it, Unit& U, int) const {
    const int nloc = gridDim.x >> 3, x = blockIdx.x & 7, loc = (blockIdx.x >> 3) + nloc * it;
    if (loc >= 8 * nNt) return false;
    const int mt = x * 8 + (loc & 7), nt = loc >> 3;
    U.m0 = LATONLY ? (mt >> 4) * RPB + CTX + (mt & 15) * 256 : mt * BM; U.n0 = nt * BN; return true;
  }
  static constexpr bool A_AFFINE = true;
  __device__ __forceinline__ int a_stride(const Unit&) const { return 64 * lda; }
  __device__ __forceinline__ int b_stride(const Unit&) const { return 64 * K; }
  __device__ __forceinline__ const bf16_t* a_row(const Unit& U, int r) const { return A + (size_t)(U.m0 + r) * lda; }
  __device__ __forceinline__ const bf16_t* b_row(const Unit& U, int r) const { return Bt + (size_t)(U.n0 + r) * K; }
  __device__ __forceinline__ int nk(const Unit&) const { return K >> 6; }
  __device__ __forceinline__ void epi(const Unit& U, int r, int c, f32x4 v0, f32x4 v1, f32x4 v2, f32x4 v3) const { ep(U.m0 + r, U.n0 + c, v0, v1, v2, v3); }
};
template <int MB, int NBW, bool LATONLY, class Epi, int GMODE = 0, bool F8 = false>
__device__ __forceinline__ void gemm_dense(const bf16_t* A, int lda, const bf16_t* Bt, int N, int K, const Epi& ep, char* lds) {
  static_assert(NBW == 2, "256-column tiles");
  DenseProv<MB * 16, 256, LATONLY, Epi> pv{A, lda, Bt, K, N / 256, ep};
  gemm_stream<MB, DenseProv<MB * 16, 256, LATONLY, Epi>, GMODE, F8>(pv, lds);
}

template <bool F8>
struct MlaUpProv {
  const bf16_t* CQ; const bf16_t* CKV; const bf16_t* WUQ; const bf16_t* WUKV; bf16_t* Q; bf16_t* KV; unsigned char* K8;
  static constexpr int QU = F8 ? QL / 2 : QL, KU = F8 ? KVL / 2 : KVL;
  struct Unit { int m0, n0, which; };
  __device__ __forceinline__ bool unit(int it, Unit& U, int) const {
    const int b = blockIdx.x; int which, t;
    if (b < 128) { if (it > 2) return false; which = it == 2; t = it == 2 ? b : 2 * b + it; }
    else { if (it > 3) return false; which = it != 0; t = it == 0 ? 256 + (b - 128) : 128 + 3 * (b - 128) + (it - 1); }
    U.which = which;
    if (which) { U.m0 = (t >> 3) * 272; U.n0 = (t & 7) * 256; } else { U.m0 = (t / 6) * 272; U.n0 = (t % 6) * 256; }
    return true;
  }
  static constexpr bool A_AFFINE = true;
  __device__ __forceinline__ int a_stride(const Unit& U) const { return U.which ? 64 * KU : 64 * QU; }
  __device__ __forceinline__ int b_stride(const Unit& U) const { return U.which ? 64 * KU : 64 * QU; }
  __device__ __forceinline__ const bf16_t* a_row(const Unit& U, int r) const { return U.which ? CKV + (size_t)(U.m0 + r) * KU : CQ + (size_t)(U.m0 + r) * QU; }
  __device__ __forceinline__ const bf16_t* b_row(const Unit& U, int r) const { return U.which ? WUKV + (size_t)(U.n0 + r) * KU : WUQ + (size_t)(U.n0 + r) * QU; }
  __device__ __forceinline__ int nk(const Unit& U) const { return U.which ? KU / 64 : QU / 64; }
  __device__ __forceinline__ void epi(const Unit& U, int r, int c, f32x4 v0, f32x4 v1, f32x4 v2, f32x4 v3) const {
    if (F8) { constexpr float is = 1.0f / 512.0f; v0 *= is; v1 *= is; v2 *= is; v3 *= is; }
    bf16_t* o = U.which ? KV + (size_t)(U.m0 + r) * 2048 + U.n0 + c : Q + (size_t)(U.m0 + r) * 1536 + U.n0 + c; *(u32x4*)o = pack8(v0, v1); *(u32x4*)(o + 8) = pack8(v2, v3);
    if (QK_F8 && U.which) { const int col = U.n0 + c, hd = col >> 8, wi = col & 255;
      if (wi < 128) { u32x4 w = {pack4_f8(v0[0] * F8_SQK, v0[1] * F8_SQK, v0[2] * F8_SQK, v0[3] * F8_SQK), pack4_f8(v1[0] * F8_SQK, v1[1] * F8_SQK, v1[2] * F8_SQK, v1[3] * F8_SQK),
                                 pack4_f8(v2[0] * F8_SQK, v2[1] * F8_SQK, v2[2] * F8_SQK, v2[3] * F8_SQK), pack4_f8(v3[0] * F8_SQK, v3[1] * F8_SQK, v3[2] * F8_SQK, v3[3] * F8_SQK)};
        *(u32x4*)(K8 + (size_t)(U.m0 + r) * 1024 + hd * 128 + wi) = w; } } }
};

template <int DK> struct AttnCfg {
  static constexpr int KROW = DK * (QK_F8 ? 1 : 2);
  static constexpr int SHM_V = 64 * 128 * 2, SHM_K = 64 * KROW;
  static constexpr int SHM = 2 * SHM_V + 2 * SHM_K + 8 * 64 * 4;
};
#define SBAR() __builtin_amdgcn_sched_barrier(0)
__device__ __forceinline__ int crow(int r, int hi) { return (r & 3) + 8 * (r >> 2) + 4 * hi; }
__device__ __forceinline__ int v_st(int k, int c) { const int kk = (k & ~0xC) | ((k & 4) << 1) | ((k & 8) >> 1); return ((kk >> 3) * 4 + (c >> 5)) * 512 + ((kk & 7) * 32 + (c & 31)) * 2; }
__device__ __forceinline__ int v_rd_base(int lane) { return ((lane & 3) << 3) | (((lane >> 2) & 3) << 6) | (((lane >> 4) & 1) << 5) | (((lane >> 5) & 1) << 8); }
constexpr int v_rd_off(int d0, int ks, int half) { return d0 * 512 + ks * 4096 + half * 2048; }
template <int OFF> __device__ __forceinline__ s16x4 tr_read(int vb) {
  s16x4 r; asm volatile("ds_read_b64_tr_b16 %0, %1 offset:%2" : "=&v"(r) : "v"(vb), "i"(OFF) : "memory"); return r;
}
template <int D0> __device__ __forceinline__ void pv_one(f32x16& od, int vb, bf16x8 pa0, bf16x8 pa1, bf16x8 pa2, bf16x8 pa3) {
  const s16x4 l0 = tr_read<v_rd_off(D0, 0, 0)>(vb), h0 = tr_read<v_rd_off(D0, 0, 1)>(vb), l1 = tr_read<v_rd_off(D0, 1, 0)>(vb), h1 = tr_read<v_rd_off(D0, 1, 1)>(vb);
  const s16x4 l2 = tr_read<v_rd_off(D0, 2, 0)>(vb), h2 = tr_read<v_rd_off(D0, 2, 1)>(vb), l3 = tr_read<v_rd_off(D0, 3, 0)>(vb), h3 = tr_read<v_rd_off(D0, 3, 1)>(vb);
  asm volatile("s_waitcnt lgkmcnt(0)" ::: "memory"); SBAR();
#define PK(L, H) (bf16x8){L[0], L[1], L[2], L[3], H[0], H[1], H[2], H[3]}
  od = __builtin_amdgcn_mfma_f32_32x32x16_bf16(pa0, PK(l0, h0), od, 0, 0, 0);
  od = __builtin_amdgcn_mfma_f32_32x32x16_bf16(pa1, PK(l1, h1), od, 0, 0, 0);
  od = __builtin_amdgcn_mfma_f32_32x32x16_bf16(pa2, PK(l2, h2), od, 0, 0, 0);
  od = __builtin_amdgcn_mfma_f32_32x32x16_bf16(pa3, PK(l3, h3), od, 0, 0, 0);
#undef PK
}
__device__ __forceinline__ void pv_d0(f32x16* o, int vb, bf16x8 pa0, bf16x8 pa1, bf16x8 pa2, bf16x8 pa3) {
  pv_one<0>(o[0], vb, pa0, pa1, pa2, pa3); pv_one<1>(o[1], vb, pa0, pa1, pa2, pa3); pv_one<2>(o[2], vb, pa0, pa1, pa2, pa3); pv_one<3>(o[3], vb, pa0, pa1, pa2, pa3);
}
constexpr float ATT_THR = 8.f;
template <int DK> __device__ __forceinline__ void partialSM(f32x16& p0, f32x16& p1, float& m_reg, float& mn, float& alpha) {
  constexpr float SCALE = (DK == 192 ? 0.07216878364870322f : 0.08838834764831845f) * (QK_F8 ? 1.0f / (F8_SQK * F8_SQK) : 1.0f);
  constexpr float C = SCALE * 1.4426950408889634f;
  float pmax = p0[0];
#pragma unroll
  for (int r = 1; r < 16; ++r) pmax = fmaxf(pmax, p0[r]);
#pragma unroll
  for (int r = 0; r < 16; ++r) pmax = fmaxf(pmax, p1[r]);
  { auto rr = __builtin_amdgcn_permlane32_swap(__float_as_uint(pmax), __float_as_uint(pmax), false, false);
    pmax = fmaxf(__uint_as_float(rr[0]), __uint_as_float(rr[1])); }
  if (__builtin_expect(__all(pmax - m_reg <= ATT_THR / SCALE), 1)) { mn = m_reg; alpha = 1.f; }
  else { mn = fmaxf(m_reg, pmax); alpha = __builtin_amdgcn_exp2f((m_reg - mn) * C); m_reg = mn; }
  const float mnC = -mn * C;
#pragma unroll
  for (int r = 0; r < 16; ++r) p0[r] = fmaf(p0[r], C, mnC);
#pragma unroll
  for (int r = 0; r < 16; ++r) p1[r] = fmaf(p1[r], C, mnC);
#pragma unroll
  for (int r = 0; r < 16; ++r) p0[r] = __builtin_amdgcn_exp2f(p0[r]);
}
__device__ __forceinline__ void finishSM(f32x16& p0, f32x16& p1, float alpha, float& l_reg, bf16x8& pa0, bf16x8& pa1, bf16x8& pa2, bf16x8& pa3) {
#pragma unroll
  for (int r = 0; r < 16; ++r) p1[r] = __builtin_amdgcn_exp2f(p1[r]);
  float ps = 0;
#pragma unroll
  for (int r = 0; r < 16; ++r) ps += p0[r];
#pragma unroll
  for (int r = 0; r < 16; ++r) ps += p1[r];
  { auto rr = __builtin_amdgcn_permlane32_swap(__float_as_uint(ps), __float_as_uint(ps), false, false);
    ps = __uint_as_float(rr[0]) + __uint_as_float(rr[1]); }
  l_reg = l_reg * alpha + ps;
#define PK4(P, BASE, OUT) do { unsigned a0 = cvtpk(P[BASE + 0], P[BASE + 1]), a1 = cvtpk(P[BASE + 2], P[BASE + 3]);   \
    unsigned b0 = cvtpk(P[BASE + 4], P[BASE + 5]), b1 = cvtpk(P[BASE + 6], P[BASE + 7]);                              \
    auto r0 = __builtin_amdgcn_permlane32_swap(a0, b0, false, false); auto r1 = __builtin_amdgcn_permlane32_swap(a1, b1, false, false); \
    u32x4 w = {r0[0], r1[0], r0[1], r1[1]}; OUT = *reinterpret_cast<bf16x8*>(&w); } while (0)
  PK4(p0, 0, pa0); PK4(p0, 8, pa1); PK4(p1, 0, pa2); PK4(p1, 8, pa3);
#undef PK4
}
template <int DK> __device__ __forceinline__ void qkt(f32x16& p0, f32x16& p1, const char* Ks, const bf16x8* qr, const int* kro) {
  constexpr int KROW = DK * 2;
  p0 = f32x16{}; p1 = f32x16{};
#pragma unroll
  for (int d0 = 0; d0 < DK / 16; ++d0) {
    bf16x8 b0 = *reinterpret_cast<const bf16x8*>(Ks + kro[d0 & 3] + (d0 >> 2) * 128);
    bf16x8 b1 = *reinterpret_cast<const bf16x8*>(Ks + kro[d0 & 3] + (d0 >> 2) * 128 + 32 * KROW);
    p0 = __builtin_amdgcn_mfma_f32_32x32x16_bf16(b0, qr[d0], p0, 0, 0, 0);
    p1 = __builtin_amdgcn_mfma_f32_32x32x16_bf16(b1, qr[d0], p1, 0, 0, 0); }
}

template <int DK, int ldq, int ldk, int ldv, int ldo>
__device__ __forceinline__ void attn_unit(const bf16_t* __restrict__ Qb, const bf16_t* __restrict__ Kh, const bf16_t* __restrict__ Kp,
                                          const bf16_t* __restrict__ Vh, bf16_t* __restrict__ Ob, int nkeys, bool rope, int qpos0,
                                          const float* __restrict__ qg, char* lds) {
  using Cfg = AttnCfg<DK>;
  constexpr int KROW = Cfg::KROW, SHM_V = Cfg::SHM_V, SHM_K = Cfg::SHM_K, ND0 = DK / 16;
  int tid = threadIdx.x; asm volatile("" : "+v"(tid));
  const int wid = tid >> 6, lane = tid & 63, r32 = lane & 31, hi = lane >> 5;
  char* V_lds = lds; char* K_lds = lds + 2 * SHM_V;
  float* wsl = (float*)(lds + 2 * SHM_V + 2 * SHM_K) + wid * 64; float* li_l = wsl; float* al_l = wsl + 32;
  float m_reg = -1e30f, l_reg = 0; f32x16 o[4] = {}; bf16x8 qr[ND0];
  {
    const int qrow = wid * 32 + r32;
    const bf16_t* Qw = Qb + (size_t)qrow * ldq + hi * 8;
    float qf[ND0][8];
#pragma unroll
    for (int d0 = 0; d0 < ND0; ++d0) { const u32x4 w = *reinterpret_cast<const u32x4*>(Qw + d0 * 16);
#pragma unroll
      for (int e = 0; e < 4; ++e) { qf[d0][2 * e] = bflo(w[e]); qf[d0][2 * e + 1] = bfhi(w[e]); } }
    const int qpos = qpos0 + qrow; const float prow = (float)(qpos >> 6), pcol = (float)(qpos & 63);
    int hio = hi; asm volatile("" : "+v"(hio));
    if constexpr (DK == 128) {
      float ss = 0.f;
#pragma unroll
      for (int d0 = 0; d0 < 8; ++d0)
#pragma unroll
        for (int e = 0; e < 8; ++e) ss += qf[d0][e] * qf[d0][e];
      ss += __shfl_xor(ss, 32);
      const float rs = rsqrtf(ss * (1.0f / 128.0f) + EPS);
#pragma unroll
      for (int d0 = 0; d0 < 8; ++d0) { const f32x4 g0 = *(const f32x4*)(qg + d0 * 16 + hi * 8), g1 = *(const f32x4*)(qg + d0 * 16 + hi * 8 + 4);
#pragma unroll
        for (int e = 0; e < 4; ++e) { qf[d0][e] *= rs * g0[e]; qf[d0][4 + e] *= rs * g1[e]; } }
      if (rope) {
#pragma unroll
        for (int hf = 0; hf < 2; ++hf) { const float pos = hf ? pcol : prow;
#pragma unroll
          for (int dd = 0; dd < 2; ++dd)
#pragma unroll
            for (int e = 0; e < 8; ++e) { const int j = dd * 16 + hio * 8 + e; const float ang = pos * rope_invf(j, 32); const float cs = __cosf(ang), sn = __sinf(ang);
              const float x1 = qf[hf * 4 + dd][e], x2 = qf[hf * 4 + dd + 2][e]; qf[hf * 4 + dd][e] = x1 * cs - x2 * sn; qf[hf * 4 + dd + 2][e] = x1 * sn + x2 * cs; } }
      }
    } else {
      if (rope) {
#pragma unroll
        for (int hf = 0; hf < 2; ++hf) { const float pos = hf ? pcol : prow;
#pragma unroll
          for (int e = 0; e < 8; ++e) { const int j = hio * 8 + e; const float ang = pos * rope_invf(j, 16); const float cs = __cosf(ang), sn = __sinf(ang);
            const float x1 = qf[8 + hf * 2][e], x2 = qf[9 + hf * 2][e]; qf[8 + hf * 2][e] = x1 * cs - x2 * sn; qf[9 + hf * 2][e] = x1 * sn + x2 * cs; } }
      }
    }
#pragma unroll
    for (int d0 = 0; d0 < ND0; ++d0) { u32x4 w = {cvtpk(qf[d0][0], qf[d0][1]), cvtpk(qf[d0][2], qf[d0][3]), cvtpk(qf[d0][4], qf[d0][5]), cvtpk(qf[d0][6], qf[d0][7])};
      qr[d0] = *reinterpret_cast<bf16x8*>(&w); }
  }
  int kro[4];
#pragma unroll
  for (int bq = 0; bq < 4; ++bq) kro[bq] = r32 * KROW + (((2 * bq + hi) ^ (r32 & 7)) << 4);
  const int sr = tid >> 4, sc = (tid & 15) * 8, vst0 = v_st(sr, sc), vst1 = v_st(32 + sr, sc);
  const int pr = tid >> 3, pcc = (tid & 7) * 8;
  const int vb0 = (int)(uintptr_t)(LAS char*)V_lds + v_rd_base(lane);
  bf16x8 vs0, vs1, ks0, ks1, kp0;
  const unsigned voff = sr * ldv + sc, koff = sr * ldk + sc, poff = pr * ROPE + pcc;
#define SLOAD(k0) do { const bf16_t* Vt = Vh + (size_t)(k0) * ldv; const bf16_t* Kt = Kh + (size_t)(k0) * ldk; \
    vs0 = *(const bf16x8*)(Vt + voff); vs1 = *(const bf16x8*)(Vt + 32 * ldv + voff); \
    ks0 = *(const bf16x8*)(Kt + koff); ks1 = *(const bf16x8*)(Kt + 32 * ldk + koff); \
    if constexpr (DK == 192) kp0 = *(const bf16x8*)(Kp + (size_t)(k0) * ROPE + poff); } while (0)
#define SWRITE(b) do { *(bf16x8*)(V_lds + (b) * SHM_V + vst0) = vs0; *(bf16x8*)(V_lds + (b) * SHM_V + vst1) = vs1; const int kc = sc * 2; \
    *(bf16x8*)(K_lds + (b) * SHM_K + sr * KROW + (kc ^ ((sr & 7) << 4))) = ks0; \
    *(bf16x8*)(K_lds + (b) * SHM_K + (32 + sr) * KROW + (kc ^ ((sr & 7) << 4))) = ks1; \
    if constexpr (DK == 192) *(bf16x8*)(K_lds + (b) * SHM_K + pr * KROW + ((256 + pcc * 2) ^ ((pr & 7) << 4))) = kp0; } while (0)
#define RESC(a) do { if (__any((a) < 1.f)) { if (hi == 0) al_l[r32] = (a); asm volatile("s_waitcnt lgkmcnt(0)" ::: "memory"); \
    for (int d = 0; d < 4; ++d) for (int r = 0; r < 16; ++r) o[d][r] *= al_l[crow(r, hi)]; } } while (0)
  f32x16 pA0, pA1, pB0, pB1; float mnA, mnB, alA, alB; bf16x8 pa0, pa1, pa2, pa3; const int NT = nkeys / 64;
  SLOAD(0); SWRITE(0); __syncthreads();
  qkt<DK>(pA0, pA1, K_lds, qr, kro); partialSM<DK>(pA0, pA1, m_reg, mnA, alA);
  SLOAD(64); SWRITE(1); __syncthreads();
  for (int j = 1; j + 1 < NT; j += 2) {
    SBAR(); qkt<DK>(pB0, pB1, K_lds + SHM_K, qr, kro);
    finishSM(pA0, pA1, alA, l_reg, pa0, pa1, pa2, pa3); SBAR();
    SLOAD((j + 1) * 64); SBAR();
    pv_d0(o, vb0, pa0, pa1, pa2, pa3); partialSM<DK>(pB0, pB1, m_reg, mnB, alB);
    __syncthreads(); SWRITE(0);
    RESC(alB); __syncthreads();
    SBAR(); qkt<DK>(pA0, pA1, K_lds, qr, kro);
    finishSM(pB0, pB1, alB, l_reg, pa0, pa1, pa2, pa3); SBAR();
    SLOAD((j + 2) * 64); SBAR();
    pv_d0(o, vb0 + SHM_V, pa0, pa1, pa2, pa3); partialSM<DK>(pA0, pA1, m_reg, mnA, alA);
    __syncthreads(); SWRITE(1);
    RESC(alA); __syncthreads();
  }
  SBAR(); qkt<DK>(pB0, pB1, K_lds + SHM_K, qr, kro);
  finishSM(pA0, pA1, alA, l_reg, pa0, pa1, pa2, pa3); SBAR();
  pv_d0(o, vb0, pa0, pa1, pa2, pa3); partialSM<DK>(pB0, pB1, m_reg, mnB, alB);
  __syncthreads(); RESC(alB);
  finishSM(pB0, pB1, alB, l_reg, pa0, pa1, pa2, pa3); SBAR();
  pv_d0(o, vb0 + SHM_V, pa0, pa1, pa2, pa3);
  if (hi == 0) li_l[r32] = l_reg; asm volatile("s_waitcnt lgkmcnt(0)" ::: "memory");
  float rli[16];
#pragma unroll
  for (int r = 0; r < 16; ++r) rli[r] = __builtin_amdgcn_rcpf(li_l[crow(r, hi)]);
  if (WO_F8) {
    unsigned char* st = (unsigned char*)K_lds + wid * 4096;
#pragma unroll
    for (int r = 0; r < 16; ++r) { const int orow = crow(r, hi); const float s = rli[r] * F8_SO;
#pragma unroll
      for (int d0 = 0; d0 < 4; ++d0) st[orow * 128 + d0 * 32 + r32] = (unsigned char)(__builtin_amdgcn_cvt_pk_fp8_f32(fminf(fmaxf(o[d0][r] * s, -448.f), 448.f), 0.f, 0, false) & 0xff); }
    asm volatile("s_waitcnt lgkmcnt(0)" ::: "memory");
    unsigned char* Ow8 = (unsigned char*)Ob + (size_t)(wid * 32) * ldo;
#pragma unroll
    for (int ps = 0; ps < 4; ++ps) { const int row = ps * 8 + (lane >> 3), ch = (lane & 7) * 16;
      *(u32x4*)(Ow8 + (size_t)row * ldo + ch) = *(const u32x4*)(st + row * 128 + ch); }
  } else {
  bf16_t* Ow = Ob + (size_t)(wid * 32) * ldo;
#pragma unroll
  for (int r = 0; r < 16; ++r) { const int orow = crow(r, hi);
#pragma unroll
    for (int d0 = 0; d0 < 4; ++d0) Ow[(size_t)orow * ldo + d0 * 32 + r32] = (bf16_t)(cvtpk(o[d0][r] * rli[r], 0.f) & 0xffffu); }
  }
  __syncthreads();
#undef SLOAD
#undef SWRITE
#undef RESC
}

__device__ __forceinline__ void tconv_tile(const float* __restrict__ src, int ldn, int k0, int n0, bf16_t* __restrict__ dst, int ldk, int rmul, int roff, float* lw, int lane) {
  const float* s = src + (size_t)k0 * ldn + n0 + lane;
  float v[64];
#pragma unroll
  for (int i = 0; i < 64; ++i) v[i] = __builtin_nontemporal_load(s + (size_t)i * ldn);
#pragma unroll
  for (int i = 0; i < 64; ++i) lw[i * 65 + lane] = v[i];
  const int kc = (lane & 7) * 8;
#pragma unroll
  for (int it = 0; it < 8; ++it) {
    const int n = it * 8 + (lane >> 3);
    float v[8];
#pragma unroll
    for (int j = 0; j < 8; ++j) v[j] = lw[(kc + j) * 65 + n];
    u32x4 w = {cvtpk(v[0], v[1]), cvtpk(v[2], v[3]), cvtpk(v[4], v[5]), cvtpk(v[6], v[7])};
    *(u32x4*)(dst + (size_t)((n0 + n) * rmul + roff) * ldk + k0 + kc) = w;
  }
}

#ifndef MOE_JIT
#define MOE_JIT 1
#endif
constexpr float F8_SH = 8.0f, F8_SWD = 32.0f;
constexpr float F8_SA = 8.0f, F8_SW = 64.0f;
__device__ __forceinline__ void tconv_tile_f8(const float* __restrict__ src, int ldn, int k0, int n0, unsigned char* __restrict__ dst, int ldk, int rmul, int roff, float scale, float* lw, int lane) {
  const float* s = src + (size_t)k0 * ldn + n0 + lane;
  float v[64];
#pragma unroll
  for (int i = 0; i < 64; ++i) v[i] = __builtin_nontemporal_load(s + (size_t)i * ldn);
#pragma unroll
  for (int i = 0; i < 64; ++i) lw[i * 65 + lane] = v[i];
  const int kc = (lane & 3) * 16;
#pragma unroll
  for (int it = 0; it < 4; ++it) {
    const int n = it * 16 + (lane >> 2);
    float x[16];
#pragma unroll
    for (int j = 0; j < 16; ++j) x[j] = lw[(kc + j) * 65 + n] * scale;
    u32x4 w = {pack4_f8(x[0], x[1], x[2], x[3]), pack4_f8(x[4], x[5], x[6], x[7]), pack4_f8(x[8], x[9], x[10], x[11]), pack4_f8(x[12], x[13], x[14], x[15])};
    *(u32x4*)(dst + (size_t)((n0 + n) * rmul + roff) * ldk + k0 + kc) = w;
  }
}
__device__ __forceinline__ void phase_conv_moe(const Params& p, int layer, char* lds) {
  int tid = threadIdx.x; asm volatile("" : "+v"(tid));
  const int wid = tid >> 6, lane = tid & 63;
  const int gw = blockIdx.x * 8 + wid, nw = gridDim.x * 8;
  char* ws = opaque_ptr(p.ws);
  float* lw = (float*)lds + wid * (64 * 65);
  for (int t = gw; t < ME * 384; t += nw) {
    const int le = layer * ME + t / 384, tt = t % 384, which = tt >> 7, ti = tt & 127;
    bf16_t* wgu = (bf16_t*)(ws + WS_WMOE + (size_t)le * MOE_WBYTES); bf16_t* wd = wgu + 1024 * 1024;
    if (which < 2) { const float* src = p.in[which == 0 ? I_MOE_GATE : I_MOE_UP] + (size_t)le * D * FF;
      const int kt = ti >> 3, nt = ti & 7;
      if (MOE_F8) tconv_tile_f8(src, FF, kt * 64, nt * 64, (unsigned char*)wgu, D, 2, which, F8_SW, lw, lane);
      else tconv_tile(src, FF, kt * 64, nt * 64, wgu, D, 2, which, lw, lane); }
    else { const float* src = p.in[I_MOE_DOWN] + (size_t)le * FF * D;
      const int kt = ti >> 4, nt = ti & 15;
      if (MOE_F8 >= 2) tconv_tile_f8(src, D, kt * 64, nt * 64, (unsigned char*)wd, FF, 1, 0, F8_SWD, lw, lane);
      else tconv_tile(src, D, kt * 64, nt * 64, wd, FF, 1, 0, lw, lane); }
  }
}
__device__ __forceinline__ void phase_prep(const Params& p, char* lds) {
  int tid = threadIdx.x; asm volatile("" : "+v"(tid));
  const int wid = tid >> 6, lane = tid & 63;
  const int gw = blockIdx.x * 8 + wid, nw = gridDim.x * 8;
  char* ws = opaque_ptr(p.ws);
  float* lw = (float*)lds + wid * (64 * 65);
  for (int t = gw + (MOE_JIT ? DEPTH * ME * 384 : 0); t < DEPTH * ME * 384; t += nw) {
    const int le = t / 384, tt = t - le * 384, which = tt >> 7, ti = tt & 127;
    bf16_t* wgu = (bf16_t*)(ws + WS_WMOE + (size_t)le * MOE_WBYTES); bf16_t* wd = wgu + 1024 * 1024;
    if (which < 2) { const float* src = p.in[which == 0 ? I_MOE_GATE : I_MOE_UP] + (size_t)le * D * FF;
      const int kt = ti >> 3, nt = ti & 7; tconv_tile(src, FF, kt * 64, nt * 64, wgu, D, 2, which, lw, lane); }
    else { const float* src = p.in[I_MOE_DOWN] + (size_t)le * FF * D;
      const int kt = ti >> 4, nt = ti & 15; tconv_tile(src, D, kt * 64, nt * 64, wd, FF, 1, 0, lw, lane); }
  }
  {
    int base = 0;
#pragma unroll 1
    for (int q = 0; q < 14; ++q) {
      const float* jsrc = p.jobs[q].src; bf16_t* jdst = p.jobs[q].dst; const int jK = p.jobs[q].K, jN = p.jobs[q].N, jroff = p.jobs[q].roff;
      const int nnt = jN >> 6, ntile = (jK >> 6) * nnt;
      for (int t = gw - base; t < ntile; t += nw) { if (t < 0) continue; const int kt = t / nnt, nt = t - kt * nnt;
        if (p.jobs[q].rmul == 8) tconv_tile_f8(jsrc, jN, kt * 64, nt * 64, (unsigned char*)jdst, jK, 1, jroff, F8_SW, lw, lane);
        else tconv_tile(jsrc, jN, kt * 64, nt * 64, jdst, jK, 1, jroff, lw, lane); }
      base = (base + ntile) % nw;
    }
  }
  for (int j = 0; j < 2; ++j) { constexpr int ES = MIX_F8 ? 1 : 2; u32x4* z = (u32x4*)(ws + WS_WMLA + j * MLA_WBYTES + MLA_W1T + (size_t)832 * 1024 * ES);
    for (int i = blockIdx.x * NTHR + tid; i < 192 * 1024 * ES / 16; i += gridDim.x * NTHR) z[i] = (u32x4){0u, 0u, 0u, 0u}; }
  if (blockIdx.x == 0 && tid < DEPTH * ME) ((int*)(ws + WS_CNT))[tid] = 0;
  if (blockIdx.x == 0 && tid == 0) ((int*)(ws + WS_CNT))[1000] = 0;
  for (int r = gw; r < R; r += nw) {
    const int b = r / RPB, ii = r - b * RPB;
    const f32x4* src = (const f32x4*)(ii < CTX ? p.in[I_CTX] + ((size_t)b * CTX + ii) * D : p.in[I_X] + ((size_t)b * SEQ + (ii - CTX)) * D);
    xres_t* dst = (xres_t*)(ws + WS_X32) + (size_t)r * D;
#pragma unroll
    for (int q = 0; q < 4; ++q) xstore4(dst + (lane + 64 * q) * 4, src[lane + 64 * q]);
  }
  {
    float* sc = (float*)lds;
    __syncthreads();
    for (int u = blockIdx.x; u < DEPTH * 12 * 8; u += gridDim.x) {
      const int i = u / 96, rem = u - i * 96, cch = rem >> 3, ks = rem & 7;
      __syncthreads();
      for (int e = tid; e < 5 * 128; e += NTHR) { const int b = e >> 7, k = ks * 128 + (e & 127); const float c = b < 4 ? p.in[I_C][b * D + k] : p.in[I_CCTX][k]; sc[e] = silu_f(c); }
      __syncthreads();
      const int col = cch * 512 + tid;
      const float* w = p.in[I_WMOD] + (size_t)i * D * NMOD + (size_t)(ks * 128) * NMOD + col;
      float a0 = 0, a1 = 0, a2 = 0, a3 = 0, a4 = 0;
#pragma unroll 8
      for (int k = 0; k < 128; ++k) { const float wv = w[(size_t)k * NMOD]; a0 += sc[k] * wv; a1 += sc[128 + k] * wv; a2 += sc[256 + k] * wv; a3 += sc[384 + k] * wv; a4 += sc[512 + k] * wv; }
      float* mp = (float*)(ws + WS_MODP) + ((size_t)(ks * DEPTH + i) * 5) * NMOD + col;
      mp[0] = a0; mp[NMOD] = a1; mp[2 * NMOD] = a2; mp[3 * NMOD] = a3; mp[4 * NMOD] = a4;
    }
    __syncthreads();
  }
}
__device__ __forceinline__ void phase_modfin(const Params& p) {
  const float* mp = (const float*)(p.ws + WS_MODP); float* mv = (float*)(p.ws + WS_MODV);
  for (int e = blockIdx.x * NTHR + threadIdx.x; e < DEPTH * 5 * NMOD; e += gridDim.x * NTHR) {
    const int i = e / (5 * NMOD), col = e % NMOD;
    float s = p.in[I_BMOD][i * NMOD + col];
#pragma unroll
    for (int ks = 0; ks < 8; ++ks) s += mp[(size_t)ks * DEPTH * 5 * NMOD + e];
    mv[e] = s;
  }
}

template <int MODE, bool COMBINE, bool DRY = false>
__device__ __forceinline__ void phase_norm(const Params& p, int layer) {
  int tid = threadIdx.x; asm volatile("" : "+v"(tid));
  const int wid = tid >> 6, lane = tid & 63;
  const int gw = blockIdx.x * 8 + wid, nw = gridDim.x * 8;
  char* ws = opaque_ptr(p.ws);
  const float* modv = (const float*)(ws + WS_MODV);
  const bf16_t* Y = (const bf16_t*)(ws + WS_Y);
  for (int r = gw; r < R; r += nw) {
    const int b = r / RPB, ii = r - b * RPB; const bool is_ctx = ii < CTX; const int bsel = is_ctx ? 4 : b;
    if (MODE == 2 && is_ctx) continue;
    xres_t* xp = (xres_t*)(ws + WS_X32) + (size_t)r * D;
    f32x4 v[4];
#pragma unroll
    for (int q = 0; q < 4; ++q) v[q] = xload4(xp + (lane + 64 * q) * 4);
    if (COMBINE) {
      const int pl = MODE == 2 ? DEPTH - 1 : layer - 1;
      if (!(pl == DEPTH - 1 && is_ctx)) {
        const float* g2 = modv + ((size_t)pl * 5 + bsel) * NMOD + 5 * D;
#pragma unroll
        for (int q = 0; q < 4; ++q) { const int c = (lane + 64 * q) * 4; const f32x4 g = *(const f32x4*)(g2 + c);
          const u32x2 y0 = *(const u32x2*)(Y + (size_t)(2 * r) * D + c), y1 = *(const u32x2*)(Y + (size_t)(2 * r + 1) * D + c);
          v[q][0] += g[0] * (bflo(y0[0]) + bflo(y1[0])); v[q][1] += g[1] * (bfhi(y0[0]) + bfhi(y1[0]));
          v[q][2] += g[2] * (bflo(y0[1]) + bflo(y1[1])); v[q][3] += g[3] * (bfhi(y0[1]) + bfhi(y1[1])); }
        if (MODE != 2 && !DRY) {
#pragma unroll
          for (int q = 0; q < 4; ++q) xstore4(xp + (lane + 64 * q) * 4, v[q]);
        }
      }
    }
    float ss = 0.f;
#pragma unroll
    for (int q = 0; q < 4; ++q) ss += v[q][0] * v[q][0] + v[q][1] * v[q][1] + v[q][2] * v[q][2] + v[q][3] * v[q][3];
    ss = wave_sum(ss);
    const float rs = rsqrtf(ss * (1.0f / D) + EPS);
    if (MODE == 2) {
      float* op = p.out + ((size_t)b * SEQ + (ii - CTX)) * D;
#pragma unroll
      for (int q = 0; q < 4; ++q) { const int c = (lane + 64 * q) * 4; const f32x4 g = *(const f32x4*)(p.in[I_FG] + c); f32x4 ov = v[q] * rs * g;
#if DBG_TIME
        { const unsigned long long* d = (const unsigned long long*)(ws + WS_CNT + 4096); const float t1 = (float)d[DBG_T1] * 0.01f, t2 = (float)d[DBG_T2] * 0.01f;
          const float a = sqrtf(t1 * 0.01f); ov = (f32x4){a, a, a, a}; if (r == CTX && c == 0) ov[0] = t2 * 0.002f; }
#endif
        if (DBG_PROBE == 20 && ((const int*)(ws + WS_CNT))[1000]) ov = (f32x4){1000.f, 1000.f, 1000.f, 1000.f};
#ifdef SANITIZE
        for (int e = 0; e < 4; ++e) if (!(fabsf(ov[e]) < 1e30f)) ov[e] = DBG_PROBE ? 0.f : 1000.0f;
        if (DBG_PROBE && ((const int*)(ws + WS_CNT))[1000]) ov = (f32x4){1000.f, 1000.f, 1000.f, 1000.f};
#endif
        *(f32x4*)(op + c) = ov; }
      continue;
    }
    const float* ng = p.in[MODE == 0 ? I_NMG : I_NFG] + layer * D;
    const float* sh = modv + ((size_t)layer * 5 + bsel) * NMOD + (MODE == 0 ? 0 : 3) * D;
    const float* scl = sh + D;
    bf16_t* ap = (bf16_t*)(ws + WS_ACT) + (size_t)r * D;
    f32x4 f[4];
#pragma unroll
    for (int q = 0; q < 4; ++q) { const int c = (lane + 64 * q) * 4; const f32x4 g = *(const f32x4*)(ng + c), s1 = *(const f32x4*)(scl + c), s0 = *(const f32x4*)(sh + c);
      f[q] = (v[q] * rs * g) * (1.0f + s1) + s0;
      if ((MODE == 1 && MOE_F8) || (MODE == 0 && MIX_F8 && layer % 3 != 1)) ((unsigned*)(ws + WS_ACT))[((size_t)r * D + c) >> 2] = pack4_f8(f[q][0] * F8_SA, f[q][1] * F8_SA, f[q][2] * F8_SA, f[q][3] * F8_SA);
      else { u32x2 w = {cvtpk(f[q][0], f[q][1]), cvtpk(f[q][2], f[q][3])}; *(u32x2*)(ap + c) = w; } }
    if (MODE == 1) {
      if (layer == DEPTH - 1 && is_ctx) continue;
      const float* wg = p.in[I_MOE_WG] + (size_t)layer * D * 4; const float* we = p.in[I_MOE_WE] + (size_t)layer * D * ME;
      float gl[4] = {0.f, 0.f, 0.f, 0.f};
#pragma unroll
      for (int q = 0; q < 4; ++q)
#pragma unroll
        for (int e = 0; e < 4; ++e) { const int c = (lane + 64 * q) * 4 + e; const f32x4 w = *(const f32x4*)(wg + (size_t)c * 4);
          gl[0] += f[q][e] * w[0]; gl[1] += f[q][e] * w[1]; gl[2] += f[q][e] * w[2]; gl[3] += f[q][e] * w[3]; }
#pragma unroll
      for (int k = 0; k < 4; ++k) gl[k] = wave_sum(gl[k]);
      const float gm = fmaxf(fmaxf(gl[0], gl[1]), fmaxf(gl[2], gl[3]));
      float gp[4], gs = 0.f;
#pragma unroll
      for (int k = 0; k < 4; ++k) { gp[k] = __expf(gl[k] - gm); gs += gp[k]; }
      const float gsi = 1.0f / gs;
      int gsel = 0; float gbest = -1e30f, gw_ = 0.f;
#pragma unroll
      for (int k = 0; k < 4; ++k) { const float pr = gp[k] * gsi; const float sc = pr + p.in[I_MOE_BG][layer * 4 + k]; if (sc > gbest) { gbest = sc; gsel = k; gw_ = pr; } }
      gsel = __builtin_amdgcn_readfirstlane(gsel);
      float el[8] = {0.f, 0.f, 0.f, 0.f, 0.f, 0.f, 0.f, 0.f};
#pragma unroll
      for (int q = 0; q < 4; ++q)
#pragma unroll
        for (int e = 0; e < 4; ++e) { const int c = (lane + 64 * q) * 4 + e; const f32x4 w0 = *(const f32x4*)(we + (size_t)c * ME + gsel * 8), w1 = *(const f32x4*)(we + (size_t)c * ME + gsel * 8 + 4);
          el[0] += f[q][e] * w0[0]; el[1] += f[q][e] * w0[1]; el[2] += f[q][e] * w0[2]; el[3] += f[q][e] * w0[3];
          el[4] += f[q][e] * w1[0]; el[5] += f[q][e] * w1[1]; el[6] += f[q][e] * w1[2]; el[7] += f[q][e] * w1[3]; }
#pragma unroll
      for (int k = 0; k < 8; ++k) el[k] = wave_sum(el[k]);
      float em = el[0];
#pragma unroll
      for (int k = 1; k < 8; ++k) em = fmaxf(em, el[k]);
      float ep[8], es = 0.f;
#pragma unroll
      for (int k = 0; k < 8; ++k) { ep[k] = __expf(el[k] - em); es += ep[k]; }
      const float esi = 1.0f / es;
      int t1 = 0, t2 = 0; float b1 = -1e30f, b2 = -1e30f, p1 = 0.f, p2 = 0.f;
#pragma unroll
      for (int k = 0; k < 8; ++k) { const float pr = ep[k] * esi; const float sc = pr + p.in[I_MOE_BE][layer * ME + gsel * 8 + k];
        if (sc > b1) { b2 = b1; t2 = t1; p2 = p1; b1 = sc; t1 = k; p1 = pr; } else if (sc > b2) { b2 = sc; t2 = k; p2 = pr; } }
      if (lane == 0 && !DRY) {
        const float inv = gw_ / (p1 + p2);
        int* cnt = (int*)(ws + WS_CNT) + layer * ME; int* list = (int*)(ws + WS_LIST); float* wts = (float*)(ws + WS_WTS);
        const int e1 = gsel * 8 + t1, e2 = gsel * 8 + t2;
        const int q1 = atomicAdd(cnt + e1, 1); list[(size_t)e1 * R + q1] = 2 * r;     wts[2 * r] = p1 * inv;
        const int q2 = atomicAdd(cnt + e2, 1); list[(size_t)e2 * R + q2] = 2 * r + 1; wts[2 * r + 1] = p2 * inv;
      }
    }
  }
}

__device__ __forceinline__ void phase_mla_mid(const Params& p, int j) {
  int tid = threadIdx.x; asm volatile("" : "+v"(tid));
  const int wid = tid >> 6, lane = tid & 63;
  const int gw = blockIdx.x * 8 + wid, nw = gridDim.x * 8;
  char* ws = opaque_ptr(p.ws);
  const float* gq = p.in[I_MLA_GQ] + j * QL; const float* gkv = p.in[I_MLA_GKV] + j * KVL;
  for (int r = gw; r < R; r += nw) {
    const int b = r / RPB, ii = r - b * RPB; const bool is_ctx = ii < CTX;
    const bf16_t* c1 = (const bf16_t*)(ws + WS_C1) + (size_t)r * 1024;
    const u32x2 q0w = *(const u32x2*)(c1 + lane * 4), q1w = *(const u32x2*)(c1 + 256 + lane * 4), kvw = *(const u32x2*)(c1 + 512 + lane * 4);
    const f32x4 q0 = {bflo(q0w[0]), bfhi(q0w[0]), bflo(q0w[1]), bfhi(q0w[1])}, q1 = {bflo(q1w[0]), bfhi(q1w[0]), bflo(q1w[1]), bfhi(q1w[1])},
                kv = {bflo(kvw[0]), bfhi(kvw[0]), bflo(kvw[1]), bfhi(kvw[1])};
    const float pe = bf2f(c1[768 + lane]);
    float sq = q0[0] * q0[0] + q0[1] * q0[1] + q0[2] * q0[2] + q0[3] * q0[3] + q1[0] * q1[0] + q1[1] * q1[1] + q1[2] * q1[2] + q1[3] * q1[3];
    float sk = kv[0] * kv[0] + kv[1] * kv[1] + kv[2] * kv[2] + kv[3] * kv[3];
    sq = wave_sum(sq); sk = wave_sum(sk);
    const float rq = rsqrtf(sq * (1.0f / QL) + EPS), rk = rsqrtf(sk * (1.0f / KVL) + EPS);
    bf16_t* cq = (bf16_t*)(ws + WS_CQ) + (size_t)r * QL; bf16_t* ckv = (bf16_t*)(ws + WS_CKV) + (size_t)r * KVL; bf16_t* kpe = (bf16_t*)(ws + WS_KPE) + (size_t)r * ROPE;
    if (MIX_F8) {
      unsigned char* cq8 = (unsigned char*)(ws + WS_CQ) + (size_t)r * QL; unsigned char* ckv8 = (unsigned char*)(ws + WS_CKV) + (size_t)r * KVL; const float sq8 = rq * F8_SA, sk8 = rk * F8_SA;
      { const f32x4 g = *(const f32x4*)(gq + lane * 4); *(unsigned*)(cq8 + lane * 4) = pack4_f8(q0[0] * sq8 * g[0], q0[1] * sq8 * g[1], q0[2] * sq8 * g[2], q0[3] * sq8 * g[3]); }
      { const f32x4 g = *(const f32x4*)(gq + 256 + lane * 4); *(unsigned*)(cq8 + 256 + lane * 4) = pack4_f8(q1[0] * sq8 * g[0], q1[1] * sq8 * g[1], q1[2] * sq8 * g[2], q1[3] * sq8 * g[3]); }
      { const f32x4 g = *(const f32x4*)(gkv + lane * 4); *(unsigned*)(ckv8 + lane * 4) = pack4_f8(kv[0] * sk8 * g[0], kv[1] * sk8 * g[1], kv[2] * sk8 * g[2], kv[3] * sk8 * g[3]); }
    } else {
    { const f32x4 g = *(const f32x4*)(gq + lane * 4); u32x2 w = {cvtpk(q0[0] * rq * g[0], q0[1] * rq * g[1]), cvtpk(q0[2] * rq * g[2], q0[3] * rq * g[3])}; *(u32x2*)(cq + lane * 4) = w; }
    { const f32x4 g = *(const f32x4*)(gq + 256 + lane * 4); u32x2 w = {cvtpk(q1[0] * rq * g[0], q1[1] * rq * g[1]), cvtpk(q1[2] * rq * g[2], q1[3] * rq * g[3])}; *(u32x2*)(cq + 256 + lane * 4) = w; }
    { const f32x4 g = *(const f32x4*)(gkv + lane * 4); u32x2 w = {cvtpk(kv[0] * rk * g[0], kv[1] * rk * g[1]), cvtpk(kv[2] * rk * g[2], kv[3] * rk * g[3])}; *(u32x2*)(ckv + lane * 4) = w; }
    }
    float outv = pe;
    const float other = __shfl_xor(pe, 16);
    if (!is_ctx) {
      const int s = ii - CTX; const float pos = (lane < 32) ? (float)(s >> 6) : (float)(s & 63);
      const float ang = pos * rope_invf(lane & 15, 16); const float cs = __cosf(ang), sn = __sinf(ang);
      outv = (lane & 16) ? (other * sn + pe * cs) : (pe * cs - other * sn);
    }
    kpe[lane] = (bf16_t)(cvtpk(outv, 0.f) & 0xffffu);
    if (QK_F8) ((unsigned char*)(ws + WS_KPE8))[(size_t)r * ROPE + lane] = (unsigned char)(__builtin_amdgcn_cvt_pk_fp8_f32(fminf(fmaxf(outv * F8_SQK, -448.f), 448.f), 0.f, 0, false) & 0xff);
  }
}

__device__ __forceinline__ void phase_gqa_k(const Params& p) {
  int tid = threadIdx.x; asm volatile("" : "+v"(tid));
  const int wid = tid >> 6, lane = tid & 63;
  const int gw = blockIdx.x * 8 + wid, nw = gridDim.x * 8;
  char* ws = opaque_ptr(p.ws); const float* kg = p.in[I_GQA_KG];
  const int sub = lane & 7;
  for (int r = gw; r < R; r += nw) {
    const int b = r / RPB, ii = r - b * RPB; const bool is_ctx = ii < CTX;
    const bf16_t* kp = (const bf16_t*)(ws + WS_QKV) + (size_t)r * 4096 + 2048 + lane * 16;
    const u32x4 w0 = *(const u32x4*)kp, w1 = *(const u32x4*)(kp + 8);
    float v[16];
#pragma unroll
    for (int e = 0; e < 4; ++e) { v[2 * e] = bflo(w0[e]); v[2 * e + 1] = bfhi(w0[e]); v[8 + 2 * e] = bflo(w1[e]); v[9 + 2 * e] = bfhi(w1[e]); }
    float ss = 0.f;
#pragma unroll
    for (int e = 0; e < 16; ++e) ss += v[e] * v[e];
    ss += __shfl_xor(ss, 1); ss += __shfl_xor(ss, 2); ss += __shfl_xor(ss, 4);
    const float rs = rsqrtf(ss * (1.0f / GD) + EPS);
#pragma unroll
    for (int e = 0; e < 16; ++e) v[e] *= rs * kg[sub * 16 + e];
    float o[16];
#pragma unroll
    for (int e = 0; e < 16; ++e) o[e] = __shfl_xor(v[e], 2);
    if (!is_ctx) {
      const int s = ii - CTX; const float pos = (sub < 4) ? (float)(s >> 6) : (float)(s & 63);
#pragma unroll
      for (int e = 0; e < 16; ++e) { const int j = (sub & 1) * 16 + e; const float ang = pos * rope_invf(j, 32); const float cs = __cosf(ang), sn = __sinf(ang);
        v[e] = (sub & 2) ? (o[e] * sn + v[e] * cs) : (v[e] * cs - o[e] * sn); }
    }
    if (QK_F8) {
      u32x4 w = {pack4_f8(v[0] * F8_SQK, v[1] * F8_SQK, v[2] * F8_SQK, v[3] * F8_SQK), pack4_f8(v[4] * F8_SQK, v[5] * F8_SQK, v[6] * F8_SQK, v[7] * F8_SQK),
                 pack4_f8(v[8] * F8_SQK, v[9] * F8_SQK, v[10] * F8_SQK, v[11] * F8_SQK), pack4_f8(v[12] * F8_SQK, v[13] * F8_SQK, v[14] * F8_SQK, v[15] * F8_SQK)};
      *(u32x4*)((unsigned char*)(ws + WS_KN) + (size_t)r * 1024 + lane * 16) = w;
    } else {
    bf16_t* op = (bf16_t*)(ws + WS_KN) + (size_t)r * 1024 + lane * 16;
    u32x4 o0 = {cvtpk(v[0], v[1]), cvtpk(v[2], v[3]), cvtpk(v[4], v[5]), cvtpk(v[6], v[7])}, o1 = {cvtpk(v[8], v[9]), cvtpk(v[10], v[11]), cvtpk(v[12], v[13]), cvtpk(v[14], v[15])};
    *(u32x4*)op = o0; *(u32x4*)(op + 8) = o1;
    }
  }
}

__device__ __forceinline__ void phase_conv_mid(const Params& p) {
  int tid = threadIdx.x; asm volatile("" : "+v"(tid));
  const int wid = tid >> 6, lane = tid & 63;
  const int gw = blockIdx.x * 8 + wid, nw = gridDim.x * 8;
  char* ws = opaque_ptr(p.ws); const float* cw = p.in[I_CONV_W];
  const bf16_t* bcu = (const bf16_t*)(ws + WS_BCU);
  for (int r = gw; r < R; r += nw) {
    const int b = r / RPB, ii = r - b * RPB; const bool is_ctx = ii < CTX;
    const bool hp = is_ctx ? (ii > 0) : (ii > CTX), hn = is_ctx ? (ii < CTX - 1) : (ii < RPB - 1);
    bf16_t* gp = (bf16_t*)(ws + WS_G) + (size_t)r * D;
#pragma unroll
    for (int q = 0; q < 4; ++q) {
      const int c = (lane + 64 * q) * 4;
      const bf16_t* row = bcu + (size_t)r * 3072 + c;
      const u32x2 bg = *(const u32x2*)row, c0 = *(const u32x2*)(row + 1024), u0 = *(const u32x2*)(row + 2048);
      u32x2 cp = {0u, 0u}, up = {0u, 0u}, cn = {0u, 0u}, un = {0u, 0u};
      if (hp) { cp = *(const u32x2*)(row - 3072 + 1024); up = *(const u32x2*)(row - 3072 + 2048); }
      if (hn) { cn = *(const u32x2*)(row + 3072 + 1024); un = *(const u32x2*)(row + 3072 + 2048); }
      const f32x4 w0 = *(const f32x4*)(cw + c), w1 = *(const f32x4*)(cw + D + c), w2 = *(const f32x4*)(cw + 2 * D + c);
      float z[4];
      z[0] = w0[0] * bflo(cp[0]) * bflo(up[0]) + w1[0] * bflo(c0[0]) * bflo(u0[0]) + w2[0] * bflo(cn[0]) * bflo(un[0]);
      z[1] = w0[1] * bfhi(cp[0]) * bfhi(up[0]) + w1[1] * bfhi(c0[0]) * bfhi(u0[0]) + w2[1] * bfhi(cn[0]) * bfhi(un[0]);
      z[2] = w0[2] * bflo(cp[1]) * bflo(up[1]) + w1[2] * bflo(c0[1]) * bflo(u0[1]) + w2[2] * bflo(cn[1]) * bflo(un[1]);
      z[3] = w0[3] * bfhi(cp[1]) * bfhi(up[1]) + w1[3] * bfhi(c0[1]) * bfhi(u0[1]) + w2[3] * bfhi(cn[1]) * bfhi(un[1]);
      u32x2 w = {cvtpk(bflo(bg[0]) * z[0], bfhi(bg[0]) * z[1]), cvtpk(bflo(bg[1]) * z[2], bfhi(bg[1]) * z[3])};
      *(u32x2*)(gp + c) = w;
    }
  }
}

constexpr int LI_OFF = 135168;
__device__ __forceinline__ void moe_prefix(const Params& p, int layer, int* li) {
  if (threadIdx.x == 0) { const int* cnt = (const int*)(p.ws + WS_CNT) + layer * ME; int o = 0, t = 0;
    for (int e = 0; e < ME; ++e) { li[e] = o; li[33 + e] = t; const int c = cnt[e]; o += c; t += (c + 127) >> 7; } li[32] = o; li[65] = t; }
  __syncthreads();
  { int t = threadIdx.x; asm volatile("" : "+v"(t));
    if (t < li[65]) { int e = 0;
#pragma unroll 1
      while (li[33 + e + 1] <= t) ++e;
      li[1024 + t] = e; } }
  __syncthreads();
}
struct MoeUnit { int e, ct, nvalid, slot0, lbase, ri0, ri1, par; };
template <bool DOWN>
struct MoeProv {
  char* ws; const int* li; const int* cnt; int layer; int* etab;
  typedef MoeUnit Unit;
  __device__ __forceinline__ bool unit(int it, Unit& U, int srow) const {
    const int un = blockIdx.x + it * gridDim.x;
    if (un >= li[65] * 4) return false;
    const int t = un >> 2, e = li[1024 + t];
    const int rt = t - li[33 + e];
    U.e = e; U.ct = un & 3; U.nvalid = min(128, cnt[e] - rt * 128); U.slot0 = li[e] + rt * 128; U.lbase = e * R + rt * 128;
    if (!DOWN) { const int* list = (const int*)(ws + WS_LIST) + U.lbase;
      U.ri0 = list[srow < U.nvalid ? srow : 0] >> 1; U.ri1 = list[srow + 64 < U.nvalid ? srow + 64 : 0] >> 1; }
    U.par = it % 3;
    if (DOWN) { int t_ = threadIdx.x; asm volatile("" : "+v"(t_));
      if (t_ < 128) { const int aid = ((const int*)(ws + WS_LIST))[U.lbase + (t_ < U.nvalid ? t_ : 0)];
        etab[(U.par * 128 + t_) * 2] = aid; etab[(U.par * 128 + t_) * 2 + 1] = __float_as_int(((const float*)(ws + WS_WTS))[aid]); } }
    return true;
  }
  static constexpr bool A_AFFINE = DOWN;
  static constexpr bool F8 = DOWN ? (MOE_F8 >= 2) : (MOE_F8 >= 1);
  static constexpr int KU = DOWN ? (F8 ? FF / 2 : FF) : (F8 ? D / 2 : D);
  __device__ __forceinline__ int a_stride(const Unit&) const { return 64 * KU; }
  __device__ __forceinline__ int b_stride(const Unit&) const { return 64 * KU; }
  __device__ __forceinline__ const bf16_t* a_row(const Unit& U, int r) const {
    if (DOWN) return (const bf16_t*)(ws + WS_HID) + (size_t)(U.slot0 + r) * KU;
    return (const bf16_t*)(ws + WS_ACT) + (size_t)(r < 64 ? U.ri0 : U.ri1) * KU;
  }
  __device__ __forceinline__ const bf16_t* b_row(const Unit& U, int r) const {
    const bf16_t* w = (const bf16_t*)(ws + WS_WMOE + (size_t)(layer * ME + U.e) * MOE_WBYTES);
    return (DOWN ? w + 1024 * 1024 : w) + (size_t)(U.ct * 256 + r) * KU;
  }
  __device__ __forceinline__ int nk(const Unit&) const { return KU / 64; }
  __device__ __forceinline__ void epi(const Unit& U, int r, int c, f32x4 v0, f32x4 v1, f32x4 v2, f32x4 v3) const {
    if (r >= U.nvalid) return;
    if (!DOWN) {
      if (F8) { constexpr float is = 1.0f / (F8_SA * F8_SW); v0 *= is; v1 *= is; v2 *= is; v3 *= is; }
      const float h0 = silu_f(v0[0]) * v0[1], h1 = silu_f(v0[2]) * v0[3], h2 = silu_f(v1[0]) * v1[1], h3 = silu_f(v1[2]) * v1[3],
                  h4 = silu_f(v2[0]) * v2[1], h5 = silu_f(v2[2]) * v2[3], h6 = silu_f(v3[0]) * v3[1], h7 = silu_f(v3[2]) * v3[3];
      if (MOE_F8 >= 2) {
        u32x2 o = {pack4_f8(h0 * F8_SH, h1 * F8_SH, h2 * F8_SH, h3 * F8_SH), pack4_f8(h4 * F8_SH, h5 * F8_SH, h6 * F8_SH, h7 * F8_SH)};
        *(u32x2*)((unsigned char*)(ws + WS_HID) + (size_t)(U.slot0 + r) * FF + ((U.ct * 256 + c) >> 1)) = o;
      } else {
        u32x4 o = {cvtpk(h0, h1), cvtpk(h2, h3), cvtpk(h4, h5), cvtpk(h6, h7)};
        *(u32x4*)((bf16_t*)(ws + WS_HID) + (size_t)(U.slot0 + r) * FF + ((U.ct * 256 + c) >> 1)) = o;
      }
    } else {
      const int aid = etab[(U.par * 128 + r) * 2]; float w = __int_as_float(etab[(U.par * 128 + r) * 2 + 1]);
      if (F8) w *= 1.0f / (F8_SH * F8_SWD);
      bf16_t* o = (bf16_t*)(ws + WS_Y) + (size_t)aid * D + U.ct * 256 + c;
      *(u32x4*)o = pack8(v0 * w, v1 * w); *(u32x4*)(o + 8) = pack8(v2 * w, v3 * w);
    }
  }
};
template <bool DOWN>
__device__ __forceinline__ void phase_moe(const Params& p, int layer, char* lds) {
  int* li = (int*)(lds + LI_OFF); moe_prefix(p, layer, li);
  char* ws = opaque_ptr(p.ws);
  MoeProv<DOWN> pv{ws, li, (const int*)(ws + WS_CNT) + layer * ME, layer, (int*)(lds + LI_OFF + 1024)};
  gemm_stream<8, MoeProv<DOWN>, 0, MoeProv<DOWN>::F8>(pv, lds);
}


template <int DK, int ldq, int ldv, int ldo>
__device__ __forceinline__ void attn_unit8(const bf16_t* __restrict__ Qb, const unsigned char* __restrict__ Kh8, const unsigned char* __restrict__ Kp8,
                                           const bf16_t* __restrict__ Vh, bf16_t* __restrict__ Ob, int nkeys, bool rope, int qpos0,
                                           const float* __restrict__ qg, char* lds) {
  using Cfg = AttnCfg<DK>;
  constexpr int KROW = Cfg::KROW, SHM_V = Cfg::SHM_V, SHM_K = Cfg::SHM_K, NS = DK / 64;
  static_assert(KROW == DK, "fp8 K rows");
  int tid = threadIdx.x; asm volatile("" : "+v"(tid));
  const int wid = tid >> 6, lane = tid & 63, r32 = lane & 31, hi = lane >> 5;
  char* V_lds = lds; char* K_lds = lds + 2 * SHM_V;
  float* wsl = (float*)(lds + 2 * SHM_V + 2 * SHM_K) + wid * 64; float* li_l = wsl; float* al_l = wsl + 32;
  float m_reg = -1e30f, l_reg = 0; f32x16 o[4] = {}; i32x8 qr8[NS];
  {
    const int qrow = wid * 32 + r32;
    const bf16_t* Qw = Qb + (size_t)qrow * ldq + hi * 32;
    float qv[NS][32];
#pragma unroll
    for (int s = 0; s < NS; ++s)
#pragma unroll
      for (int cqd = 0; cqd < 4; ++cqd) { const u32x4 w = *reinterpret_cast<const u32x4*>(Qw + s * 64 + cqd * 8);
#pragma unroll
        for (int e = 0; e < 4; ++e) { qv[s][cqd * 8 + 2 * e] = bflo(w[e]); qv[s][cqd * 8 + 2 * e + 1] = bfhi(w[e]); } }
    const int qpos = qpos0 + qrow; const float prow = (float)(qpos >> 6), pcol = (float)(qpos & 63);
    if constexpr (DK == 128) {
      float ss = 0.f;
#pragma unroll
      for (int s = 0; s < 2; ++s)
#pragma unroll
        for (int e = 0; e < 32; ++e) ss += qv[s][e] * qv[s][e];
      ss += __shfl_xor(ss, 32);
      const float rs = rsqrtf(ss * (1.0f / 128.0f) + EPS);
#pragma unroll
      for (int s = 0; s < 2; ++s)
#pragma unroll
        for (int e4 = 0; e4 < 8; ++e4) { const f32x4 g = *(const f32x4*)(qg + s * 64 + hi * 32 + e4 * 4);
#pragma unroll
          for (int e = 0; e < 4; ++e) qv[s][e4 * 4 + e] *= rs * g[e]; }
      if (rope) {
#pragma unroll
        for (int s = 0; s < 2; ++s) { const float pos = s ? pcol : prow;
#pragma unroll
          for (int e = 0; e < 32; ++e) { const float ang = pos * rope_invf(e, 32); const float cs = __cosf(ang), sn = __sinf(ang);
            const float own = qv[s][e], oth = __shfl_xor(own, 32);
            qv[s][e] = hi ? (oth * sn + own * cs) : (own * cs - oth * sn); } }
      }
    } else {
      if (rope) {
        const float pos = hi ? pcol : prow;
#pragma unroll
        for (int e = 0; e < 16; ++e) { const float ang = pos * rope_invf(e, 16); const float cs = __cosf(ang), sn = __sinf(ang);
          const float x1 = qv[2][e], x2 = qv[2][16 + e]; qv[2][e] = x1 * cs - x2 * sn; qv[2][16 + e] = x1 * sn + x2 * cs; }
      }
    }
#pragma unroll
    for (int s = 0; s < NS; ++s)
#pragma unroll
      for (int w8 = 0; w8 < 8; ++w8) qr8[s][w8] = (int)pack4_f8(qv[s][4 * w8] * F8_SQK, qv[s][4 * w8 + 1] * F8_SQK, qv[s][4 * w8 + 2] * F8_SQK, qv[s][4 * w8 + 3] * F8_SQK);
  }
  int kq0[NS], kq1[NS];
#pragma unroll
  for (int s = 0; s < NS; ++s) {
    if constexpr (DK == 192) { const int x = (r32 >> 2) & 3; kq0[s] = r32 * KROW + s * 64 + (((2 * hi) ^ x) << 4); kq1[s] = r32 * KROW + s * 64 + (((2 * hi + 1) ^ x) << 4); }
    else { const int x = (r32 >> 1) & 7; kq0[s] = r32 * KROW + (((4 * s + 2 * hi) ^ x) << 4); kq1[s] = r32 * KROW + (((4 * s + 2 * hi + 1) ^ x) << 4); }
  }
  const int sr = tid >> 4, sc = (tid & 15) * 8, vst0 = v_st(sr, sc), vst1 = v_st(32 + sr, sc);
  const int krow = tid >> 3, kch = tid & 7, prw = (tid >> 2) & 63, pch = tid & 3;
  const int kst = DK == 192 ? krow * KROW + (((kch & ~3) | ((kch & 3) ^ ((krow >> 2) & 3))) << 4) : krow * KROW + ((kch ^ ((krow >> 1) & 7)) << 4);
  const int pst = prw * KROW + ((8 | (pch ^ ((prw >> 2) & 3))) << 4);
  const int vb0 = (int)(uintptr_t)(LAS char*)V_lds + v_rd_base(lane);
  bf16x8 vs0, vs1; u32x4 ks, kp;
  const unsigned voff = sr * ldv + sc, koff = krow * 1024 + kch * 16, poff = prw * 64 + pch * 16;
#define SLOAD(k0) do { const bf16_t* Vt = Vh + (size_t)(k0) * ldv; \
    vs0 = *(const bf16x8*)(Vt + voff); vs1 = *(const bf16x8*)(Vt + 32 * ldv + voff); \
    ks = *(const u32x4*)(Kh8 + (size_t)(k0) * 1024 + koff); \
    if constexpr (DK == 192) { if (tid < 256) kp = *(const u32x4*)(Kp8 + (size_t)(k0) * 64 + poff); } } while (0)
#define SWRITE(b) do { *(bf16x8*)(V_lds + (b) * SHM_V + vst0) = vs0; *(bf16x8*)(V_lds + (b) * SHM_V + vst1) = vs1; \
    *(u32x4*)(K_lds + (b) * SHM_K + kst) = ks; \
    if constexpr (DK == 192) { if (tid < 256) *(u32x4*)(K_lds + (b) * SHM_K + pst) = kp; } } while (0)
#define RESC(a) do { if (__any((a) < 1.f)) { if (hi == 0) al_l[r32] = (a); asm volatile("s_waitcnt lgkmcnt(0)" ::: "memory"); \
    for (int d = 0; d < 4; ++d) for (int r = 0; r < 16; ++r) o[d][r] *= al_l[crow(r, hi)]; } } while (0)
#define QKT8(P0, P1, KS) do { P0 = f32x16{}; P1 = f32x16{}; \
    _Pragma("unroll") for (int s = 0; s < NS; ++s) { \
      const u32x4 a0l = *(const u32x4*)((KS) + kq0[s]), a0h = *(const u32x4*)((KS) + kq1[s]), a1l = *(const u32x4*)((KS) + kq0[s] + 32 * KROW), a1h = *(const u32x4*)((KS) + kq1[s] + 32 * KROW); \
      const i32x8 a0 = {(int)a0l[0], (int)a0l[1], (int)a0l[2], (int)a0l[3], (int)a0h[0], (int)a0h[1], (int)a0h[2], (int)a0h[3]}; \
      const i32x8 a1 = {(int)a1l[0], (int)a1l[1], (int)a1l[2], (int)a1l[3], (int)a1h[0], (int)a1h[1], (int)a1h[2], (int)a1h[3]}; \
      P0 = __builtin_amdgcn_mfma_scale_f32_32x32x64_f8f6f4(a0, qr8[s], P0, 0, 0, 0, 0x7f7f7f7f, 0, 0x7f7f7f7f); \
      P1 = __builtin_amdgcn_mfma_scale_f32_32x32x64_f8f6f4(a1, qr8[s], P1, 0, 0, 0, 0x7f7f7f7f, 0, 0x7f7f7f7f); } } while (0)
  f32x16 pA0, pA1, pB0, pB1; float mnA, mnB, alA, alB; bf16x8 pa0, pa1, pa2, pa3; const int NT = nkeys / 64;
  SLOAD(0); SWRITE(0); __syncthreads();
  QKT8(pA0, pA1, K_lds); partialSM<DK>(pA0, pA1, m_reg, mnA, alA);
  SLOAD(64); SWRITE(1); __syncthreads();
  for (int j = 1; j + 1 < NT; j += 2) {
    SBAR(); QKT8(pB0, pB1, K_lds + SHM_K);
    finishSM(pA0, pA1, alA, l_reg, pa0, pa1, pa2, pa3); SBAR();
    SLOAD((j + 1) * 64); SBAR();
    pv_d0(o, vb0, pa0, pa1, pa2, pa3); partialSM<DK>(pB0, pB1, m_reg, mnB, alB);
    __syncthreads(); SWRITE(0);
    RESC(alB); __syncthreads();
    SBAR(); QKT8(pA0, pA1, K_lds);
    finishSM(pB0, pB1, alB, l_reg, pa0, pa1, pa2, pa3); SBAR();
    SLOAD((j + 2) * 64); SBAR();
    pv_d0(o, vb0 + SHM_V, pa0, pa1, pa2, pa3); partialSM<DK>(pA0, pA1, m_reg, mnA, alA);
    __syncthreads(); SWRITE(1);
    RESC(alA); __syncthreads();
  }
  SBAR(); QKT8(pB0, pB1, K_lds + SHM_K);
  finishSM(pA0, pA1, alA, l_reg, pa0, pa1, pa2, pa3); SBAR();
  pv_d0(o, vb0, pa0, pa1, pa2, pa3); partialSM<DK>(pB0, pB1, m_reg, mnB, alB);
  __syncthreads(); RESC(alB);
  finishSM(pB0, pB1, alB, l_reg, pa0, pa1, pa2, pa3); SBAR();
  pv_d0(o, vb0 + SHM_V, pa0, pa1, pa2, pa3);
  if (hi == 0) li_l[r32] = l_reg; asm volatile("s_waitcnt lgkmcnt(0)" ::: "memory");
  float rli[16];
#pragma unroll
  for (int r = 0; r < 16; ++r) rli[r] = __builtin_amdgcn_rcpf(li_l[crow(r, hi)]);
  __syncthreads();
  if (WO_F8) {
    unsigned char* st = (unsigned char*)lds + wid * 4096;
#pragma unroll
    for (int r = 0; r < 16; ++r) { const int orow = crow(r, hi); const float s = rli[r] * F8_SO;
#pragma unroll
      for (int d0 = 0; d0 < 4; ++d0) st[orow * 128 + d0 * 32 + r32] = (unsigned char)(__builtin_amdgcn_cvt_pk_fp8_f32(fminf(fmaxf(o[d0][r] * s, -448.f), 448.f), 0.f, 0, false) & 0xff); }
    asm volatile("s_waitcnt lgkmcnt(0)" ::: "memory");
    unsigned char* Ow8 = (unsigned char*)Ob + (size_t)(wid * 32) * ldo;
#pragma unroll
    for (int ps = 0; ps < 4; ++ps) { const int row = ps * 8 + (lane >> 3), ch = (lane & 7) * 16;
      *(u32x4*)(Ow8 + (size_t)row * ldo + ch) = *(const u32x4*)(st + row * 128 + ch); }
  } else {
    bf16_t* Ow = Ob + (size_t)(wid * 32) * ldo;
#pragma unroll
    for (int r = 0; r < 16; ++r) { const int orow = crow(r, hi);
#pragma unroll
      for (int d0 = 0; d0 < 4; ++d0) Ow[(size_t)orow * ldo + d0 * 32 + r32] = (bf16_t)(cvtpk(o[d0][r] * rli[r], 0.f) & 0xffffu); }
  }
  __syncthreads();
#undef SLOAD
#undef SWRITE
#undef RESC
#undef QKT8
}

__device__ __forceinline__ void phase_attn_mla(const Params& p, bool ctx_out, char* lds) {
  char* ws = opaque_ptr(p.ws);
  const bf16_t* Q = (const bf16_t*)(ws + WS_Q); const bf16_t* KV = (const bf16_t*)(ws + WS_KV); const bf16_t* KPE = (const bf16_t*)(ws + WS_KPE); bf16_t* O = (bf16_t*)(ws + WS_O);
  const int x = blockIdx.x & 7, nloc = gridDim.x >> 3, nlat = NB * MLA_H * 2  , nctx = ctx_out ? 4 : 0;
  for (int lu = (blockIdx.x >> 3); lu < nlat + nctx; lu += nloc) {
    int b, h, q0, nkeys; bool rope;
    if (lu < nlat) { const int pair = x * 4 + (lu >> 4), qb = lu & 15; b = pair / MLA_H; h = pair % MLA_H; q0 = CTX + qb * 256; nkeys = RPB; rope = true; }
    else { const int pair = x * 4 + (lu - nlat); b = pair / MLA_H; h = pair % MLA_H; q0 = 0; nkeys = CTX; rope = false; }
    const size_t rb = (size_t)b * RPB;
    if (QK_F8) attn_unit8<192, 1536, 2048, 1024>(Q + (rb + q0) * 1536 + h * 192, (const unsigned char*)(ws + WS_K8) + rb * 1024 + h * 128, (const unsigned char*)(ws + WS_KPE8) + rb * ROPE,
                   KV + rb * 2048 + h * 256 + 128, WO_F8 ? (bf16_t*)((unsigned char*)O + (rb + q0) * 1024 + h * 128) : O + (rb + q0) * 1024 + h * 128, nkeys, rope, q0 - CTX, nullptr, lds);
    else attn_unit<192, 1536, 2048, 2048, 1024>(Q + (rb + q0) * 1536 + h * 192, KV + rb * 2048 + h * 256, KPE + rb * ROPE, KV + rb * 2048 + h * 256 + 128,
                   WO_F8 ? (bf16_t*)((unsigned char*)O + (rb + q0) * 1024 + h * 128) : O + (rb + q0) * 1024 + h * 128, nkeys, rope, q0 - CTX, nullptr, lds);
  }
}
__device__ __forceinline__ void phase_attn_gqa(const Params& p, char* lds) {
  char* ws = opaque_ptr(p.ws);
  const bf16_t* QKV = (const bf16_t*)(ws + WS_QKV); const bf16_t* KN = (const bf16_t*)(ws + WS_KN); bf16_t* O = (bf16_t*)(ws + WS_OG);
  const int x = blockIdx.x & 7, nloc = gridDim.x >> 3, nlat = 128, nctx = 8;
  for (int lu = (blockIdx.x >> 3); lu < nlat + nctx; lu += nloc) {
    int b, h, q0, nkeys; bool rope;
    if (lu < nlat) { const int pair = x * 8 + (lu >> 4), qb = lu & 15; b = pair / GH; h = pair % GH; q0 = CTX + qb * 256; nkeys = RPB; rope = true; }
    else { const int pair = x * 8 + (lu - nlat); b = pair / GH; h = pair % GH; q0 = 0; nkeys = CTX; rope = false; }
    const size_t rb = (size_t)b * RPB; const int kvh = h >> 1;
    if (QK_F8) attn_unit8<128, 4096, 4096, 2048>(QKV + (rb + q0) * 4096 + h * 128, (const unsigned char*)(ws + WS_KN) + rb * 1024 + kvh * 128, nullptr, QKV + rb * 4096 + 3072 + kvh * 128,
                   WO_F8 ? (bf16_t*)((unsigned char*)O + (rb + q0) * 2048 + h * 128) : O + (rb + q0) * 2048 + h * 128, nkeys, rope, q0 - CTX, p.in[I_GQA_QG], lds);
    else attn_unit<128, 4096, 1024, 4096, 2048>(QKV + (rb + q0) * 4096 + h * 128, KN + rb * 1024 + kvh * 128, nullptr, QKV + rb * 4096 + 3072 + kvh * 128,
                   WO_F8 ? (bf16_t*)((unsigned char*)O + (rb + q0) * 2048 + h * 128) : O + (rb + q0) * 2048 + h * 128, nkeys, rope, q0 - CTX, p.in[I_GQA_QG], lds);
  }
}


__device__ __forceinline__ void dbg_probe(const Params& p) {
  char* ws = opaque_ptr(p.ws);
  size_t off = 0, n = 0; bool is_bf = true;
  switch (DBG_PROBE) {
    case 1: off = WS_MODV; n = (size_t)4 * 5 * NMOD; is_bf = false; break;
    case 2: off = WS_ACT; n = (size_t)R * D; break;
    case 3: off = WS_C1; n = (size_t)R * 1024; is_bf = false; break;
    case 4: off = WS_CQ; n = (size_t)R * 512; break;
    case 5: off = WS_CKV; n = (size_t)R * 256; break;
    case 6: off = WS_KPE; n = (size_t)R * 64; break;
    case 7: off = WS_Q; n = (size_t)R * 1536; break;
    case 8: off = WS_KV; n = (size_t)R * 2048; break;
    case 9: off = WS_O; n = (size_t)R * 1024; break;
    case 10: off = WS_X32; n = (size_t)R * D; is_bf = XBF16; break;
    case 11: off = WS_WMLA; n = MLA_WBYTES / 2; break;
    default: break;
  }
  int bad = 0;
  for (size_t i = (size_t)blockIdx.x * NTHR + threadIdx.x; i < n; i += (size_t)gridDim.x * NTHR) {
    float v = is_bf ? bf2f(((const bf16_t*)(ws + off))[i]) : ((const float*)(ws + off))[i];
    if (!(fabsf(v) < 1e30f)) bad = 1;
  }
  if (bad) atomicOr((int*)(ws + WS_CNT) + 1000, 1);
}

constexpr int DYN_LDS = 143360;
extern __shared__ __attribute__((aligned(16))) char smem[];

__global__ void __launch_bounds__(NTHR, 2) fwd_megakernel(Params p) {
  cg::grid_group grid = cg::this_grid();
  char* lds = smem;
#define WSO() char* ws = opaque_ptr(p.ws)
  volatile LAS unsigned* xst = (volatile LAS unsigned*)(LAS char*)(smem + DYN_LDS - 16);
  if (threadIdx.x == 0) { xst[0] = 0u; xst[1] = 0u; }
  __syncthreads();
  const XcdBarrier xb = xcd_barrier_post((unsigned*)(p.ws + WS_BAR), xst);
#if DBG_TIME
  unsigned long long tc_prep = 0, tc_norm = 0, tc_gemm = 0, tc_mid = 0, tc_amla = 0, tc_agqa = 0, tc_moe1 = 0, tc_moe2 = 0, tc_sync = 0, tA, tB, tC;
#define PH(cat, ...) do { tA = __builtin_amdgcn_s_memrealtime(); __VA_ARGS__; tB = __builtin_amdgcn_s_memrealtime(); xcd_barrier(xb); tC = __builtin_amdgcn_s_memrealtime(); \
    tc_##cat += tC - tA; tc_sync += tC - tB; } while (0)
#else
#define PH(cat, ...) do { __VA_ARGS__; xcd_barrier(xb); } while (0)
#endif
#define PHD(cat, id, ...) do { PH(cat, __VA_ARGS__); if (DUP == id) PH(cat, __VA_ARGS__); } while (0)
#define PHR(...) do { if (DUP == 15) { xres_t* const DRYP = (xres_t*)(p.ws + WS_Y); PH(gemm, __VA_ARGS__); } { xres_t* const DRYP = nullptr; PH(gemm, __VA_ARGS__); } } while (0)
#if DBG_TIME
  tA = __builtin_amdgcn_s_memrealtime();
#endif
#pragma unroll 1
  for (int rep_ = 0; rep_ < (DUP == 18 ? 2 : 1); ++rep_) {
  if (rep_ == 1) xcd_barrier(xb);
  if (DBG_PROBE == 20 && threadIdx.x == 0) ((int*)(p.ws + WS_CNT))[1024 + blockIdx.x] = (int)xb.x;
  phase_prep(p, lds);
  if (p.out == nullptr) grid.sync();
  xcd_barrier(xb);
#if DBG_TIME
  tc_prep += __builtin_amdgcn_s_memrealtime() - tA;
#endif
  if (DUP == 12) { xcd_barrier(xb); phase_prep(p, lds); xcd_barrier(xb); }
  if (DBG_PROBE == 20 && blockIdx.x == 0 && threadIdx.x == 0) { const int* t = (const int*)(p.ws + WS_CNT) + 1024; int bad = 0, seen = 0;
    for (int i = 0; i < (int)gridDim.x; ++i) { if (t[i] != t[i & 7]) bad = 1; }
    for (int i = 0; i < 8; ++i) seen |= 1 << t[i];
    if (bad || seen != 0xff) ((int*)(p.ws + WS_CNT))[1000] = 1; }
  PH(prep, phase_modfin(p));
  if (DUP == 14) { for (int q = 0; q < 40; ++q) xcd_barrier(xb); }
  if (STOP_AFTER == 0) { phase_norm<2, false>(p, 0); return; }
#pragma unroll 1
  for (int layer = 0; layer < DEPTH; ++layer) {
    const int kind = layer % 3, j = layer / 3; const bool ctx_out = layer < DEPTH - 1;
    if (DUP == 17 && layer > 0) PH(norm, phase_norm<0, true, true>(p, layer));
    PH(norm, if (layer == 0) phase_norm<0, false>(p, layer); else phase_norm<0, true>(p, layer));
    if (DUP == 13 && layer == 0) { for (int q = 0; q < 4; ++q) PH(norm, phase_norm<0, false>(p, layer)); }
    if (kind == 0) {
      PHD(gemm, 1, { WSO(); const char* wb = ws + WS_WMLA + j * MLA_WBYTES;
        if (MIX_F8) gemm_dense<17, 2, false, EpiBf16, 0, true>((const bf16_t*)(ws + WS_ACT), D / 2, (const bf16_t*)(wb + MLA_W1T), 1024, D / 2, EpiBf16{(bf16_t*)(ws + WS_C1), 1024, 1.0f / 512.0f}, lds);
        else gemm_dense<17, 2, false>((const bf16_t*)(ws + WS_ACT), D, (const bf16_t*)(wb + MLA_W1T), 1024, D, EpiBf16{(bf16_t*)(ws + WS_C1), 1024}, lds); });
      PHD(mid, 2, phase_mla_mid(p, j));
      PHD(gemm, 3, { WSO(); const char* wb = ws + WS_WMLA + j * MLA_WBYTES;
        MlaUpProv<(MIX_F8 != 0)> pv{(const bf16_t*)(ws + WS_CQ), (const bf16_t*)(ws + WS_CKV), (const bf16_t*)(wb + MLA_WUQT), (const bf16_t*)(wb + MLA_WUKVT), (bf16_t*)(ws + WS_Q), (bf16_t*)(ws + WS_KV), (unsigned char*)(ws + WS_K8)};
        gemm_stream<17, MlaUpProv<(MIX_F8 != 0)>, 0, (MIX_F8 != 0)>(pv, lds); });
      PHD(amla, 4, phase_attn_mla(p, ctx_out, lds));
      PHR({ WSO(); const char* wb = ws + WS_WMLA + j * MLA_WBYTES;
        const EpiResid er{(xres_t*)(ws + WS_X32), (const float*)(ws + WS_MODV) + (size_t)layer * 5 * NMOD + 2 * D, DRYP, WO_F8 ? 1.0f / (F8_SO * F8_SW) : 1.0f};
        if (WO_F8) { if (ctx_out) gemm_dense<17, 2, false, EpiResid, 0, true>((const bf16_t*)(ws + WS_O), 512, (const bf16_t*)(wb + MLA_WOT), D, 512, er, lds);
          else gemm_dense<16, 2, true, EpiResid, 0, true>((const bf16_t*)(ws + WS_O), 512, (const bf16_t*)(wb + MLA_WOT), D, 512, er, lds); }
        else { if (ctx_out) gemm_dense<17, 2, false>((const bf16_t*)(ws + WS_O), 1024, (const bf16_t*)(wb + MLA_WOT), D, 1024, er, lds);
          else gemm_dense<16, 2, true>((const bf16_t*)(ws + WS_O), 1024, (const bf16_t*)(wb + MLA_WOT), D, 1024, er, lds); } });
    } else if (kind == 1) {
      PHD(gemm, 5, { WSO(); gemm_dense<17, 2, false>((const bf16_t*)(ws + WS_ACT), D, (const bf16_t*)(ws + WS_WCONV_IN), 3072, D, EpiBf16{(bf16_t*)(ws + WS_BCU), 3072}, lds); });
      if (DUP == 21) PH(gemm, { WSO(); gemm_dense<17, 2, false, EpiBf16, 1>((const bf16_t*)(ws + WS_ACT), D, (const bf16_t*)(ws + WS_WCONV_IN), 3072, D, EpiBf16{(bf16_t*)(ws + WS_G + (size_t)R * 1024 * 2), 3072}, lds); });
      if (DUP == 22) PH(gemm, { WSO(); gemm_dense<17, 2, false, EpiBf16, 2>((const bf16_t*)(ws + WS_ACT), D, (const bf16_t*)(ws + WS_WCONV_IN), 3072, D, EpiBf16{(bf16_t*)(ws + WS_G + (size_t)R * 1024 * 2), 3072}, lds); });
      if (DUP == 23) PH(gemm, { WSO(); gemm_dense<17, 2, false, EpiBf16, 0>((const bf16_t*)(ws + WS_ACT), D, (const bf16_t*)(ws + WS_WCONV_IN), 3072, D, EpiBf16{(bf16_t*)(ws + WS_G + (size_t)R * 1024 * 2), 3072}, lds); });
      PHD(mid, 6, phase_conv_mid(p));
      PHR({ WSO(); gemm_dense<17, 2, false>((const bf16_t*)(ws + WS_G), D, (const bf16_t*)(ws + WS_WCONV_OUT), D, D,
                                EpiResid{(xres_t*)(ws + WS_X32), (const float*)(ws + WS_MODV) + (size_t)layer * 5 * NMOD + 2 * D, DRYP}, lds); });
    } else {
      PHD(gemm, 7, { WSO(); if (MIX_F8) gemm_dense<17, 2, false, EpiBf16, 0, true>((const bf16_t*)(ws + WS_ACT), D / 2, (const bf16_t*)(ws + WS_WGQA_QKV), 4096, D / 2, EpiBf16{(bf16_t*)(ws + WS_QKV), 4096, 1.0f / 512.0f}, lds);
        else gemm_dense<17, 2, false>((const bf16_t*)(ws + WS_ACT), D, (const bf16_t*)(ws + WS_WGQA_QKV), 4096, D, EpiBf16{(bf16_t*)(ws + WS_QKV), 4096}, lds); });
      PHD(mid, 8, phase_gqa_k(p));
      PHD(agqa, 9, phase_attn_gqa(p, lds));
      PHR({ WSO(); if (WO_F8) gemm_dense<17, 2, false, EpiResid, 0, true>((const bf16_t*)(ws + WS_OG), 1024, (const bf16_t*)(ws + WS_WGQA_O), D, 1024,
                                EpiResid{(xres_t*)(ws + WS_X32), (const float*)(ws + WS_MODV) + (size_t)layer * 5 * NMOD + 2 * D, DRYP, 1.0f / (F8_SO * F8_SW)}, lds);
        else gemm_dense<17, 2, false>((const bf16_t*)(ws + WS_OG), 2048, (const bf16_t*)(ws + WS_WGQA_O), D, 2048,
                                EpiResid{(xres_t*)(ws + WS_X32), (const float*)(ws + WS_MODV) + (size_t)layer * 5 * NMOD + 2 * D, DRYP}, lds); });
    }
    if (STOP_AFTER == 2 * layer + 1) { if (DBG_PROBE) { dbg_probe(p); xcd_barrier(xb); } phase_norm<2, false>(p, 0); return; }
    if (DUP == 16) PH(norm, phase_norm<1, false, true>(p, layer));
    PH(norm, { if (MOE_JIT) phase_conv_moe(p, layer, lds); phase_norm<1, false>(p, layer); });
    PHD(moe1, 10, phase_moe<false>(p, layer, lds));
    PHD(moe2, 11, phase_moe<true>(p, layer, lds));
    if (STOP_AFTER == 2 * layer + 2) break;
  }
  }
#if DBG_TIME
  if (blockIdx.x == 0 && threadIdx.x == 0) {
    unsigned long long* d = (unsigned long long*)(p.ws + WS_CNT + 4096);
    d[0] = tc_prep; d[1] = tc_norm; d[2] = tc_gemm; d[3] = tc_mid; d[4] = tc_amla; d[5] = tc_agqa; d[6] = tc_moe1; d[7] = tc_moe2; d[8] = tc_sync;
  }
  xcd_barrier(xb);
#endif
  phase_norm<2, true>(p, 0);
}

extern "C" void kernel_launch(void* const* d_in, const int* in_sizes, int n_in, void* d_out, int out_size, void* d_ws, size_t ws_size,
                              hipStream_t stream) {
  static int grid_blocks = 0;
  if (!grid_blocks) {
    int dev = 0, cus = 0, per_cu = 0;
    (void)hipGetDevice(&dev);
    (void)hipDeviceGetAttribute(&cus, hipDeviceAttributeMultiprocessorCount, dev);
    (void)hipFuncSetAttribute((const void*)fwd_megakernel, hipFuncAttributeMaxDynamicSharedMemorySize, DYN_LDS);
    (void)hipOccupancyMaxActiveBlocksPerMultiprocessor(&per_cu, fwd_megakernel, NTHR, DYN_LDS);
    grid_blocks = per_cu >= 1 ? cus : 0;
    if (ws_size < WS_END || n_in != N_IN) { fprintf(stderr, "kernel_launch: ws %zu < %zu or n_in %d\n", ws_size, (size_t)WS_END, n_in); grid_blocks = 0; }
    if (!grid_blocks) { fprintf(stderr, "kernel_launch: cannot launch (per_cu %d)\n", per_cu); return; }
  }
  Params p{};
  for (int i = 0; i < N_IN; ++i) p.in[i] = (const float*)d_in[i];
  p.out = (float*)d_out; p.ws = (char*)d_ws;
  {
    char* ws = p.ws; int nj = 0;
    for (int j = 0; j < 2; ++j) {
      char* wb = ws + WS_WMLA + j * MLA_WBYTES;
      p.jobs[nj++] = TJob{p.in[I_MLA_WDQ] + (size_t)j * D * QL, (bf16_t*)(wb + MLA_W1T), D, QL, MIX_F8 ? 8 : 1, 0};
      p.jobs[nj++] = TJob{p.in[I_MLA_WDKV] + (size_t)j * D * 320, (bf16_t*)(wb + MLA_W1T), D, 320, MIX_F8 ? 8 : 1, 512};
      p.jobs[nj++] = TJob{p.in[I_MLA_WUQ] + (size_t)j * QL * 1536, (bf16_t*)(wb + MLA_WUQT), QL, 1536, MIX_F8 ? 8 : 1, 0};
      p.jobs[nj++] = TJob{p.in[I_MLA_WUKV] + (size_t)j * KVL * 2048, (bf16_t*)(wb + MLA_WUKVT), KVL, 2048, MIX_F8 ? 8 : 1, 0};
      p.jobs[nj++] = TJob{p.in[I_MLA_WO] + (size_t)j * 1024 * D, (bf16_t*)(wb + MLA_WOT), 1024, D, WO_F8 ? 8 : 1, 0};
    }
    p.jobs[nj++] = TJob{p.in[I_CONV_WIN], (bf16_t*)(ws + WS_WCONV_IN), D, 3072, 1, 0};
    p.jobs[nj++] = TJob{p.in[I_CONV_WOUT], (bf16_t*)(ws + WS_WCONV_OUT), D, D, 1, 0};
    p.jobs[nj++] = TJob{p.in[I_GQA_WQKV], (bf16_t*)(ws + WS_WGQA_QKV), D, 4096, MIX_F8 ? 8 : 1, 0};
    p.jobs[nj++] = TJob{p.in[I_GQA_WO], (bf16_t*)(ws + WS_WGQA_O), 2048, D, WO_F8 ? 8 : 1, 0};
  }
  (void)hipMemsetAsync((char*)d_ws + WS_BAR, 0, XCD_BAR_WORDS * 4, stream);
  void* args[] = {&p};
  hipError_t e = hipLaunchCooperativeKernel((void*)fwd_megakernel, dim3(grid_blocks), dim3(NTHR), args, DYN_LDS, stream);
  if (e != hipSuccess) fprintf(stderr, "cooperative launch failed: %s (grid %d)\n", hipGetErrorString(e), grid_blocks);
}
```

```cpp
#include <hip/hip_runtime.h>
#include <hip/hip_cooperative_groups.h>
#include <cstdio>
#include <cstdint>
namespace cg = cooperative_groups;

#ifndef DUP
#define DUP 0
#endif
#ifndef DBG_TIME
#define DBG_TIME 0
#endif
#ifndef DBG_T1
#define DBG_T1 0
#define DBG_T2 1
#endif
#ifndef DBG_PROBE
#define DBG_PROBE 0
#endif
#ifndef STOP_AFTER
#define STOP_AFTER 8
#endif

#ifndef PV_F8
#define PV_F8 1
#endif
#ifndef QK_F8
#define QK_F8 1
#endif
#ifndef WO_F8
#define WO_F8 1
#endif
#ifndef MIX_F8
#define MIX_F8 1
#endif
#ifndef MOE_F8
#define MOE_F8 2
#endif
constexpr float F8_SO = 64.0f;
constexpr float F8_SQK = 16.0f;
constexpr float F8_SP = 16.0f, F8_SV = 16.0f;
#define LAS __attribute__((address_space(3)))
typedef unsigned short bf16_t;
typedef short bf16x8 __attribute__((ext_vector_type(8)));
typedef short s16x4 __attribute__((ext_vector_type(4)));
typedef float f32x4 __attribute__((ext_vector_type(4)));
typedef float f32x16 __attribute__((ext_vector_type(16)));
typedef unsigned u32x4 __attribute__((ext_vector_type(4)));
typedef unsigned u32x2 __attribute__((ext_vector_type(2)));
typedef int i32x8 __attribute__((ext_vector_type(8)));

constexpr int D = 1024, NB = 4, SEQ = 4096, CTX = 256, RPB = SEQ + CTX, R = NB * RPB;
constexpr int DEPTH = 4, NMOD = 6 * D;
constexpr int MLA_H = 8, QL = 512, KVL = 256, NOPE = 128, ROPE = 64, MV = 128;
constexpr int GH = 16, GKV = 8, GD = 128;
constexpr int ME = 32, FF = 512;
constexpr float EPS = 1e-6f;
constexpr int NTHR = 512;

enum { I_X = 0, I_C, I_CTX, I_CCTX, I_WMOD, I_BMOD, I_NMG, I_NFG, I_MLA_WDQ, I_MLA_GQ, I_MLA_WUQ, I_MLA_WDKV, I_MLA_GKV, I_MLA_WUKV, I_MLA_WO,
       I_CONV_WIN, I_CONV_W, I_CONV_WOUT, I_GQA_WQKV, I_GQA_QG, I_GQA_KG, I_GQA_WO, I_MOE_WG, I_MOE_BG, I_MOE_WE, I_MOE_BE, I_MOE_GATE, I_MOE_UP, I_MOE_DOWN, I_FG, N_IN };

constexpr size_t al256(size_t x) { return (x + 255) / 256 * 256; }
constexpr size_t WS_BAR = 0;
constexpr size_t WS_CNT = 16384;
constexpr size_t WS_MODP = 16384 + 8192;
constexpr size_t WS_MODV = WS_MODP + (size_t)8 * 4 * 5 * NMOD * 4;
constexpr size_t WS_WTS = WS_MODV + (size_t)4 * 5 * NMOD * 4;
constexpr size_t WS_LIST = al256(WS_WTS + (size_t)2 * R * 4);
#ifndef XBF16
#define XBF16 1
#endif
constexpr size_t WS_X32 = al256(WS_LIST + (size_t)32 * R * 4);
constexpr size_t WS_ACT = WS_X32 + (size_t)R * D * (XBF16 ? 2 : 4);
constexpr size_t WS_HID = WS_ACT + (size_t)R * D * 2;
constexpr size_t WS_Y = WS_HID + (size_t)(2 * R + 256) * FF * 2;
constexpr size_t WS_MIX = WS_Y + (size_t)2 * R * D * 2;
constexpr size_t MIX_BYTES = (size_t)R * (1024 * 4 + 512 * 2 + 256 * 2 + 64 * 2 + 1536 * 2 + 2048 * 2 + 1024 * 2);
constexpr size_t WS_C1 = WS_MIX;
constexpr size_t WS_K8 = WS_C1 + (size_t)R * 2048;
constexpr size_t WS_KPE8 = WS_K8 + (size_t)R * 1024;
constexpr size_t WS_CQ = WS_C1 + (size_t)R * 1024 * 4;
constexpr size_t WS_CKV = WS_CQ + (size_t)R * 512 * 2;
constexpr size_t WS_KPE = WS_CKV + (size_t)R * 256 * 2;
constexpr size_t WS_Q = WS_KPE + (size_t)R * 64 * 2;
constexpr size_t WS_KV = WS_Q + (size_t)R * 1536 * 2;
constexpr size_t WS_O = WS_KV + (size_t)R * 2048 * 2;
constexpr size_t WS_QKV = WS_MIX;
constexpr size_t WS_KN = WS_QKV + (size_t)R * 4096 * 2;
constexpr size_t WS_OG = WS_KN + (size_t)R * 1024 * 2;
constexpr size_t WS_BCU = WS_MIX;
constexpr size_t WS_G = WS_BCU + (size_t)R * 3072 * 2;
static_assert(WS_OG + (size_t)R * 2048 * 2 <= WS_MIX + MIX_BYTES, "gqa scratch");
static_assert(WS_G + (size_t)R * 1024 * 2 <= WS_MIX + MIX_BYTES, "conv scratch");
constexpr size_t WS_WT = al256(WS_MIX + MIX_BYTES);
constexpr size_t MLA_W1T = 0, MLA_WUQT = MLA_W1T + (size_t)1024 * 1024 * 2, MLA_WUKVT = MLA_WUQT + (size_t)1536 * 512 * 2, MLA_WOT = MLA_WUKVT + (size_t)2048 * 256 * 2,
                 MLA_WBYTES = MLA_WOT + (size_t)1024 * 1024 * 2;
constexpr size_t WS_WMLA = WS_WT;
constexpr size_t WS_WCONV_IN = WS_WMLA + 2 * MLA_WBYTES;
constexpr size_t WS_WCONV_OUT = WS_WCONV_IN + (size_t)3072 * 1024 * 2;
constexpr size_t WS_WGQA_QKV = WS_WCONV_OUT + (size_t)1024 * 1024 * 2;
constexpr size_t WS_WGQA_O = WS_WGQA_QKV + (size_t)4096 * 1024 * 2;
constexpr size_t WS_WMOE = WS_WGQA_O + (size_t)1024 * 2048 * 2;
constexpr size_t MOE_WBYTES = (size_t)1024 * 1024 * 2 + (size_t)1024 * 512 * 2;
constexpr size_t WS_END = WS_WMOE + (size_t)DEPTH * ME * MOE_WBYTES;
static_assert(WS_END <= (size_t)1073741824, "workspace over 1 GiB");

struct TJob { const float* src; bf16_t* dst; int K, N, rmul, roff; };
struct Params {
  const float* in[N_IN];
  float* out;
  char* ws;
  TJob jobs[14];
};

typedef __bf16 bf16x2_t __attribute__((ext_vector_type(2)));
__device__ __forceinline__ unsigned cvtpk(float lo, float hi) { bf16x2_t v = {(__bf16)lo, (__bf16)hi}; return __builtin_bit_cast(unsigned, v); }
__device__ __forceinline__ unsigned pack4_f8(float a, float b, float c, float d) {
  int w = __builtin_amdgcn_cvt_pk_fp8_f32(fminf(fmaxf(a, -448.f), 448.f), fminf(fmaxf(b, -448.f), 448.f), 0, false);
  w = __builtin_amdgcn_cvt_pk_fp8_f32(fminf(fmaxf(c, -448.f), 448.f), fminf(fmaxf(d, -448.f), 448.f), w, true); return (unsigned)w; }
__device__ __forceinline__ float bf2f(unsigned short h) { return __uint_as_float((unsigned)h << 16); }
__device__ __forceinline__ float bflo(unsigned w) { return __uint_as_float(w << 16); }
__device__ __forceinline__ float bfhi(unsigned w) { return __uint_as_float(w & 0xffff0000u); }
#if XBF16
typedef bf16_t xres_t;
__device__ __forceinline__ f32x4 xload4(const xres_t* q) { const u32x2 w = *(const u32x2*)q; return (f32x4){bflo(w[0]), bfhi(w[0]), bflo(w[1]), bfhi(w[1])}; }
__device__ __forceinline__ void xstore4(xres_t* q, f32x4 v) { u32x2 w = {cvtpk(v[0], v[1]), cvtpk(v[2], v[3])}; *(u32x2*)q = w; }
#else
typedef float xres_t;
__device__ __forceinline__ f32x4 xload4(const xres_t* q) { return *(const f32x4*)q; }
__device__ __forceinline__ void xstore4(xres_t* q, f32x4 v) { *(f32x4*)q = v; }
#endif
__device__ __forceinline__ float wave_sum(float v) {
#pragma unroll
  for (int o = 32; o > 0; o >>= 1) v += __shfl_xor(v, o);
  return v;
}
__device__ __forceinline__ float silu_f(float x) { return x / (1.0f + __expf(-x)); }
__device__ __forceinline__ void glds16(const void* g, char* l) { __builtin_amdgcn_global_load_lds((const unsigned*)g, (LAS unsigned*)l, 16, 0, 0); }
__device__ __forceinline__ char* opaque_ptr(char* q) {
  unsigned lo = __builtin_amdgcn_readfirstlane((unsigned)(uintptr_t)q), hi = __builtin_amdgcn_readfirstlane((unsigned)((uintptr_t)q >> 32));
  asm volatile("" : "+s"(lo), "+s"(hi));
  return (char*)(((uintptr_t)hi << 32) | (uintptr_t)lo); }
__device__ __forceinline__ float rope_invf(int j, int half) { return exp2f(-(float)j * (13.287712379549449f / (float)half)); }


#define XB_TMO      128
#define XB_XCNT(j)  (256  + 64 * (j))
#define XB_XSUB(j)  (1280 + 64 * (j))
#define XB_XGEN(j)  (2304 + 64 * (j))
#define XB_TOP      3328
#define XB_TOPGEN   3392
#define XCD_BAR_WORDS 3456
#define XB_SPIN_CAP (1u << 22)
__device__ __forceinline__ unsigned xb_ld(unsigned* p)              { return __hip_atomic_load(p, __ATOMIC_RELAXED, __HIP_MEMORY_SCOPE_AGENT); }
__device__ __forceinline__ unsigned xb_add(unsigned* p, unsigned v) { return __hip_atomic_fetch_add(p, v, __ATOMIC_RELAXED, __HIP_MEMORY_SCOPE_AGENT); }
__device__ __forceinline__ unsigned xb_xcc_id() { return (unsigned)__builtin_amdgcn_s_getreg((3 << 11) | 20) & 0xFu; }
#define XB_SPIN(cond, bar) do { unsigned _sp = 0; while (cond) { __builtin_amdgcn_s_sleep(1); \
    if ((++_sp & 255u) == 0u) { if (xb_ld(&(bar)[XB_TMO])) break; if (_sp > XB_SPIN_CAP) { atomicAdd(&(bar)[XB_TMO], 1u); break; } } } } while (0)
struct XcdBarrier { unsigned* bar; unsigned x; volatile LAS unsigned* st; };
__device__ __forceinline__ XcdBarrier xcd_barrier_post(unsigned* bar, volatile LAS unsigned* st) {
  XcdBarrier b; b.bar = bar; b.x = xb_xcc_id(); b.st = st;
  if (threadIdx.x == 0) (void)xb_add(&bar[XB_XCNT(b.x)], 1u);
  return b;
}
__device__ __forceinline__ void xcd_barrier_complete(unsigned* bar, unsigned x, unsigned& nloc, unsigned& nx) {
  const unsigned G = gridDim.x * gridDim.y * gridDim.z;
  unsigned sum, cnt, mine, sp = 0u;
  for (;;) {
    sum = 0u; cnt = 0u; mine = 0u;
#pragma unroll
    for (unsigned j = 0; j < 16; ++j) { const unsigned c = xb_ld(&bar[XB_XCNT(j)]); sum += c; cnt += (c > 0u) ? 1u : 0u; mine = (j == x) ? c : mine; }
    if (sum == G) break;
    __builtin_amdgcn_s_sleep(1);
    if ((++sp & 255u) == 0u) { if (xb_ld(&bar[XB_TMO])) break; if (sp > XB_SPIN_CAP) { atomicAdd(&bar[XB_TMO], 1u); break; } }
  }
  nloc = mine > 0u ? mine : 1u; nx = cnt > 0u ? cnt : 1u;
}
__device__ __forceinline__ void xcd_barrier(const XcdBarrier& b) {
  asm volatile("s_waitcnt vmcnt(0)" ::: "memory");
  __syncthreads();
  if (threadIdx.x == 0) {
    unsigned* bar = b.bar;
    __builtin_amdgcn_s_waitcnt(0);
    unsigned nloc = b.st[0], nx = b.st[1];
    if (nloc == 0u) { xcd_barrier_complete(bar, b.x, nloc, nx); b.st[0] = nloc; b.st[1] = nx; }
    const unsigned old = xb_add(&bar[XB_XSUB(b.x)], 1u);
    const unsigned gen = old / nloc;
    if (old + 1u == (gen + 1u) * nloc) {
      __builtin_amdgcn_fence(__ATOMIC_RELEASE, "agent");
      asm volatile("s_waitcnt vmcnt(0)" ::: "memory");
      const unsigned og = xb_add(&bar[XB_TOP], 1u);
      const unsigned tg = og / nx;
      if (og + 1u == (tg + 1u) * nx) xb_add(&bar[XB_TOPGEN], 1u);
      else XB_SPIN(xb_ld(&bar[XB_TOPGEN]) == tg, bar);
      __builtin_amdgcn_fence(__ATOMIC_ACQUIRE, "agent");
      xb_add(&bar[XB_XGEN(b.x)], 1u);
      asm volatile("s_waitcnt vmcnt(0)" ::: "memory");
    } else {
      XB_SPIN(xb_ld(&bar[XB_XGEN(b.x)]) == gen, bar);
      __builtin_amdgcn_fence(__ATOMIC_ACQUIRE, "agent");
      asm volatile("s_waitcnt vmcnt(0)" ::: "memory");
    }
  }
  __syncthreads();
}

template <int MB, class Prov, int GMODE = 0, bool F8 = false>
__device__ __forceinline__ void gemm_stream(const Prov& pv, char* lds) {
  constexpr int BM = MB * 16, BN = 256, A_BYTES = BM * 128, STAGE = (BM + BN) * 128, AR = (BM + 63) / 64, BR = BN / 64, MB0 = (MB + 1) / 2, NW = 4;
  static_assert(2 * STAGE <= 135168, "GEMM LDS stages");
  int tid = threadIdx.x; asm volatile("" : "+v"(tid));
  const int wid = tid >> 6, lane = tid & 63, fr = lane & 15, fq = lane >> 4, wm = wid >> 2, wn = wid & 3;
  const int srow = tid >> 3, pc = tid & 7, lc = pc ^ (srow & 7);
  const int lds_base = (int)(uintptr_t)(LAS char*)lds;
  const int a_off = lds_base + (wm * MB0 * 16 + fr) * 128, b_off = lds_base + A_BYTES + (wn * 64 + fr) * 128;
  const int ch0 = (fq ^ (fr & 7)) * 16, ch1 = ((4 + fq) ^ (fr & 7)) * 16;
  const int bsrc = 16 * ((srow >> 2) & 3) + 4 * (srow >> 4) + (srow & 3);
  const bool lastm = (MB % 2 == 0) || wm == 0;
  typename Prov::Unit u, un;
  int it = 0;
  if (!pv.unit(it, u, srow)) return;
  constexpr int APN = Prov::A_AFFINE ? 1 : AR;
  const bf16_t* ap[APN]; const bf16_t* bp0; int astr = 0, bstr = 0;
#define GS_LOADPTR(U) do { _Pragma("unroll") for (int i = 0; i < APN; ++i) ap[i] = pv.a_row(U, srow + 64 * i) + lc * 8; \
    bp0 = pv.b_row(U, bsrc) + lc * 8; astr = pv.a_stride(U); bstr = pv.b_stride(U); } while (0)
#define GS_ISSUE(KO, BUF) do { char* base_ = lds + (BUF) * STAGE; \
    _Pragma("unroll") for (int i = 0; i < AR; ++i) if (AR * 64 == BM || srow + 64 * i < BM) glds16((Prov::A_AFFINE ? ap[0] + (size_t)i * astr : ap[i < APN ? i : 0]) + (KO), base_ + i * 8192 + tid * 16); \
    _Pragma("unroll") for (int i = 0; i < BR; ++i) glds16(bp0 + (size_t)i * bstr + (KO), base_ + A_BYTES + i * 8192 + tid * 16); } while (0)
#define GS_DSR(dst, addr) asm volatile("ds_read_b128 %0, %1" : "=v"(dst) : "v"(addr) : "memory")
  GS_LOADPTR(u); GS_ISSUE(0, 0);
  int buf = 0;
  for (;;) {
    const bool have_n = pv.unit(it + 1, un, srow);
    const int nk = pv.nk(u);
    f32x4 acc[MB0][NW];
#pragma unroll
    for (int m = 0; m < MB0; ++m)
#pragma unroll
      for (int n = 0; n < NW; ++n) acc[m][n] = (f32x4){0.f, 0.f, 0.f, 0.f};
#pragma unroll 1
    for (int kt = 0; kt < nk; ++kt) {
      asm volatile("s_waitcnt vmcnt(0)" ::: "memory");
      __syncthreads();
      if (GMODE != 2) { if (kt + 1 < nk) { GS_ISSUE((kt + 1) * 64, buf ^ 1); }
      else if (have_n) { GS_LOADPTR(un); GS_ISSUE(0, buf ^ 1); } }
      if (GMODE != 1 && F8) {
        constexpr int GS = MB0 > 4 ? 1 : 2, NG = (MB0 + GS - 1) / GS;
        const int sbo = buf * STAGE;
        const int cl = ((2 * fq) ^ (fr & 7)) * 16, chh = ((2 * fq + 1) ^ (fr & 7)) * 16;
        const int aaL = sbo + a_off + cl, aaH = sbo + a_off + chh, bbL = sbo + b_off + cl, bbH = sbo + b_off + chh;
        u32x4 fbl[NW], fbh[NW], fal[2][GS], fah[2][GS];
#define GS_DSR8(dst, addr) asm volatile("ds_read_b128 %0, %1" : "=v"(dst) : "v"(addr) : "memory")
#pragma unroll
        for (int n = 0; n < NW; ++n) { GS_DSR8(fbl[n], bbL + n * 2048); GS_DSR8(fbh[n], bbH + n * 2048); }
#pragma unroll
        for (int j = 0; j < GS; ++j) if (j < MB0) { GS_DSR8(fal[0][j], aaL + j * 2048); GS_DSR8(fah[0][j], aaH + j * 2048); }
#pragma unroll
        for (int g = 0; g < NG; ++g) {
          int nnext = 0;
          if (g + 1 < NG) {
#pragma unroll
            for (int j = 0; j < GS; ++j) { const int i = (g + 1) * GS + j; if (i < MB0) { GS_DSR8(fal[(g + 1) & 1][j], aaL + i * 2048); GS_DSR8(fah[(g + 1) & 1][j], aaH + i * 2048); nnext += 2; } }
          }
          if (nnext == 4) asm volatile("s_waitcnt lgkmcnt(4)" ::: "memory"); else if (nnext == 2) asm volatile("s_waitcnt lgkmcnt(2)" ::: "memory");
          else asm volatile("s_waitcnt lgkmcnt(0)" ::: "memory");
          __builtin_amdgcn_sched_barrier(0);
#pragma unroll
          for (int j = 0; j < GS; ++j) { const int m = g * GS + j;
            if (m < MB0 && (m < MB0 - 1 || lastm)) {
              const i32x8 av = {(int)fal[g & 1][j][0], (int)fal[g & 1][j][1], (int)fal[g & 1][j][2], (int)fal[g & 1][j][3], (int)fah[g & 1][j][0], (int)fah[g & 1][j][1], (int)fah[g & 1][j][2], (int)fah[g & 1][j][3]};
#pragma unroll
              for (int n = 0; n < NW; ++n) { const i32x8 bv = {(int)fbl[n][0], (int)fbl[n][1], (int)fbl[n][2], (int)fbl[n][3], (int)fbh[n][0], (int)fbh[n][1], (int)fbh[n][2], (int)fbh[n][3]};
                acc[m][n] = __builtin_amdgcn_mfma_scale_f32_16x16x128_f8f6f4(bv, av, acc[m][n], 0, 0, 0, 0x7f7f7f7f, 0, 0x7f7f7f7f); }
#pragma unroll
              for (int n = 0; n < NW; ++n) asm volatile("" : "+v"(acc[m][n]));
            } }
          __builtin_amdgcn_sched_barrier(0);
        }
#undef GS_DSR8
      }
      if (GMODE != 1 && !F8) {
        constexpr int NI = 2 * MB0, GS = 2, NG = (NI + GS - 1) / GS;
        const int sbo = buf * STAGE;
        const int aa0 = sbo + a_off + ch0, aa1 = sbo + a_off + ch1, bb0 = sbo + b_off + ch0, bb1 = sbo + b_off + ch1;
        bf16x8 fb[2][NW], fa[2][GS];
#pragma unroll
        for (int n = 0; n < NW; ++n) GS_DSR(fb[0][n], bb0 + n * 2048);
#pragma unroll
        for (int j = 0; j < GS; ++j) GS_DSR(fa[0][j], aa0 + j * 2048);
#pragma unroll
        for (int n = 0; n < NW; ++n) GS_DSR(fb[1][n], bb1 + n * 2048);
#pragma unroll
        for (int g = 0; g < NG; ++g) {
          int nnext = 0;
          if (g + 1 < NG) {
#pragma unroll
            for (int j = 0; j < GS; ++j) { const int i = (g + 1) * GS + j; if (i < NI) { GS_DSR(fa[(g + 1) & 1][j], (i / MB0 ? aa1 : aa0) + (i % MB0) * 2048); ++nnext; } }
          }
          if (g == 0) nnext += NW;
          if (nnext == 8) asm volatile("s_waitcnt lgkmcnt(8)" ::: "memory"); else if (nnext == 7) asm volatile("s_waitcnt lgkmcnt(7)" ::: "memory");
          else if (nnext == 6) asm volatile("s_waitcnt lgkmcnt(6)" ::: "memory"); else if (nnext == 5) asm volatile("s_waitcnt lgkmcnt(5)" ::: "memory");
          else if (nnext == 4) asm volatile("s_waitcnt lgkmcnt(4)" ::: "memory"); else if (nnext == 3) asm volatile("s_waitcnt lgkmcnt(3)" ::: "memory");
          else if (nnext == 2) asm volatile("s_waitcnt lgkmcnt(2)" ::: "memory"); else if (nnext == 1) asm volatile("s_waitcnt lgkmcnt(1)" ::: "memory");
          else asm volatile("s_waitcnt lgkmcnt(0)" ::: "memory");
          __builtin_amdgcn_sched_barrier(0);
#pragma unroll
          for (int j = 0; j < GS; ++j) { const int i = g * GS + j;
            if (i < NI) { const int m = i % MB0;
              if (m < MB0 - 1 || lastm) {
#pragma unroll
                for (int n = 0; n < NW; ++n) acc[m][n] = __builtin_amdgcn_mfma_f32_16x16x32_bf16(fb[i / MB0][n], fa[g & 1][j], acc[m][n], 0, 0, 0);
              } } }
          __builtin_amdgcn_sched_barrier(0);
        }
      }
      buf ^= 1;
    }
#pragma unroll
    for (int m = 0; m < MB0; ++m) if (m < MB0 - 1 || lastm) {
      pv.epi(u, (wm * MB0 + m) * 16 + fr, wn * 64 + fq * 16, acc[m][0], acc[m][1], acc[m][2], acc[m][3]);
    }
    if (!have_n) break;
    u = un; ++it;
  }
  __syncthreads();
#undef GS_LOADPTR
#undef GS_ISSUE
#undef GS_DSR
}

__device__ __forceinline__ u32x4 pack8(f32x4 a, f32x4 b) { return (u32x4){cvtpk(a[0], a[1]), cvtpk(a[2], a[3]), cvtpk(b[0], b[1]), cvtpk(b[2], b[3])}; }
struct EpiBf16 { bf16_t* C; int ldc; float sc = 1.0f; __device__ __forceinline__ void operator()(int r, int c, f32x4 v0, f32x4 v1, f32x4 v2, f32x4 v3) const {
  bf16_t* o = C + (size_t)r * ldc + c; *(u32x4*)o = pack8(v0 * sc, v1 * sc); *(u32x4*)(o + 8) = pack8(v2 * sc, v3 * sc); } };
struct EpiResid { xres_t* X; const float* gate; xres_t* dry; float sc = 1.0f;
  __device__ __forceinline__ void half8(int row, int c, int bsel, f32x4 v0, f32x4 v1) const {
    const f32x4 g0 = *(const f32x4*)(gate + (size_t)bsel * NMOD + c), g1 = *(const f32x4*)(gate + (size_t)bsel * NMOD + c + 4);
#if XBF16
    const u32x4 xw = *(const u32x4*)(X + (size_t)row * D + c);
    f32x4 x0 = {bflo(xw[0]), bfhi(xw[0]), bflo(xw[1]), bfhi(xw[1])}, x1 = {bflo(xw[2]), bfhi(xw[2]), bflo(xw[3]), bfhi(xw[3])};
    x0 += g0 * v0; x1 += g1 * v1;
    *(u32x4*)((dry ? dry : X) + (size_t)row * D + c) = pack8(x0, x1);
#else
    f32x4 x0 = xload4(X + (size_t)row * D + c), x1 = xload4(X + (size_t)row * D + c + 4); x0 += g0 * v0; x1 += g1 * v1;
    xstore4((dry ? dry : X) + (size_t)row * D + c, x0); xstore4((dry ? dry : X) + (size_t)row * D + c + 4, x1);
#endif
  }
  __device__ __forceinline__ void operator()(int row, int c, f32x4 v0, f32x4 v1, f32x4 v2, f32x4 v3) const {
    const int b = row / RPB, ii = row - b * RPB, bsel = ii < CTX ? 4 : b;
    half8(row, c, bsel, v0 * sc, v1 * sc); half8(row, c + 8, bsel, v2 * sc, v3 * sc); } };

template <int BM, int BN, bool LATONLY, class Epi>
struct DenseProv {
  const bf16_t* A; int lda; const bf16_t* Bt; int K; int nNt; Epi ep;
  struct Unit { int m0, n0; };
  __device__ __forceinline__ bool unit(int it, Unit& U, int) const {
    const int nloc = gridDim.x >> 3, x = blockIdx.x & 7, loc = (blockIdx.x >> 3) + nloc * it;
    if (loc >= 8 * nNt) return false;
    const int mt = x * 8 + (loc & 7), nt = loc >> 3;
    U.m0 = LATONLY ? (mt >> 4) * RPB + CTX + (mt & 15) * 256 : mt * BM; U.n0 = nt * BN; return true;
  }
  static constexpr bool A_AFFINE = true;
  __device__ __forceinline__ int a_stride(const Unit&) const { return 64 * lda; }
  __device__ __forceinline__ int b_stride(const Unit&) const { return 64 * K; }
  __device__ __forceinline__ const bf16_t* a_row(const Unit& U, int r) const { return A + (size_t)(U.m0 + r) * lda; }
  __device__ __forceinline__ const bf16_t* b_row(const Unit& U, int r) const { return Bt + (size_t)(U.n0 + r) * K; }
  __device__ __forceinline__ int nk(const Unit&) const { return K >> 6; }
  __device__ __forceinline__ void epi(const Unit& U, int r, int c, f32x4 v0, f32x4 v1, f32x4 v2, f32x4 v3) const { ep(U.m0 + r, U.n0 + c, v0, v1, v2, v3); }
};
template <int MB, int NBW, bool LATONLY, class Epi, int GMODE = 0, bool F8 = false>
__device__ __forceinline__ void gemm_dense(const bf16_t* A, int lda, const bf16_t* Bt, int N, int K, const Epi& ep, char* lds) {
  static_assert(NBW == 2, "256-column tiles");
  DenseProv<MB * 16, 256, LATONLY, Epi> pv{A, lda, Bt, K, N / 256, ep};
  gemm_stream<MB, DenseProv<MB * 16, 256, LATONLY, Epi>, GMODE, F8>(pv, lds);
}

template <bool F8>
struct MlaUpProv {
  const bf16_t* CQ; const bf16_t* CKV; const bf16_t* WUQ; const bf16_t* WUKV; bf16_t* Q; bf16_t* KV; unsigned char* K8;
  static constexpr int QU = F8 ? QL / 2 : QL, KU = F8 ? KVL / 2 : KVL;
  struct Unit { int m0, n0, which; };
  __device__ __forceinline__ bool unit(int it, Unit& U, int) const {
    const int b = blockIdx.x; int which, t;
    if (b < 128) { if (it > 2) return false; which = it == 2; t = it == 2 ? b : 2 * b + it; }
    else { if (it > 3) return false; which = it != 0; t = it == 0 ? 256 + (b - 128) : 128 + 3 * (b - 128) + (it - 1); }
    U.which = which;
    if (which) { U.m0 = (t >> 3) * 272; U.n0 = (t & 7) * 256; } else { U.m0 = (t / 6) * 272; U.n0 = (t % 6) * 256; }
    return true;
  }
  static constexpr bool A_AFFINE = true;
  __device__ __forceinline__ int a_stride(const Unit& U) const { return U.which ? 64 * KU : 64 * QU; }
  __device__ __forceinline__ int b_stride(const Unit& U) const { return U.which ? 64 * KU : 64 * QU; }
  __device__ __forceinline__ const bf16_t* a_row(const Unit& U, int r) const { return U.which ? CKV + (size_t)(U.m0 + r) * KU : CQ + (size_t)(U.m0 + r) * QU; }
  __device__ __forceinline__ const bf16_t* b_row(const Unit& U, int r) const { return U.which ? WUKV + (size_t)(U.n0 + r) * KU : WUQ + (size_t)(U.n0 + r) * QU; }
  __device__ __forceinline__ int nk(const Unit& U) const { return U.which ? KU / 64 : QU / 64; }
  __device__ __forceinline__ void epi(const Unit& U, int r, int c, f32x4 v0, f32x4 v1, f32x4 v2, f32x4 v3) const {
    if (F8) { constexpr float is = 1.0f / 512.0f; v0 *= is; v1 *= is; v2 *= is; v3 *= is; }
    bf16_t* o = U.which ? KV + (size_t)(U.m0 + r) * 2048 + U.n0 + c : Q + (size_t)(U.m0 + r) * 1536 + U.n0 + c; *(u32x4*)o = pack8(v0, v1); *(u32x4*)(o + 8) = pack8(v2, v3);
    if (QK_F8 && U.which) { const int col = U.n0 + c, hd = col >> 8, wi = col & 255;
      if (wi < 128) { u32x4 w = {pack4_f8(v0[0] * F8_SQK, v0[1] * F8_SQK, v0[2] * F8_SQK, v0[3] * F8_SQK), pack4_f8(v1[0] * F8_SQK, v1[1] * F8_SQK, v1[2] * F8_SQK, v1[3] * F8_SQK),
                                 pack4_f8(v2[0] * F8_SQK, v2[1] * F8_SQK, v2[2] * F8_SQK, v2[3] * F8_SQK), pack4_f8(v3[0] * F8_SQK, v3[1] * F8_SQK, v3[2] * F8_SQK, v3[3] * F8_SQK)};
        *(u32x4*)(K8 + (size_t)(U.m0 + r) * 1024 + hd * 128 + wi) = w; } } }
};

template <int DK> struct AttnCfg {
  static constexpr int KROW = DK * (QK_F8 ? 1 : 2);
  static constexpr int SHM_V = 64 * 128 * ((QK_F8 && PV_F8) ? 1 : 2), SHM_K = 64 * KROW;
  static constexpr int SHM = 2 * SHM_V + 2 * SHM_K + 8 * 64 * 4;
};
#define SBAR() __builtin_amdgcn_sched_barrier(0)
__device__ __forceinline__ int crow(int r, int hi) { return (r & 3) + 8 * (r >> 2) + 4 * hi; }
__device__ __forceinline__ int v_st(int k, int c) { const int kk = (k & ~0xC) | ((k & 4) << 1) | ((k & 8) >> 1); return ((kk >> 3) * 4 + (c >> 5)) * 512 + ((kk & 7) * 32 + (c & 31)) * 2; }
__device__ __forceinline__ int v_rd_base(int lane) { return ((lane & 3) << 3) | (((lane >> 2) & 3) << 6) | (((lane >> 4) & 1) << 5) | (((lane >> 5) & 1) << 8); }
constexpr int v_rd_off(int d0, int ks, int half) { return d0 * 512 + ks * 4096 + half * 2048; }
template <int OFF> __device__ __forceinline__ s16x4 tr_read(int vb) {
  s16x4 r; asm volatile("ds_read_b64_tr_b16 %0, %1 offset:%2" : "=&v"(r) : "v"(vb), "i"(OFF) : "memory"); return r;
}
template <int D0> __device__ __forceinline__ void pv_one(f32x16& od, int vb, bf16x8 pa0, bf16x8 pa1, bf16x8 pa2, bf16x8 pa3) {
  const s16x4 l0 = tr_read<v_rd_off(D0, 0, 0)>(vb), h0 = tr_read<v_rd_off(D0, 0, 1)>(vb), l1 = tr_read<v_rd_off(D0, 1, 0)>(vb), h1 = tr_read<v_rd_off(D0, 1, 1)>(vb);
  const s16x4 l2 = tr_read<v_rd_off(D0, 2, 0)>(vb), h2 = tr_read<v_rd_off(D0, 2, 1)>(vb), l3 = tr_read<v_rd_off(D0, 3, 0)>(vb), h3 = tr_read<v_rd_off(D0, 3, 1)>(vb);
  asm volatile("s_waitcnt lgkmcnt(0)" ::: "memory"); SBAR();
#define PK(L, H) (bf16x8){L[0], L[1], L[2], L[3], H[0], H[1], H[2], H[3]}
  od = __builtin_amdgcn_mfma_f32_32x32x16_bf16(pa0, PK(l0, h0), od, 0, 0, 0);
  od = __builtin_amdgcn_mfma_f32_32x32x16_bf16(pa1, PK(l1, h1), od, 0, 0, 0);
  od = __builtin_amdgcn_mfma_f32_32x32x16_bf16(pa2, PK(l2, h2), od, 0, 0, 0);
  od = __builtin_amdgcn_mfma_f32_32x32x16_bf16(pa3, PK(l3, h3), od, 0, 0, 0);
#undef PK
}
__device__ __forceinline__ void pv_d0(f32x16* o, int vb, bf16x8 pa0, bf16x8 pa1, bf16x8 pa2, bf16x8 pa3) {
  pv_one<0>(o[0], vb, pa0, pa1, pa2, pa3); pv_one<1>(o[1], vb, pa0, pa1, pa2, pa3); pv_one<2>(o[2], vb, pa0, pa1, pa2, pa3); pv_one<3>(o[3], vb, pa0, pa1, pa2, pa3);
}
constexpr float ATT_THR = (QK_F8 && PV_F8) ? 3.f : 8.f;
template <int DK> __device__ __forceinline__ void partialSM(f32x16& p0, f32x16& p1, float& m_reg, float& mn, float& alpha) {
  constexpr float SCALE = (DK == 192 ? 0.07216878364870322f : 0.08838834764831845f) * (QK_F8 ? 1.0f / (F8_SQK * F8_SQK) : 1.0f);
  constexpr float C = SCALE * 1.4426950408889634f;
  float pmax = p0[0];
#pragma unroll
  for (int r = 1; r < 16; ++r) pmax = fmaxf(pmax, p0[r]);
#pragma unroll
  for (int r = 0; r < 16; ++r) pmax = fmaxf(pmax, p1[r]);
  { auto rr = __builtin_amdgcn_permlane32_swap(__float_as_uint(pmax), __float_as_uint(pmax), false, false);
    pmax = fmaxf(__uint_as_float(rr[0]), __uint_as_float(rr[1])); }
  if (__builtin_expect(__all(pmax - m_reg <= ATT_THR / SCALE), 1)) { mn = m_reg; alpha = 1.f; }
  else { mn = fmaxf(m_reg, pmax); alpha = __builtin_amdgcn_exp2f((m_reg - mn) * C); m_reg = mn; }
  const float mnC = -mn * C + ((QK_F8 && PV_F8) ? 4.0f : 0.0f);
#pragma unroll
  for (int r = 0; r < 16; ++r) p0[r] = fmaf(p0[r], C, mnC);
#pragma unroll
  for (int r = 0; r < 16; ++r) p1[r] = fmaf(p1[r], C, mnC);
#pragma unroll
  for (int r = 0; r < 16; ++r) p0[r] = __builtin_amdgcn_exp2f(p0[r]);
}
__device__ __forceinline__ void finishSM(f32x16& p0, f32x16& p1, float alpha, float& l_reg, bf16x8& pa0, bf16x8& pa1, bf16x8& pa2, bf16x8& pa3) {
#pragma unroll
  for (int r = 0; r < 16; ++r) p1[r] = __builtin_amdgcn_exp2f(p1[r]);
  float ps = 0;
#pragma unroll
  for (int r = 0; r < 16; ++r) ps += p0[r];
#pragma unroll
  for (int r = 0; r < 16; ++r) ps += p1[r];
  { auto rr = __builtin_amdgcn_permlane32_swap(__float_as_uint(ps), __float_as_uint(ps), false, false);
    ps = __uint_as_float(rr[0]) + __uint_as_float(rr[1]); }
  l_reg = l_reg * alpha + ps;
#define PK4(P, BASE, OUT) do { unsigned a0 = cvtpk(P[BASE + 0], P[BASE + 1]), a1 = cvtpk(P[BASE + 2], P[BASE + 3]);   \
    unsigned b0 = cvtpk(P[BASE + 4], P[BASE + 5]), b1 = cvtpk(P[BASE + 6], P[BASE + 7]);                              \
    auto r0 = __builtin_amdgcn_permlane32_swap(a0, b0, false, false); auto r1 = __builtin_amdgcn_permlane32_swap(a1, b1, false, false); \
    u32x4 w = {r0[0], r1[0], r0[1], r1[1]}; OUT = *reinterpret_cast<bf16x8*>(&w); } while (0)
  PK4(p0, 0, pa0); PK4(p0, 8, pa1); PK4(p1, 0, pa2); PK4(p1, 8, pa3);
#undef PK4
}
template <int DK> __device__ __forceinline__ void qkt(f32x16& p0, f32x16& p1, const char* Ks, const bf16x8* qr, const int* kro) {
  constexpr int KROW = DK * 2;
  p0 = f32x16{}; p1 = f32x16{};
#pragma unroll
  for (int d0 = 0; d0 < DK / 16; ++d0) {
    bf16x8 b0 = *reinterpret_cast<const bf16x8*>(Ks + kro[d0 & 3] + (d0 >> 2) * 128);
    bf16x8 b1 = *reinterpret_cast<const bf16x8*>(Ks + kro[d0 & 3] + (d0 >> 2) * 128 + 32 * KROW);
    p0 = __builtin_amdgcn_mfma_f32_32x32x16_bf16(b0, qr[d0], p0, 0, 0, 0);
    p1 = __builtin_amdgcn_mfma_f32_32x32x16_bf16(b1, qr[d0], p1, 0, 0, 0); }
}

template <int DK, int ldq, int ldk, int ldv, int ldo>
__device__ __forceinline__ void attn_unit(const bf16_t* __restrict__ Qb, const bf16_t* __restrict__ Kh, const bf16_t* __restrict__ Kp,
                                          const bf16_t* __restrict__ Vh, bf16_t* __restrict__ Ob, int nkeys, bool rope, int qpos0,
                                          const float* __restrict__ qg, char* lds) {
  using Cfg = AttnCfg<DK>;
  constexpr int KROW = Cfg::KROW, SHM_V = Cfg::SHM_V, SHM_K = Cfg::SHM_K, ND0 = DK / 16;
  int tid = threadIdx.x; asm volatile("" : "+v"(tid));
  const int wid = tid >> 6, lane = tid & 63, r32 = lane & 31, hi = lane >> 5;
  char* V_lds = lds; char* K_lds = lds + 2 * SHM_V;
  float* wsl = (float*)(lds + 2 * SHM_V + 2 * SHM_K) + wid * 64; float* li_l = wsl; float* al_l = wsl + 32;
  float m_reg = -1e30f, l_reg = 0; f32x16 o[4] = {}; bf16x8 qr[ND0];
  {
    const int qrow = wid * 32 + r32;
    const bf16_t* Qw = Qb + (size_t)qrow * ldq + hi * 8;
    float qf[ND0][8];
#pragma unroll
    for (int d0 = 0; d0 < ND0; ++d0) { const u32x4 w = *reinterpret_cast<const u32x4*>(Qw + d0 * 16);
#pragma unroll
      for (int e = 0; e < 4; ++e) { qf[d0][2 * e] = bflo(w[e]); qf[d0][2 * e + 1] = bfhi(w[e]); } }
    const int qpos = qpos0 + qrow; const float prow = (float)(qpos >> 6), pcol = (float)(qpos & 63);
    int hio = hi; asm volatile("" : "+v"(hio));
    if constexpr (DK == 128) {
      float ss = 0.f;
#pragma unroll
      for (int d0 = 0; d0 < 8; ++d0)
#pragma unroll
        for (int e = 0; e < 8; ++e) ss += qf[d0][e] * qf[d0][e];
      ss += __shfl_xor(ss, 32);
      const float rs = rsqrtf(ss * (1.0f / 128.0f) + EPS);
#pragma unroll
      for (int d0 = 0; d0 < 8; ++d0) { const f32x4 g0 = *(const f32x4*)(qg + d0 * 16 + hi * 8), g1 = *(const f32x4*)(qg + d0 * 16 + hi * 8 + 4);
#pragma unroll
        for (int e = 0; e < 4; ++e) { qf[d0][e] *= rs * g0[e]; qf[d0][4 + e] *= rs * g1[e]; } }
      if (rope) {
#pragma unroll
        for (int hf = 0; hf < 2; ++hf) { const float pos = hf ? pcol : prow;
#pragma unroll
          for (int dd = 0; dd < 2; ++dd)
#pragma unroll
            for (int e = 0; e < 8; ++e) { const int j = dd * 16 + hio * 8 + e; const float ang = pos * rope_invf(j, 32); const float cs = __cosf(ang), sn = __sinf(ang);
              const float x1 = qf[hf * 4 + dd][e], x2 = qf[hf * 4 + dd + 2][e]; qf[hf * 4 + dd][e] = x1 * cs - x2 * sn; qf[hf * 4 + dd + 2][e] = x1 * sn + x2 * cs; } }
      }
    } else {
      if (rope) {
#pragma unroll
        for (int hf = 0; hf < 2; ++hf) { const float pos = hf ? pcol : prow;
#pragma unroll
          for (int e = 0; e < 8; ++e) { const int j = hio * 8 + e; const float ang = pos * rope_invf(j, 16); const float cs = __cosf(ang), sn = __sinf(ang);
            const float x1 = qf[8 + hf * 2][e], x2 = qf[9 + hf * 2][e]; qf[8 + hf * 2][e] = x1 * cs - x2 * sn; qf[9 + hf * 2][e] = x1 * sn + x2 * cs; } }
      }
    }
#pragma unroll
    for (int d0 = 0; d0 < ND0; ++d0) { u32x4 w = {cvtpk(qf[d0][0], qf[d0][1]), cvtpk(qf[d0][2], qf[d0][3]), cvtpk(qf[d0][4], qf[d0][5]), cvtpk(qf[d0][6], qf[d0][7])};
      qr[d0] = *reinterpret_cast<bf16x8*>(&w); }
  }
  int kro[4];
#pragma unroll
  for (int bq = 0; bq < 4; ++bq) kro[bq] = r32 * KROW + (((2 * bq + hi) ^ (r32 & 7)) << 4);
  const int sr = tid >> 4, sc = (tid & 15) * 8, vst0 = v_st(sr, sc), vst1 = v_st(32 + sr, sc);
  const int pr = tid >> 3, pcc = (tid & 7) * 8;
  const int vb0 = (int)(uintptr_t)(LAS char*)V_lds + v_rd_base(lane);
  bf16x8 vs0, vs1, ks0, ks1, kp0;
  const unsigned voff = sr * ldv + sc, koff = sr * ldk + sc, poff = pr * ROPE + pcc;
#define SLOAD(k0) do { const bf16_t* Vt = Vh + (size_t)(k0) * ldv; const bf16_t* Kt = Kh + (size_t)(k0) * ldk; \
    vs0 = *(const bf16x8*)(Vt + voff); vs1 = *(const bf16x8*)(Vt + 32 * ldv + voff); \
    ks0 = *(const bf16x8*)(Kt + koff); ks1 = *(const bf16x8*)(Kt + 32 * ldk + koff); \
    if constexpr (DK == 192) kp0 = *(const bf16x8*)(Kp + (size_t)(k0) * ROPE + poff); } while (0)
#define SWRITE(b) do { *(bf16x8*)(V_lds + (b) * SHM_V + vst0) = vs0; *(bf16x8*)(V_lds + (b) * SHM_V + vst1) = vs1; const int kc = sc * 2; \
    *(bf16x8*)(K_lds + (b) * SHM_K + sr * KROW + (kc ^ ((sr & 7) << 4))) = ks0; \
    *(bf16x8*)(K_lds + (b) * SHM_K + (32 + sr) * KROW + (kc ^ ((sr & 7) << 4))) = ks1; \
    if constexpr (DK == 192) *(bf16x8*)(K_lds + (b) * SHM_K + pr * KROW + ((256 + pcc * 2) ^ ((pr & 7) << 4))) = kp0; } while (0)
#define RESC(a) do { if (__any((a) < 1.f)) { if (hi == 0) al_l[r32] = (a); asm volatile("s_waitcnt lgkmcnt(0)" ::: "memory"); \
    for (int d = 0; d < 4; ++d) for (int r = 0; r < 16; ++r) o[d][r] *= al_l[crow(r, hi)]; } } while (0)
  f32x16 pA0, pA1, pB0, pB1; float mnA, mnB, alA, alB; bf16x8 pa0, pa1, pa2, pa3; const int NT = nkeys / 64;
  SLOAD(0); SWRITE(0); __syncthreads();
  qkt<DK>(pA0, pA1, K_lds, qr, kro); partialSM<DK>(pA0, pA1, m_reg, mnA, alA);
  SLOAD(64); SWRITE(1); __syncthreads();
  for (int j = 1; j + 1 < NT; j += 2) {
    SBAR(); qkt<DK>(pB0, pB1, K_lds + SHM_K, qr, kro);
    finishSM(pA0, pA1, alA, l_reg, pa0, pa1, pa2, pa3); SBAR();
    SLOAD((j + 1) * 64); SBAR();
    pv_d0(o, vb0, pa0, pa1, pa2, pa3); partialSM<DK>(pB0, pB1, m_reg, mnB, alB);
    __syncthreads(); SWRITE(0);
    RESC(alB); __syncthreads();
    SBAR(); qkt<DK>(pA0, pA1, K_lds, qr, kro);
    finishSM(pB0, pB1, alB, l_reg, pa0, pa1, pa2, pa3); SBAR();
    SLOAD((j + 2) * 64); SBAR();
    pv_d0(o, vb0 + SHM_V, pa0, pa1, pa2, pa3); partialSM<DK>(pA0, pA1, m_reg, mnA, alA);
    __syncthreads(); SWRITE(1);
    RESC(alA); __syncthreads();
  }
  SBAR(); qkt<DK>(pB0, pB1, K_lds + SHM_K, qr, kro);
  finishSM(pA0, pA1, alA, l_reg, pa0, pa1, pa2, pa3); SBAR();
  pv_d0(o, vb0, pa0, pa1, pa2, pa3); partialSM<DK>(pB0, pB1, m_reg, mnB, alB);
  __syncthreads(); RESC(alB);
  finishSM(pB0, pB1, alB, l_reg, pa0, pa1, pa2, pa3); SBAR();
  pv_d0(o, vb0 + SHM_V, pa0, pa1, pa2, pa3);
  if (hi == 0) li_l[r32] = l_reg; asm volatile("s_waitcnt lgkmcnt(0)" ::: "memory");
  float rli[16];
#pragma unroll
  for (int r = 0; r < 16; ++r) rli[r] = __builtin_amdgcn_rcpf(li_l[crow(r, hi)]);
  if (WO_F8) {
    unsigned char* st = (unsigned char*)K_lds + wid * 4096;
#pragma unroll
    for (int r = 0; r < 16; ++r) { const int orow = crow(r, hi); const float s = rli[r] * F8_SO;
#pragma unroll
      for (int d0 = 0; d0 < 4; ++d0) st[orow * 128 + d0 * 32 + r32] = (unsigned char)(__builtin_amdgcn_cvt_pk_fp8_f32(fminf(fmaxf(o[d0][r] * s, -448.f), 448.f), 0.f, 0, false) & 0xff); }
    asm volatile("s_waitcnt lgkmcnt(0)" ::: "memory");
    unsigned char* Ow8 = (unsigned char*)Ob + (size_t)(wid * 32) * ldo;
#pragma unroll
    for (int ps = 0; ps < 4; ++ps) { const int row = ps * 8 + (lane >> 3), ch = (lane & 7) * 16;
      *(u32x4*)(Ow8 + (size_t)row * ldo + ch) = *(const u32x4*)(st + row * 128 + ch); }
  } else {
  bf16_t* Ow = Ob + (size_t)(wid * 32) * ldo;
#pragma unroll
  for (int r = 0; r < 16; ++r) { const int orow = crow(r, hi);
#pragma unroll
    for (int d0 = 0; d0 < 4; ++d0) Ow[(size_t)orow * ldo + d0 * 32 + r32] = (bf16_t)(cvtpk(o[d0][r] * rli[r], 0.f) & 0xffffu); }
  }
  __syncthreads();
#undef SLOAD
#undef SWRITE
#undef RESC
}

__device__ __forceinline__ void tconv_tile(const float* __restrict__ src, int ldn, int k0, int n0, bf16_t* __restrict__ dst, int ldk, int rmul, int roff, float* lw, int lane) {
  const float* s = src + (size_t)k0 * ldn + n0 + lane;
  float v[64];
#pragma unroll
  for (int i = 0; i < 64; ++i) v[i] = __builtin_nontemporal_load(s + (size_t)i * ldn);
#pragma unroll
  for (int i = 0; i < 64; ++i) lw[i * 65 + lane] = v[i];
  const int kc = (lane & 7) * 8;
#pragma unroll
  for (int it = 0; it < 8; ++it) {
    const int n = it * 8 + (lane >> 3);
    float v[8];
#pragma unroll
    for (int j = 0; j < 8; ++j) v[j] = lw[(kc + j) * 65 + n];
    u32x4 w = {cvtpk(v[0], v[1]), cvtpk(v[2], v[3]), cvtpk(v[4], v[5]), cvtpk(v[6], v[7])};
    *(u32x4*)(dst + (size_t)((n0 + n) * rmul + roff) * ldk + k0 + kc) = w;
  }
}

#ifndef MOE_JIT
#define MOE_JIT 1
#endif
constexpr float F8_SH = 8.0f, F8_SWD = 32.0f;
constexpr float F8_SA = 8.0f, F8_SW = 64.0f;
__device__ __forceinline__ void tconv_tile_f8(const float* __restrict__ src, int ldn, int k0, int n0, unsigned char* __restrict__ dst, int ldk, int rmul, int roff, float scale, float* lw, int lane) {
  const float* s = src + (size_t)k0 * ldn + n0 + lane;
  float v[64];
#pragma unroll
  for (int i = 0; i < 64; ++i) v[i] = __builtin_nontemporal_load(s + (size_t)i * ldn);
#pragma unroll
  for (int i = 0; i < 64; ++i) lw[i * 65 + lane] = v[i];
  const int kc = (lane & 3) * 16;
#pragma unroll
  for (int it = 0; it < 4; ++it) {
    const int n = it * 16 + (lane >> 2);
    float x[16];
#pragma unroll
    for (int j = 0; j < 16; ++j) x[j] = lw[(kc + j) * 65 + n] * scale;
    u32x4 w = {pack4_f8(x[0], x[1], x[2], x[3]), pack4_f8(x[4], x[5], x[6], x[7]), pack4_f8(x[8], x[9], x[10], x[11]), pack4_f8(x[12], x[13], x[14], x[15])};
    *(u32x4*)(dst + (size_t)((n0 + n) * rmul + roff) * ldk + k0 + kc) = w;
  }
}
__device__ __forceinline__ void phase_conv_moe(const Params& p, int layer, char* lds) {
  int tid = threadIdx.x; asm volatile("" : "+v"(tid));
  const int wid = tid >> 6, lane = tid & 63;
  const int gw = blockIdx.x * 8 + wid, nw = gridDim.x * 8;
  char* ws = opaque_ptr(p.ws);
  float* lw = (float*)lds + wid * (64 * 65);
  for (int t = gw; t < ME * 384; t += nw) {
    const int le = layer * ME + t / 384, tt = t % 384, which = tt >> 7, ti = tt & 127;
    bf16_t* wgu = (bf16_t*)(ws + WS_WMOE + (size_t)le * MOE_WBYTES); bf16_t* wd = wgu + 1024 * 1024;
    if (which < 2) { const float* src = p.in[which == 0 ? I_MOE_GATE : I_MOE_UP] + (size_t)le * D * FF;
      const int kt = ti >> 3, nt = ti & 7;
      if (MOE_F8) tconv_tile_f8(src, FF, kt * 64, nt * 64, (unsigned char*)wgu, D, 2, which, F8_SW, lw, lane);
      else tconv_tile(src, FF, kt * 64, nt * 64, wgu, D, 2, which, lw, lane); }
    else { const float* src = p.in[I_MOE_DOWN] + (size_t)le * FF * D;
      const int kt = ti >> 4, nt = ti & 15;
      if (MOE_F8 >= 2) tconv_tile_f8(src, D, kt * 64, nt * 64, (unsigned char*)wd, FF, 1, 0, F8_SWD, lw, lane);
      else tconv_tile(src, D, kt * 64, nt * 64, wd, FF, 1, 0, lw, lane); }
  }
}
__device__ __forceinline__ void phase_prep(const Params& p, char* lds) {
  int tid = threadIdx.x; asm volatile("" : "+v"(tid));
  const int wid = tid >> 6, lane = tid & 63;
  const int gw = blockIdx.x * 8 + wid, nw = gridDim.x * 8;
  char* ws = opaque_ptr(p.ws);
  float* lw = (float*)lds + wid * (64 * 65);
  for (int t = gw + (MOE_JIT ? DEPTH * ME * 384 : 0); t < DEPTH * ME * 384; t += nw) {
    const int le = t / 384, tt = t - le * 384, which = tt >> 7, ti = tt & 127;
    bf16_t* wgu = (bf16_t*)(ws + WS_WMOE + (size_t)le * MOE_WBYTES); bf16_t* wd = wgu + 1024 * 1024;
    if (which < 2) { const float* src = p.in[which == 0 ? I_MOE_GATE : I_MOE_UP] + (size_t)le * D * FF;
      const int kt = ti >> 3, nt = ti & 7; tconv_tile(src, FF, kt * 64, nt * 64, wgu, D, 2, which, lw, lane); }
    else { const float* src = p.in[I_MOE_DOWN] + (size_t)le * FF * D;
      const int kt = ti >> 4, nt = ti & 15; tconv_tile(src, D, kt * 64, nt * 64, wd, FF, 1, 0, lw, lane); }
  }
  {
    int base = 0;
#pragma unroll 1
    for (int q = 0; q < 14; ++q) {
      const float* jsrc = p.jobs[q].src; bf16_t* jdst = p.jobs[q].dst; const int jK = p.jobs[q].K, jN = p.jobs[q].N, jroff = p.jobs[q].roff;
      const int nnt = jN >> 6, ntile = (jK >> 6) * nnt;
      for (int t = gw - base; t < ntile; t += nw) { if (t < 0) continue; const int kt = t / nnt, nt = t - kt * nnt;
        if (p.jobs[q].rmul == 8) tconv_tile_f8(jsrc, jN, kt * 64, nt * 64, (unsigned char*)jdst, jK, 1, jroff, F8_SW, lw, lane);
        else tconv_tile(jsrc, jN, kt * 64, nt * 64, jdst, jK, 1, jroff, lw, lane); }
      base = (base + ntile) % nw;
    }
  }
  for (int j = 0; j < 2; ++j) { constexpr int ES = MIX_F8 ? 1 : 2; u32x4* z = (u32x4*)(ws + WS_WMLA + j * MLA_WBYTES + MLA_W1T + (size_t)832 * 1024 * ES);
    for (int i = blockIdx.x * NTHR + tid; i < 192 * 1024 * ES / 16; i += gridDim.x * NTHR) z[i] = (u32x4){0u, 0u, 0u, 0u}; }
  if (blockIdx.x == 0 && tid < DEPTH * ME) ((int*)(ws + WS_CNT))[tid] = 0;
  if (blockIdx.x == 0 && tid == 0) ((int*)(ws + WS_CNT))[1000] = 0;
  for (int r = gw; r < R; r += nw) {
    const int b = r / RPB, ii = r - b * RPB;
    const f32x4* src = (const f32x4*)(ii < CTX ? p.in[I_CTX] + ((size_t)b * CTX + ii) * D : p.in[I_X] + ((size_t)b * SEQ + (ii - CTX)) * D);
    xres_t* dst = (xres_t*)(ws + WS_X32) + (size_t)r * D;
#pragma unroll
    for (int q = 0; q < 4; ++q) xstore4(dst + (lane + 64 * q) * 4, src[lane + 64 * q]);
  }
  {
    float* sc = (float*)lds;
    __syncthreads();
    for (int u = blockIdx.x; u < DEPTH * 12 * 8; u += gridDim.x) {
      const int i = u / 96, rem = u - i * 96, cch = rem >> 3, ks = rem & 7;
      __syncthreads();
      for (int e = tid; e < 5 * 128; e += NTHR) { const int b = e >> 7, k = ks * 128 + (e & 127); const float c = b < 4 ? p.in[I_C][b * D + k] : p.in[I_CCTX][k]; sc[e] = silu_f(c); }
      __syncthreads();
      const int col = cch * 512 + tid;
      const float* w = p.in[I_WMOD] + (size_t)i * D * NMOD + (size_t)(ks * 128) * NMOD + col;
      float a0 = 0, a1 = 0, a2 = 0, a3 = 0, a4 = 0;
#pragma unroll 8
      for (int k = 0; k < 128; ++k) { const float wv = w[(size_t)k * NMOD]; a0 += sc[k] * wv; a1 += sc[128 + k] * wv; a2 += sc[256 + k] * wv; a3 += sc[384 + k] * wv; a4 += sc[512 + k] * wv; }
      float* mp = (float*)(ws + WS_MODP) + ((size_t)(ks * DEPTH + i) * 5) * NMOD + col;
      mp[0] = a0; mp[NMOD] = a1; mp[2 * NMOD] = a2; mp[3 * NMOD] = a3; mp[4 * NMOD] = a4;
    }
    __syncthreads();
  }
}
__device__ __forceinline__ void phase_modfin(const Params& p) {
  const float* mp = (const float*)(p.ws + WS_MODP); float* mv = (float*)(p.ws + WS_MODV);
  for (int e = blockIdx.x * NTHR + threadIdx.x; e < DEPTH * 5 * NMOD; e += gridDim.x * NTHR) {
    const int i = e / (5 * NMOD), col = e % NMOD;
    float s = p.in[I_BMOD][i * NMOD + col];
#pragma unroll
    for (int ks = 0; ks < 8; ++ks) s += mp[(size_t)ks * DEPTH * 5 * NMOD + e];
    mv[e] = s;
  }
}

template <int MODE, bool COMBINE, bool DRY = false>
__device__ __forceinline__ void phase_norm(const Params& p, int layer) {
  int tid = threadIdx.x; asm volatile("" : "+v"(tid));
  const int wid = tid >> 6, lane = tid & 63;
  const int gw = blockIdx.x * 8 + wid, nw = gridDim.x * 8;
  char* ws = opaque_ptr(p.ws);
  const float* modv = (const float*)(ws + WS_MODV);
  const bf16_t* Y = (const bf16_t*)(ws + WS_Y);
  for (int r = gw; r < R; r += nw) {
    const int b = r / RPB, ii = r - b * RPB; const bool is_ctx = ii < CTX; const int bsel = is_ctx ? 4 : b;
    if (MODE == 2 && is_ctx) continue;
    xres_t* xp = (xres_t*)(ws + WS_X32) + (size_t)r * D;
    f32x4 v[4];
#pragma unroll
    for (int q = 0; q < 4; ++q) v[q] = xload4(xp + (lane + 64 * q) * 4);
    if (COMBINE) {
      const int pl = MODE == 2 ? DEPTH - 1 : layer - 1;
      if (!(pl == DEPTH - 1 && is_ctx)) {
        const float* g2 = modv + ((size_t)pl * 5 + bsel) * NMOD + 5 * D;
#pragma unroll
        for (int q = 0; q < 4; ++q) { const int c = (lane + 64 * q) * 4; const f32x4 g = *(const f32x4*)(g2 + c);
          const u32x2 y0 = *(const u32x2*)(Y + (size_t)(2 * r) * D + c), y1 = *(const u32x2*)(Y + (size_t)(2 * r + 1) * D + c);
          v[q][0] += g[0] * (bflo(y0[0]) + bflo(y1[0])); v[q][1] += g[1] * (bfhi(y0[0]) + bfhi(y1[0]));
          v[q][2] += g[2] * (bflo(y0[1]) + bflo(y1[1])); v[q][3] += g[3] * (bfhi(y0[1]) + bfhi(y1[1])); }
        if (MODE != 2 && !DRY) {
#pragma unroll
          for (int q = 0; q < 4; ++q) xstore4(xp + (lane + 64 * q) * 4, v[q]);
        }
      }
    }
    float ss = 0.f;
#pragma unroll
    for (int q = 0; q < 4; ++q) ss += v[q][0] * v[q][0] + v[q][1] * v[q][1] + v[q][2] * v[q][2] + v[q][3] * v[q][3];
    ss = wave_sum(ss);
    const float rs = rsqrtf(ss * (1.0f / D) + EPS);
    if (MODE == 2) {
      float* op = p.out + ((size_t)b * SEQ + (ii - CTX)) * D;
#pragma unroll
      for (int q = 0; q < 4; ++q) { const int c = (lane + 64 * q) * 4; const f32x4 g = *(const f32x4*)(p.in[I_FG] + c); f32x4 ov = v[q] * rs * g;
#if DBG_TIME
        { const unsigned long long* d = (const unsigned long long*)(ws + WS_CNT + 4096); const float t1 = (float)d[DBG_T1] * 0.01f, t2 = (float)d[DBG_T2] * 0.01f;
          const float a = sqrtf(t1 * 0.01f); ov = (f32x4){a, a, a, a}; if (r == CTX && c == 0) ov[0] = t2 * 0.002f; }
#endif
        if (DBG_PROBE == 20 && ((const int*)(ws + WS_CNT))[1000]) ov = (f32x4){1000.f, 1000.f, 1000.f, 1000.f};
#ifdef SANITIZE
        for (int e = 0; e < 4; ++e) if (!(fabsf(ov[e]) < 1e30f)) ov[e] = DBG_PROBE ? 0.f : 1000.0f;
        if (DBG_PROBE && ((const int*)(ws + WS_CNT))[1000]) ov = (f32x4){1000.f, 1000.f, 1000.f, 1000.f};
#endif
        *(f32x4*)(op + c) = ov; }
      continue;
    }
    const float* ng = p.in[MODE == 0 ? I_NMG : I_NFG] + layer * D;
    const float* sh = modv + ((size_t)layer * 5 + bsel) * NMOD + (MODE == 0 ? 0 : 3) * D;
    const float* scl = sh + D;
    bf16_t* ap = (bf16_t*)(ws + WS_ACT) + (size_t)r * D;
    f32x4 f[4];
#pragma unroll
    for (int q = 0; q < 4; ++q) { const int c = (lane + 64 * q) * 4; const f32x4 g = *(const f32x4*)(ng + c), s1 = *(const f32x4*)(scl + c), s0 = *(const f32x4*)(sh + c);
      f[q] = (v[q] * rs * g) * (1.0f + s1) + s0;
      if ((MODE == 1 && MOE_F8) || (MODE == 0 && MIX_F8 && layer % 3 != 1)) ((unsigned*)(ws + WS_ACT))[((size_t)r * D + c) >> 2] = pack4_f8(f[q][0] * F8_SA, f[q][1] * F8_SA, f[q][2] * F8_SA, f[q][3] * F8_SA);
      else { u32x2 w = {cvtpk(f[q][0], f[q][1]), cvtpk(f[q][2], f[q][3])}; *(u32x2*)(ap + c) = w; } }
    if (MODE == 1) {
      if (layer == DEPTH - 1 && is_ctx) continue;
      const float* wg = p.in[I_MOE_WG] + (size_t)layer * D * 4; const float* we = p.in[I_MOE_WE] + (size_t)layer * D * ME;
      float gl[4] = {0.f, 0.f, 0.f, 0.f};
#pragma unroll
      for (int q = 0; q < 4; ++q)
#pragma unroll
        for (int e = 0; e < 4; ++e) { const int c = (lane + 64 * q) * 4 + e; const f32x4 w = *(const f32x4*)(wg + (size_t)c * 4);
          gl[0] += f[q][e] * w[0]; gl[1] += f[q][e] * w[1]; gl[2] += f[q][e] * w[2]; gl[3] += f[q][e] * w[3]; }
#pragma unroll
      for (int k = 0; k < 4; ++k) gl[k] = wave_sum(gl[k]);
      const float gm = fmaxf(fmaxf(gl[0], gl[1]), fmaxf(gl[2], gl[3]));
      float gp[4], gs = 0.f;
#pragma unroll
      for (int k = 0; k < 4; ++k) { gp[k] = __expf(gl[k] - gm); gs += gp[k]; }
      const float gsi = 1.0f / gs;
      int gsel = 0; float gbest = -1e30f, gw_ = 0.f;
#pragma unroll
      for (int k = 0; k < 4; ++k) { const float pr = gp[k] * gsi; const float sc = pr + p.in[I_MOE_BG][layer * 4 + k]; if (sc > gbest) { gbest = sc; gsel = k; gw_ = pr; } }
      gsel = __builtin_amdgcn_readfirstlane(gsel);
      float el[8] = {0.f, 0.f, 0.f, 0.f, 0.f, 0.f, 0.f, 0.f};
#pragma unroll
      for (int q = 0; q < 4; ++q)
#pragma unroll
        for (int e = 0; e < 4; ++e) { const int c = (lane + 64 * q) * 4 + e; const f32x4 w0 = *(const f32x4*)(we + (size_t)c * ME + gsel * 8), w1 = *(const f32x4*)(we + (size_t)c * ME + gsel * 8 + 4);
          el[0] += f[q][e] * w0[0]; el[1] += f[q][e] * w0[1]; el[2] += f[q][e] * w0[2]; el[3] += f[q][e] * w0[3];
          el[4] += f[q][e] * w1[0]; el[5] += f[q][e] * w1[1]; el[6] += f[q][e] * w1[2]; el[7] += f[q][e] * w1[3]; }
#pragma unroll
      for (int k = 0; k < 8; ++k) el[k] = wave_sum(el[k]);
      float em = el[0];
#pragma unroll
      for (int k = 1; k < 8; ++k) em = fmaxf(em, el[k]);
      float ep[8], es = 0.f;
#pragma unroll
      for (int k = 0; k < 8; ++k) { ep[k] = __expf(el[k] - em); es += ep[k]; }
      const float esi = 1.0f / es;
      int t1 = 0, t2 = 0; float b1 = -1e30f, b2 = -1e30f, p1 = 0.f, p2 = 0.f;
#pragma unroll
      for (int k = 0; k < 8; ++k) { const float pr = ep[k] * esi; const float sc = pr + p.in[I_MOE_BE][layer * ME + gsel * 8 + k];
        if (sc > b1) { b2 = b1; t2 = t1; p2 = p1; b1 = sc; t1 = k; p1 = pr; } else if (sc > b2) { b2 = sc; t2 = k; p2 = pr; } }
      if (lane == 0 && !DRY) {
        const float inv = gw_ / (p1 + p2);
        int* cnt = (int*)(ws + WS_CNT) + layer * ME; int* list = (int*)(ws + WS_LIST); float* wts = (float*)(ws + WS_WTS);
        const int e1 = gsel * 8 + t1, e2 = gsel * 8 + t2;
        const int q1 = atomicAdd(cnt + e1, 1); list[(size_t)e1 * R + q1] = 2 * r;     wts[2 * r] = p1 * inv;
        const int q2 = atomicAdd(cnt + e2, 1); list[(size_t)e2 * R + q2] = 2 * r + 1; wts[2 * r + 1] = p2 * inv;
      }
    }
  }
}

__device__ __forceinline__ void phase_mla_mid(const Params& p, int j) {
  int tid = threadIdx.x; asm volatile("" : "+v"(tid));
  const int wid = tid >> 6, lane = tid & 63;
  const int gw = blockIdx.x * 8 + wid, nw = gridDim.x * 8;
  char* ws = opaque_ptr(p.ws);
  const float* gq = p.in[I_MLA_GQ] + j * QL; const float* gkv = p.in[I_MLA_GKV] + j * KVL;
  for (int r = gw; r < R; r += nw) {
    const int b = r / RPB, ii = r - b * RPB; const bool is_ctx = ii < CTX;
    const bf16_t* c1 = (const bf16_t*)(ws + WS_C1) + (size_t)r * 1024;
    const u32x2 q0w = *(const u32x2*)(c1 + lane * 4), q1w = *(const u32x2*)(c1 + 256 + lane * 4), kvw = *(const u32x2*)(c1 + 512 + lane * 4);
    const f32x4 q0 = {bflo(q0w[0]), bfhi(q0w[0]), bflo(q0w[1]), bfhi(q0w[1])}, q1 = {bflo(q1w[0]), bfhi(q1w[0]), bflo(q1w[1]), bfhi(q1w[1])},
                kv = {bflo(kvw[0]), bfhi(kvw[0]), bflo(kvw[1]), bfhi(kvw[1])};
    const float pe = bf2f(c1[768 + lane]);
    float sq = q0[0] * q0[0] + q0[1] * q0[1] + q0[2] * q0[2] + q0[3] * q0[3] + q1[0] * q1[0] + q1[1] * q1[1] + q1[2] * q1[2] + q1[3] * q1[3];
    float sk = kv[0] * kv[0] + kv[1] * kv[1] + kv[2] * kv[2] + kv[3] * kv[3];
    sq = wave_sum(sq); sk = wave_sum(sk);
    const float rq = rsqrtf(sq * (1.0f / QL) + EPS), rk = rsqrtf(sk * (1.0f / KVL) + EPS);
    bf16_t* cq = (bf16_t*)(ws + WS_CQ) + (size_t)r * QL; bf16_t* ckv = (bf16_t*)(ws + WS_CKV) + (size_t)r * KVL; bf16_t* kpe = (bf16_t*)(ws + WS_KPE) + (size_t)r * ROPE;
    if (MIX_F8) {
      unsigned char* cq8 = (unsigned char*)(ws + WS_CQ) + (size_t)r * QL; unsigned char* ckv8 = (unsigned char*)(ws + WS_CKV) + (size_t)r * KVL; const float sq8 = rq * F8_SA, sk8 = rk * F8_SA;
      { const f32x4 g = *(const f32x4*)(gq + lane * 4); *(unsigned*)(cq8 + lane * 4) = pack4_f8(q0[0] * sq8 * g[0], q0[1] * sq8 * g[1], q0[2] * sq8 * g[2], q0[3] * sq8 * g[3]); }
      { const f32x4 g = *(const f32x4*)(gq + 256 + lane * 4); *(unsigned*)(cq8 + 256 + lane * 4) = pack4_f8(q1[0] * sq8 * g[0], q1[1] * sq8 * g[1], q1[2] * sq8 * g[2], q1[3] * sq8 * g[3]); }
      { const f32x4 g = *(const f32x4*)(gkv + lane * 4); *(unsigned*)(ckv8 + lane * 4) = pack4_f8(kv[0] * sk8 * g[0], kv[1] * sk8 * g[1], kv[2] * sk8 * g[2], kv[3] * sk8 * g[3]); }
    } else {
    { const f32x4 g = *(const f32x4*)(gq + lane * 4); u32x2 w = {cvtpk(q0[0] * rq * g[0], q0[1] * rq * g[1]), cvtpk(q0[2] * rq * g[2], q0[3] * rq * g[3])}; *(u32x2*)(cq + lane * 4) = w; }
    { const f32x4 g = *(const f32x4*)(gq + 256 + lane * 4); u32x2 w = {cvtpk(q1[0] * rq * g[0], q1[1] * rq * g[1]), cvtpk(q1[2] * rq * g[2], q1[3] * rq * g[3])}; *(u32x2*)(cq + 256 + lane * 4) = w; }
    { const f32x4 g = *(const f32x4*)(gkv + lane * 4); u32x2 w = {cvtpk(kv[0] * rk * g[0], kv[1] * rk * g[1]), cvtpk(kv[2] * rk * g[2], kv[3] * rk * g[3])}; *(u32x2*)(ckv + lane * 4) = w; }
    }
    float outv = pe;
    const float other = __shfl_xor(pe, 16);
    if (!is_ctx) {
      const int s = ii - CTX; const float pos = (lane < 32) ? (float)(s >> 6) : (float)(s & 63);
      const float ang = pos * rope_invf(lane & 15, 16); const float cs = __cosf(ang), sn = __sinf(ang);
      outv = (lane & 16) ? (other * sn + pe * cs) : (pe * cs - other * sn);
    }
    kpe[lane] = (bf16_t)(cvtpk(outv, 0.f) & 0xffffu);
    if (QK_F8) ((unsigned char*)(ws + WS_KPE8))[(size_t)r * ROPE + lane] = (unsigned char)(__builtin_amdgcn_cvt_pk_fp8_f32(fminf(fmaxf(outv * F8_SQK, -448.f), 448.f), 0.f, 0, false) & 0xff);
  }
}

__device__ __forceinline__ void phase_gqa_k(const Params& p) {
  int tid = threadIdx.x; asm volatile("" : "+v"(tid));
  const int wid = tid >> 6, lane = tid & 63;
  const int gw = blockIdx.x * 8 + wid, nw = gridDim.x * 8;
  char* ws = opaque_ptr(p.ws); const float* kg = p.in[I_GQA_KG];
  const int sub = lane & 7;
  for (int r = gw; r < R; r += nw) {
    const int b = r / RPB, ii = r - b * RPB; const bool is_ctx = ii < CTX;
    const bf16_t* kp = (const bf16_t*)(ws + WS_QKV) + (size_t)r * 4096 + 2048 + lane * 16;
    const u32x4 w0 = *(const u32x4*)kp, w1 = *(const u32x4*)(kp + 8);
    float v[16];
#pragma unroll
    for (int e = 0; e < 4; ++e) { v[2 * e] = bflo(w0[e]); v[2 * e + 1] = bfhi(w0[e]); v[8 + 2 * e] = bflo(w1[e]); v[9 + 2 * e] = bfhi(w1[e]); }
    float ss = 0.f;
#pragma unroll
    for (int e = 0; e < 16; ++e) ss += v[e] * v[e];
    ss += __shfl_xor(ss, 1); ss += __shfl_xor(ss, 2); ss += __shfl_xor(ss, 4);
    const float rs = rsqrtf(ss * (1.0f / GD) + EPS);
#pragma unroll
    for (int e = 0; e < 16; ++e) v[e] *= rs * kg[sub * 16 + e];
    float o[16];
#pragma unroll
    for (int e = 0; e < 16; ++e) o[e] = __shfl_xor(v[e], 2);
    if (!is_ctx) {
      const int s = ii - CTX; const float pos = (sub < 4) ? (float)(s >> 6) : (float)(s & 63);
#pragma unroll
      for (int e = 0; e < 16; ++e) { const int j = (sub & 1) * 16 + e; const float ang = pos * rope_invf(j, 32); const float cs = __cosf(ang), sn = __sinf(ang);
        v[e] = (sub & 2) ? (o[e] * sn + v[e] * cs) : (v[e] * cs - o[e] * sn); }
    }
    if (QK_F8) {
      u32x4 w = {pack4_f8(v[0] * F8_SQK, v[1] * F8_SQK, v[2] * F8_SQK, v[3] * F8_SQK), pack4_f8(v[4] * F8_SQK, v[5] * F8_SQK, v[6] * F8_SQK, v[7] * F8_SQK),
                 pack4_f8(v[8] * F8_SQK, v[9] * F8_SQK, v[10] * F8_SQK, v[11] * F8_SQK), pack4_f8(v[12] * F8_SQK, v[13] * F8_SQK, v[14] * F8_SQK, v[15] * F8_SQK)};
      *(u32x4*)((unsigned char*)(ws + WS_KN) + (size_t)r * 1024 + lane * 16) = w;
    } else {
    bf16_t* op = (bf16_t*)(ws + WS_KN) + (size_t)r * 1024 + lane * 16;
    u32x4 o0 = {cvtpk(v[0], v[1]), cvtpk(v[2], v[3]), cvtpk(v[4], v[5]), cvtpk(v[6], v[7])}, o1 = {cvtpk(v[8], v[9]), cvtpk(v[10], v[11]), cvtpk(v[12], v[13]), cvtpk(v[14], v[15])};
    *(u32x4*)op = o0; *(u32x4*)(op + 8) = o1;
    }
  }
}

__device__ __forceinline__ void phase_conv_mid(const Params& p) {
  int tid = threadIdx.x; asm volatile("" : "+v"(tid));
  const int wid = tid >> 6, lane = tid & 63;
  const int gw = blockIdx.x * 8 + wid, nw = gridDim.x * 8;
  char* ws = opaque_ptr(p.ws); const float* cw = p.in[I_CONV_W];
  const bf16_t* bcu = (const bf16_t*)(ws + WS_BCU);
  for (int r = gw; r < R; r += nw) {
    const int b = r / RPB, ii = r - b * RPB; const bool is_ctx = ii < CTX;
    const bool hp = is_ctx ? (ii > 0) : (ii > CTX), hn = is_ctx ? (ii < CTX - 1) : (ii < RPB - 1);
    bf16_t* gp = (bf16_t*)(ws + WS_G) + (size_t)r * D;
#pragma unroll
    for (int q = 0; q < 4; ++q) {
      const int c = (lane + 64 * q) * 4;
      const bf16_t* row = bcu + (size_t)r * 3072 + c;
      const u32x2 bg = *(const u32x2*)row, c0 = *(const u32x2*)(row + 1024), u0 = *(const u32x2*)(row + 2048);
      u32x2 cp = {0u, 0u}, up = {0u, 0u}, cn = {0u, 0u}, un = {0u, 0u};
      if (hp) { cp = *(const u32x2*)(row - 3072 + 1024); up = *(const u32x2*)(row - 3072 + 2048); }
      if (hn) { cn = *(const u32x2*)(row + 3072 + 1024); un = *(const u32x2*)(row + 3072 + 2048); }
      const f32x4 w0 = *(const f32x4*)(cw + c), w1 = *(const f32x4*)(cw + D + c), w2 = *(const f32x4*)(cw + 2 * D + c);
      float z[4];
      z[0] = w0[0] * bflo(cp[0]) * bflo(up[0]) + w1[0] * bflo(c0[0]) * bflo(u0[0]) + w2[0] * bflo(cn[0]) * bflo(un[0]);
      z[1] = w0[1] * bfhi(cp[0]) * bfhi(up[0]) + w1[1] * bfhi(c0[0]) * bfhi(u0[0]) + w2[1] * bfhi(cn[0]) * bfhi(un[0]);
      z[2] = w0[2] * bflo(cp[1]) * bflo(up[1]) + w1[2] * bflo(c0[1]) * bflo(u0[1]) + w2[2] * bflo(cn[1]) * bflo(un[1]);
      z[3] = w0[3] * bfhi(cp[1]) * bfhi(up[1]) + w1[3] * bfhi(c0[1]) * bfhi(u0[1]) + w2[3] * bfhi(cn[1]) * bfhi(un[1]);
      u32x2 w = {cvtpk(bflo(bg[0]) * z[0], bfhi(bg[0]) * z[1]), cvtpk(bflo(bg[1]) * z[2], bfhi(bg[1]) * z[3])};
      *(u32x2*)(gp + c) = w;
    }
  }
}

constexpr int LI_OFF = 135168;
__device__ __forceinline__ void moe_prefix(const Params& p, int layer, int* li) {
  if (threadIdx.x == 0) { const int* cnt = (const int*)(p.ws + WS_CNT) + layer * ME; int o = 0, t = 0;
    for (int e = 0; e < ME; ++e) { li[e] = o; li[33 + e] = t; const int c = cnt[e]; o += c; t += (c + 127) >> 7; } li[32] = o; li[65] = t; }
  __syncthreads();
  { int t = threadIdx.x; asm volatile("" : "+v"(t));
    if (t < li[65]) { int e = 0;
#pragma unroll 1
      while (li[33 + e + 1] <= t) ++e;
      li[1024 + t] = e; } }
  __syncthreads();
}
struct MoeUnit { int e, ct, nvalid, slot0, lbase, ri0, ri1, par; };
template <bool DOWN>
struct MoeProv {
  char* ws; const int* li; const int* cnt; int layer; int* etab;
  typedef MoeUnit Unit;
  __device__ __forceinline__ bool unit(int it, Unit& U, int srow) const {
    const int un = blockIdx.x + it * gridDim.x;
    if (un >= li[65] * 4) return false;
    const int t = un >> 2, e = li[1024 + t];
    const int rt = t - li[33 + e];
    U.e = e; U.ct = un & 3; U.nvalid = min(128, cnt[e] - rt * 128); U.slot0 = li[e] + rt * 128; U.lbase = e * R + rt * 128;
    if (!DOWN) { const int* list = (const int*)(ws + WS_LIST) + U.lbase;
      U.ri0 = list[srow < U.nvalid ? srow : 0] >> 1; U.ri1 = list[srow + 64 < U.nvalid ? srow + 64 : 0] >> 1; }
    U.par = it % 3;
    if (DOWN) { int t_ = threadIdx.x; asm volatile("" : "+v"(t_));
      if (t_ < 128) { const int aid = ((const int*)(ws + WS_LIST))[U.lbase + (t_ < U.nvalid ? t_ : 0)];
        etab[(U.par * 128 + t_) * 2] = aid; etab[(U.par * 128 + t_) * 2 + 1] = __float_as_int(((const float*)(ws + WS_WTS))[aid]); } }
    return true;
  }
  static constexpr bool A_AFFINE = DOWN;
  static constexpr bool F8 = DOWN ? (MOE_F8 >= 2) : (MOE_F8 >= 1);
  static constexpr int KU = DOWN ? (F8 ? FF / 2 : FF) : (F8 ? D / 2 : D);
  __device__ __forceinline__ int a_stride(const Unit&) const { return 64 * KU; }
  __device__ __forceinline__ int b_stride(const Unit&) const { return 64 * KU; }
  __device__ __forceinline__ const bf16_t* a_row(const Unit& U, int r) const {
    if (DOWN) return (const bf16_t*)(ws + WS_HID) + (size_t)(U.slot0 + r) * KU;
    return (const bf16_t*)(ws + WS_ACT) + (size_t)(r < 64 ? U.ri0 : U.ri1) * KU;
  }
  __device__ __forceinline__ const bf16_t* b_row(const Unit& U, int r) const {
    const bf16_t* w = (const bf16_t*)(ws + WS_WMOE + (size_t)(layer * ME + U.e) * MOE_WBYTES);
    return (DOWN ? w + 1024 * 1024 : w) + (size_t)(U.ct * 256 + r) * KU;
  }
  __device__ __forceinline__ int nk(const Unit&) const { return KU / 64; }
  __device__ __forceinline__ void epi(const Unit& U, int r, int c, f32x4 v0, f32x4 v1, f32x4 v2, f32x4 v3) const {
    if (r >= U.nvalid) return;
    if (!DOWN) {
      if (F8) { constexpr float is = 1.0f / (F8_SA * F8_SW); v0 *= is; v1 *= is; v2 *= is; v3 *= is; }
      const float h0 = silu_f(v0[0]) * v0[1], h1 = silu_f(v0[2]) * v0[3], h2 = silu_f(v1[0]) * v1[1], h3 = silu_f(v1[2]) * v1[3],
                  h4 = silu_f(v2[0]) * v2[1], h5 = silu_f(v2[2]) * v2[3], h6 = silu_f(v3[0]) * v3[1], h7 = silu_f(v3[2]) * v3[3];
      if (MOE_F8 >= 2) {
        u32x2 o = {pack4_f8(h0 * F8_SH, h1 * F8_SH, h2 * F8_SH, h3 * F8_SH), pack4_f8(h4 * F8_SH, h5 * F8_SH, h6 * F8_SH, h7 * F8_SH)};
        *(u32x2*)((unsigned char*)(ws + WS_HID) + (size_t)(U.slot0 + r) * FF + ((U.ct * 256 + c) >> 1)) = o;
      } else {
        u32x4 o = {cvtpk(h0, h1), cvtpk(h2, h3), cvtpk(h4, h5), cvtpk(h6, h7)};
        *(u32x4*)((bf16_t*)(ws + WS_HID) + (size_t)(U.slot0 + r) * FF + ((U.ct * 256 + c) >> 1)) = o;
      }
    } else {
      const int aid = etab[(U.par * 128 + r) * 2]; float w = __int_as_float(etab[(U.par * 128 + r) * 2 + 1]);
      if (F8) w *= 1.0f / (F8_SH * F8_SWD);
      bf16_t* o = (bf16_t*)(ws + WS_Y) + (size_t)aid * D + U.ct * 256 + c;
      *(u32x4*)o = pack8(v0 * w, v1 * w); *(u32x4*)(o + 8) = pack8(v2 * w, v3 * w);
    }
  }
};
template <bool DOWN>
__device__ __forceinline__ void phase_moe(const Params& p, int layer, char* lds) {
  int* li = (int*)(lds + LI_OFF); moe_prefix(p, layer, li);
  char* ws = opaque_ptr(p.ws);
  MoeProv<DOWN> pv{ws, li, (const int*)(ws + WS_CNT) + layer * ME, layer, (int*)(lds + LI_OFF + 1024)};
  gemm_stream<8, MoeProv<DOWN>, 0, MoeProv<DOWN>::F8>(pv, lds);
}


template <int DK, int ldq, int ldv, int ldo>
__device__ __forceinline__ void attn_unit8(const bf16_t* __restrict__ Qb, const unsigned char* __restrict__ Kh8, const unsigned char* __restrict__ Kp8,
                                           const bf16_t* __restrict__ Vh, bf16_t* __restrict__ Ob, int nkeys, bool rope, int qpos0,
                                           const float* __restrict__ qg, char* lds) {
  using Cfg = AttnCfg<DK>;
  constexpr int KROW = Cfg::KROW, SHM_V = Cfg::SHM_V, SHM_K = Cfg::SHM_K, NS = DK / 64;
  static_assert(KROW == DK, "fp8 K rows");
  int tid = threadIdx.x; asm volatile("" : "+v"(tid));
  const int wid = tid >> 6, lane = tid & 63, r32 = lane & 31, hi = lane >> 5;
  char* V_lds = lds; char* K_lds = lds + 3 * SHM_V;
  float* wsl = (float*)(lds + 3 * SHM_V + 3 * SHM_K) + wid * 64; float* li_l = wsl; float* al_l = wsl + 32;
  float m_reg = -1e30f, l_reg = 0; f32x16 o[4] = {}; i32x8 qr8[NS];
  {
    const int qrow = wid * 32 + r32;
    const bf16_t* Qw = Qb + (size_t)qrow * ldq + hi * 32;
    float qv[NS][32];
#pragma unroll
    for (int s = 0; s < NS; ++s)
#pragma unroll
      for (int cqd = 0; cqd < 4; ++cqd) { const u32x4 w = *reinterpret_cast<const u32x4*>(Qw + s * 64 + cqd * 8);
#pragma unroll
        for (int e = 0; e < 4; ++e) { qv[s][cqd * 8 + 2 * e] = bflo(w[e]); qv[s][cqd * 8 + 2 * e + 1] = bfhi(w[e]); } }
    const int qpos = qpos0 + qrow; const float prow = (float)(qpos >> 6), pcol = (float)(qpos & 63);
    if constexpr (DK == 128) {
      float ss = 0.f;
#pragma unroll
      for (int s = 0; s < 2; ++s)
#pragma unroll
        for (int e = 0; e < 32; ++e) ss += qv[s][e] * qv[s][e];
      ss += __shfl_xor(ss, 32);
      const float rs = rsqrtf(ss * (1.0f / 128.0f) + EPS);
#pragma unroll
      for (int s = 0; s < 2; ++s)
#pragma unroll
        for (int e4 = 0; e4 < 8; ++e4) { const f32x4 g = *(const f32x4*)(qg + s * 64 + hi * 32 + e4 * 4);
#pragma unroll
          for (int e = 0; e < 4; ++e) qv[s][e4 * 4 + e] *= rs * g[e]; }
      if (rope) {
#pragma unroll
        for (int s = 0; s < 2; ++s) { const float pos = s ? pcol : prow;
#pragma unroll
          for (int e = 0; e < 32; ++e) { const float ang = pos * rope_invf(e, 32); const float cs = __cosf(ang), sn = __sinf(ang);
            const float own = qv[s][e], oth = __shfl_xor(own, 32);
            qv[s][e] = hi ? (oth * sn + own * cs) : (own * cs - oth * sn); } }
      }
    } else {
      if (rope) {
        const float pos = hi ? pcol : prow;
#pragma unroll
        for (int e = 0; e < 16; ++e) { const float ang = pos * rope_invf(e, 16); const float cs = __cosf(ang), sn = __sinf(ang);
          const float x1 = qv[2][e], x2 = qv[2][16 + e]; qv[2][e] = x1 * cs - x2 * sn; qv[2][16 + e] = x1 * sn + x2 * cs; }
      }
    }
#pragma unroll
    for (int s = 0; s < NS; ++s)
#pragma unroll
      for (int w8 = 0; w8 < 8; ++w8) qr8[s][w8] = (int)pack4_f8(qv[s][4 * w8] * F8_SQK, qv[s][4 * w8 + 1] * F8_SQK, qv[s][4 * w8 + 2] * F8_SQK, qv[s][4 * w8 + 3] * F8_SQK);
  }
  int kq0[NS], kq1[NS];
#pragma unroll
  for (int s = 0; s < NS; ++s) {
    if constexpr (DK == 192) { const int x = (r32 >> 2) & 3; kq0[s] = r32 * KROW + s * 64 + (((2 * hi) ^ x) << 4); kq1[s] = r32 * KROW + s * 64 + (((2 * hi + 1) ^ x) << 4); }
    else { const int x = (r32 >> 1) & 7; kq0[s] = r32 * KROW + (((4 * s + 2 * hi) ^ x) << 4); kq1[s] = r32 * KROW + (((4 * s + 2 * hi + 1) ^ x) << 4); }
  }
  const int sr = tid >> 4, sc = (tid & 15) * 8, vst0 = v_st(sr, sc), vst1 = v_st(32 + sr, sc);
  const int krow = tid >> 3, kch = tid & 7, prw = (tid >> 2) & 63, pch = tid & 3;
#define KPERM(k) ((QK_F8 && PV_F8) ? ((((k) & 31) < 16) ? crow((k) & 15, (k) >> 5) : 32 + crow((k) & 15, (k) >> 5)) : (k))
  const int krl = KPERM(krow), prl = KPERM(prw);
  const int kst = DK == 192 ? krl * KROW + (((kch & ~3) | ((kch & 3) ^ ((krl >> 2) & 3))) << 4) : krl * KROW + ((kch ^ ((krl >> 1) & 7)) << 4);
  const int pst = prl * KROW + ((8 | (pch ^ ((prl >> 2) & 3))) << 4);
  const int vb0 = (int)(uintptr_t)(LAS char*)V_lds + v_rd_base(lane);
  bf16x8 vs0, vs1; u32x4 ks, kp, vt;
  const unsigned voff = sr * ldv + sc, koff = krow * 1024 + kch * 16, poff = prw * 64 + pch * 16;
  const int vcol = tid >> 2, vch = tid & 3, vtst = vcol * 64 + ((vch ^ ((vcol >> 2) & 3)) << 4);
  const unsigned char* Vt8 = (const unsigned char*)Vh;
  const int vr0 = r32 * 64 + (((2 * hi) ^ ((r32 >> 2) & 3)) << 4), vr1 = r32 * 64 + (((2 * hi + 1) ^ ((r32 >> 2) & 3)) << 4);
#define SLOAD(k0) do { if constexpr (PV_F8) { vt = *(const u32x4*)(Vt8 + (size_t)vcol * RPB + (k0) + vch * 16); } \
    else { const bf16_t* Vt = Vh + (size_t)(k0) * ldv; vs0 = *(const bf16x8*)(Vt + voff); vs1 = *(const bf16x8*)(Vt + 32 * ldv + voff); } \
    ks = *(const u32x4*)(Kh8 + (size_t)(k0) * 1024 + koff); \
    if constexpr (DK == 192) { if (tid < 256) kp = *(const u32x4*)(Kp8 + (size_t)(k0) * 64 + poff); } } while (0)
#define SWRITE(b) do { if constexpr (PV_F8) { *(u32x4*)(V_lds + (b) * SHM_V + vtst) = vt; } \
    else { *(bf16x8*)(V_lds + (b) * SHM_V + vst0) = vs0; *(bf16x8*)(V_lds + (b) * SHM_V + vst1) = vs1; } \
    *(u32x4*)(K_lds + (b) * SHM_K + kst) = ks; \
    if constexpr (DK == 192) { if (tid < 256) *(u32x4*)(K_lds + (b) * SHM_K + pst) = kp; } } while (0)
#define FIN8(P0, P1, AL, PF) do { _Pragma("unroll") for (int r = 0; r < 16; ++r) P1[r] = __builtin_amdgcn_exp2f(P1[r]); \
    float ps_ = 0; _Pragma("unroll") for (int r = 0; r < 16; ++r) ps_ += P0[r]; _Pragma("unroll") for (int r = 0; r < 16; ++r) ps_ += P1[r]; \
    { auto rr_ = __builtin_amdgcn_permlane32_swap(__float_as_uint(ps_), __float_as_uint(ps_), false, false); ps_ = __uint_as_float(rr_[0]) + __uint_as_float(rr_[1]); } \
    l_reg = l_reg * (AL) + ps_; \
    _Pragma("unroll") for (int w_ = 0; w_ < 4; ++w_) {   \
      PF[w_] = __builtin_amdgcn_cvt_pk_fp8_f32(P0[4 * w_ + 2], P0[4 * w_ + 3], __builtin_amdgcn_cvt_pk_fp8_f32(P0[4 * w_], P0[4 * w_ + 1], 0, false), true); \
      PF[4 + w_] = __builtin_amdgcn_cvt_pk_fp8_f32(P1[4 * w_ + 2], P1[4 * w_ + 3], __builtin_amdgcn_cvt_pk_fp8_f32(P1[4 * w_], P1[4 * w_ + 1], 0, false), true); } } while (0)
#define PV8(VB, PF) do { _Pragma("unroll") for (int d0 = 0; d0 < 4; ++d0) { \
      const u32x4 vl_ = *(const u32x4*)((VB) + d0 * 2048 + vr0), vh_ = *(const u32x4*)((VB) + d0 * 2048 + vr1); \
      const i32x8 vf_ = {(int)vl_[0], (int)vl_[1], (int)vl_[2], (int)vl_[3], (int)vh_[0], (int)vh_[1], (int)vh_[2], (int)vh_[3]}; \
      o[d0] = __builtin_amdgcn_mfma_scale_f32_32x32x64_f8f6f4(PF, vf_, o[d0], 0, 0, 0, 0x7f7f7f7f, 0, 0x7f7f7f7f); } } while (0)
#define RESC(a) do { if (__any((a) < 1.f)) { if (hi == 0) al_l[r32] = (a); asm volatile("s_waitcnt lgkmcnt(0)" ::: "memory"); \
    for (int d = 0; d < 4; ++d) for (int r = 0; r < 16; ++r) o[d][r] *= al_l[crow(r, hi)]; } } while (0)
#define QKT8(P0, P1, KS) do { P0 = f32x16{}; P1 = f32x16{}; \
    _Pragma("unroll") for (int s = 0; s < NS; ++s) { \
      const u32x4 a0l = *(const u32x4*)((KS) + kq0[s]), a0h = *(const u32x4*)((KS) + kq1[s]), a1l = *(const u32x4*)((KS) + kq0[s] + 32 * KROW), a1h = *(const u32x4*)((KS) + kq1[s] + 32 * KROW); \
      const i32x8 a0 = {(int)a0l[0], (int)a0l[1], (int)a0l[2], (int)a0l[3], (int)a0h[0], (int)a0h[1], (int)a0h[2], (int)a0h[3]}; \
      const i32x8 a1 = {(int)a1l[0], (int)a1l[1], (int)a1l[2], (int)a1l[3], (int)a1h[0], (int)a1h[1], (int)a1h[2], (int)a1h[3]}; \
      P0 = __builtin_amdgcn_mfma_scale_f32_32x32x64_f8f6f4(a0, qr8[s], P0, 0, 0, 0, 0x7f7f7f7f, 0, 0x7f7f7f7f); \
      P1 = __builtin_amdgcn_mfma_scale_f32_32x32x64_f8f6f4(a1, qr8[s], P1, 0, 0, 0, 0x7f7f7f7f, 0, 0x7f7f7f7f); } } while (0)
  f32x16 pA0, pA1, pB0, pB1; float mnA, mnB, alA, alB; bf16x8 pa0, pa1, pa2, pa3; i32x8 pf8; const int NT = nkeys / 64;
#define FINISH(P0, P1, AL) do { if constexpr (PV_F8) { FIN8(P0, P1, AL, pf8); } else { finishSM(P0, P1, AL, l_reg, pa0, pa1, pa2, pa3); } } while (0)
#define PVMUL(BUF) do { if constexpr (PV_F8) { PV8(V_lds + (BUF) * SHM_V, pf8); } else { pv_d0(o, vb0 + (BUF) * SHM_V, pa0, pa1, pa2, pa3); } } while (0)
  SLOAD(0); SWRITE(0); SLOAD(64); __syncthreads();
  QKT8(pA0, pA1, K_lds); partialSM<DK>(pA0, pA1, m_reg, mnA, alA);
  SWRITE(1); if (2 < NT) SLOAD(128); __syncthreads();
  int sq = 1, sv = 0, sw = 2;
#define RING_NEXT() do { sv = sq; sq = sw; sw = sw == 2 ? 0 : sw + 1; } while (0)
  for (int j = 1; j + 1 < NT; j += 2) {
    SBAR(); QKT8(pB0, pB1, K_lds + sq * SHM_K);
    FINISH(pA0, pA1, alA); SBAR();
    PVMUL(sv); partialSM<DK>(pB0, pB1, m_reg, mnB, alB);
    RESC(alB);
    SWRITE(sw); if (j + 2 < NT) SLOAD((j + 2) * 64);
    __syncthreads(); RING_NEXT();
    SBAR(); QKT8(pA0, pA1, K_lds + sq * SHM_K);
    FINISH(pB0, pB1, alB); SBAR();
    PVMUL(sv); partialSM<DK>(pA0, pA1, m_reg, mnA, alA);
    RESC(alA);
    SWRITE(sw); if (j + 3 < NT) SLOAD((j + 3) * 64);
    __syncthreads(); RING_NEXT();
  }
  SBAR(); QKT8(pB0, pB1, K_lds + sq * SHM_K);
  FINISH(pA0, pA1, alA); SBAR();
  PVMUL(sv); partialSM<DK>(pB0, pB1, m_reg, mnB, alB);
  RESC(alB);
  FINISH(pB0, pB1, alB); SBAR();
  PVMUL(sq);
#undef RING_NEXT
  if (hi == 0) li_l[r32] = l_reg; asm volatile("s_waitcnt lgkmcnt(0)" ::: "memory");
  float rli[16];
#pragma unroll
  for (int r = 0; r < 16; ++r) rli[r] = __builtin_amdgcn_rcpf(li_l[crow(r, hi)]) * (PV_F8 ? 1.0f / F8_SV : 1.0f);
  __syncthreads();
  if (WO_F8) {
    unsigned char* st = (unsigned char*)lds + wid * 4096;
#pragma unroll
    for (int r = 0; r < 16; ++r) { const int orow = crow(r, hi); const float s = rli[r] * F8_SO;
#pragma unroll
      for (int d0 = 0; d0 < 4; ++d0) st[orow * 128 + d0 * 32 + r32] = (unsigned char)(__builtin_amdgcn_cvt_pk_fp8_f32(fminf(fmaxf(o[d0][r] * s, -448.f), 448.f), 0.f, 0, false) & 0xff); }
    asm volatile("s_waitcnt lgkmcnt(0)" ::: "memory");
    unsigned char* Ow8 = (unsigned char*)Ob + (size_t)(wid * 32) * ldo;
#pragma unroll
    for (int ps = 0; ps < 4; ++ps) { const int row = ps * 8 + (lane >> 3), ch = (lane & 7) * 16;
      *(u32x4*)(Ow8 + (size_t)row * ldo + ch) = *(const u32x4*)(st + row * 128 + ch); }
  } else {
    bf16_t* Ow = Ob + (size_t)(wid * 32) * ldo;
#pragma unroll
    for (int r = 0; r < 16; ++r) { const int orow = crow(r, hi);
#pragma unroll
      for (int d0 = 0; d0 < 4; ++d0) Ow[(size_t)orow * ldo + d0 * 32 + r32] = (bf16_t)(cvtpk(o[d0][r] * rli[r], 0.f) & 0xffffu); }
  }
  __syncthreads();
#undef SLOAD
#undef SWRITE
#undef RESC
#undef QKT8
#undef KPERM
#undef FIN8
#undef PV8
#undef FINISH
#undef PVMUL
}


template <int HK, int LDV>
__device__ __forceinline__ void phase_vt8(const Params& p, const bf16_t* Vbase  , int hstride, char* lds) {
  int tid = threadIdx.x; asm volatile("" : "+v"(tid));
  const int wid = tid >> 6, lane = tid & 63;
  const int gw = blockIdx.x * 8 + wid, nw = gridDim.x * 8;
  char* ws = opaque_ptr(p.ws);
  unsigned char* lw = (unsigned char*)lds + wid * 4096;
  unsigned char* VT = (unsigned char*)(ws + WS_Y);
  constexpr int NKT = RPB / 64;
  for (int t = gw; t < NB * HK * NKT * 2; t += nw) {
    const int ch = t & 1, kt = (t >> 1) % NKT, bh = (t >> 1) / NKT, b = bh / HK, h = bh % HK;
    const bf16_t* src = Vbase + (size_t)(b * RPB + kt * 64 + lane) * LDV + h * hstride + ch * 64;
    u32x4 w[8];
#pragma unroll
    for (int i = 0; i < 8; ++i) w[i] = *(const u32x4*)(src + i * 8);
#pragma unroll
    for (int i = 0; i < 8; ++i)
#pragma unroll
      for (int e = 0; e < 4; ++e) { const int c = i * 8 + 2 * e;
        lw[c * 64 + lane] = (unsigned char)(__builtin_amdgcn_cvt_pk_fp8_f32(fminf(fmaxf(bflo(w[i][e]) * F8_SV, -448.f), 448.f), 0.f, 0, false) & 0xff);
        lw[(c + 1) * 64 + lane] = (unsigned char)(__builtin_amdgcn_cvt_pk_fp8_f32(fminf(fmaxf(bfhi(w[i][e]) * F8_SV, -448.f), 448.f), 0.f, 0, false) & 0xff); }
    unsigned char* dst = VT + ((size_t)bh * 128 + ch * 64 + lane) * RPB + kt * 64;
#pragma unroll
    for (int i = 0; i < 4; ++i) *(u32x4*)(dst + i * 16) = *(const u32x4*)(lw + lane * 64 + i * 16);
  }
}

__device__ __forceinline__ void phase_attn_mla(const Params& p, bool ctx_out, char* lds) {
  char* ws = opaque_ptr(p.ws);
  const bf16_t* Q = (const bf16_t*)(ws + WS_Q); const bf16_t* KV = (const bf16_t*)(ws + WS_KV); const bf16_t* KPE = (const bf16_t*)(ws + WS_KPE); bf16_t* O = (bf16_t*)(ws + WS_O);
  const int x = blockIdx.x & 7, nloc = gridDim.x >> 3, nlat = NB * MLA_H * 2  , nctx = ctx_out ? 4 : 0;
  for (int lu = (blockIdx.x >> 3); lu < nlat + nctx; lu += nloc) {
    int b, h, q0, nkeys; bool rope;
    if (lu < nlat) { const int pair = x * 4 + (lu >> 4), qb = lu & 15; b = pair / MLA_H; h = pair % MLA_H; q0 = CTX + qb * 256; nkeys = RPB; rope = true; }
    else { const int pair = x * 4 + (lu - nlat); b = pair / MLA_H; h = pair % MLA_H; q0 = 0; nkeys = CTX; rope = false; }
    const size_t rb = (size_t)b * RPB;
    if (QK_F8) attn_unit8<192, 1536, 2048, 1024>(Q + (rb + q0) * 1536 + h * 192, (const unsigned char*)(ws + WS_K8) + rb * 1024 + h * 128, (const unsigned char*)(ws + WS_KPE8) + rb * ROPE,
                   PV_F8 ? (const bf16_t*)((const unsigned char*)(ws + WS_Y) + (size_t)(b * MLA_H + h) * 128 * RPB) : KV + rb * 2048 + h * 256 + 128,
                   WO_F8 ? (bf16_t*)((unsigned char*)O + (rb + q0) * 1024 + h * 128) : O + (rb + q0) * 1024 + h * 128, nkeys, rope, q0 - CTX, nullptr, lds);
    else attn_unit<192, 1536, 2048, 2048, 1024>(Q + (rb + q0) * 1536 + h * 192, KV + rb * 2048 + h * 256, KPE + rb * ROPE, KV + rb * 2048 + h * 256 + 128,
                   WO_F8 ? (bf16_t*)((unsigned char*)O + (rb + q0) * 1024 + h * 128) : O + (rb + q0) * 1024 + h * 128, nkeys, rope, q0 - CTX, nullptr, lds);
  }
}
__device__ __forceinline__ void phase_attn_gqa(const Params& p, char* lds) {
  char* ws = opaque_ptr(p.ws);
  const bf16_t* QKV = (const bf16_t*)(ws + WS_QKV); const bf16_t* KN = (const bf16_t*)(ws + WS_KN); bf16_t* O = (bf16_t*)(ws + WS_OG);
  const int x = blockIdx.x & 7, nloc = gridDim.x >> 3, nlat = 128, nctx = 8;
  for (int lu = (blockIdx.x >> 3); lu < nlat + nctx; lu += nloc) {
    int b, h, q0, nkeys; bool rope;
    if (lu < nlat) { const int pair = x * 8 + (lu >> 4), qb = lu & 15; b = pair / GH; h = pair % GH; q0 = CTX + qb * 256; nkeys = RPB; rope = true; }
    else { const int pair = x * 8 + (lu - nlat); b = pair / GH; h = pair % GH; q0 = 0; nkeys = CTX; rope = false; }
    const size_t rb = (size_t)b * RPB; const int kvh = h >> 1;
    if (QK_F8) attn_unit8<128, 4096, 4096, 2048>(QKV + (rb + q0) * 4096 + h * 128, (const unsigned char*)(ws + WS_KN) + rb * 1024 + kvh * 128, nullptr,
                   PV_F8 ? (const bf16_t*)((const unsigned char*)(ws + WS_Y) + (size_t)(b * GKV + kvh) * 128 * RPB) : QKV + rb * 4096 + 3072 + kvh * 128,
                   WO_F8 ? (bf16_t*)((unsigned char*)O + (rb + q0) * 2048 + h * 128) : O + (rb + q0) * 2048 + h * 128, nkeys, rope, q0 - CTX, p.in[I_GQA_QG], lds);
    else attn_unit<128, 4096, 1024, 4096, 2048>(QKV + (rb + q0) * 4096 + h * 128, KN + rb * 1024 + kvh * 128, nullptr, QKV + rb * 4096 + 3072 + kvh * 128,
                   WO_F8 ? (bf16_t*)((unsigned char*)O + (rb + q0) * 2048 + h * 128) : O + (rb + q0) * 2048 + h * 128, nkeys, rope, q0 - CTX, p.in[I_GQA_QG], lds);
  }
}


__device__ __forceinline__ void dbg_probe(const Params& p) {
  char* ws = opaque_ptr(p.ws);
  size_t off = 0, n = 0; bool is_bf = true;
  switch (DBG_PROBE) {
    case 1: off = WS_MODV; n = (size_t)4 * 5 * NMOD; is_bf = false; break;
    case 2: off = WS_ACT; n = (size_t)R * D; break;
    case 3: off = WS_C1; n = (size_t)R * 1024; is_bf = false; break;
    case 4: off = WS_CQ; n = (size_t)R * 512; break;
    case 5: off = WS_CKV; n = (size_t)R * 256; break;
    case 6: off = WS_KPE; n = (size_t)R * 64; break;
    case 7: off = WS_Q; n = (size_t)R * 1536; break;
    case 8: off = WS_KV; n = (size_t)R * 2048; break;
    case 9: off = WS_O; n = (size_t)R * 1024; break;
    case 10: off = WS_X32; n = (size_t)R * D; is_bf = XBF16; break;
    case 11: off = WS_WMLA; n = MLA_WBYTES / 2; break;
    default: break;
  }
  int bad = 0;
  for (size_t i = (size_t)blockIdx.x * NTHR + threadIdx.x; i < n; i += (size_t)gridDim.x * NTHR) {
    float v = is_bf ? bf2f(((const bf16_t*)(ws + off))[i]) : ((const float*)(ws + off))[i];
    if (!(fabsf(v) < 1e30f)) bad = 1;
  }
  if (bad) atomicOr((int*)(ws + WS_CNT) + 1000, 1);
}

constexpr int DYN_LDS = 143360;
extern __shared__ __attribute__((aligned(16))) char smem[];

__global__ void __launch_bounds__(NTHR, 2) fwd_megakernel(Params p) {
  cg::grid_group grid = cg::this_grid();
  char* lds = smem;
#define WSO() char* ws = opaque_ptr(p.ws)
  volatile LAS unsigned* xst = (volatile LAS unsigned*)(LAS char*)(smem + DYN_LDS - 16);
  if (threadIdx.x == 0) { xst[0] = 0u; xst[1] = 0u; }
  __syncthreads();
  const XcdBarrier xb = xcd_barrier_post((unsigned*)(p.ws + WS_BAR), xst);
#if DBG_TIME
  unsigned long long tc_prep = 0, tc_norm = 0, tc_gemm = 0, tc_mid = 0, tc_amla = 0, tc_agqa = 0, tc_moe1 = 0, tc_moe2 = 0, tc_sync = 0, tA, tB, tC;
#define PH(cat, ...) do { tA = __builtin_amdgcn_s_memrealtime(); __VA_ARGS__; tB = __builtin_amdgcn_s_memrealtime(); xcd_barrier(xb); tC = __builtin_amdgcn_s_memrealtime(); \
    tc_##cat += tC - tA; tc_sync += tC - tB; } while (0)
#else
#define PH(cat, ...) do { __VA_ARGS__; xcd_barrier(xb); } while (0)
#endif
#define PHD(cat, id, ...) do { PH(cat, __VA_ARGS__); if (DUP == id) PH(cat, __VA_ARGS__); } while (0)
#define PHR(...) do { if (DUP == 15) { xres_t* const DRYP = (xres_t*)(p.ws + WS_Y); PH(gemm, __VA_ARGS__); } { xres_t* const DRYP = nullptr; PH(gemm, __VA_ARGS__); } } while (0)
#if DBG_TIME
  tA = __builtin_amdgcn_s_memrealtime();
#endif
#pragma unroll 1
  for (int rep_ = 0; rep_ < (DUP == 18 ? 2 : 1); ++rep_) {
  if (rep_ == 1) xcd_barrier(xb);
  if (DBG_PROBE == 20 && threadIdx.x == 0) ((int*)(p.ws + WS_CNT))[1024 + blockIdx.x] = (int)xb.x;
  phase_prep(p, lds);
  if (p.out == nullptr) grid.sync();
  xcd_barrier(xb);
#if DBG_TIME
  tc_prep += __builtin_amdgcn_s_memrealtime() - tA;
#endif
  if (DUP == 12) { xcd_barrier(xb); phase_prep(p, lds); xcd_barrier(xb); }
  if (DBG_PROBE == 20 && blockIdx.x == 0 && threadIdx.x == 0) { const int* t = (const int*)(p.ws + WS_CNT) + 1024; int bad = 0, seen = 0;
    for (int i = 0; i < (int)gridDim.x; ++i) { if (t[i] != t[i & 7]) bad = 1; }
    for (int i = 0; i < 8; ++i) seen |= 1 << t[i];
    if (bad || seen != 0xff) ((int*)(p.ws + WS_CNT))[1000] = 1; }
  PH(prep, phase_modfin(p));
  if (DUP == 14) { for (int q = 0; q < 40; ++q) xcd_barrier(xb); }
  if (STOP_AFTER == 0) { phase_norm<2, false>(p, 0); return; }
#pragma unroll 1
  for (int layer = 0; layer < DEPTH; ++layer) {
    const int kind = layer % 3, j = layer / 3; const bool ctx_out = layer < DEPTH - 1;
    if (DUP == 17 && layer > 0) PH(norm, phase_norm<0, true, true>(p, layer));
    PH(norm, if (layer == 0) phase_norm<0, false>(p, layer); else phase_norm<0, true>(p, layer));
    if (DUP == 13 && layer == 0) { for (int q = 0; q < 4; ++q) PH(norm, phase_norm<0, false>(p, layer)); }
    if (kind == 0) {
      PHD(gemm, 1, { WSO(); const char* wb = ws + WS_WMLA + j * MLA_WBYTES;
        if (MIX_F8) gemm_dense<17, 2, false, EpiBf16, 0, true>((const bf16_t*)(ws + WS_ACT), D / 2, (const bf16_t*)(wb + MLA_W1T), 1024, D / 2, EpiBf16{(bf16_t*)(ws + WS_C1), 1024, 1.0f / 512.0f}, lds);
        else gemm_dense<17, 2, false>((const bf16_t*)(ws + WS_ACT), D, (const bf16_t*)(wb + MLA_W1T), 1024, D, EpiBf16{(bf16_t*)(ws + WS_C1), 1024}, lds); });
      PHD(mid, 2, phase_mla_mid(p, j));
      PHD(gemm, 3, { WSO(); const char* wb = ws + WS_WMLA + j * MLA_WBYTES;
        MlaUpProv<(MIX_F8 != 0)> pv{(const bf16_t*)(ws + WS_CQ), (const bf16_t*)(ws + WS_CKV), (const bf16_t*)(wb + MLA_WUQT), (const bf16_t*)(wb + MLA_WUKVT), (bf16_t*)(ws + WS_Q), (bf16_t*)(ws + WS_KV), (unsigned char*)(ws + WS_K8)};
        gemm_stream<17, MlaUpProv<(MIX_F8 != 0)>, 0, (MIX_F8 != 0)>(pv, lds); });
      if (QK_F8 && PV_F8) PH(mid, { WSO(); phase_vt8<MLA_H, 2048>(p, (const bf16_t*)(ws + WS_KV) + 128, 256, lds); });
      PHD(amla, 4, phase_attn_mla(p, ctx_out, lds));
      PHR({ WSO(); const char* wb = ws + WS_WMLA + j * MLA_WBYTES;
        const EpiResid er{(xres_t*)(ws + WS_X32), (const float*)(ws + WS_MODV) + (size_t)layer * 5 * NMOD + 2 * D, DRYP, WO_F8 ? 1.0f / (F8_SO * F8_SW) : 1.0f};
        if (WO_F8) { if (ctx_out) gemm_dense<17, 2, false, EpiResid, 0, true>((const bf16_t*)(ws + WS_O), 512, (const bf16_t*)(wb + MLA_WOT), D, 512, er, lds);
          else gemm_dense<16, 2, true, EpiResid, 0, true>((const bf16_t*)(ws + WS_O), 512, (const bf16_t*)(wb + MLA_WOT), D, 512, er, lds); }
        else { if (ctx_out) gemm_dense<17, 2, false>((const bf16_t*)(ws + WS_O), 1024, (const bf16_t*)(wb + MLA_WOT), D, 1024, er, lds);
          else gemm_dense<16, 2, true>((const bf16_t*)(ws + WS_O), 1024, (const bf16_t*)(wb + MLA_WOT), D, 1024, er, lds); } });
    } else if (kind == 1) {
      PHD(gemm, 5, { WSO(); gemm_dense<17, 2, false>((const bf16_t*)(ws + WS_ACT), D, (const bf16_t*)(ws + WS_WCONV_IN), 3072, D, EpiBf16{(bf16_t*)(ws + WS_BCU), 3072}, lds); });
      if (DUP == 21) PH(gemm, { WSO(); gemm_dense<17, 2, false, EpiBf16, 1>((const bf16_t*)(ws + WS_ACT), D, (const bf16_t*)(ws + WS_WCONV_IN), 3072, D, EpiBf16{(bf16_t*)(ws + WS_G + (size_t)R * 1024 * 2), 3072}, lds); });
      if (DUP == 22) PH(gemm, { WSO(); gemm_dense<17, 2, false, EpiBf16, 2>((const bf16_t*)(ws + WS_ACT), D, (const bf16_t*)(ws + WS_WCONV_IN), 3072, D, EpiBf16{(bf16_t*)(ws + WS_G + (size_t)R * 1024 * 2), 3072}, lds); });
      if (DUP == 23) PH(gemm, { WSO(); gemm_dense<17, 2, false, EpiBf16, 0>((const bf16_t*)(ws + WS_ACT), D, (const bf16_t*)(ws + WS_WCONV_IN), 3072, D, EpiBf16{(bf16_t*)(ws + WS_G + (size_t)R * 1024 * 2), 3072}, lds); });
      PHD(mid, 6, phase_conv_mid(p));
      PHR({ WSO(); gemm_dense<17, 2, false>((const bf16_t*)(ws + WS_G), D, (const bf16_t*)(ws + WS_WCONV_OUT), D, D,
                                EpiResid{(xres_t*)(ws + WS_X32), (const float*)(ws + WS_MODV) + (size_t)layer * 5 * NMOD + 2 * D, DRYP}, lds); });
    } else {
      PHD(gemm, 7, { WSO(); if (MIX_F8) gemm_dense<17, 2, false, EpiBf16, 0, true>((const bf16_t*)(ws + WS_ACT), D / 2, (const bf16_t*)(ws + WS_WGQA_QKV), 4096, D / 2, EpiBf16{(bf16_t*)(ws + WS_QKV), 4096, 1.0f / 512.0f}, lds);
        else gemm_dense<17, 2, false>((const bf16_t*)(ws + WS_ACT), D, (const bf16_t*)(ws + WS_WGQA_QKV), 4096, D, EpiBf16{(bf16_t*)(ws + WS_QKV), 4096}, lds); });
      PHD(mid, 8, phase_gqa_k(p));
      if (QK_F8 && PV_F8) PH(mid, { WSO(); phase_vt8<GKV, 4096>(p, (const bf16_t*)(ws + WS_QKV) + 3072, 128, lds); });
      PHD(agqa, 9, phase_attn_gqa(p, lds));
      PHR({ WSO(); if (WO_F8) gemm_dense<17, 2, false, EpiResid, 0, true>((const bf16_t*)(ws + WS_OG), 1024, (const bf16_t*)(ws + WS_WGQA_O), D, 1024,
                                EpiResid{(xres_t*)(ws + WS_X32), (const float*)(ws + WS_MODV) + (size_t)layer * 5 * NMOD + 2 * D, DRYP, 1.0f / (F8_SO * F8_SW)}, lds);
        else gemm_dense<17, 2, false>((const bf16_t*)(ws + WS_OG), 2048, (const bf16_t*)(ws + WS_WGQA_O), D, 2048,
                                EpiResid{(xres_t*)(ws + WS_X32), (const float*)(ws + WS_MODV) + (size_t)layer * 5 * NMOD + 2 * D, DRYP}, lds); });
    }
    if (STOP_AFTER == 2 * layer + 1) { if (DBG_PROBE) { dbg_probe(p); xcd_barrier(xb); } phase_norm<2, false>(p, 0); return; }
    if (DUP == 16) PH(norm, phase_norm<1, false, true>(p, layer));
    PH(norm, { if (MOE_JIT) phase_conv_moe(p, layer, lds); phase_norm<1, false>(p, layer); });
    PHD(moe1, 10, phase_moe<false>(p, layer, lds));
    PHD(moe2, 11, phase_moe<true>(p, layer, lds));
    if (STOP_AFTER == 2 * layer + 2) break;
  }
  }
#if DBG_TIME
  if (blockIdx.x == 0 && threadIdx.x == 0) {
    unsigned long long* d = (unsigned long long*)(p.ws + WS_CNT + 4096);
    d[0] = tc_prep; d[1] = tc_norm; d[2] = tc_gemm; d[3] = tc_mid; d[4] = tc_amla; d[5] = tc_agqa; d[6] = tc_moe1; d[7] = tc_moe2; d[8] = tc_sync;
  }
  xcd_barrier(xb);
#endif
  phase_norm<2, true>(p, 0);
}

extern "C" void kernel_launch(void* const* d_in, const int* in_sizes, int n_in, void* d_out, int out_size, void* d_ws, size_t ws_size,
                              hipStream_t stream) {
  static int grid_blocks = 0;
  if (!grid_blocks) {
    int dev = 0, cus = 0, per_cu = 0;
    (void)hipGetDevice(&dev);
    (void)hipDeviceGetAttribute(&cus, hipDeviceAttributeMultiprocessorCount, dev);
    (void)hipFuncSetAttribute((const void*)fwd_megakernel, hipFuncAttributeMaxDynamicSharedMemorySize, DYN_LDS);
    (void)hipOccupancyMaxActiveBlocksPerMultiprocessor(&per_cu, fwd_megakernel, NTHR, DYN_LDS);
    grid_blocks = per_cu >= 1 ? cus : 0;
    if (ws_size < WS_END || n_in != N_IN) { fprintf(stderr, "kernel_launch: ws %zu < %zu or n_in %d\n", ws_size, (size_t)WS_END, n_in); grid_blocks = 0; }
    if (!grid_blocks) { fprintf(stderr, "kernel_launch: cannot launch (per_cu %d)\n", per_cu); return; }
  }
  Params p{};
  for (int i = 0; i < N_IN; ++i) p.in[i] = (const float*)d_in[i];
  p.out = (float*)d_out; p.ws = (char*)d_ws;
  {
    char* ws = p.ws; int nj = 0;
    for (int j = 0; j < 2; ++j) {
      char* wb = ws + WS_WMLA + j * MLA_WBYTES;
      p.jobs[nj++] = TJob{p.in[I_MLA_WDQ] + (size_t)j * D * QL, (bf16_t*)(wb + MLA_W1T), D, QL, MIX_F8 ? 8 : 1, 0};
      p.jobs[nj++] = TJob{p.in[I_MLA_WDKV] + (size_t)j * D * 320, (bf16_t*)(wb + MLA_W1T), D, 320, MIX_F8 ? 8 : 1, 512};
      p.jobs[nj++] = TJob{p.in[I_MLA_WUQ] + (size_t)j * QL * 1536, (bf16_t*)(wb + MLA_WUQT), QL, 1536, MIX_F8 ? 8 : 1, 0};
      p.jobs[nj++] = TJob{p.in[I_MLA_WUKV] + (size_t)j * KVL * 2048, (bf16_t*)(wb + MLA_WUKVT), KVL, 2048, MIX_F8 ? 8 : 1, 0};
      p.jobs[nj++] = TJob{p.in[I_MLA_WO] + (size_t)j * 1024 * D, (bf16_t*)(wb + MLA_WOT), 1024, D, WO_F8 ? 8 : 1, 0};
    }
    p.jobs[nj++] = TJob{p.in[I_CONV_WIN], (bf16_t*)(ws + WS_WCONV_IN), D, 3072, 1, 0};
    p.jobs[nj++] = TJob{p.in[I_CONV_WOUT], (bf16_t*)(ws + WS_WCONV_OUT), D, D, 1, 0};
    p.jobs[nj++] = TJob{p.in[I_GQA_WQKV], (bf16_t*)(ws + WS_WGQA_QKV), D, 4096, MIX_F8 ? 8 : 1, 0};
    p.jobs[nj++] = TJob{p.in[I_GQA_WO], (bf16_t*)(ws + WS_WGQA_O), 2048, D, WO_F8 ? 8 : 1, 0};
  }
  (void)hipMemsetAsync((char*)d_ws + WS_BAR, 0, XCD_BAR_WORDS * 4, stream);
  void* args[] = {&p};
  hipError_t e = hipLaunchCooperativeKernel((void*)fwd_megakernel, dim3(grid_blocks), dim3(NTHR), args, DYN_LDS, stream);
  if (e != hipSuccess) fprintf(stderr, "cooperative launch failed: %s (grid %d)\n", hipGetErrorString(e), grid_blocks);
}
```

```cpp
#include <hip/hip_runtime.h>
#include <hip/hip_cooperative_groups.h>
#include <cstdio>
#include <cstdint>
namespace cg = cooperative_groups;

#ifndef DUP
#define DUP 0
#endif
#ifndef DBG_TIME
#define DBG_TIME 0
#endif
#ifndef DBG_T1
#define DBG_T1 0
#define DBG_T2 1
#endif
#ifndef DBG_PROBE
#define DBG_PROBE 0
#endif
#ifndef STOP_AFTER
#define STOP_AFTER 8
#endif

#ifndef PV_F8
#define PV_F8 1
#endif
#ifndef QK_F8
#define QK_F8 1
#endif
#ifndef WO_F8
#define WO_F8 1
#endif
#ifndef MIX_F8
#define MIX_F8 1
#endif
#ifndef MOE_F8
#define MOE_F8 2
#endif
constexpr float F8_SO = 64.0f;
constexpr float F8_SQK = 16.0f;
constexpr float F8_SP = 16.0f, F8_SV = 16.0f;
#define LAS __attribute__((address_space(3)))
typedef unsigned short bf16_t;
typedef short bf16x8 __attribute__((ext_vector_type(8)));
typedef short s16x4 __attribute__((ext_vector_type(4)));
typedef float f32x4 __attribute__((ext_vector_type(4)));
typedef float f32x16 __attribute__((ext_vector_type(16)));
typedef unsigned u32x4 __attribute__((ext_vector_type(4)));
typedef unsigned u32x2 __attribute__((ext_vector_type(2)));
typedef int i32x8 __attribute__((ext_vector_type(8)));

constexpr int D = 1024, NB = 4, SEQ = 4096, CTX = 256, RPB = SEQ + CTX, R = NB * RPB;
constexpr int DEPTH = 4, NMOD = 6 * D;
constexpr int MLA_H = 8, QL = 512, KVL = 256, NOPE = 128, ROPE = 64, MV = 128;
constexpr int GH = 16, GKV = 8, GD = 128;
constexpr int ME = 32, FF = 512;
constexpr float EPS = 1e-6f;
constexpr int NTHR = 512;

enum { I_X = 0, I_C, I_CTX, I_CCTX, I_WMOD, I_BMOD, I_NMG, I_NFG, I_MLA_WDQ, I_MLA_GQ, I_MLA_WUQ, I_MLA_WDKV, I_MLA_GKV, I_MLA_WUKV, I_MLA_WO,
       I_CONV_WIN, I_CONV_W, I_CONV_WOUT, I_GQA_WQKV, I_GQA_QG, I_GQA_KG, I_GQA_WO, I_MOE_WG, I_MOE_BG, I_MOE_WE, I_MOE_BE, I_MOE_GATE, I_MOE_UP, I_MOE_DOWN, I_FG, N_IN };

constexpr size_t al256(size_t x) { return (x + 255) / 256 * 256; }
constexpr size_t WS_BAR = 0;
constexpr size_t WS_CNT = 16384;
constexpr int MODKS = 16, MODKL = 1024 / MODKS;
constexpr size_t WS_MODP = 16384 + 8192;
constexpr size_t WS_MODV = WS_MODP + (size_t)MODKS * 4 * 5 * NMOD * 4;
constexpr size_t WS_WTS = WS_MODV + (size_t)4 * 5 * NMOD * 4;
constexpr size_t WS_LIST = al256(WS_WTS + (size_t)2 * R * 4);
#ifndef XBF16
#define XBF16 1
#endif
constexpr size_t WS_X32 = al256(WS_LIST + (size_t)32 * R * 4);
constexpr size_t WS_ACT = WS_X32 + (size_t)R * D * (XBF16 ? 2 : 4);
constexpr size_t WS_HID = WS_ACT + (size_t)R * D * 2;
constexpr size_t WS_Y = WS_HID + (size_t)(2 * R + 256) * FF * 2;
constexpr size_t WS_MIX = WS_Y + (size_t)2 * R * D * 2;
constexpr size_t MIX_BYTES = (size_t)R * (1024 * 4 + 512 * 2 + 256 * 2 + 64 * 2 + 1536 * 2 + 2048 * 2 + 1024 * 2);
constexpr size_t WS_C1 = WS_MIX;
constexpr size_t WS_K8 = WS_C1 + (size_t)R * 2048;
constexpr size_t WS_KPE8 = WS_K8 + (size_t)R * 1024;
constexpr size_t WS_CQ = WS_C1 + (size_t)R * 1024 * 4;
constexpr size_t WS_CKV = WS_CQ + (size_t)R * 512 * 2;
constexpr size_t WS_KPE = WS_CKV + (size_t)R * 256 * 2;
constexpr size_t WS_Q = WS_KPE + (size_t)R * 64 * 2;
constexpr size_t WS_KV = WS_Q + (size_t)R * 1536 * 2;
constexpr size_t WS_O = WS_KV + (size_t)R * 2048 * 2;
constexpr size_t WS_QKV = WS_MIX;
constexpr size_t WS_KN = WS_QKV + (size_t)R * 4096 * 2;
constexpr size_t WS_OG = WS_KN + (size_t)R * 1024 * 2;
constexpr size_t WS_BCU = WS_MIX;
constexpr size_t WS_G = WS_BCU + (size_t)R * 3072 * 2;
static_assert(WS_OG + (size_t)R * 2048 * 2 <= WS_MIX + MIX_BYTES, "gqa scratch");
static_assert(WS_G + (size_t)R * 1024 * 2 <= WS_MIX + MIX_BYTES, "conv scratch");
constexpr size_t WS_WT = al256(WS_MIX + MIX_BYTES);
constexpr size_t MLA_W1T = 0, MLA_WUQT = MLA_W1T + (size_t)1024 * 1024 * 2, MLA_WUKVT = MLA_WUQT + (size_t)1536 * 512 * 2, MLA_WOT = MLA_WUKVT + (size_t)2048 * 256 * 2,
                 MLA_WBYTES = MLA_WOT + (size_t)1024 * 1024 * 2;
constexpr size_t WS_WMLA = WS_WT;
constexpr size_t WS_WCONV_IN = WS_WMLA + 2 * MLA_WBYTES;
constexpr size_t WS_WCONV_OUT = WS_WCONV_IN + (size_t)3072 * 1024 * 2;
constexpr size_t WS_WGQA_QKV = WS_WCONV_OUT + (size_t)1024 * 1024 * 2;
constexpr size_t WS_WGQA_O = WS_WGQA_QKV + (size_t)4096 * 1024 * 2;
constexpr size_t WS_WMOE = WS_WGQA_O + (size_t)1024 * 2048 * 2;
constexpr size_t MOE_WBYTES = (size_t)1024 * 1024 * 2 + (size_t)1024 * 512 * 2;
constexpr size_t WS_END = WS_WMOE + (size_t)DEPTH * ME * MOE_WBYTES;
static_assert(WS_END <= (size_t)1073741824, "workspace over 1 GiB");

struct TJob { const float* src; bf16_t* dst; int K, N, rmul, roff; };
struct Params {
  const float* in[N_IN];
  float* out;
  char* ws;
  TJob jobs[14];
};

typedef __bf16 bf16x2_t __attribute__((ext_vector_type(2)));
__device__ __forceinline__ unsigned cvtpk(float lo, float hi) { bf16x2_t v = {(__bf16)lo, (__bf16)hi}; return __builtin_bit_cast(unsigned, v); }
__device__ __forceinline__ unsigned pack4_f8(float a, float b, float c, float d) {
  int w = __builtin_amdgcn_cvt_pk_fp8_f32(fminf(fmaxf(a, -448.f), 448.f), fminf(fmaxf(b, -448.f), 448.f), 0, false);
  w = __builtin_amdgcn_cvt_pk_fp8_f32(fminf(fmaxf(c, -448.f), 448.f), fminf(fmaxf(d, -448.f), 448.f), w, true); return (unsigned)w; }
__device__ __forceinline__ float bf2f(unsigned short h) { return __uint_as_float((unsigned)h << 16); }
__device__ __forceinline__ float bflo(unsigned w) { return __uint_as_float(w << 16); }
__device__ __forceinline__ float bfhi(unsigned w) { return __uint_as_float(w & 0xffff0000u); }
#if XBF16
typedef bf16_t xres_t;
__device__ __forceinline__ f32x4 xload4(const xres_t* q) { const u32x2 w = *(const u32x2*)q; return (f32x4){bflo(w[0]), bfhi(w[0]), bflo(w[1]), bfhi(w[1])}; }
__device__ __forceinline__ void xstore4(xres_t* q, f32x4 v) { u32x2 w = {cvtpk(v[0], v[1]), cvtpk(v[2], v[3])}; *(u32x2*)q = w; }
#else
typedef float xres_t;
__device__ __forceinline__ f32x4 xload4(const xres_t* q) { return *(const f32x4*)q; }
__device__ __forceinline__ void xstore4(xres_t* q, f32x4 v) { *(f32x4*)q = v; }
#endif
template <int CTRL> __device__ __forceinline__ float dpp_mov_f(float v) { return __uint_as_float((unsigned)__builtin_amdgcn_update_dpp(0, (int)__float_as_uint(v), CTRL, 0xF, 0xF, true)); }
__device__ __forceinline__ float wave_sum(float v) {
  v += dpp_mov_f<0xB1>(v);
  v += dpp_mov_f<0x4E>(v);
  v += dpp_mov_f<0x141>(v);
  v += dpp_mov_f<0x140>(v);
  const int u = (int)__float_as_uint(v);
  return (__uint_as_float((unsigned)__builtin_amdgcn_readlane(u, 0)) + __uint_as_float((unsigned)__builtin_amdgcn_readlane(u, 16))) +
         (__uint_as_float((unsigned)__builtin_amdgcn_readlane(u, 32)) + __uint_as_float((unsigned)__builtin_amdgcn_readlane(u, 48)));
}
__device__ __forceinline__ float xor32_f(float v, int lane) { auto r = __builtin_amdgcn_permlane32_swap(__float_as_uint(v), __float_as_uint(v), false, false);
  return __uint_as_float((lane & 32) ? r[0] : r[1]); }
__device__ __forceinline__ float xor16_f(float v, int lane) { auto r = __builtin_amdgcn_permlane16_swap(__float_as_uint(v), __float_as_uint(v), false, false);
  return __uint_as_float((lane & 16) ? r[0] : r[1]); }
__device__ __forceinline__ float silu_f(float x) { return x / (1.0f + __expf(-x)); }
__device__ __forceinline__ void glds16(const void* g, char* l) { __builtin_amdgcn_global_load_lds((const unsigned*)g, (LAS unsigned*)l, 16, 0, 0); }
__device__ __forceinline__ char* opaque_ptr(char* q) {
  unsigned lo = __builtin_amdgcn_readfirstlane((unsigned)(uintptr_t)q), hi = __builtin_amdgcn_readfirstlane((unsigned)((uintptr_t)q >> 32));
  asm volatile("" : "+s"(lo), "+s"(hi));
  return (char*)(__attribute__((address_space(1))) char*)(((uintptr_t)hi << 32) | (uintptr_t)lo); }
__device__ __forceinline__ float rope_invf(int j, int half) { return exp2f(-(float)j * (13.287712379549449f / (float)half)); }


#define XB_TMO      128
#define XB_XCNT(j)  (256  + 64 * (j))
#define XB_XSUB(j)  (1280 + 64 * (j))
#define XB_XGEN(j)  (2304 + 64 * (j))
#define XB_TOP      3328
#define XB_TOPGEN   3392
#define XCD_BAR_WORDS 3456
#define XB_SPIN_CAP (1u << 22)
__device__ __forceinline__ unsigned xb_ld(unsigned* p)              { return __hip_atomic_load(p, __ATOMIC_RELAXED, __HIP_MEMORY_SCOPE_AGENT); }
__device__ __forceinline__ unsigned xb_add(unsigned* p, unsigned v) { return __hip_atomic_fetch_add(p, v, __ATOMIC_RELAXED, __HIP_MEMORY_SCOPE_AGENT); }
__device__ __forceinline__ unsigned xb_xcc_id() { return (unsigned)__builtin_amdgcn_s_getreg((3 << 11) | 20) & 0xFu; }
#define XB_SPIN(cond, bar) do { unsigned _sp = 0; while (cond) { __builtin_amdgcn_s_sleep(1); \
    if ((++_sp & 255u) == 0u) { if (xb_ld(&(bar)[XB_TMO])) break; if (_sp > XB_SPIN_CAP) { atomicAdd(&(bar)[XB_TMO], 1u); break; } } } } while (0)
struct XcdBarrier { unsigned* bar; unsigned x; volatile LAS unsigned* st; };
__device__ __forceinline__ XcdBarrier xcd_barrier_post(unsigned* bar, volatile LAS unsigned* st) {
  XcdBarrier b; b.bar = bar; b.x = xb_xcc_id(); b.st = st;
  if (threadIdx.x == 0) (void)xb_add(&bar[XB_XCNT(b.x)], 1u);
  return b;
}
__device__ __forceinline__ void xcd_barrier_complete(unsigned* bar, unsigned x, unsigned& nloc, unsigned& nx) {
  const unsigned G = gridDim.x * gridDim.y * gridDim.z;
  unsigned sum, cnt, mine, sp = 0u;
  for (;;) {
    sum = 0u; cnt = 0u; mine = 0u;
#pragma unroll
    for (unsigned j = 0; j < 16; ++j) { const unsigned c = xb_ld(&bar[XB_XCNT(j)]); sum += c; cnt += (c > 0u) ? 1u : 0u; mine = (j == x) ? c : mine; }
    if (sum == G) break;
    __builtin_amdgcn_s_sleep(1);
    if ((++sp & 255u) == 0u) { if (xb_ld(&bar[XB_TMO])) break; if (sp > XB_SPIN_CAP) { atomicAdd(&bar[XB_TMO], 1u); break; } }
  }
  nloc = mine > 0u ? mine : 1u; nx = cnt > 0u ? cnt : 1u;
}
__device__ __forceinline__ void xcd_barrier(const XcdBarrier& b) {
  asm volatile("s_waitcnt vmcnt(0)" ::: "memory");
  __syncthreads();
  if (threadIdx.x == 0) {
    unsigned* bar = b.bar;
    __builtin_amdgcn_s_waitcnt(0);
    unsigned nloc = b.st[0], nx = b.st[1];
    if (nloc == 0u) { xcd_barrier_complete(bar, b.x, nloc, nx); b.st[0] = nloc; b.st[1] = nx; }
    const unsigned old = xb_add(&bar[XB_XSUB(b.x)], 1u);
    const unsigned gen = old / nloc;
    const bool lastx = old + 1u == (gen + 1u) * nloc;
    if (!lastx) __builtin_amdgcn_fence(__ATOMIC_ACQUIRE, "agent");
    if (lastx) {
      __builtin_amdgcn_fence(__ATOMIC_RELEASE, "agent");
      asm volatile("s_waitcnt vmcnt(0)" ::: "memory");
      const unsigned og = xb_add(&bar[XB_TOP], 1u);
      const unsigned tg = og / nx;
      __builtin_amdgcn_fence(__ATOMIC_ACQUIRE, "agent");
      if (og + 1u != (tg + 1u) * nx) XB_SPIN(xb_ld(&bar[XB_TOP]) < (tg + 1u) * nx, bar);
      asm volatile("s_waitcnt vmcnt(0)" ::: "memory");
    } else {
      XB_SPIN(xb_ld(&bar[XB_TOP]) < (gen + 1u) * nx, bar);
      asm volatile("s_waitcnt vmcnt(0)" ::: "memory");
    }
  }
  __syncthreads();
}
__device__ __forceinline__ void xcd_barrier_arrive(const XcdBarrier& b) {
  asm volatile("s_waitcnt vmcnt(0)" ::: "memory");
  __syncthreads();
  if (threadIdx.x == 0) {
    unsigned* bar = b.bar;
    __builtin_amdgcn_s_waitcnt(0);
    unsigned nloc = b.st[0], nx = b.st[1];
    if (nloc == 0u) { xcd_barrier_complete(bar, b.x, nloc, nx); b.st[0] = nloc; b.st[1] = nx; }
    const unsigned old = xb_add(&bar[XB_XSUB(b.x)], 1u);
    const unsigned gen = old / nloc;
    if (old + 1u != (gen + 1u) * nloc) __builtin_amdgcn_fence(__ATOMIC_ACQUIRE, "agent");
    else {
      __builtin_amdgcn_fence(__ATOMIC_RELEASE, "agent");
      asm volatile("s_waitcnt vmcnt(0)" ::: "memory");
      (void)xb_add(&bar[XB_TOP], 1u);
      asm volatile("s_waitcnt vmcnt(0)" ::: "memory");
      __builtin_amdgcn_fence(__ATOMIC_ACQUIRE, "agent");
    }
    b.st[2] = (gen + 1u) * nx;
  }
}
__device__ __forceinline__ void xcd_barrier_wait(const XcdBarrier& b) {
  if (threadIdx.x == 0) {
    unsigned* bar = b.bar;
    const unsigned target = b.st[2];
    XB_SPIN(xb_ld(&bar[XB_TOP]) < target, bar);
    asm volatile("s_waitcnt vmcnt(0)" ::: "memory");
  }
  __syncthreads();
}

template <int MB, class Prov, int GMODE = 0, bool F8 = false>
__device__ __forceinline__ void gemm_stream(const Prov& pv, char* lds) {
  constexpr int BM = MB * 16, BN = 256, A_BYTES = BM * 128, STAGE = (BM + BN) * 128, AR = (BM + 63) / 64, BR = BN / 64, MB0 = (MB + 1) / 2, NW = 4;
  static_assert(2 * STAGE <= 135168, "GEMM LDS stages");
  int tid = threadIdx.x; asm volatile("" : "+v"(tid));
  const int wid = tid >> 6, lane = tid & 63, fr = lane & 15, fq = lane >> 4, wm = wid >> 2, wn = wid & 3;
  const int srow = tid >> 3, pc = tid & 7, lc = pc ^ (srow & 7);
  const int lds_base = (int)(uintptr_t)(LAS char*)lds;
  const int a_off = lds_base + (wm * MB0 * 16 + fr) * 128, b_off = lds_base + A_BYTES + (wn * 64 + fr) * 128;
  const int ch0 = (fq ^ (fr & 7)) * 16, ch1 = ((4 + fq) ^ (fr & 7)) * 16;
  const int bsrc = 16 * ((srow >> 2) & 3) + 4 * (srow >> 4) + (srow & 3);
  const bool lastm = (MB % 2 == 0) || wm == 0;
  typename Prov::Unit u, un;
  int it = 0;
  if (!pv.unit(it, u, srow)) return;
  constexpr int APN = Prov::A_AFFINE ? 1 : AR;
  const bf16_t* ap[APN]; const bf16_t* bp0; int astr = 0, bstr = 0;
#define GS_LOADPTR(U) do { _Pragma("unroll") for (int i = 0; i < APN; ++i) ap[i] = pv.a_row(U, srow + 64 * i) + lc * 8; \
    bp0 = pv.b_row(U, bsrc) + lc * 8; astr = pv.a_stride(U); bstr = pv.b_stride(U); } while (0)
#define GS_ISSUE(KO, BUF) do { char* base_ = lds + (BUF) * STAGE; \
    _Pragma("unroll") for (int i = 0; i < AR; ++i) if (AR * 64 == BM || srow + 64 * i < BM) glds16((Prov::A_AFFINE ? ap[0] + (size_t)i * astr : ap[i < APN ? i : 0]) + (KO), base_ + i * 8192 + tid * 16); \
    _Pragma("unroll") for (int i = 0; i < BR; ++i) glds16(bp0 + (size_t)i * bstr + (KO), base_ + A_BYTES + i * 8192 + tid * 16); } while (0)
#define GS_DSR(dst, addr) asm volatile("ds_read_b128 %0, %1" : "=v"(dst) : "v"(addr) : "memory")
  GS_LOADPTR(u); GS_ISSUE(0, 0);
  int buf = 0;
  for (;;) {
    const bool have_n = pv.unit(it + 1, un, srow);
    const int nk = pv.nk(u);
    f32x4 acc[MB0][NW];
#pragma unroll
    for (int m = 0; m < MB0; ++m)
#pragma unroll
      for (int n = 0; n < NW; ++n) acc[m][n] = (f32x4){0.f, 0.f, 0.f, 0.f};
#pragma unroll 1
    for (int kt = 0; kt < nk; ++kt) {
      asm volatile("s_waitcnt vmcnt(0)" ::: "memory");
      __syncthreads();
      if (GMODE != 2) { if (kt + 1 < nk) { GS_ISSUE((kt + 1) * 64, buf ^ 1); }
      else if (have_n) { GS_LOADPTR(un); GS_ISSUE(0, buf ^ 1); } }
      if (GMODE != 1 && F8) {
        constexpr int GS = MB0 > 4 ? 1 : 2, NG = (MB0 + GS - 1) / GS;
        const int sbo = buf * STAGE;
        const int cl = ((2 * fq) ^ (fr & 7)) * 16, chh = ((2 * fq + 1) ^ (fr & 7)) * 16;
        const int aaL = sbo + a_off + cl, aaH = sbo + a_off + chh, bbL = sbo + b_off + cl, bbH = sbo + b_off + chh;
        u32x4 fbl[NW], fbh[NW], fal[2][GS], fah[2][GS];
#define GS_DSR8(dst, addr) asm volatile("ds_read_b128 %0, %1" : "=v"(dst) : "v"(addr) : "memory")
#pragma unroll
        for (int n = 0; n < NW; ++n) { GS_DSR8(fbl[n], bbL + n * 2048); GS_DSR8(fbh[n], bbH + n * 2048); }
#pragma unroll
        for (int j = 0; j < GS; ++j) if (j < MB0) { GS_DSR8(fal[0][j], aaL + j * 2048); GS_DSR8(fah[0][j], aaH + j * 2048); }
#pragma unroll
        for (int g = 0; g < NG; ++g) {
          int nnext = 0;
          if (g + 1 < NG) {
#pragma unroll
            for (int j = 0; j < GS; ++j) { const int i = (g + 1) * GS + j; if (i < MB0) { GS_DSR8(fal[(g + 1) & 1][j], aaL + i * 2048); GS_DSR8(fah[(g + 1) & 1][j], aaH + i * 2048); nnext += 2; } }
          }
          if (nnext == 4) asm volatile("s_waitcnt lgkmcnt(4)" ::: "memory"); else if (nnext == 2) asm volatile("s_waitcnt lgkmcnt(2)" ::: "memory");
          else asm volatile("s_waitcnt lgkmcnt(0)" ::: "memory");
          __builtin_amdgcn_sched_barrier(0);
#pragma unroll
          for (int j = 0; j < GS; ++j) { const int m = g * GS + j;
            if (m < MB0 && (m < MB0 - 1 || lastm)) {
              const i32x8 av = {(int)fal[g & 1][j][0], (int)fal[g & 1][j][1], (int)fal[g & 1][j][2], (int)fal[g & 1][j][3], (int)fah[g & 1][j][0], (int)fah[g & 1][j][1], (int)fah[g & 1][j][2], (int)fah[g & 1][j][3]};
#pragma unroll
              for (int n = 0; n < NW; ++n) { const i32x8 bv = {(int)fbl[n][0], (int)fbl[n][1], (int)fbl[n][2], (int)fbl[n][3], (int)fbh[n][0], (int)fbh[n][1], (int)fbh[n][2], (int)fbh[n][3]};
                acc[m][n] = __builtin_amdgcn_mfma_scale_f32_16x16x128_f8f6f4(bv, av, acc[m][n], 0, 0, 0, 0x7f7f7f7f, 0, 0x7f7f7f7f); }
#pragma unroll
              for (int n = 0; n < NW; ++n) asm volatile("" : "+v"(acc[m][n]));
            } }
          __builtin_amdgcn_sched_barrier(0);
        }
#undef GS_DSR8
      }
      if (GMODE != 1 && !F8) {
        constexpr int NI = 2 * MB0, GS = 2, NG = (NI + GS - 1) / GS;
        const int sbo = buf * STAGE;
        const int aa0 = sbo + a_off + ch0, aa1 = sbo + a_off + ch1, bb0 = sbo + b_off + ch0, bb1 = sbo + b_off + ch1;
        bf16x8 fb[2][NW], fa[2][GS];
#pragma unroll
        for (int n = 0; n < NW; ++n) GS_DSR(fb[0][n], bb0 + n * 2048);
#pragma unroll
        for (int j = 0; j < GS; ++j) GS_DSR(fa[0][j], aa0 + j * 2048);
#pragma unroll
        for (int n = 0; n < NW; ++n) GS_DSR(fb[1][n], bb1 + n * 2048);
#pragma unroll
        for (int g = 0; g < NG; ++g) {
          int nnext = 0;
          if (g + 1 < NG) {
#pragma unroll
            for (int j = 0; j < GS; ++j) { const int i = (g + 1) * GS + j; if (i < NI) { GS_DSR(fa[(g + 1) & 1][j], (i / MB0 ? aa1 : aa0) + (i % MB0) * 2048); ++nnext; } }
          }
          if (g == 0) nnext += NW;
          if (nnext == 8) asm volatile("s_waitcnt lgkmcnt(8)" ::: "memory"); else if (nnext == 7) asm volatile("s_waitcnt lgkmcnt(7)" ::: "memory");
          else if (nnext == 6) asm volatile("s_waitcnt lgkmcnt(6)" ::: "memory"); else if (nnext == 5) asm volatile("s_waitcnt lgkmcnt(5)" ::: "memory");
          else if (nnext == 4) asm volatile("s_waitcnt lgkmcnt(4)" ::: "memory"); else if (nnext == 3) asm volatile("s_waitcnt lgkmcnt(3)" ::: "memory");
          else if (nnext == 2) asm volatile("s_waitcnt lgkmcnt(2)" ::: "memory"); else if (nnext == 1) asm volatile("s_waitcnt lgkmcnt(1)" ::: "memory");
          else asm volatile("s_waitcnt lgkmcnt(0)" ::: "memory");
          __builtin_amdgcn_sched_barrier(0);
#pragma unroll
          for (int j = 0; j < GS; ++j) { const int i = g * GS + j;
            if (i < NI) { const int m = i % MB0;
              if (m < MB0 - 1 || lastm) {
#pragma unroll
                for (int n = 0; n < NW; ++n) acc[m][n] = __builtin_amdgcn_mfma_f32_16x16x32_bf16(fb[i / MB0][n], fa[g & 1][j], acc[m][n], 0, 0, 0);
              } } }
          __builtin_amdgcn_sched_barrier(0);
        }
      }
      buf ^= 1;
    }
#pragma unroll
    for (int m = 0; m < MB0; ++m) if (m < MB0 - 1 || lastm) {
      pv.epi(u, (wm * MB0 + m) * 16 + fr, wn * 64 + fq * 16, acc[m][0], acc[m][1], acc[m][2], acc[m][3]);
    }
    if (!have_n) break;
    u = un; ++it;
  }
  __syncthreads();
#undef GS_LOADPTR
#undef GS_ISSUE
#undef GS_DSR
}

__device__ __forceinline__ u32x4 pack8(f32x4 a, f32x4 b) { return (u32x4){cvtpk(a[0], a[1]), cvtpk(a[2], a[3]), cvtpk(b[0], b[1]), cvtpk(b[2], b[3])}; }
struct EpiBf16 { bf16_t* C; int ldc; float sc = 1.0f; __device__ __forceinline__ void operator()(int r, int c, f32x4 v0, f32x4 v1, f32x4 v2, f32x4 v3) const {
  bf16_t* o = C + (size_t)r * ldc + c; *(u32x4*)o = pack8(v0 * sc, v1 * sc); *(u32x4*)(o + 8) = pack8(v2 * sc, v3 * sc); } };
struct EpiResid { xres_t* X; const float* gate; xres_t* dry; float sc = 1.0f;
  __device__ __forceinline__ void half8(int row, int c, int bsel, f32x4 v0, f32x4 v1) const {
    const f32x4 g0 = *(const f32x4*)(gate + (size_t)bsel * NMOD + c), g1 = *(const f32x4*)(gate + (size_t)bsel * NMOD + c + 4);
#if XBF16
    const u32x4 xw = *(const u32x4*)(X + (size_t)row * D + c);
    f32x4 x0 = {bflo(xw[0]), bfhi(xw[0]), bflo(xw[1]), bfhi(xw[1])}, x1 = {bflo(xw[2]), bfhi(xw[2]), bflo(xw[3]), bfhi(xw[3])};
    x0 += g0 * v0; x1 += g1 * v1;
    *(u32x4*)((dry ? dry : X) + (size_t)row * D + c) = pack8(x0, x1);
#else
    f32x4 x0 = xload4(X + (size_t)row * D + c), x1 = xload4(X + (size_t)row * D + c + 4); x0 += g0 * v0; x1 += g1 * v1;
    xstore4((dry ? dry : X) + (size_t)row * D + c, x0); xstore4((dry ? dry : X) + (size_t)row * D + c + 4, x1);
#endif
  }
  __device__ __forceinline__ void operator()(int row, int c, f32x4 v0, f32x4 v1, f32x4 v2, f32x4 v3) const {
    const int b = row / RPB, ii = row - b * RPB, bsel = ii < CTX ? 4 : b;
    half8(row, c, bsel, v0 * sc, v1 * sc); half8(row, c + 8, bsel, v2 * sc, v3 * sc); } };

template <int BM, int BN, bool LATONLY, class Epi>
struct DenseProv {
  const bf16_t* A; int lda; const bf16_t* Bt; int K; int nNt; Epi ep;
  struct Unit { int m0, n0; };
  __device__ __forceinline__ bool unit(int it, Unit& U, int) const {
    const int nloc = gridDim.x >> 3, x = blockIdx.x & 7, loc = (blockIdx.x >> 3) + nloc * it;
    if (loc >= 8 * nNt) return false;
    const int mt = x * 8 + (loc & 7), nt = loc >> 3;
    U.m0 = LATONLY ? (mt >> 4) * RPB + CTX + (mt & 15) * 256 : mt * BM; U.n0 = nt * BN; return true;
  }
  static constexpr bool A_AFFINE = true;
  __device__ __forceinline__ int a_stride(const Unit&) const { return 64 * lda; }
  __device__ __forceinline__ int b_stride(const Unit&) const { return 64 * K; }
  __device__ __forceinline__ const bf16_t* a_row(const Unit& U, int r) const { return A + (size_t)(U.m0 + r) * lda; }
  __device__ __forceinline__ const bf16_t* b_row(const Unit& U, int r) const { return Bt + (size_t)(U.n0 + r) * K; }
  __device__ __forceinline__ int nk(const Unit&) const { return K >> 6; }
  __device__ __forceinline__ void epi(const Unit& U, int r, int c, f32x4 v0, f32x4 v1, f32x4 v2, f32x4 v3) const { ep(U.m0 + r, U.n0 + c, v0, v1, v2, v3); }
};
template <int MB, int NBW, bool LATONLY, class Epi, int GMODE = 0, bool F8 = false>
__device__ __forceinline__ void gemm_dense(const bf16_t* A, int lda, const bf16_t* Bt, int N, int K, const Epi& ep, char* lds) {
  static_assert(NBW == 2, "256-column tiles");
  DenseProv<MB * 16, 256, LATONLY, Epi> pv{A, lda, Bt, K, N / 256, ep};
  gemm_stream<MB, DenseProv<MB * 16, 256, LATONLY, Epi>, GMODE, F8>(pv, lds);
}

template <bool F8>
struct MlaUpProv {
  const bf16_t* CQ; const bf16_t* CKV; const bf16_t* WUQ; const bf16_t* WUKV; bf16_t* Q; bf16_t* KV; unsigned char* K8;
  static constexpr int QU = F8 ? QL / 2 : QL, KU = F8 ? KVL / 2 : KVL;
  struct Unit { int m0, n0, which; };
  __device__ __forceinline__ bool unit(int it, Unit& U, int) const {
    const int b = blockIdx.x; int which, t;
    if (b < 128) { if (it > 2) return false; which = it == 2; t = it == 2 ? b : 2 * b + it; }
    else { if (it > 3) return false; which = it != 0; t = it == 0 ? 256 + (b - 128) : 128 + 3 * (b - 128) + (it - 1); }
    U.which = which;
    if (which) { U.m0 = (t >> 3) * 272; U.n0 = (t & 7) * 256; } else { U.m0 = (t / 6) * 272; U.n0 = (t % 6) * 256; }
    return true;
  }
  static constexpr bool A_AFFINE = true;
  __device__ __forceinline__ int a_stride(const Unit& U) const { return U.which ? 64 * KU : 64 * QU; }
  __device__ __forceinline__ int b_stride(const Unit& U) const { return U.which ? 64 * KU : 64 * QU; }
  __device__ __forceinline__ const bf16_t* a_row(const Unit& U, int r) const { return U.which ? CKV + (size_t)(U.m0 + r) * KU : CQ + (size_t)(U.m0 + r) * QU; }
  __device__ __forceinline__ const bf16_t* b_row(const Unit& U, int r) const { return U.which ? WUKV + (size_t)(U.n0 + r) * KU : WUQ + (size_t)(U.n0 + r) * QU; }
  __device__ __forceinline__ int nk(const Unit& U) const { return U.which ? KU / 64 : QU / 64; }
  __device__ __forceinline__ void epi(const Unit& U, int r, int c, f32x4 v0, f32x4 v1, f32x4 v2, f32x4 v3) const {
    if (F8) { constexpr float is = 1.0f / 512.0f; v0 *= is; v1 *= is; v2 *= is; v3 *= is; }
    bf16_t* o = U.which ? KV + (size_t)(U.m0 + r) * 2048 + U.n0 + c : Q + (size_t)(U.m0 + r) * 1536 + U.n0 + c; *(u32x4*)o = pack8(v0, v1); *(u32x4*)(o + 8) = pack8(v2, v3);
    if (QK_F8 && U.which) { const int col = U.n0 + c, hd = col >> 8, wi = col & 255;
      if (wi < 128) { u32x4 w = {pack4_f8(v0[0] * F8_SQK, v0[1] * F8_SQK, v0[2] * F8_SQK, v0[3] * F8_SQK), pack4_f8(v1[0] * F8_SQK, v1[1] * F8_SQK, v1[2] * F8_SQK, v1[3] * F8_SQK),
                                 pack4_f8(v2[0] * F8_SQK, v2[1] * F8_SQK, v2[2] * F8_SQK, v2[3] * F8_SQK), pack4_f8(v3[0] * F8_SQK, v3[1] * F8_SQK, v3[2] * F8_SQK, v3[3] * F8_SQK)};
        *(u32x4*)(K8 + (size_t)(U.m0 + r) * 1024 + hd * 128 + wi) = w; } } }
};

template <int DK> struct AttnCfg {
  static constexpr int KROW = DK * (QK_F8 ? 1 : 2);
  static constexpr int SHM_V = 64 * 128 * ((QK_F8 && PV_F8) ? 1 : 2), SHM_K = 64 * KROW;
  static constexpr int SHM = 2 * SHM_V + 2 * SHM_K + 8 * 64 * 4;
};
#define SBAR() __builtin_amdgcn_sched_barrier(0)
__device__ __forceinline__ int crow(int r, int hi) { return (r & 3) + 8 * (r >> 2) + 4 * hi; }
__device__ __forceinline__ int v_st(int k, int c) { const int kk = (k & ~0xC) | ((k & 4) << 1) | ((k & 8) >> 1); return ((kk >> 3) * 4 + (c >> 5)) * 512 + ((kk & 7) * 32 + (c & 31)) * 2; }
__device__ __forceinline__ int v_rd_base(int lane) { return ((lane & 3) << 3) | (((lane >> 2) & 3) << 6) | (((lane >> 4) & 1) << 5) | (((lane >> 5) & 1) << 8); }
constexpr int v_rd_off(int d0, int ks, int half) { return d0 * 512 + ks * 4096 + half * 2048; }
template <int OFF> __device__ __forceinline__ s16x4 tr_read(int vb) {
  s16x4 r; asm volatile("ds_read_b64_tr_b16 %0, %1 offset:%2" : "=&v"(r) : "v"(vb), "i"(OFF) : "memory"); return r;
}
template <int D0> __device__ __forceinline__ void pv_one(f32x16& od, int vb, bf16x8 pa0, bf16x8 pa1, bf16x8 pa2, bf16x8 pa3) {
  const s16x4 l0 = tr_read<v_rd_off(D0, 0, 0)>(vb), h0 = tr_read<v_rd_off(D0, 0, 1)>(vb), l1 = tr_read<v_rd_off(D0, 1, 0)>(vb), h1 = tr_read<v_rd_off(D0, 1, 1)>(vb);
  const s16x4 l2 = tr_read<v_rd_off(D0, 2, 0)>(vb), h2 = tr_read<v_rd_off(D0, 2, 1)>(vb), l3 = tr_read<v_rd_off(D0, 3, 0)>(vb), h3 = tr_read<v_rd_off(D0, 3, 1)>(vb);
  asm volatile("s_waitcnt lgkmcnt(0)" ::: "memory"); SBAR();
#define PK(L, H) (bf16x8){L[0], L[1], L[2], L[3], H[0], H[1], H[2], H[3]}
  od = __builtin_amdgcn_mfma_f32_32x32x16_bf16(pa0, PK(l0, h0), od, 0, 0, 0);
  od = __builtin_amdgcn_mfma_f32_32x32x16_bf16(pa1, PK(l1, h1), od, 0, 0, 0);
  od = __builtin_amdgcn_mfma_f32_32x32x16_bf16(pa2, PK(l2, h2), od, 0, 0, 0);
  od = __builtin_amdgcn_mfma_f32_32x32x16_bf16(pa3, PK(l3, h3), od, 0, 0, 0);
#undef PK
}
__device__ __forceinline__ void pv_d0(f32x16* o, int vb, bf16x8 pa0, bf16x8 pa1, bf16x8 pa2, bf16x8 pa3) {
  pv_one<0>(o[0], vb, pa0, pa1, pa2, pa3); pv_one<1>(o[1], vb, pa0, pa1, pa2, pa3); pv_one<2>(o[2], vb, pa0, pa1, pa2, pa3); pv_one<3>(o[3], vb, pa0, pa1, pa2, pa3);
}
constexpr float ATT_THR = (QK_F8 && PV_F8) ? 3.f : 8.f;
template <int DK> __device__ __forceinline__ void partialSM(f32x16& p0, f32x16& p1, float& m_reg, float& mn, float& alpha) {
  constexpr float SCALE = (DK == 192 ? 0.07216878364870322f : 0.08838834764831845f) * (QK_F8 ? 1.0f / (F8_SQK * F8_SQK) : 1.0f);
  constexpr float C = SCALE * 1.4426950408889634f;
  float pmax = p0[0];
#pragma unroll
  for (int r = 1; r < 16; ++r) pmax = fmaxf(pmax, p0[r]);
#pragma unroll
  for (int r = 0; r < 16; ++r) pmax = fmaxf(pmax, p1[r]);
  { auto rr = __builtin_amdgcn_permlane32_swap(__float_as_uint(pmax), __float_as_uint(pmax), false, false);
    pmax = fmaxf(__uint_as_float(rr[0]), __uint_as_float(rr[1])); }
  mn = (pmax - m_reg > ATT_THR / SCALE) ? pmax : m_reg; alpha = __builtin_amdgcn_exp2f((m_reg - mn) * C); m_reg = mn;
  const float mnC = -mn * C + ((QK_F8 && PV_F8) ? 4.0f : 0.0f);
#pragma unroll
  for (int r = 0; r < 16; ++r) p0[r] = fmaf(p0[r], C, mnC);
#pragma unroll
  for (int r = 0; r < 16; ++r) p1[r] = fmaf(p1[r], C, mnC);
#pragma unroll
  for (int r = 0; r < 16; ++r) p0[r] = __builtin_amdgcn_exp2f(p0[r]);
}
__device__ __forceinline__ void finishSM(f32x16& p0, f32x16& p1, float alpha, float& l_reg, bf16x8& pa0, bf16x8& pa1, bf16x8& pa2, bf16x8& pa3) {
#pragma unroll
  for (int r = 0; r < 16; ++r) p1[r] = __builtin_amdgcn_exp2f(p1[r]);
  float ps = 0;
#pragma unroll
  for (int r = 0; r < 16; ++r) ps += p0[r];
#pragma unroll
  for (int r = 0; r < 16; ++r) ps += p1[r];
  { auto rr = __builtin_amdgcn_permlane32_swap(__float_as_uint(ps), __float_as_uint(ps), false, false);
    ps = __uint_as_float(rr[0]) + __uint_as_float(rr[1]); }
  l_reg = l_reg * alpha + ps;
#define PK4(P, BASE, OUT) do { unsigned a0 = cvtpk(P[BASE + 0], P[BASE + 1]), a1 = cvtpk(P[BASE + 2], P[BASE + 3]);   \
    unsigned b0 = cvtpk(P[BASE + 4], P[BASE + 5]), b1 = cvtpk(P[BASE + 6], P[BASE + 7]);                              \
    auto r0 = __builtin_amdgcn_permlane32_swap(a0, b0, false, false); auto r1 = __builtin_amdgcn_permlane32_swap(a1, b1, false, false); \
    u32x4 w = {r0[0], r1[0], r0[1], r1[1]}; OUT = *reinterpret_cast<bf16x8*>(&w); } while (0)
  PK4(p0, 0, pa0); PK4(p0, 8, pa1); PK4(p1, 0, pa2); PK4(p1, 8, pa3);
#undef PK4
}
template <int DK> __device__ __forceinline__ void qkt(f32x16& p0, f32x16& p1, const char* Ks, const bf16x8* qr, const int* kro) {
  constexpr int KROW = DK * 2;
  p0 = f32x16{}; p1 = f32x16{};
#pragma unroll
  for (int d0 = 0; d0 < DK / 16; ++d0) {
    bf16x8 b0 = *reinterpret_cast<const bf16x8*>(Ks + kro[d0 & 3] + (d0 >> 2) * 128);
    bf16x8 b1 = *reinterpret_cast<const bf16x8*>(Ks + kro[d0 & 3] + (d0 >> 2) * 128 + 32 * KROW);
    p0 = __builtin_amdgcn_mfma_f32_32x32x16_bf16(b0, qr[d0], p0, 0, 0, 0);
    p1 = __builtin_amdgcn_mfma_f32_32x32x16_bf16(b1, qr[d0], p1, 0, 0, 0); }
}

template <int DK, int ldq, int ldk, int ldv, int ldo>
__device__ __forceinline__ void attn_unit(const bf16_t* __restrict__ Qb, const bf16_t* __restrict__ Kh, const bf16_t* __restrict__ Kp,
                                          const bf16_t* __restrict__ Vh, bf16_t* __restrict__ Ob, int nkeys, bool rope, int qpos0,
                                          const float* __restrict__ qg, char* lds) {
  using Cfg = AttnCfg<DK>;
  constexpr int KROW = Cfg::KROW, SHM_V = Cfg::SHM_V, SHM_K = Cfg::SHM_K, ND0 = DK / 16;
  int tid = threadIdx.x; asm volatile("" : "+v"(tid));
  const int wid = tid >> 6, lane = tid & 63, r32 = lane & 31, hi = lane >> 5;
  char* V_lds = lds; char* K_lds = lds + 2 * SHM_V;
  float* wsl = (float*)(lds + 2 * SHM_V + 2 * SHM_K) + wid * 64; float* li_l = wsl; float* al_l = wsl + 32;
  float m_reg = -1e30f, l_reg = 0; f32x16 o[4] = {}; bf16x8 qr[ND0];
  {
    const int qrow = wid * 32 + r32;
    const bf16_t* Qw = Qb + (size_t)qrow * ldq + hi * 8;
    float qf[ND0][8];
#pragma unroll
    for (int d0 = 0; d0 < ND0; ++d0) { const u32x4 w = *reinterpret_cast<const u32x4*>(Qw + d0 * 16);
#pragma unroll
      for (int e = 0; e < 4; ++e) { qf[d0][2 * e] = bflo(w[e]); qf[d0][2 * e + 1] = bfhi(w[e]); } }
    const int qpos = qpos0 + qrow; const float prow = (float)(qpos >> 6), pcol = (float)(qpos & 63);
    int hio = hi; asm volatile("" : "+v"(hio));
    if constexpr (DK == 128) {
      float ss = 0.f;
#pragma unroll
      for (int d0 = 0; d0 < 8; ++d0)
#pragma unroll
        for (int e = 0; e < 8; ++e) ss += qf[d0][e] * qf[d0][e];
      ss += __shfl_xor(ss, 32);
      const float rs = rsqrtf(ss * (1.0f / 128.0f) + EPS);
#pragma unroll
      for (int d0 = 0; d0 < 8; ++d0) { const f32x4 g0 = *(const f32x4*)(qg + d0 * 16 + hi * 8), g1 = *(const f32x4*)(qg + d0 * 16 + hi * 8 + 4);
#pragma unroll
        for (int e = 0; e < 4; ++e) { qf[d0][e] *= rs * g0[e]; qf[d0][4 + e] *= rs * g1[e]; } }
      if (rope) {
#pragma unroll
        for (int hf = 0; hf < 2; ++hf) { const float pos = hf ? pcol : prow;
#pragma unroll
          for (int dd = 0; dd < 2; ++dd)
#pragma unroll
            for (int e = 0; e < 8; ++e) { const int j = dd * 16 + hio * 8 + e; const float ang = pos * rope_invf(j, 32); const float cs = __cosf(ang), sn = __sinf(ang);
              const float x1 = qf[hf * 4 + dd][e], x2 = qf[hf * 4 + dd + 2][e]; qf[hf * 4 + dd][e] = x1 * cs - x2 * sn; qf[hf * 4 + dd + 2][e] = x1 * sn + x2 * cs; } }
      }
    } else {
      if (rope) {
#pragma unroll
        for (int hf = 0; hf < 2; ++hf) { const float pos = hf ? pcol : prow;
#pragma unroll
          for (int e = 0; e < 8; ++e) { const int j = hio * 8 + e; const float ang = pos * rope_invf(j, 16); const float cs = __cosf(ang), sn = __sinf(ang);
            const float x1 = qf[8 + hf * 2][e], x2 = qf[9 + hf * 2][e]; qf[8 + hf * 2][e] = x1 * cs - x2 * sn; qf[9 + hf * 2][e] = x1 * sn + x2 * cs; } }
      }
    }
#pragma unroll
    for (int d0 = 0; d0 < ND0; ++d0) { u32x4 w = {cvtpk(qf[d0][0], qf[d0][1]), cvtpk(qf[d0][2], qf[d0][3]), cvtpk(qf[d0][4], qf[d0][5]), cvtpk(qf[d0][6], qf[d0][7])};
      qr[d0] = *reinterpret_cast<bf16x8*>(&w); }
  }
  int kro[4];
#pragma unroll
  for (int bq = 0; bq < 4; ++bq) kro[bq] = r32 * KROW + (((2 * bq + hi) ^ (r32 & 7)) << 4);
  const int sr = tid >> 4, sc = (tid & 15) * 8, vst0 = v_st(sr, sc), vst1 = v_st(32 + sr, sc);
  const int pr = tid >> 3, pcc = (tid & 7) * 8;
  const int vb0 = (int)(uintptr_t)(LAS char*)V_lds + v_rd_base(lane);
  bf16x8 vs0, vs1, ks0, ks1, kp0;
  const unsigned voff = sr * ldv + sc, koff = sr * ldk + sc, poff = pr * ROPE + pcc;
#define SLOAD(k0) do { const bf16_t* Vt = Vh + (size_t)(k0) * ldv; const bf16_t* Kt = Kh + (size_t)(k0) * ldk; \
    vs0 = *(const bf16x8*)(Vt + voff); vs1 = *(const bf16x8*)(Vt + 32 * ldv + voff); \
    ks0 = *(const bf16x8*)(Kt + koff); ks1 = *(const bf16x8*)(Kt + 32 * ldk + koff); \
    if constexpr (DK == 192) kp0 = *(const bf16x8*)(Kp + (size_t)(k0) * ROPE + poff); } while (0)
#define SWRITE(b) do { *(bf16x8*)(V_lds + (b) * SHM_V + vst0) = vs0; *(bf16x8*)(V_lds + (b) * SHM_V + vst1) = vs1; const int kc = sc * 2; \
    *(bf16x8*)(K_lds + (b) * SHM_K + sr * KROW + (kc ^ ((sr & 7) << 4))) = ks0; \
    *(bf16x8*)(K_lds + (b) * SHM_K + (32 + sr) * KROW + (kc ^ ((sr & 7) << 4))) = ks1; \
    if constexpr (DK == 192) *(bf16x8*)(K_lds + (b) * SHM_K + pr * KROW + ((256 + pcc * 2) ^ ((pr & 7) << 4))) = kp0; } while (0)
#define RESC(a) do { if (__any((a) < 1.f)) { if (hi == 0) al_l[r32] = (a); asm volatile("s_waitcnt lgkmcnt(0)" ::: "memory"); \
    for (int d = 0; d < 4; ++d) for (int r = 0; r < 16; ++r) o[d][r] *= al_l[crow(r, hi)]; } } while (0)
  f32x16 pA0, pA1, pB0, pB1; float mnA, mnB, alA, alB; bf16x8 pa0, pa1, pa2, pa3; const int NT = nkeys / 64;
  SLOAD(0); SWRITE(0); __syncthreads();
  qkt<DK>(pA0, pA1, K_lds, qr, kro); partialSM<DK>(pA0, pA1, m_reg, mnA, alA);
  SLOAD(64); SWRITE(1); __syncthreads();
  for (int j = 1; j + 1 < NT; j += 2) {
    SBAR(); qkt<DK>(pB0, pB1, K_lds + SHM_K, qr, kro);
    finishSM(pA0, pA1, alA, l_reg, pa0, pa1, pa2, pa3); SBAR();
    SLOAD((j + 1) * 64); SBAR();
    pv_d0(o, vb0, pa0, pa1, pa2, pa3); partialSM<DK>(pB0, pB1, m_reg, mnB, alB);
    __syncthreads(); SWRITE(0);
    RESC(alB); __syncthreads();
    SBAR(); qkt<DK>(pA0, pA1, K_lds, qr, kro);
    finishSM(pB0, pB1, alB, l_reg, pa0, pa1, pa2, pa3); SBAR();
    SLOAD((j + 2) * 64); SBAR();
    pv_d0(o, vb0 + SHM_V, pa0, pa1, pa2, pa3); partialSM<DK>(pA0, pA1, m_reg, mnA, alA);
    __syncthreads(); SWRITE(1);
    RESC(alA); __syncthreads();
  }
  SBAR(); qkt<DK>(pB0, pB1, K_lds + SHM_K, qr, kro);
  finishSM(pA0, pA1, alA, l_reg, pa0, pa1, pa2, pa3); SBAR();
  pv_d0(o, vb0, pa0, pa1, pa2, pa3); partialSM<DK>(pB0, pB1, m_reg, mnB, alB);
  __syncthreads(); RESC(alB);
  finishSM(pB0, pB1, alB, l_reg, pa0, pa1, pa2, pa3); SBAR();
  pv_d0(o, vb0 + SHM_V, pa0, pa1, pa2, pa3);
  if (hi == 0) li_l[r32] = l_reg; asm volatile("s_waitcnt lgkmcnt(0)" ::: "memory");
  float rli[16];
#pragma unroll
  for (int r = 0; r < 16; ++r) rli[r] = __builtin_amdgcn_rcpf(li_l[crow(r, hi)]);
  if (WO_F8) {
    unsigned char* st = (unsigned char*)K_lds + wid * 4096;
#pragma unroll
    for (int r = 0; r < 16; ++r) { const int orow = crow(r, hi); const float s = rli[r] * F8_SO;
#pragma unroll
      for (int d0 = 0; d0 < 4; ++d0) st[orow * 128 + d0 * 32 + r32] = (unsigned char)(__builtin_amdgcn_cvt_pk_fp8_f32(fminf(fmaxf(o[d0][r] * s, -448.f), 448.f), 0.f, 0, false) & 0xff); }
    asm volatile("s_waitcnt lgkmcnt(0)" ::: "memory");
    unsigned char* Ow8 = (unsigned char*)Ob + (size_t)(wid * 32) * ldo;
#pragma unroll
    for (int ps = 0; ps < 4; ++ps) { const int row = ps * 8 + (lane >> 3), ch = (lane & 7) * 16;
      *(u32x4*)(Ow8 + (size_t)row * ldo + ch) = *(const u32x4*)(st + row * 128 + ch); }
  } else {
  bf16_t* Ow = Ob + (size_t)(wid * 32) * ldo;
#pragma unroll
  for (int r = 0; r < 16; ++r) { const int orow = crow(r, hi);
#pragma unroll
    for (int d0 = 0; d0 < 4; ++d0) Ow[(size_t)orow * ldo + d0 * 32 + r32] = (bf16_t)(cvtpk(o[d0][r] * rli[r], 0.f) & 0xffffu); }
  }
  __syncthreads();
#undef SLOAD
#undef SWRITE
#undef RESC
}

__device__ __forceinline__ void tconv_tile(const float* __restrict__ src, int ldn, int k0, int n0, bf16_t* __restrict__ dst, int ldk, int rmul, int roff, float* lw, int lane) {
  const float* s = src + (size_t)k0 * ldn + n0 + lane;
  float v[64];
#pragma unroll
  for (int i = 0; i < 64; ++i) v[i] = __builtin_nontemporal_load(s + (size_t)i * ldn);
#pragma unroll
  for (int i = 0; i < 64; ++i) lw[i * 65 + lane] = v[i];
  const int kc = (lane & 7) * 8;
#pragma unroll
  for (int it = 0; it < 8; ++it) {
    const int n = it * 8 + (lane >> 3);
    float v[8];
#pragma unroll
    for (int j = 0; j < 8; ++j) v[j] = lw[(kc + j) * 65 + n];
    u32x4 w = {cvtpk(v[0], v[1]), cvtpk(v[2], v[3]), cvtpk(v[4], v[5]), cvtpk(v[6], v[7])};
    *(u32x4*)(dst + (size_t)((n0 + n) * rmul + roff) * ldk + k0 + kc) = w;
  }
}

#ifndef MOE_JIT
#define MOE_JIT 1
#endif
constexpr float F8_SH = 8.0f, F8_SWD = 32.0f;
constexpr float F8_SA = 8.0f, F8_SW = 64.0f;
__device__ __forceinline__ void tconv_tile_f8(const float* __restrict__ src, int ldn, int k0, int n0, unsigned char* __restrict__ dst, int ldk, int rmul, int roff, float scale, float* lw, int lane) {
  const float* s = src + (size_t)k0 * ldn + n0 + lane;
  float v[64];
#pragma unroll
  for (int i = 0; i < 64; ++i) v[i] = __builtin_nontemporal_load(s + (size_t)i * ldn);
#pragma unroll
  for (int i = 0; i < 64; ++i) lw[i * 65 + lane] = v[i];
  const int kc = (lane & 3) * 16;
#pragma unroll
  for (int it = 0; it < 4; ++it) {
    const int n = it * 16 + (lane >> 2);
    float x[16];
#pragma unroll
    for (int j = 0; j < 16; ++j) x[j] = lw[(kc + j) * 65 + n] * scale;
    u32x4 w = {pack4_f8(x[0], x[1], x[2], x[3]), pack4_f8(x[4], x[5], x[6], x[7]), pack4_f8(x[8], x[9], x[10], x[11]), pack4_f8(x[12], x[13], x[14], x[15])};
    *(u32x4*)(dst + (size_t)((n0 + n) * rmul + roff) * ldk + k0 + kc) = w;
  }
}
struct ConvTile { const float* s; unsigned char* d; int ldn, rs; float scale; };
__device__ __forceinline__ ConvTile conv_moe_tile(const Params& p, char* ws, int layer, int t, int lane) {
  const int le = layer * ME + t / 384, tt = t % 384, which = tt >> 7, ti = tt & 127;
  unsigned char* wgu = (unsigned char*)(ws + WS_WMOE + (size_t)le * MOE_WBYTES); unsigned char* wd = wgu + 1024 * 1024 * 2;
  ConvTile c;
  if (which < 2) { const int kt = ti >> 3, nt = ti & 7;
    c.s = p.in[which == 0 ? I_MOE_GATE : I_MOE_UP] + (size_t)le * D * FF + (size_t)(kt * 64) * FF + nt * 64 + lane; c.ldn = FF;
    c.d = wgu + (size_t)((nt * 64) * 2 + which) * D + kt * 64; c.rs = 2 * D; c.scale = F8_SW; }
  else { const int kt = ti >> 4, nt = ti & 15;
    c.s = p.in[I_MOE_DOWN] + (size_t)le * FF * D + (size_t)(kt * 64) * D + nt * 64 + lane; c.ldn = D;
    c.d = wd + (size_t)(nt * 64) * FF + kt * 64; c.rs = FF; c.scale = F8_SWD; }
  return c;
}
__device__ __forceinline__ void conv_tile_ld(float (&v)[64], const ConvTile& c) {
#pragma unroll
  for (int i = 0; i < 64; ++i) v[i] = __builtin_nontemporal_load(c.s + (size_t)i * c.ldn);
}
__device__ __forceinline__ void conv_tile_st(const float (&v)[64], const ConvTile& c, int lane) {
  unsigned m[16];
  const float sc = c.scale;
#pragma unroll
  for (int j = 0; j < 16; ++j) m[j] = pack4_f8(v[4 * j] * sc, v[4 * j + 1] * sc, v[4 * j + 2] * sc, v[4 * j + 3] * sc);
  const bool o1 = lane & 1, o2 = lane & 2;
  unsigned t1[16];
#pragma unroll
  for (int cc = 0; cc < 4; ++cc)
#pragma unroll
    for (int w = 0; w < 4; ++w) {
      const unsigned other = (unsigned)__builtin_amdgcn_mov_dpp((int)m[(cc ^ 1) * 4 + w], 0xB1, 0xF, 0xF, true);
      t1[cc * 4 + w] = (o1 != (bool)(cc & 1)) ? other : m[cc * 4 + w]; }
  unsigned t2[16];
#pragma unroll
  for (int cc = 0; cc < 4; ++cc)
#pragma unroll
    for (int w = 0; w < 4; ++w) {
      const unsigned other = (unsigned)__builtin_amdgcn_mov_dpp((int)t1[(cc ^ 2) * 4 + w], 0x4E, 0xF, 0xF, true);
      t2[cc * 4 + w] = (o2 != (bool)(cc & 2)) ? other : t1[cc * 4 + w]; }
  unsigned char* d0 = c.d + (size_t)((lane >> 2) * 4) * c.rs + (lane & 3) * 16;
#pragma unroll
  for (int cc = 0; cc < 4; ++cc) { u32x4 w = {t2[cc * 4], t2[cc * 4 + 1], t2[cc * 4 + 2], t2[cc * 4 + 3]}; *(u32x4*)(d0 + (size_t)cc * c.rs) = w; }
}
template <int CW>
__device__ __forceinline__ void conv_moe_waves(const Params& p, char* ws, int layer, int wid, int lane) {
  static_assert(MOE_F8 >= 2, "the streamed converter writes fp8 gate/up/down");
  constexpr int NT = ME * 384;
  const int gw = blockIdx.x * CW + wid, nw = gridDim.x * CW;
  float va[64], vb[64];
  ConvTile ca = conv_moe_tile(p, ws, layer, gw < NT ? gw : 0, lane), cb = ca;
  if (gw < NT) conv_tile_ld(va, ca);
  for (int t = gw; t < NT; t += 2 * nw) {
    const bool hb = t + nw < NT, ha = t + 2 * nw < NT;
    if (hb) { cb = conv_moe_tile(p, ws, layer, t + nw, lane); conv_tile_ld(vb, cb); }
    conv_tile_st(va, ca, lane);
    if (ha) { ca = conv_moe_tile(p, ws, layer, t + 2 * nw, lane); conv_tile_ld(va, ca); }
    if (hb) conv_tile_st(vb, cb, lane);
  }
}
__device__ __forceinline__ void phase_prep(const Params& p, char* lds) {
  int tid = threadIdx.x; asm volatile("" : "+v"(tid));
  const int wid = tid >> 6, lane = tid & 63;
  const int gw = blockIdx.x * 8 + wid, nw = gridDim.x * 8;
  char* ws = opaque_ptr(p.ws);
  float* lw = (float*)lds + wid * (64 * 65);
  for (int t = gw + (MOE_JIT ? DEPTH * ME * 384 : 0); t < DEPTH * ME * 384; t += nw) {
    const int le = t / 384, tt = t - le * 384, which = tt >> 7, ti = tt & 127;
    bf16_t* wgu = (bf16_t*)(ws + WS_WMOE + (size_t)le * MOE_WBYTES); bf16_t* wd = wgu + 1024 * 1024;
    if (which < 2) { const float* src = p.in[which == 0 ? I_MOE_GATE : I_MOE_UP] + (size_t)le * D * FF;
      const int kt = ti >> 3, nt = ti & 7; tconv_tile(src, FF, kt * 64, nt * 64, wgu, D, 2, which, lw, lane); }
    else { const float* src = p.in[I_MOE_DOWN] + (size_t)le * FF * D;
      const int kt = ti >> 4, nt = ti & 15; tconv_tile(src, D, kt * 64, nt * 64, wd, FF, 1, 0, lw, lane); }
  }
  {
    int base = 0;
#pragma unroll 1
    for (int q = 0; q < 14; ++q) {
      const float* jsrc = p.jobs[q].src; bf16_t* jdst = p.jobs[q].dst; const int jK = p.jobs[q].K, jN = p.jobs[q].N, jroff = p.jobs[q].roff;
      const int nnt = jN >> 6, ntile = (jK >> 6) * nnt;
      for (int t = gw - base; t < ntile; t += nw) { if (t < 0) continue; const int kt = t / nnt, nt = t - kt * nnt;
        if (p.jobs[q].rmul == 8) tconv_tile_f8(jsrc, jN, kt * 64, nt * 64, (unsigned char*)jdst, jK, 1, jroff, F8_SW, lw, lane);
        else tconv_tile(jsrc, jN, kt * 64, nt * 64, jdst, jK, 1, jroff, lw, lane); }
      base = (base + ntile) % nw;
    }
  }
  for (int j = 0; j < 2; ++j) { constexpr int ES = MIX_F8 ? 1 : 2; u32x4* z = (u32x4*)(ws + WS_WMLA + j * MLA_WBYTES + MLA_W1T + (size_t)832 * 1024 * ES);
    for (int i = blockIdx.x * NTHR + tid; i < 192 * 1024 * ES / 16; i += gridDim.x * NTHR) z[i] = (u32x4){0u, 0u, 0u, 0u}; }
  if (blockIdx.x == 0 && tid < DEPTH * ME) ((int*)(ws + WS_CNT))[tid] = 0;
  if (blockIdx.x == 0 && tid == 0) ((int*)(ws + WS_CNT))[1000] = 0;
  for (int r = gw; r < R; r += nw) {
    const int b = r / RPB, ii = r - b * RPB;
    const f32x4* src = (const f32x4*)(ii < CTX ? p.in[I_CTX] + ((size_t)b * CTX + ii) * D : p.in[I_X] + ((size_t)b * SEQ + (ii - CTX)) * D);
    xres_t* dst = (xres_t*)(ws + WS_X32) + (size_t)r * D;
#pragma unroll
    for (int q = 0; q < 4; ++q) xstore4(dst + (lane + 64 * q) * 4, src[lane + 64 * q]);
  }
  {
    float* sc = (float*)lds;
    __syncthreads();
    for (int u = blockIdx.x; u < DEPTH * 12 * MODKS; u += gridDim.x) {
      const int i = u / (12 * MODKS), rem = u - i * (12 * MODKS), cch = rem / MODKS, ks = rem % MODKS;
      __syncthreads();
      for (int e = tid; e < 5 * MODKL; e += NTHR) { const int b = e / MODKL, k = ks * MODKL + (e % MODKL); const float c = b < 4 ? p.in[I_C][b * D + k] : p.in[I_CCTX][k]; sc[e] = silu_f(c); }
      __syncthreads();
      const int col = cch * 512 + tid;
      const float* w = p.in[I_WMOD] + (size_t)i * D * NMOD + (size_t)(ks * MODKL) * NMOD + col;
      float a0 = 0, a1 = 0, a2 = 0, a3 = 0, a4 = 0;
      float wv[MODKL];
#pragma unroll
      for (int k = 0; k < MODKL; ++k) wv[k] = __builtin_nontemporal_load(w + (size_t)k * NMOD);
#pragma unroll
      for (int k = 0; k < MODKL; ++k) { a0 += sc[k] * wv[k]; a1 += sc[MODKL + k] * wv[k]; a2 += sc[2 * MODKL + k] * wv[k]; a3 += sc[3 * MODKL + k] * wv[k]; a4 += sc[4 * MODKL + k] * wv[k]; }
      float* mp = (float*)(ws + WS_MODP) + ((size_t)(ks * DEPTH + i) * 5) * NMOD + col;
      mp[0] = a0; mp[NMOD] = a1; mp[2 * NMOD] = a2; mp[3 * NMOD] = a3; mp[4 * NMOD] = a4;
    }
    __syncthreads();
  }
}
__device__ __forceinline__ void phase_modfin(const Params& p) {
  const float* mp = (const float*)(p.ws + WS_MODP); float* mv = (float*)(p.ws + WS_MODV);
  for (int e = blockIdx.x * NTHR + threadIdx.x; e < DEPTH * 5 * NMOD; e += gridDim.x * NTHR) {
    const int i = e / (5 * NMOD), col = e % NMOD;
    float s = p.in[I_BMOD][i * NMOD + col];
#pragma unroll
    for (int ks = 0; ks < MODKS; ++ks) s += mp[(size_t)ks * DEPTH * 5 * NMOD + e];
    mv[e] = s;
  }
}

constexpr int RT_OFF = 139264, RT_NREC = ((R + 2047) / 2048) * 8 * 2;
#if XBF16
typedef u32x2 xraw_t;
__device__ __forceinline__ xraw_t xraw_ld(const xres_t* q) { return *(const u32x2*)q; }
__device__ __forceinline__ f32x4 xraw_cvt(xraw_t w) { return (f32x4){bflo(w[0]), bfhi(w[0]), bflo(w[1]), bfhi(w[1])}; }
#else
typedef f32x4 xraw_t;
__device__ __forceinline__ xraw_t xraw_ld(const xres_t* q) { return *(const f32x4*)q; }
__device__ __forceinline__ f32x4 xraw_cvt(xraw_t w) { return w; }
#endif
__device__ __forceinline__ void norm1_prologue(const Params& p, int layer, char* lds) {
  int tid = threadIdx.x; asm volatile("" : "+v"(tid));
  LAS int* lcnt = (LAS int*)(LAS char*)(lds + RT_OFF); LAS int* lrec = lcnt + 64; LAS char* wel = (LAS char*)lds;
  if (tid < 32) lcnt[tid] = 0;
  if (tid < 2 * RT_NREC) lrec[tid] = -1;
  const float* we = p.in[I_MOE_WE] + (size_t)layer * D * ME;
#pragma unroll 8
  for (int i = tid; i < D * 8; i += NTHR) { const int c = i >> 3, j = i & 7; *(LAS f32x4*)(wel + c * 128 + ((j ^ ((c >> 2) & 7)) << 4)) = *(const f32x4*)(we + (size_t)c * ME + j * 4); }
}
template <int MODE, bool COMBINE, bool DRY = false, bool PRE = false>
__device__ __forceinline__ void phase_norm(const Params& p, int layer, char* lds = nullptr) {
  int tid = threadIdx.x; asm volatile("" : "+v"(tid));
  const int wid = tid >> 6, lane = tid & 63;
  constexpr int CW = (MODE == 1 && MOE_JIT && !DRY) ? 2 : 0;
  constexpr int RW = 8 - CW;
  const int gw = blockIdx.x * RW + (wid - CW), nw = gridDim.x * RW;
  char* ws = opaque_ptr(p.ws);
  const float* modv = (const float*)(ws + WS_MODV);
  const bf16_t* Y = (const bf16_t*)(ws + WS_Y);
  constexpr bool ROUTE = MODE == 1 && !DRY;
  LAS int* lcnt = (LAS int*)(LAS char*)(lds + RT_OFF); LAS int* lrec = lcnt + 64;
  LAS char* wel = (LAS char*)lds;
  f32x4 wgr[16];
  if (MODE == 1 && !PRE) { norm1_prologue(p, layer, lds); __syncthreads(); }
  if (CW > 0 && wid < CW) conv_moe_waves<(CW > 0 ? CW : 1)>(p, ws, layer, wid, lane);
  __builtin_amdgcn_sched_barrier(0);
  float bg4[4] = {0.f, 0.f, 0.f, 0.f}; float bev = 0.f;
  if (MODE == 1) {
#pragma unroll
    for (int k = 0; k < 4; ++k) bg4[k] = p.in[I_MOE_BG][layer * 4 + k];
    bev = p.in[I_MOE_BE][layer * ME + (lane & 31)];
    const float* wg = p.in[I_MOE_WG] + (size_t)layer * D * 4;
#pragma unroll
    for (int q = 0; q < 4; ++q)
#pragma unroll
      for (int e = 0; e < 4; ++e) wgr[q * 4 + e] = *(const f32x4*)(wg + (size_t)((lane + 64 * q) * 4 + e) * 4);
  }
  f32x4 ngv[4];
  { const float* ng = MODE == 2 ? p.in[I_FG] : p.in[MODE == 0 ? I_NMG : I_NFG] + layer * D;
#pragma unroll
    for (int q = 0; q < 4; ++q) ngv[q] = *(const f32x4*)(ng + (lane + 64 * q) * 4); }
  xraw_t xn[4]; u32x2 y0n[4], y1n[4]; f32x4 s1n[4], s0n[4], g2n[4];
  constexpr int PL = MODE == 2 ? DEPTH - 1 : 0;
#define NORM_PREFETCH(rr) do { const int ii_ = (rr) % RPB, b_ = (rr) / RPB; const int bs_ = ii_ < CTX ? 4 : b_; \
    const float* sh_ = modv + ((size_t)layer * 5 + bs_) * NMOD + (MODE == 0 ? 0 : 3) * D; \
    const float* g2_ = modv + ((size_t)(MODE == 2 ? PL : layer - 1) * 5 + bs_) * NMOD + 5 * D; \
    _Pragma("unroll") for (int q = 0; q < 4; ++q) { const int c = (lane + 64 * q) * 4; xn[q] = xraw_ld((const xres_t*)(ws + WS_X32) + (size_t)(rr) * D + c); \
      if (COMBINE) { y0n[q] = *(const u32x2*)(Y + (size_t)(2 * (rr)) * D + c); y1n[q] = *(const u32x2*)(Y + (size_t)(2 * (rr) + 1) * D + c); g2n[q] = *(const f32x4*)(g2_ + c); } \
      if (MODE != 2) { s1n[q] = *(const f32x4*)(sh_ + D + c); s0n[q] = *(const f32x4*)(sh_ + c); } } } while (0)
  if (wid >= CW && gw < R) NORM_PREFETCH(gw);
  for (int r = (wid >= CW ? gw : R), it = 0; r < R; r += nw, ++it) {
    const int b = r / RPB, ii = r - b * RPB; const bool is_ctx = ii < CTX; const int bsel = is_ctx ? 4 : b;
    f32x4 v[4]; u32x2 y0[4], y1[4];
#pragma unroll
    for (int q = 0; q < 4; ++q) { v[q] = xraw_cvt(xn[q]); if (COMBINE) { y0[q] = y0n[q]; y1[q] = y1n[q]; } }
    const int pl = MODE == 2 ? DEPTH - 1 : layer - 1;
    f32x4 s1[4], s0[4], g2v[4];
#pragma unroll
    for (int q = 0; q < 4; ++q) { if (MODE != 2) { s1[q] = s1n[q]; s0[q] = s0n[q]; } if (COMBINE) g2v[q] = g2n[q]; }
    __builtin_amdgcn_sched_barrier(0);
    if (r + nw < R) NORM_PREFETCH(r + nw);
    __builtin_amdgcn_sched_barrier(0);
    if (MODE == 2 && is_ctx) continue;
    xres_t* xp = (xres_t*)(ws + WS_X32) + (size_t)r * D;
    if (COMBINE) {
      if (!(pl == DEPTH - 1 && is_ctx)) {
#pragma unroll
        for (int q = 0; q < 4; ++q) { const f32x4 g = g2v[q];
          v[q][0] += g[0] * (bflo(y0[q][0]) + bflo(y1[q][0])); v[q][1] += g[1] * (bfhi(y0[q][0]) + bfhi(y1[q][0]));
          v[q][2] += g[2] * (bflo(y0[q][1]) + bflo(y1[q][1])); v[q][3] += g[3] * (bfhi(y0[q][1]) + bfhi(y1[q][1])); }
        if (MODE != 2 && !DRY) {
#pragma unroll
          for (int q = 0; q < 4; ++q) xstore4(xp + (lane + 64 * q) * 4, v[q]);
        }
      }
    }
    float ss = 0.f;
#pragma unroll
    for (int q = 0; q < 4; ++q) ss += v[q][0] * v[q][0] + v[q][1] * v[q][1] + v[q][2] * v[q][2] + v[q][3] * v[q][3];
    ss = wave_sum(ss);
    const float rs = rsqrtf(ss * (1.0f / D) + EPS);
    if (MODE == 2) {
      float* op = p.out + ((size_t)b * SEQ + (ii - CTX)) * D;
#pragma unroll
      for (int q = 0; q < 4; ++q) { const int c = (lane + 64 * q) * 4; f32x4 ov = v[q] * rs * ngv[q];
        if (DBG_PROBE == 20 && ((const int*)(ws + WS_CNT))[1000]) ov = (f32x4){1000.f, 1000.f, 1000.f, 1000.f};
        *(f32x4*)(op + c) = ov; }
      continue;
    }
    bf16_t* ap = (bf16_t*)(ws + WS_ACT) + (size_t)r * D;
    f32x4 f[4];
#pragma unroll
    for (int q = 0; q < 4; ++q) { const int c = (lane + 64 * q) * 4;
      f[q] = (v[q] * rs * ngv[q]) * (1.0f + s1[q]) + s0[q];
      if ((MODE == 1 && MOE_F8) || (MODE == 0 && MIX_F8 && layer % 3 != 1)) ((unsigned*)(ws + WS_ACT))[((size_t)r * D + c) >> 2] = pack4_f8(f[q][0] * F8_SA, f[q][1] * F8_SA, f[q][2] * F8_SA, f[q][3] * F8_SA);
      else { u32x2 w = {cvtpk(f[q][0], f[q][1]), cvtpk(f[q][2], f[q][3])}; *(u32x2*)(ap + c) = w; } }
    if (MODE == 1) {
      if (layer == DEPTH - 1 && is_ctx) continue;
      float gl[4] = {0.f, 0.f, 0.f, 0.f};
#pragma unroll
      for (int q = 0; q < 4; ++q)
#pragma unroll
        for (int e = 0; e < 4; ++e) { const f32x4 w = wgr[q * 4 + e];
          gl[0] += f[q][e] * w[0]; gl[1] += f[q][e] * w[1]; gl[2] += f[q][e] * w[2]; gl[3] += f[q][e] * w[3]; }
#pragma unroll
      for (int k = 0; k < 4; ++k) gl[k] = wave_sum(gl[k]);
      const float gm = fmaxf(fmaxf(gl[0], gl[1]), fmaxf(gl[2], gl[3]));
      float gp[4], gs = 0.f;
#pragma unroll
      for (int k = 0; k < 4; ++k) { gp[k] = __expf(gl[k] - gm); gs += gp[k]; }
      const float gsi = 1.0f / gs;
      int gsel = 0; float gbest = -1e30f, gw_ = 0.f;
#pragma unroll
      for (int k = 0; k < 4; ++k) { const float pr = gp[k] * gsi; const float sc = pr + bg4[k]; if (sc > gbest) { gbest = sc; gsel = k; gw_ = pr; } }
      gsel = __builtin_amdgcn_readfirstlane(gsel);
      float el[8] = {0.f, 0.f, 0.f, 0.f, 0.f, 0.f, 0.f, 0.f};
      const unsigned ea0 = (unsigned)(lane * 512) + ((unsigned)((gsel * 2) ^ (lane & 7)) << 4), ea1 = ea0 ^ 16u;
#pragma unroll
      for (int q = 0; q < 4; ++q)
#pragma unroll
        for (int e = 0; e < 4; ++e) { const f32x4 w0 = *(LAS f32x4*)(wel + ea0 + (q * 256 + e) * 128), w1 = *(LAS f32x4*)(wel + ea1 + (q * 256 + e) * 128);
          el[0] += f[q][e] * w0[0]; el[1] += f[q][e] * w0[1]; el[2] += f[q][e] * w0[2]; el[3] += f[q][e] * w0[3];
          el[4] += f[q][e] * w1[0]; el[5] += f[q][e] * w1[1]; el[6] += f[q][e] * w1[2]; el[7] += f[q][e] * w1[3]; }
#pragma unroll
      for (int k = 0; k < 8; ++k) el[k] = wave_sum(el[k]);
      float em = el[0];
#pragma unroll
      for (int k = 1; k < 8; ++k) em = fmaxf(em, el[k]);
      float ep[8], es = 0.f;
#pragma unroll
      for (int k = 0; k < 8; ++k) { ep[k] = __expf(el[k] - em); es += ep[k]; }
      const float esi = 1.0f / es;
      int t1 = 0, t2 = 0; float b1 = -1e30f, b2 = -1e30f, p1 = 0.f, p2 = 0.f;
#pragma unroll
      for (int k = 0; k < 8; ++k) { const float pr = ep[k] * esi; const float sc = pr + __uint_as_float(__builtin_amdgcn_readlane(__float_as_uint(bev), gsel * 8 + k));
        if (sc > b1) { b2 = b1; t2 = t1; p2 = p1; b1 = sc; t1 = k; p1 = pr; } else if (sc > b2) { b2 = sc; t2 = k; p2 = pr; } }
      if (lane == 0 && !DRY) {
        const float inv = gw_ / (p1 + p2);
        int* cnt = (int*)(ws + WS_CNT) + layer * ME; int* list = (int*)(ws + WS_LIST); float* wts = (float*)(ws + WS_WTS);
        const int e1 = gsel * 8 + t1, e2 = gsel * 8 + t2;
        const int q1 = __hip_atomic_fetch_add(lcnt + e1, 1, __ATOMIC_RELAXED, __HIP_MEMORY_SCOPE_WORKGROUP);
        const int q2 = __hip_atomic_fetch_add(lcnt + e2, 1, __ATOMIC_RELAXED, __HIP_MEMORY_SCOPE_WORKGROUP);
        LAS int* rc = lrec + (it * RW + (wid - CW)) * 4;
        rc[0] = e1 | (q1 << 8); rc[1] = 2 * r; rc[2] = e2 | (q2 << 8); rc[3] = 2 * r + 1;
        wts[2 * r] = p1 * inv; wts[2 * r + 1] = p2 * inv;
        (void)cnt; (void)list;
      }
    }
  }
  if (ROUTE) {
    int* cnt = (int*)(ws + WS_CNT) + layer * ME; int* list = (int*)(ws + WS_LIST);
    __syncthreads();
    if (tid < 32) { const int c = lcnt[tid]; lcnt[32 + tid] = c ? atomicAdd(cnt + tid, c) : 0; }
    __syncthreads();
    if (tid < RT_NREC) { const int rc = lrec[2 * tid];
      if (rc >= 0) { const int e = rc & 255; list[(size_t)e * R + lcnt[32 + e] + (rc >> 8)] = lrec[2 * tid + 1]; } }
  }
}

__device__ __forceinline__ void phase_mla_mid(const Params& p, int j) {
  int tid = threadIdx.x; asm volatile("" : "+v"(tid));
  const int wid = tid >> 6, lane = tid & 63;
  const int gw = blockIdx.x * 8 + wid, nw = gridDim.x * 8;
  char* ws = opaque_ptr(p.ws);
  const float* gq = p.in[I_MLA_GQ] + j * QL; const float* gkv = p.in[I_MLA_GKV] + j * KVL;
  const f32x4 gq0 = *(const f32x4*)(gq + lane * 4), gq1 = *(const f32x4*)(gq + 256 + lane * 4), gk0 = *(const f32x4*)(gkv + lane * 4);
  const float invf = rope_invf(lane & 15, 16);
  const bf16_t* C1 = (const bf16_t*)(ws + WS_C1);
  u32x2 nq0, nq1, nkv; unsigned short npe;
  { const bf16_t* c1 = C1 + (size_t)gw * 1024; nq0 = *(const u32x2*)(c1 + lane * 4); nq1 = *(const u32x2*)(c1 + 256 + lane * 4); nkv = *(const u32x2*)(c1 + 512 + lane * 4); npe = c1[768 + lane]; }
  for (int r = gw; r < R; r += nw) {
    const int b = r / RPB, ii = r - b * RPB; const bool is_ctx = ii < CTX;
    const u32x2 q0w = nq0, q1w = nq1, kvw = nkv; const float pe = bf2f(npe);
    if (r + nw < R) { const bf16_t* c1 = C1 + (size_t)(r + nw) * 1024; nq0 = *(const u32x2*)(c1 + lane * 4); nq1 = *(const u32x2*)(c1 + 256 + lane * 4); nkv = *(const u32x2*)(c1 + 512 + lane * 4); npe = c1[768 + lane]; }
    const f32x4 q0 = {bflo(q0w[0]), bfhi(q0w[0]), bflo(q0w[1]), bfhi(q0w[1])}, q1 = {bflo(q1w[0]), bfhi(q1w[0]), bflo(q1w[1]), bfhi(q1w[1])},
                kv = {bflo(kvw[0]), bfhi(kvw[0]), bflo(kvw[1]), bfhi(kvw[1])};
    float sq = q0[0] * q0[0] + q0[1] * q0[1] + q0[2] * q0[2] + q0[3] * q0[3] + q1[0] * q1[0] + q1[1] * q1[1] + q1[2] * q1[2] + q1[3] * q1[3];
    float sk = kv[0] * kv[0] + kv[1] * kv[1] + kv[2] * kv[2] + kv[3] * kv[3];
    sq = wave_sum(sq); sk = wave_sum(sk);
    const float rq = rsqrtf(sq * (1.0f / QL) + EPS), rk = rsqrtf(sk * (1.0f / KVL) + EPS);
    bf16_t* cq = (bf16_t*)(ws + WS_CQ) + (size_t)r * QL; bf16_t* ckv = (bf16_t*)(ws + WS_CKV) + (size_t)r * KVL; bf16_t* kpe = (bf16_t*)(ws + WS_KPE) + (size_t)r * ROPE;
    if (MIX_F8) {
      unsigned char* cq8 = (unsigned char*)(ws + WS_CQ) + (size_t)r * QL; unsigned char* ckv8 = (unsigned char*)(ws + WS_CKV) + (size_t)r * KVL; const float sq8 = rq * F8_SA, sk8 = rk * F8_SA;
      *(unsigned*)(cq8 + lane * 4) = pack4_f8(q0[0] * sq8 * gq0[0], q0[1] * sq8 * gq0[1], q0[2] * sq8 * gq0[2], q0[3] * sq8 * gq0[3]);
      *(unsigned*)(cq8 + 256 + lane * 4) = pack4_f8(q1[0] * sq8 * gq1[0], q1[1] * sq8 * gq1[1], q1[2] * sq8 * gq1[2], q1[3] * sq8 * gq1[3]);
      *(unsigned*)(ckv8 + lane * 4) = pack4_f8(kv[0] * sk8 * gk0[0], kv[1] * sk8 * gk0[1], kv[2] * sk8 * gk0[2], kv[3] * sk8 * gk0[3]);
    } else {
    { const f32x4 g = gq0; u32x2 w = {cvtpk(q0[0] * rq * g[0], q0[1] * rq * g[1]), cvtpk(q0[2] * rq * g[2], q0[3] * rq * g[3])}; *(u32x2*)(cq + lane * 4) = w; }
    { const f32x4 g = gq1; u32x2 w = {cvtpk(q1[0] * rq * g[0], q1[1] * rq * g[1]), cvtpk(q1[2] * rq * g[2], q1[3] * rq * g[3])}; *(u32x2*)(cq + 256 + lane * 4) = w; }
    { const f32x4 g = gk0; u32x2 w = {cvtpk(kv[0] * rk * g[0], kv[1] * rk * g[1]), cvtpk(kv[2] * rk * g[2], kv[3] * rk * g[3])}; *(u32x2*)(ckv + lane * 4) = w; }
    }
    float outv = pe;
    const float other = xor16_f(pe, lane);
    if (!is_ctx) {
      const int s = ii - CTX; const float pos = (lane < 32) ? (float)(s >> 6) : (float)(s & 63);
      const float ang = pos * invf; const float cs = __cosf(ang), sn = __sinf(ang);
      outv = (lane & 16) ? (other * sn + pe * cs) : (pe * cs - other * sn);
    }
    kpe[lane] = (bf16_t)(cvtpk(outv, 0.f) & 0xffffu);
    if (QK_F8) ((unsigned char*)(ws + WS_KPE8))[(size_t)r * ROPE + lane] = (unsigned char)(__builtin_amdgcn_cvt_pk_fp8_f32(fminf(fmaxf(outv * F8_SQK, -448.f), 448.f), 0.f, 0, false) & 0xff);
  }
}

__device__ __forceinline__ void phase_gqa_k(const Params& p) {
  int tid = threadIdx.x; asm volatile("" : "+v"(tid));
  const int wid = tid >> 6, lane = tid & 63;
  const int gw = blockIdx.x * 8 + wid, nw = gridDim.x * 8;
  char* ws = opaque_ptr(p.ws); const float* kg = p.in[I_GQA_KG];
  const int sub = lane & 7;
  float kgv[16], invf[16];
#pragma unroll
  for (int e = 0; e < 16; ++e) { kgv[e] = kg[sub * 16 + e]; invf[e] = rope_invf((sub & 1) * 16 + e, 32); }
  const bf16_t* KP = (const bf16_t*)(ws + WS_QKV) + 2048 + lane * 16;
  u32x4 n0 = *(const u32x4*)(KP + (size_t)gw * 4096), n1 = *(const u32x4*)(KP + (size_t)gw * 4096 + 8);
  for (int r = gw; r < R; r += nw) {
    const int b = r / RPB, ii = r - b * RPB; const bool is_ctx = ii < CTX;
    const u32x4 w0 = n0, w1 = n1;
    if (r + nw < R) { n0 = *(const u32x4*)(KP + (size_t)(r + nw) * 4096); n1 = *(const u32x4*)(KP + (size_t)(r + nw) * 4096 + 8); }
    float v[16];
#pragma unroll
    for (int e = 0; e < 4; ++e) { v[2 * e] = bflo(w0[e]); v[2 * e + 1] = bfhi(w0[e]); v[8 + 2 * e] = bflo(w1[e]); v[9 + 2 * e] = bfhi(w1[e]); }
    float ss = 0.f;
#pragma unroll
    for (int e = 0; e < 16; ++e) ss += v[e] * v[e];
    ss += dpp_mov_f<0xB1>(ss); ss += dpp_mov_f<0x4E>(ss); ss += dpp_mov_f<0x141>(ss);
    const float rs = rsqrtf(ss * (1.0f / GD) + EPS);
#pragma unroll
    for (int e = 0; e < 16; ++e) v[e] *= rs * kgv[e];
    float o[16];
#pragma unroll
    for (int e = 0; e < 16; ++e) o[e] = dpp_mov_f<0x4E>(v[e]);
    if (!is_ctx) {
      const int s = ii - CTX; const float pos = (sub < 4) ? (float)(s >> 6) : (float)(s & 63);
#pragma unroll
      for (int e = 0; e < 16; ++e) { const float ang = pos * invf[e]; const float cs = __cosf(ang), sn = __sinf(ang);
        v[e] = (sub & 2) ? (o[e] * sn + v[e] * cs) : (v[e] * cs - o[e] * sn); }
    }
    if (QK_F8) {
      u32x4 w = {pack4_f8(v[0] * F8_SQK, v[1] * F8_SQK, v[2] * F8_SQK, v[3] * F8_SQK), pack4_f8(v[4] * F8_SQK, v[5] * F8_SQK, v[6] * F8_SQK, v[7] * F8_SQK),
                 pack4_f8(v[8] * F8_SQK, v[9] * F8_SQK, v[10] * F8_SQK, v[11] * F8_SQK), pack4_f8(v[12] * F8_SQK, v[13] * F8_SQK, v[14] * F8_SQK, v[15] * F8_SQK)};
      *(u32x4*)((unsigned char*)(ws + WS_KN) + (size_t)r * 1024 + lane * 16) = w;
    } else {
    bf16_t* op = (bf16_t*)(ws + WS_KN) + (size_t)r * 1024 + lane * 16;
    u32x4 o0 = {cvtpk(v[0], v[1]), cvtpk(v[2], v[3]), cvtpk(v[4], v[5]), cvtpk(v[6], v[7])}, o1 = {cvtpk(v[8], v[9]), cvtpk(v[10], v[11]), cvtpk(v[12], v[13]), cvtpk(v[14], v[15])};
    *(u32x4*)op = o0; *(u32x4*)(op + 8) = o1;
    }
  }
}

__device__ __forceinline__ void phase_conv_mid(const Params& p) {
  int tid = threadIdx.x; asm volatile("" : "+v"(tid));
  const int wid = tid >> 6, lane = tid & 63;
  const int gw = blockIdx.x * 8 + wid, nw = gridDim.x * 8;
  char* ws = opaque_ptr(p.ws); const float* cw = p.in[I_CONV_W];
  const bf16_t* bcu = (const bf16_t*)(ws + WS_BCU);
  for (int r = gw; r < R; r += nw) {
    const int b = r / RPB, ii = r - b * RPB; const bool is_ctx = ii < CTX;
    const bool hp = is_ctx ? (ii > 0) : (ii > CTX), hn = is_ctx ? (ii < CTX - 1) : (ii < RPB - 1);
    bf16_t* gp = (bf16_t*)(ws + WS_G) + (size_t)r * D;
#pragma unroll
    for (int q = 0; q < 4; ++q) {
      const int c = (lane + 64 * q) * 4;
      const bf16_t* row = bcu + (size_t)r * 3072 + c;
      const u32x2 bg = *(const u32x2*)row, c0 = *(const u32x2*)(row + 1024), u0 = *(const u32x2*)(row + 2048);
      u32x2 cp = {0u, 0u}, up = {0u, 0u}, cn = {0u, 0u}, un = {0u, 0u};
      if (hp) { cp = *(const u32x2*)(row - 3072 + 1024); up = *(const u32x2*)(row - 3072 + 2048); }
      if (hn) { cn = *(const u32x2*)(row + 3072 + 1024); un = *(const u32x2*)(row + 3072 + 2048); }
      const f32x4 w0 = *(const f32x4*)(cw + c), w1 = *(const f32x4*)(cw + D + c), w2 = *(const f32x4*)(cw + 2 * D + c);
      float z[4];
      z[0] = w0[0] * bflo(cp[0]) * bflo(up[0]) + w1[0] * bflo(c0[0]) * bflo(u0[0]) + w2[0] * bflo(cn[0]) * bflo(un[0]);
      z[1] = w0[1] * bfhi(cp[0]) * bfhi(up[0]) + w1[1] * bfhi(c0[0]) * bfhi(u0[0]) + w2[1] * bfhi(cn[0]) * bfhi(un[0]);
      z[2] = w0[2] * bflo(cp[1]) * bflo(up[1]) + w1[2] * bflo(c0[1]) * bflo(u0[1]) + w2[2] * bflo(cn[1]) * bflo(un[1]);
      z[3] = w0[3] * bfhi(cp[1]) * bfhi(up[1]) + w1[3] * bfhi(c0[1]) * bfhi(u0[1]) + w2[3] * bfhi(cn[1]) * bfhi(un[1]);
      u32x2 w = {cvtpk(bflo(bg[0]) * z[0], bfhi(bg[0]) * z[1]), cvtpk(bflo(bg[1]) * z[2], bfhi(bg[1]) * z[3])};
      *(u32x2*)(gp + c) = w;
    }
  }
}

constexpr int LI_OFF = 135168;
__device__ __forceinline__ void moe_prefix(const Params& p, int layer, int* li) {
  if (threadIdx.x == 0) { const int* cnt = (const int*)(p.ws + WS_CNT) + layer * ME; int o = 0, t = 0;
    for (int e = 0; e < ME; ++e) { li[e] = o; li[33 + e] = t; const int c = cnt[e]; o += c; t += (c + 127) >> 7; } li[32] = o; li[65] = t; }
  __syncthreads();
  { int t = threadIdx.x; asm volatile("" : "+v"(t));
    if (t < li[65]) { int e = 0;
#pragma unroll 1
      while (li[33 + e + 1] <= t) ++e;
      li[1024 + t] = e; } }
  __syncthreads();
}
struct MoeUnit { int e, ct, nvalid, slot0, lbase, ri0, ri1, par; };
template <bool DOWN>
struct MoeProv {
  char* ws; const int* li; const int* cnt; int layer; int* etab;
  typedef MoeUnit Unit;
  __device__ __forceinline__ bool unit(int it, Unit& U, int srow) const {
    const int un = blockIdx.x + it * gridDim.x;
    if (un >= li[65] * 4) return false;
    const int t = un >> 2, e = li[1024 + t];
    const int rt = t - li[33 + e];
    U.e = e; U.ct = un & 3; U.nvalid = min(128, cnt[e] - rt * 128); U.slot0 = li[e] + rt * 128; U.lbase = e * R + rt * 128;
    if (!DOWN) { const int* list = (const int*)(ws + WS_LIST) + U.lbase;
      U.ri0 = list[srow < U.nvalid ? srow : 0] >> 1; U.ri1 = list[srow + 64 < U.nvalid ? srow + 64 : 0] >> 1; }
    U.par = it % 3;
    if (DOWN) { int t_ = threadIdx.x; asm volatile("" : "+v"(t_));
      if (t_ < 128) { const int aid = ((const int*)(ws + WS_LIST))[U.lbase + (t_ < U.nvalid ? t_ : 0)];
        etab[(U.par * 128 + t_) * 2] = aid; etab[(U.par * 128 + t_) * 2 + 1] = __float_as_int(((const float*)(ws + WS_WTS))[aid]); } }
    return true;
  }
  static constexpr bool A_AFFINE = DOWN;
  static constexpr bool F8 = DOWN ? (MOE_F8 >= 2) : (MOE_F8 >= 1);
  static constexpr int KU = DOWN ? (F8 ? FF / 2 : FF) : (F8 ? D / 2 : D);
  __device__ __forceinline__ int a_stride(const Unit&) const { return 64 * KU; }
  __device__ __forceinline__ int b_stride(const Unit&) const { return 64 * KU; }
  __device__ __forceinline__ const bf16_t* a_row(const Unit& U, int r) const {
    if (DOWN) return (const bf16_t*)(ws + WS_HID) + (size_t)(U.slot0 + r) * KU;
    return (const bf16_t*)(ws + WS_ACT) + (size_t)(r < 64 ? U.ri0 : U.ri1) * KU;
  }
  __device__ __forceinline__ const bf16_t* b_row(const Unit& U, int r) const {
    const bf16_t* w = (const bf16_t*)(ws + WS_WMOE + (size_t)(layer * ME + U.e) * MOE_WBYTES);
    return (DOWN ? w + 1024 * 1024 : w) + (size_t)(U.ct * 256 + r) * KU;
  }
  __device__ __forceinline__ int nk(const Unit&) const { return KU / 64; }
  __device__ __forceinline__ void epi(const Unit& U, int r, int c, f32x4 v0, f32x4 v1, f32x4 v2, f32x4 v3) const {
    if (r >= U.nvalid) return;
    if (!DOWN) {
      if (F8) { constexpr float is = 1.0f / (F8_SA * F8_SW); v0 *= is; v1 *= is; v2 *= is; v3 *= is; }
      const float h0 = silu_f(v0[0]) * v0[1], h1 = silu_f(v0[2]) * v0[3], h2 = silu_f(v1[0]) * v1[1], h3 = silu_f(v1[2]) * v1[3],
                  h4 = silu_f(v2[0]) * v2[1], h5 = silu_f(v2[2]) * v2[3], h6 = silu_f(v3[0]) * v3[1], h7 = silu_f(v3[2]) * v3[3];
      if (MOE_F8 >= 2) {
        u32x2 o = {pack4_f8(h0 * F8_SH, h1 * F8_SH, h2 * F8_SH, h3 * F8_SH), pack4_f8(h4 * F8_SH, h5 * F8_SH, h6 * F8_SH, h7 * F8_SH)};
        *(u32x2*)((unsigned char*)(ws + WS_HID) + (size_t)(U.slot0 + r) * FF + ((U.ct * 256 + c) >> 1)) = o;
      } else {
        u32x4 o = {cvtpk(h0, h1), cvtpk(h2, h3), cvtpk(h4, h5), cvtpk(h6, h7)};
        *(u32x4*)((bf16_t*)(ws + WS_HID) + (size_t)(U.slot0 + r) * FF + ((U.ct * 256 + c) >> 1)) = o;
      }
    } else {
      const int aid = etab[(U.par * 128 + r) * 2]; float w = __int_as_float(etab[(U.par * 128 + r) * 2 + 1]);
      if (F8) w *= 1.0f / (F8_SH * F8_SWD);
      bf16_t* o = (bf16_t*)(ws + WS_Y) + (size_t)aid * D + U.ct * 256 + c;
      *(u32x4*)o = pack8(v0 * w, v1 * w); *(u32x4*)(o + 8) = pack8(v2 * w, v3 * w);
    }
  }
};
template <bool DOWN>
__device__ __forceinline__ void phase_moe(const Params& p, int layer, char* lds) {
  int* li = (int*)(lds + LI_OFF); if (!DOWN) moe_prefix(p, layer, li);
  char* ws = opaque_ptr(p.ws);
  MoeProv<DOWN> pv{ws, li, (const int*)(ws + WS_CNT) + layer * ME, layer, (int*)(lds + LI_OFF + 1024)};
  gemm_stream<8, MoeProv<DOWN>, 0, MoeProv<DOWN>::F8>(pv, lds);
}


template <int DK, int ldq, int ldv, int ldo>
__device__ __forceinline__ void attn_unit8(const bf16_t* __restrict__ Qb, const unsigned char* __restrict__ Kh8, const unsigned char* __restrict__ Kp8,
                                           const bf16_t* __restrict__ Vh, bf16_t* __restrict__ Ob, int nkeys, bool rope, int qpos0,
                                           const float* __restrict__ qg, char* lds) {
  using Cfg = AttnCfg<DK>;
  constexpr int KROW = Cfg::KROW, SHM_V = Cfg::SHM_V, SHM_K = Cfg::SHM_K, NS = DK / 64;
  static_assert(KROW == DK, "fp8 K rows");
  int tid = threadIdx.x; asm volatile("" : "+v"(tid));
  const int wid = tid >> 6, lane = tid & 63, r32 = lane & 31, hi = lane >> 5;
  char* V_lds = lds; char* K_lds = lds + 3 * SHM_V;
  float* wsl = (float*)(lds + 3 * SHM_V + 3 * SHM_K) + wid * 64; float* li_l = wsl; float* al_l = wsl + 32;
  float m_reg = -1e30f, l_reg = 0; f32x16 o[4] = {}; i32x8 qr8[NS];
  f32x16 lacc = {}; const i32x8 ones8 = {0x38383838, 0x38383838, 0x38383838, 0x38383838, 0x38383838, 0x38383838, 0x38383838, 0x38383838};
  {
    const int qrow = wid * 32 + r32;
    const bf16_t* Qw = Qb + (size_t)qrow * ldq + hi * 32;
    float qv[NS][32];
#pragma unroll
    for (int s = 0; s < NS; ++s)
#pragma unroll
      for (int cqd = 0; cqd < 4; ++cqd) { const u32x4 w = *reinterpret_cast<const u32x4*>(Qw + s * 64 + cqd * 8);
#pragma unroll
        for (int e = 0; e < 4; ++e) { qv[s][cqd * 8 + 2 * e] = bflo(w[e]); qv[s][cqd * 8 + 2 * e + 1] = bfhi(w[e]); } }
    const int qpos = qpos0 + qrow; const float prow = (float)(qpos >> 6), pcol = (float)(qpos & 63);
    if constexpr (DK == 128) {
      float ss = 0.f;
#pragma unroll
      for (int s = 0; s < 2; ++s)
#pragma unroll
        for (int e = 0; e < 32; ++e) ss += qv[s][e] * qv[s][e];
      ss += xor32_f(ss, lane);
      const float rs = rsqrtf(ss * (1.0f / 128.0f) + EPS);
#pragma unroll
      for (int s = 0; s < 2; ++s)
#pragma unroll
        for (int e4 = 0; e4 < 8; ++e4) { const f32x4 g = *(const f32x4*)(qg + s * 64 + hi * 32 + e4 * 4);
#pragma unroll
          for (int e = 0; e < 4; ++e) qv[s][e4 * 4 + e] *= rs * g[e]; }
      if (rope) {
#pragma unroll
        for (int s = 0; s < 2; ++s) { const float pos = s ? pcol : prow;
#pragma unroll
          for (int e = 0; e < 32; ++e) { const float ang = pos * rope_invf(e, 32); const float cs = __cosf(ang), sn = __sinf(ang);
            const float own = qv[s][e], oth = xor32_f(own, lane);
            qv[s][e] = hi ? (oth * sn + own * cs) : (own * cs - oth * sn); } }
      }
    } else {
      if (rope) {
        const float pos = hi ? pcol : prow;
#pragma unroll
        for (int e = 0; e < 16; ++e) { const float ang = pos * rope_invf(e, 16); const float cs = __cosf(ang), sn = __sinf(ang);
          const float x1 = qv[2][e], x2 = qv[2][16 + e]; qv[2][e] = x1 * cs - x2 * sn; qv[2][16 + e] = x1 * sn + x2 * cs; }
      }
    }
#pragma unroll
    for (int s = 0; s < NS; ++s)
#pragma unroll
      for (int w8 = 0; w8 < 8; ++w8) qr8[s][w8] = (int)pack4_f8(qv[s][4 * w8] * F8_SQK, qv[s][4 * w8 + 1] * F8_SQK, qv[s][4 * w8 + 2] * F8_SQK, qv[s][4 * w8 + 3] * F8_SQK);
  }
  int kq0[NS], kq1[NS];
#pragma unroll
  for (int s = 0; s < NS; ++s) {
    if constexpr (DK == 192) { const int x = (r32 >> 2) & 3; kq0[s] = r32 * KROW + s * 64 + (((2 * hi) ^ x) << 4); kq1[s] = r32 * KROW + s * 64 + (((2 * hi + 1) ^ x) << 4); }
    else { const int x = (r32 >> 1) & 7; kq0[s] = r32 * KROW + (((4 * s + 2 * hi) ^ x) << 4); kq1[s] = r32 * KROW + (((4 * s + 2 * hi + 1) ^ x) << 4); }
  }
  const int sr = tid >> 4, sc = (tid & 15) * 8, vst0 = v_st(sr, sc), vst1 = v_st(32 + sr, sc);
  const int krow = tid >> 3, kch = tid & 7, prw = (tid >> 2) & 63, pch = tid & 3;
#define KPERM(k) ((QK_F8 && PV_F8) ? ((((k) & 31) < 16) ? crow((k) & 15, (k) >> 5) : 32 + crow((k) & 15, (k) >> 5)) : (k))
  const int krl = KPERM(krow), prl = KPERM(prw);
  const int kst = DK == 192 ? krl * KROW + (((kch & ~3) | ((kch & 3) ^ ((krl >> 2) & 3))) << 4) : krl * KROW + ((kch ^ ((krl >> 1) & 7)) << 4);
  const int pst = prl * KROW + ((8 | (pch ^ ((prl >> 2) & 3))) << 4);
  const int vb0 = (int)(uintptr_t)(LAS char*)V_lds + v_rd_base(lane);
  bf16x8 vs0, vs1; u32x4 ks, kp, vt;
  const unsigned voff = sr * ldv + sc, koff = krow * 1024 + kch * 16, poff = prw * 64 + pch * 16;
  const int vcol = tid >> 2, vch = tid & 3, vtst = vcol * 64 + ((vch ^ ((vcol >> 2) & 3)) << 4);
  const unsigned char* Vt8 = (const unsigned char*)Vh;
  const int vr0 = r32 * 64 + (((2 * hi) ^ ((r32 >> 2) & 3)) << 4), vr1 = r32 * 64 + (((2 * hi + 1) ^ ((r32 >> 2) & 3)) << 4);
#define GLD16(p_) (*(const __attribute__((address_space(1))) u32x4*)(p_))
#define SLOAD(k0) do { if constexpr (PV_F8) { vt = GLD16(Vt8 + (size_t)vcol * RPB + (k0) + vch * 16); } \
    else { const bf16_t* Vt = Vh + (size_t)(k0) * ldv; vs0 = *(const bf16x8*)(Vt + voff); vs1 = *(const bf16x8*)(Vt + 32 * ldv + voff); } \
    ks = GLD16(Kh8 + (size_t)(k0) * 1024 + koff); \
    if constexpr (DK == 192) { if (tid < 256) kp = GLD16(Kp8 + (size_t)(k0) * 64 + poff); } } while (0)
#define SWRITE(b) do { if constexpr (PV_F8) { *(u32x4*)(V_lds + (b) * SHM_V + vtst) = vt; } \
    else { *(bf16x8*)(V_lds + (b) * SHM_V + vst0) = vs0; *(bf16x8*)(V_lds + (b) * SHM_V + vst1) = vs1; } \
    *(u32x4*)(K_lds + (b) * SHM_K + kst) = ks; \
    if constexpr (DK == 192) { if (tid < 256) *(u32x4*)(K_lds + (b) * SHM_K + pst) = kp; } } while (0)
#define FIN8(P0, P1, AL, PF) do { _Pragma("unroll") for (int r = 0; r < 16; ++r) P1[r] = __builtin_amdgcn_exp2f(P1[r]); \
    _Pragma("unroll") for (int w_ = 0; w_ < 4; ++w_) {   \
      PF[w_] = __builtin_amdgcn_cvt_pk_fp8_f32(P0[4 * w_ + 2], P0[4 * w_ + 3], __builtin_amdgcn_cvt_pk_fp8_f32(P0[4 * w_], P0[4 * w_ + 1], 0, false), true); \
      PF[4 + w_] = __builtin_amdgcn_cvt_pk_fp8_f32(P1[4 * w_ + 2], P1[4 * w_ + 3], __builtin_amdgcn_cvt_pk_fp8_f32(P1[4 * w_], P1[4 * w_ + 1], 0, false), true); } } while (0)
#define PV8(VB, PF) do { _Pragma("unroll") for (int d0 = 0; d0 < 4; ++d0) { \
      const u32x4 vl_ = *(const u32x4*)((VB) + d0 * 2048 + vr0), vh_ = *(const u32x4*)((VB) + d0 * 2048 + vr1); \
      const i32x8 vf_ = {(int)vl_[0], (int)vl_[1], (int)vl_[2], (int)vl_[3], (int)vh_[0], (int)vh_[1], (int)vh_[2], (int)vh_[3]}; \
      o[d0] = __builtin_amdgcn_mfma_scale_f32_32x32x64_f8f6f4(PF, vf_, o[d0], 0, 0, 0, 0x7f7f7f7f, 0, 0x7f7f7f7f); } \
    lacc = __builtin_amdgcn_mfma_scale_f32_32x32x64_f8f6f4(PF, ones8, lacc, 0, 0, 0, 0x7f7f7f7f, 0, 0x7f7f7f7f); } while (0)
#define RESC(a) do { if (__any((a) < 1.f)) { if (hi == 0) al_l[r32] = (a); asm volatile("s_waitcnt lgkmcnt(0)" ::: "memory"); \
    for (int d = 0; d < 4; ++d) for (int r = 0; r < 16; ++r) o[d][r] *= al_l[crow(r, hi)]; \
    if constexpr (PV_F8) { for (int r = 0; r < 16; ++r) lacc[r] *= al_l[crow(r, hi)]; } } } while (0)
#define QKT8(P0, P1, KS) do { P0 = f32x16{}; P1 = f32x16{}; \
    _Pragma("unroll") for (int s = 0; s < NS; ++s) { \
      const u32x4 a0l = *(const u32x4*)((KS) + kq0[s]), a0h = *(const u32x4*)((KS) + kq1[s]), a1l = *(const u32x4*)((KS) + kq0[s] + 32 * KROW), a1h = *(const u32x4*)((KS) + kq1[s] + 32 * KROW); \
      const i32x8 a0 = {(int)a0l[0], (int)a0l[1], (int)a0l[2], (int)a0l[3], (int)a0h[0], (int)a0h[1], (int)a0h[2], (int)a0h[3]}; \
      const i32x8 a1 = {(int)a1l[0], (int)a1l[1], (int)a1l[2], (int)a1l[3], (int)a1h[0], (int)a1h[1], (int)a1h[2], (int)a1h[3]}; \
      P0 = __builtin_amdgcn_mfma_scale_f32_32x32x64_f8f6f4(a0, qr8[s], P0, 0, 0, 0, 0x7f7f7f7f, 0, 0x7f7f7f7f); \
      P1 = __builtin_amdgcn_mfma_scale_f32_32x32x64_f8f6f4(a1, qr8[s], P1, 0, 0, 0, 0x7f7f7f7f, 0, 0x7f7f7f7f); } } while (0)
  f32x16 pA0, pA1, pB0, pB1; float mnA, mnB, alA, alB; bf16x8 pa0, pa1, pa2, pa3; i32x8 pf8; const int NT = nkeys / 64;
#define FINISH(P0, P1, AL) do { if constexpr (PV_F8) { FIN8(P0, P1, AL, pf8); } else { finishSM(P0, P1, AL, l_reg, pa0, pa1, pa2, pa3); } } while (0)
#define PVMUL(BUF) do { if constexpr (PV_F8) { PV8(V_lds + (BUF) * SHM_V, pf8); } else { pv_d0(o, vb0 + (BUF) * SHM_V, pa0, pa1, pa2, pa3); } } while (0)
  constexpr float SM_SCALE = (DK == 192 ? 0.07216878364870322f : 0.08838834764831845f) / (F8_SQK * F8_SQK), SM_C = SM_SCALE * 1.4426950408889634f;
  i32x8 vfa, vfb;
#define VLD(VF, VB, d0) do { const u32x4 vl_ = *(const u32x4*)((VB) + (d0) * 2048 + vr0), vh_ = *(const u32x4*)((VB) + (d0) * 2048 + vr1); \
    VF = (i32x8){(int)vl_[0], (int)vl_[1], (int)vl_[2], (int)vl_[3], (int)vh_[0], (int)vh_[1], (int)vh_[2], (int)vh_[3]}; } while (0)
#define PVSM(BUF, P0, P1, MN, AL) do { const char* vb_ = V_lds + (BUF) * SHM_V; \
    VLD(vfb, vb_, 1); o[0] = __builtin_amdgcn_mfma_scale_f32_32x32x64_f8f6f4(pf8, vfa, o[0], 0, 0, 0, 0x7f7f7f7f, 0, 0x7f7f7f7f); \
    float pmax_ = P0[0]; _Pragma("unroll") for (int r = 1; r < 16; ++r) pmax_ = fmaxf(pmax_, P0[r]); _Pragma("unroll") for (int r = 0; r < 16; ++r) pmax_ = fmaxf(pmax_, P1[r]); \
    { auto rr_ = __builtin_amdgcn_permlane32_swap(__float_as_uint(pmax_), __float_as_uint(pmax_), false, false); pmax_ = fmaxf(__uint_as_float(rr_[0]), __uint_as_float(rr_[1])); } \
    MN = (pmax_ - m_reg > ATT_THR / SM_SCALE) ? pmax_ : m_reg; AL = __builtin_amdgcn_exp2f((m_reg - MN) * SM_C); m_reg = MN; \
    const float mnC_ = -MN * SM_C + 4.0f; SBAR(); \
    VLD(vfa, vb_, 2); o[1] = __builtin_amdgcn_mfma_scale_f32_32x32x64_f8f6f4(pf8, vfb, o[1], 0, 0, 0, 0x7f7f7f7f, 0, 0x7f7f7f7f); \
    _Pragma("unroll") for (int r = 0; r < 16; ++r) P0[r] = fmaf(P0[r], SM_C, mnC_); asm volatile("" : "+v"(P0)); SBAR(); \
    VLD(vfb, vb_, 3); o[2] = __builtin_amdgcn_mfma_scale_f32_32x32x64_f8f6f4(pf8, vfa, o[2], 0, 0, 0, 0x7f7f7f7f, 0, 0x7f7f7f7f); \
    _Pragma("unroll") for (int r = 0; r < 16; ++r) P1[r] = fmaf(P1[r], SM_C, mnC_); asm volatile("" : "+v"(P1)); SBAR(); \
    o[3] = __builtin_amdgcn_mfma_scale_f32_32x32x64_f8f6f4(pf8, vfb, o[3], 0, 0, 0, 0x7f7f7f7f, 0, 0x7f7f7f7f); \
    _Pragma("unroll") for (int r = 0; r < 8; ++r) P0[r] = __builtin_amdgcn_exp2f(P0[r]); asm volatile("" : "+v"(P0)); SBAR(); \
    lacc = __builtin_amdgcn_mfma_scale_f32_32x32x64_f8f6f4(pf8, ones8, lacc, 0, 0, 0, 0x7f7f7f7f, 0, 0x7f7f7f7f); \
    _Pragma("unroll") for (int r = 8; r < 16; ++r) P0[r] = __builtin_amdgcn_exp2f(P0[r]); asm volatile("" : "+v"(P0)); SBAR(); } while (0)
  SLOAD(0); SWRITE(0); SLOAD(64); __syncthreads();
  QKT8(pA0, pA1, K_lds); partialSM<DK>(pA0, pA1, m_reg, mnA, alA);
  SWRITE(1); if (2 < NT) SLOAD(128); __syncthreads();
  int sq = 1, sv = 0, sw = 2;
#define RING_NEXT() do { sv = sq; sq = sw; sw = sw == 2 ? 0 : sw + 1; } while (0)
  for (int j = 1; j + 1 < NT; j += 2) {
    SBAR(); QKT8(pB0, pB1, K_lds + sq * SHM_K);
    FINISH(pA0, pA1, alA); if constexpr (PV_F8) VLD(vfa, V_lds + sv * SHM_V, 0); SBAR();
    if constexpr (PV_F8) { PVSM(sv, pB0, pB1, mnB, alB); } else { PVMUL(sv); partialSM<DK>(pB0, pB1, m_reg, mnB, alB); }
    RESC(alB);
    SWRITE(sw); if (j + 2 < NT) SLOAD((j + 2) * 64);
    __syncthreads(); RING_NEXT();
    SBAR(); QKT8(pA0, pA1, K_lds + sq * SHM_K);
    FINISH(pB0, pB1, alB); if constexpr (PV_F8) VLD(vfa, V_lds + sv * SHM_V, 0); SBAR();
    if constexpr (PV_F8) { PVSM(sv, pA0, pA1, mnA, alA); } else { PVMUL(sv); partialSM<DK>(pA0, pA1, m_reg, mnA, alA); }
    RESC(alA);
    SWRITE(sw); if (j + 3 < NT) SLOAD((j + 3) * 64);
    __syncthreads(); RING_NEXT();
  }
  SBAR(); QKT8(pB0, pB1, K_lds + sq * SHM_K);
  FINISH(pA0, pA1, alA); SBAR();
  PVMUL(sv); partialSM<DK>(pB0, pB1, m_reg, mnB, alB);
  RESC(alB);
  FINISH(pB0, pB1, alB); SBAR();
  PVMUL(sq);
#undef RING_NEXT
  float rli[16];
  if constexpr (PV_F8) {
#pragma unroll
    for (int r = 0; r < 16; ++r) rli[r] = __builtin_amdgcn_rcpf(lacc[r]) * (1.0f / F8_SV);
  } else {
    if (hi == 0) li_l[r32] = l_reg; asm volatile("s_waitcnt lgkmcnt(0)" ::: "memory");
#pragma unroll
    for (int r = 0; r < 16; ++r) rli[r] = __builtin_amdgcn_rcpf(li_l[crow(r, hi)]);
  }
  __syncthreads();
  if (WO_F8) {
    unsigned char* st = (unsigned char*)lds + wid * 4096;
#pragma unroll
    for (int r = 0; r < 16; ++r) { const int orow = crow(r, hi); const float s = rli[r] * F8_SO;
#pragma unroll
      for (int d0 = 0; d0 < 4; ++d0) st[orow * 128 + d0 * 32 + r32] = (unsigned char)(__builtin_amdgcn_cvt_pk_fp8_f32(fminf(fmaxf(o[d0][r] * s, -448.f), 448.f), 0.f, 0, false) & 0xff); }
    asm volatile("s_waitcnt lgkmcnt(0)" ::: "memory");
    unsigned char* Ow8 = (unsigned char*)Ob + (size_t)(wid * 32) * ldo;
#pragma unroll
    for (int ps = 0; ps < 4; ++ps) { const int row = ps * 8 + (lane >> 3), ch = (lane & 7) * 16;
      *(u32x4*)(Ow8 + (size_t)row * ldo + ch) = *(const u32x4*)(st + row * 128 + ch); }
  } else {
    bf16_t* Ow = Ob + (size_t)(wid * 32) * ldo;
#pragma unroll
    for (int r = 0; r < 16; ++r) { const int orow = crow(r, hi);
#pragma unroll
      for (int d0 = 0; d0 < 4; ++d0) Ow[(size_t)orow * ldo + d0 * 32 + r32] = (bf16_t)(cvtpk(o[d0][r] * rli[r], 0.f) & 0xffffu); }
  }
  __syncthreads();
#undef SLOAD
#undef GLD16
#undef SWRITE
#undef RESC
#undef QKT8
#undef KPERM
#undef FIN8
#undef PV8
#undef FINISH
#undef PVMUL
#undef PVSM
#undef VLD
}


template <int HK, int LDV>
__device__ __forceinline__ void phase_vt8(const Params& p, const bf16_t* Vbase  , int hstride, char* lds) {
  int tid = threadIdx.x; asm volatile("" : "+v"(tid));
  const int wid = tid >> 6, lane = tid & 63;
  const int gw = blockIdx.x * 8 + wid, nw = gridDim.x * 8;
  char* ws = opaque_ptr(p.ws);
  unsigned char* lw = (unsigned char*)lds + wid * 4096;
  unsigned char* VT = (unsigned char*)(ws + WS_Y);
  constexpr int NKT = RPB / 64;
  for (int t = gw; t < NB * HK * NKT * 2; t += nw) {
    const int ch = t & 1, kt = (t >> 1) % NKT, bh = (t >> 1) / NKT, b = bh / HK, h = bh % HK;
    const bf16_t* src = Vbase + (size_t)(b * RPB + kt * 64 + lane) * LDV + h * hstride + ch * 64;
    u32x4 w[8];
#pragma unroll
    for (int i = 0; i < 8; ++i) w[i] = *(const u32x4*)(src + i * 8);
#pragma unroll
    for (int i = 0; i < 8; ++i)
#pragma unroll
      for (int e = 0; e < 4; ++e) { const int c = i * 8 + 2 * e;
        lw[c * 64 + lane] = (unsigned char)(__builtin_amdgcn_cvt_pk_fp8_f32(fminf(fmaxf(bflo(w[i][e]) * F8_SV, -448.f), 448.f), 0.f, 0, false) & 0xff);
        lw[(c + 1) * 64 + lane] = (unsigned char)(__builtin_amdgcn_cvt_pk_fp8_f32(fminf(fmaxf(bfhi(w[i][e]) * F8_SV, -448.f), 448.f), 0.f, 0, false) & 0xff); }
    unsigned char* dst = VT + ((size_t)bh * 128 + ch * 64 + lane) * RPB + kt * 64;
#pragma unroll
    for (int i = 0; i < 4; ++i) *(u32x4*)(dst + i * 16) = *(const u32x4*)(lw + lane * 64 + i * 16);
  }
}

__device__ __forceinline__ void phase_attn_mla(const Params& p, bool ctx_out, char* lds) {
  char* ws = opaque_ptr(p.ws);
  const bf16_t* Q = (const bf16_t*)(ws + WS_Q); const bf16_t* KV = (const bf16_t*)(ws + WS_KV); const bf16_t* KPE = (const bf16_t*)(ws + WS_KPE); bf16_t* O = (bf16_t*)(ws + WS_O);
  const int x = blockIdx.x & 7, nloc = gridDim.x >> 3, nlat = NB * MLA_H * 2  , nctx = ctx_out ? 4 : 0;
  for (int lu = (blockIdx.x >> 3); lu < nlat + nctx; lu += nloc) {
    int b, h, q0, nkeys; bool rope;
    if (lu < nlat) { const int pair = x * 4 + (lu >> 4), qb = lu & 15; b = pair / MLA_H; h = pair % MLA_H; q0 = CTX + qb * 256; nkeys = RPB; rope = true; }
    else { const int pair = x * 4 + (lu - nlat); b = pair / MLA_H; h = pair % MLA_H; q0 = 0; nkeys = CTX; rope = false; }
    const size_t rb = (size_t)b * RPB;
    if (QK_F8) attn_unit8<192, 1536, 2048, 1024>(Q + (rb + q0) * 1536 + h * 192, (const unsigned char*)(ws + WS_K8) + rb * 1024 + h * 128, (const unsigned char*)(ws + WS_KPE8) + rb * ROPE,
                   PV_F8 ? (const bf16_t*)((const unsigned char*)(ws + WS_Y) + (size_t)(b * MLA_H + h) * 128 * RPB) : KV + rb * 2048 + h * 256 + 128,
                   WO_F8 ? (bf16_t*)((unsigned char*)O + (rb + q0) * 1024 + h * 128) : O + (rb + q0) * 1024 + h * 128, nkeys, rope, q0 - CTX, nullptr, lds);
    else attn_unit<192, 1536, 2048, 2048, 1024>(Q + (rb + q0) * 1536 + h * 192, KV + rb * 2048 + h * 256, KPE + rb * ROPE, KV + rb * 2048 + h * 256 + 128,
                   WO_F8 ? (bf16_t*)((unsigned char*)O + (rb + q0) * 1024 + h * 128) : O + (rb + q0) * 1024 + h * 128, nkeys, rope, q0 - CTX, nullptr, lds);
  }
}
__device__ __forceinline__ void phase_attn_gqa(const Params& p, char* lds) {
  char* ws = opaque_ptr(p.ws);
  const bf16_t* QKV = (const bf16_t*)(ws + WS_QKV); const bf16_t* KN = (const bf16_t*)(ws + WS_KN); bf16_t* O = (bf16_t*)(ws + WS_OG);
  const int x = blockIdx.x & 7, nloc = gridDim.x >> 3, nlat = 128, nctx = 8;
  for (int lu = (blockIdx.x >> 3); lu < nlat + nctx; lu += nloc) {
    int b, h, q0, nkeys; bool rope;
    if (lu < nlat) { const int pair = x * 8 + (lu >> 4), qb = lu & 15; b = pair / GH; h = pair % GH; q0 = CTX + qb * 256; nkeys = RPB; rope = true; }
    else { const int pair = x * 8 + (lu - nlat); b = pair / GH; h = pair % GH; q0 = 0; nkeys = CTX; rope = false; }
    const size_t rb = (size_t)b * RPB; const int kvh = h >> 1;
    if (QK_F8) attn_unit8<128, 4096, 4096, 2048>(QKV + (rb + q0) * 4096 + h * 128, (const unsigned char*)(ws + WS_KN) + rb * 1024 + kvh * 128, nullptr,
                   PV_F8 ? (const bf16_t*)((const unsigned char*)(ws + WS_Y) + (size_t)(b * GKV + kvh) * 128 * RPB) : QKV + rb * 4096 + 3072 + kvh * 128,
                   WO_F8 ? (bf16_t*)((unsigned char*)O + (rb + q0) * 2048 + h * 128) : O + (rb + q0) * 2048 + h * 128, nkeys, rope, q0 - CTX, p.in[I_GQA_QG], lds);
    else attn_unit<128, 4096, 1024, 4096, 2048>(QKV + (rb + q0) * 4096 + h * 128, KN + rb * 1024 + kvh * 128, nullptr, QKV + rb * 4096 + 3072 + kvh * 128,
                   WO_F8 ? (bf16_t*)((unsigned char*)O + (rb + q0) * 2048 + h * 128) : O + (rb + q0) * 2048 + h * 128, nkeys, rope, q0 - CTX, p.in[I_GQA_QG], lds);
  }
}


__device__ __forceinline__ void dbg_probe(const Params& p) {
  char* ws = opaque_ptr(p.ws);
  size_t off = 0, n = 0; bool is_bf = true;
  switch (DBG_PROBE) {
    case 1: off = WS_MODV; n = (size_t)4 * 5 * NMOD; is_bf = false; break;
    case 2: off = WS_ACT; n = (size_t)R * D; break;
    case 3: off = WS_C1; n = (size_t)R * 1024; is_bf = false; break;
    case 4: off = WS_CQ; n = (size_t)R * 512; break;
    case 5: off = WS_CKV; n = (size_t)R * 256; break;
    case 6: off = WS_KPE; n = (size_t)R * 64; break;
    case 7: off = WS_Q; n = (size_t)R * 1536; break;
    case 8: off = WS_KV; n = (size_t)R * 2048; break;
    case 9: off = WS_O; n = (size_t)R * 1024; break;
    case 10: off = WS_X32; n = (size_t)R * D; is_bf = XBF16; break;
    case 11: off = WS_WMLA; n = MLA_WBYTES / 2; break;
    default: break;
  }
  int bad = 0;
  for (size_t i = (size_t)blockIdx.x * NTHR + threadIdx.x; i < n; i += (size_t)gridDim.x * NTHR) {
    float v = is_bf ? bf2f(((const bf16_t*)(ws + off))[i]) : ((const float*)(ws + off))[i];
    if (!(fabsf(v) < 1e30f)) bad = 1;
  }
  if (bad) atomicOr((int*)(ws + WS_CNT) + 1000, 1);
}

constexpr int DYN_LDS = 143360;
extern __shared__ __attribute__((aligned(16))) char smem[];

__global__ void __launch_bounds__(NTHR, 2) fwd_megakernel(Params p) {
  cg::grid_group grid = cg::this_grid();
  char* lds = smem;
#define WSO() char* ws = opaque_ptr(p.ws)
  volatile LAS unsigned* xst = (volatile LAS unsigned*)(LAS char*)(smem + DYN_LDS - 16);
  if (threadIdx.x == 0) { xst[0] = 0u; xst[1] = 0u; }
  __syncthreads();
  const XcdBarrier xb = xcd_barrier_post((unsigned*)(p.ws + WS_BAR), xst);
#if DBG_TIME
  unsigned long long tc_prep = 0, tc_norm = 0, tc_gemm = 0, tc_mid = 0, tc_amla = 0, tc_agqa = 0, tc_moe1 = 0, tc_moe2 = 0, tc_sync = 0, tA, tB, tC;
#define PH(cat, ...) do { tA = __builtin_amdgcn_s_memrealtime(); __VA_ARGS__; tB = __builtin_amdgcn_s_memrealtime(); xcd_barrier(xb); tC = __builtin_amdgcn_s_memrealtime(); \
    tc_##cat += tC - tA; tc_sync += tC - tB; } while (0)
#else
#define PH(cat, ...) do { __VA_ARGS__; xcd_barrier(xb); } while (0)
#endif
#define PHD(cat, id, ...) do { PH(cat, __VA_ARGS__); if (DUP == id) PH(cat, __VA_ARGS__); } while (0)
#define PHR(...) do { if (DUP == 15) { xres_t* const DRYP = (xres_t*)(p.ws + WS_Y); PH(gemm, __VA_ARGS__); } \
    { xres_t* const DRYP = nullptr; __VA_ARGS__; xcd_barrier_arrive(xb); norm1_prologue(p, layer, lds); xcd_barrier_wait(xb); } } while (0)
#if DBG_TIME
  tA = __builtin_amdgcn_s_memrealtime();
#endif
#pragma unroll 1
  for (int rep_ = 0; rep_ < (DUP == 18 ? 2 : 1); ++rep_) {
  if (rep_ == 1) xcd_barrier(xb);
  if (DBG_PROBE == 20 && threadIdx.x == 0) ((int*)(p.ws + WS_CNT))[1024 + blockIdx.x] = (int)xb.x;
  phase_prep(p, lds);
  if (p.out == nullptr) grid.sync();
  xcd_barrier(xb);
#if DBG_TIME
  tc_prep += __builtin_amdgcn_s_memrealtime() - tA;
#endif
  if (DUP == 12) { xcd_barrier(xb); phase_prep(p, lds); xcd_barrier(xb); }
  if (DBG_PROBE == 20 && blockIdx.x == 0 && threadIdx.x == 0) { const int* t = (const int*)(p.ws + WS_CNT) + 1024; int bad = 0, seen = 0;
    for (int i = 0; i < (int)gridDim.x; ++i) { if (t[i] != t[i & 7]) bad = 1; }
    for (int i = 0; i < 8; ++i) seen |= 1 << t[i];
    if (bad || seen != 0xff) ((int*)(p.ws + WS_CNT))[1000] = 1; }
  PH(prep, phase_modfin(p));
  if (DUP == 14) { for (int q = 0; q < 40; ++q) xcd_barrier(xb); }
  if (STOP_AFTER == 0) { phase_norm<2, false>(p, 0); return; }
#pragma unroll 1
  for (int layer = 0; layer < DEPTH; ++layer) {
    const int kind = layer % 3, j = layer / 3; const bool ctx_out = layer < DEPTH - 1;
    if (DUP == 17 && layer > 0) PH(norm, phase_norm<0, true, true>(p, layer));
    PH(norm, if (layer == 0) phase_norm<0, false>(p, layer); else phase_norm<0, true>(p, layer));
    if (DUP == 13 && layer == 0) { for (int q = 0; q < 4; ++q) PH(norm, phase_norm<0, false>(p, layer)); }
    if (kind == 0) {
      PHD(gemm, 1, { WSO(); const char* wb = ws + WS_WMLA + j * MLA_WBYTES;
        if (MIX_F8) gemm_dense<17, 2, false, EpiBf16, 0, true>((const bf16_t*)(ws + WS_ACT), D / 2, (const bf16_t*)(wb + MLA_W1T), 1024, D / 2, EpiBf16{(bf16_t*)(ws + WS_C1), 1024, 1.0f / 512.0f}, lds);
        else gemm_dense<17, 2, false>((const bf16_t*)(ws + WS_ACT), D, (const bf16_t*)(wb + MLA_W1T), 1024, D, EpiBf16{(bf16_t*)(ws + WS_C1), 1024}, lds); });
      PHD(mid, 2, phase_mla_mid(p, j));
      PHD(gemm, 3, { WSO(); const char* wb = ws + WS_WMLA + j * MLA_WBYTES;
        MlaUpProv<(MIX_F8 != 0)> pv{(const bf16_t*)(ws + WS_CQ), (const bf16_t*)(ws + WS_CKV), (const bf16_t*)(wb + MLA_WUQT), (const bf16_t*)(wb + MLA_WUKVT), (bf16_t*)(ws + WS_Q), (bf16_t*)(ws + WS_KV), (unsigned char*)(ws + WS_K8)};
        gemm_stream<17, MlaUpProv<(MIX_F8 != 0)>, 0, (MIX_F8 != 0)>(pv, lds); });
      if (QK_F8 && PV_F8) PH(mid, { WSO(); phase_vt8<MLA_H, 2048>(p, (const bf16_t*)(ws + WS_KV) + 128, 256, lds); });
      PHD(amla, 4, phase_attn_mla(p, ctx_out, lds));
      PHR({ WSO(); const char* wb = ws + WS_WMLA + j * MLA_WBYTES;
        const EpiResid er{(xres_t*)(ws + WS_X32), (const float*)(ws + WS_MODV) + (size_t)layer * 5 * NMOD + 2 * D, DRYP, WO_F8 ? 1.0f / (F8_SO * F8_SW) : 1.0f};
        if (WO_F8) { if (ctx_out) gemm_dense<17, 2, false, EpiResid, 0, true>((const bf16_t*)(ws + WS_O), 512, (const bf16_t*)(wb + MLA_WOT), D, 512, er, lds);
          else gemm_dense<16, 2, true, EpiResid, 0, true>((const bf16_t*)(ws + WS_O), 512, (const bf16_t*)(wb + MLA_WOT), D, 512, er, lds); }
        else { if (ctx_out) gemm_dense<17, 2, false>((const bf16_t*)(ws + WS_O), 1024, (const bf16_t*)(wb + MLA_WOT), D, 1024, er, lds);
          else gemm_dense<16, 2, true>((const bf16_t*)(ws + WS_O), 1024, (const bf16_t*)(wb + MLA_WOT), D, 1024, er, lds); } });
    } else if (kind == 1) {
      PHD(gemm, 5, { WSO(); gemm_dense<17, 2, false>((const bf16_t*)(ws + WS_ACT), D, (const bf16_t*)(ws + WS_WCONV_IN), 3072, D, EpiBf16{(bf16_t*)(ws + WS_BCU), 3072}, lds); });
      if (DUP == 21) PH(gemm, { WSO(); gemm_dense<17, 2, false, EpiBf16, 1>((const bf16_t*)(ws + WS_ACT), D, (const bf16_t*)(ws + WS_WCONV_IN), 3072, D, EpiBf16{(bf16_t*)(ws + WS_G + (size_t)R * 1024 * 2), 3072}, lds); });
      if (DUP == 22) PH(gemm, { WSO(); gemm_dense<17, 2, false, EpiBf16, 2>((const bf16_t*)(ws + WS_ACT), D, (const bf16_t*)(ws + WS_WCONV_IN), 3072, D, EpiBf16{(bf16_t*)(ws + WS_G + (size_t)R * 1024 * 2), 3072}, lds); });
      if (DUP == 23) PH(gemm, { WSO(); gemm_dense<17, 2, false, EpiBf16, 0>((const bf16_t*)(ws + WS_ACT), D, (const bf16_t*)(ws + WS_WCONV_IN), 3072, D, EpiBf16{(bf16_t*)(ws + WS_G + (size_t)R * 1024 * 2), 3072}, lds); });
      PHD(mid, 6, phase_conv_mid(p));
      PHR({ WSO(); gemm_dense<17, 2, false>((const bf16_t*)(ws + WS_G), D, (const bf16_t*)(ws + WS_WCONV_OUT), D, D,
                                EpiResid{(xres_t*)(ws + WS_X32), (const float*)(ws + WS_MODV) + (size_t)layer * 5 * NMOD + 2 * D, DRYP}, lds); });
    } else {
      PHD(gemm, 7, { WSO(); if (MIX_F8) gemm_dense<17, 2, false, EpiBf16, 0, true>((const bf16_t*)(ws + WS_ACT), D / 2, (const bf16_t*)(ws + WS_WGQA_QKV), 4096, D / 2, EpiBf16{(bf16_t*)(ws + WS_QKV), 4096, 1.0f / 512.0f}, lds);
        else gemm_dense<17, 2, false>((const bf16_t*)(ws + WS_ACT), D, (const bf16_t*)(ws + WS_WGQA_QKV), 4096, D, EpiBf16{(bf16_t*)(ws + WS_QKV), 4096}, lds); });
      if (QK_F8 && PV_F8 && DUP != 8) PH(mid, { WSO(); phase_gqa_k(p); phase_vt8<GKV, 4096>(p, (const bf16_t*)(ws + WS_QKV) + 3072, 128, lds); });
      else { PHD(mid, 8, phase_gqa_k(p));
        if (QK_F8 && PV_F8) PH(mid, { WSO(); phase_vt8<GKV, 4096>(p, (const bf16_t*)(ws + WS_QKV) + 3072, 128, lds); }); }
      PHD(agqa, 9, phase_attn_gqa(p, lds));
      PHR({ WSO(); if (WO_F8) gemm_dense<17, 2, false, EpiResid, 0, true>((const bf16_t*)(ws + WS_OG), 1024, (const bf16_t*)(ws + WS_WGQA_O), D, 1024,
                                EpiResid{(xres_t*)(ws + WS_X32), (const float*)(ws + WS_MODV) + (size_t)layer * 5 * NMOD + 2 * D, DRYP, 1.0f / (F8_SO * F8_SW)}, lds);
        else gemm_dense<17, 2, false>((const bf16_t*)(ws + WS_OG), 2048, (const bf16_t*)(ws + WS_WGQA_O), D, 2048,
                                EpiResid{(xres_t*)(ws + WS_X32), (const float*)(ws + WS_MODV) + (size_t)layer * 5 * NMOD + 2 * D, DRYP}, lds); });
    }
    if (STOP_AFTER == 2 * layer + 1) { if (DBG_PROBE) { dbg_probe(p); xcd_barrier(xb); } phase_norm<2, false>(p, 0); return; }
    if (DUP == 16) PH(norm, phase_norm<1, false, true>(p, layer));
    PH(norm, phase_norm<1, false, false, true>(p, layer, lds));
    PHD(moe1, 10, phase_moe<false>(p, layer, lds));
    PHD(moe2, 11, phase_moe<true>(p, layer, lds));
    if (STOP_AFTER == 2 * layer + 2) break;
  }
  }
#if DBG_TIME
  if (blockIdx.x == 0 && threadIdx.x == 0) {
    unsigned long long* d = (unsigned long long*)(p.ws + WS_CNT + 4096);
    d[0] = tc_prep; d[1] = tc_norm; d[2] = tc_gemm; d[3] = tc_mid; d[4] = tc_amla; d[5] = tc_agqa; d[6] = tc_moe1; d[7] = tc_moe2; d[8] = tc_sync;
  }
  xcd_barrier(xb);
#endif
  phase_norm<2, true>(p, 0);
}

extern "C" void kernel_launch(void* const* d_in, const int* in_sizes, int n_in, void* d_out, int out_size, void* d_ws, size_t ws_size,
                              hipStream_t stream) {
  static int grid_blocks = 0;
  if (!grid_blocks) {
    int dev = 0, cus = 0, per_cu = 0;
    (void)hipGetDevice(&dev);
    (void)hipDeviceGetAttribute(&cus, hipDeviceAttributeMultiprocessorCount, dev);
    (void)hipFuncSetAttribute((const void*)fwd_megakernel, hipFuncAttributeMaxDynamicSharedMemorySize, DYN_LDS);
    (void)hipOccupancyMaxActiveBlocksPerMultiprocessor(&per_cu, fwd_megakernel, NTHR, DYN_LDS);
    grid_blocks = per_cu >= 1 ? cus : 0;
    if (ws_size < WS_END || n_in != N_IN) { fprintf(stderr, "kernel_launch: ws %zu < %zu or n_in %d\n", ws_size, (size_t)WS_END, n_in); grid_blocks = 0; }
    if (!grid_blocks) { fprintf(stderr, "kernel_launch: cannot launch (per_cu %d)\n", per_cu); return; }
  }
  Params p{};
  for (int i = 0; i < N_IN; ++i) p.in[i] = (const float*)d_in[i];
  p.out = (float*)d_out; p.ws = (char*)d_ws;
  {
    char* ws = p.ws; int nj = 0;
    for (int j = 0; j < 2; ++j) {
      char* wb = ws + WS_WMLA + j * MLA_WBYTES;
      p.jobs[nj++] = TJob{p.in[I_MLA_WDQ] + (size_t)j * D * QL, (bf16_t*)(wb + MLA_W1T), D, QL, MIX_F8 ? 8 : 1, 0};
      p.jobs[nj++] = TJob{p.in[I_MLA_WDKV] + (size_t)j * D * 320, (bf16_t*)(wb + MLA_W1T), D, 320, MIX_F8 ? 8 : 1, 512};
      p.jobs[nj++] = TJob{p.in[I_MLA_WUQ] + (size_t)j * QL * 1536, (bf16_t*)(wb + MLA_WUQT), QL, 1536, MIX_F8 ? 8 : 1, 0};
      p.jobs[nj++] = TJob{p.in[I_MLA_WUKV] + (size_t)j * KVL * 2048, (bf16_t*)(wb + MLA_WUKVT), KVL, 2048, MIX_F8 ? 8 : 1, 0};
      p.jobs[nj++] = TJob{p.in[I_MLA_WO] + (size_t)j * 1024 * D, (bf16_t*)(wb + MLA_WOT), 1024, D, WO_F8 ? 8 : 1, 0};
    }
    p.jobs[nj++] = TJob{p.in[I_CONV_WIN], (bf16_t*)(ws + WS_WCONV_IN), D, 3072, 1, 0};
    p.jobs[nj++] = TJob{p.in[I_CONV_WOUT], (bf16_t*)(ws + WS_WCONV_OUT), D, D, 1, 0};
    p.jobs[nj++] = TJob{p.in[I_GQA_WQKV], (bf16_t*)(ws + WS_WGQA_QKV), D, 4096, MIX_F8 ? 8 : 1, 0};
    p.jobs[nj++] = TJob{p.in[I_GQA_WO], (bf16_t*)(ws + WS_WGQA_O), 2048, D, WO_F8 ? 8 : 1, 0};
  }
  (void)hipMemsetAsync((char*)d_ws + WS_BAR, 0, XCD_BAR_WORDS * 4, stream);
  void* args[] = {&p};
  hipError_t e = hipLaunchCooperativeKernel((void*)fwd_megakernel, dim3(grid_blocks), dim3(NTHR), args, DYN_LDS, stream);
  if (e != hipSuccess) fprintf(stderr, "cooperative launch failed: %s (grid %d)\n", hipGetErrorString(e), grid_blocks);
}
```
